# Optimizing an MI355X kernel written in HIP

```python
import math
import jax, jax.numpy as jnp
from jax import lax
import numpy as np

D_MODEL = 1024
BATCH = 4
SEQ = 4096
DEPTH = 1

NSA_HEADS = 8
NSA_KV_HEADS = 2
HEAD_DIM = 64
NSA_WIDTH = NSA_HEADS * HEAD_DIM
KV_WIDTH = NSA_KV_HEADS * HEAD_DIM
POOL_WIDTH = D_MODEL - NSA_WIDTH
POOL_GROUPS = 4
POOL_GROUP_DIM = POOL_WIDTH // POOL_GROUPS
POOL_WINDOWS = (2, 4, 8, 16)
N_GATES = 3 * NSA_HEADS
IN_WIDTH = NSA_WIDTH + 6 * KV_WIDTH + N_GATES + POOL_WIDTH
CMP_BLOCK = 32
CMP_STRIDE = 16
CMP_HIDDEN = 256
SLC_BLOCK = 64
SLC_COUNT = 16
WINDOW = 512
Q_BLOCK = 128
NEG = -1e30
FORCE = 1e6
N_BUCKETS = 32
MAX_DISTANCE = 128
PEER_HEADS = 8
PEER_KEYS = 128
PEER_EXPERTS = PEER_KEYS * PEER_KEYS
PEER_QDIM = 256
PEER_TOPK = 16
TOKEN_CHUNK = 128
ALPHA = (2 * DEPTH) ** 0.25
BETA = (8 * DEPTH) ** -0.25
LN_EPS = 1e-5

kernel_name = "nsa_pool_peer_hybrid_deepnorm"


def layer_norm(x, g, b):
    xf = x.astype(jnp.float32)
    mu = jnp.mean(xf, axis=-1, keepdims=True)
    var = jnp.mean(jnp.square(xf - mu), axis=-1, keepdims=True)
    return ((xf - mu) * lax.rsqrt(var + LN_EPS)).astype(x.dtype) * g + b


def rel_bucket(dist):
    dist = jnp.maximum(dist, 0)
    max_exact = N_BUCKETS // 2
    large = max_exact + (jnp.log(jnp.maximum(dist, 1).astype(jnp.float32) / max_exact)
                         / math.log(MAX_DISTANCE / max_exact)
                         * (N_BUCKETS - max_exact)).astype(jnp.int32)
    large = jnp.minimum(large, N_BUCKETS - 1)
    return jnp.where(dist < max_exact, dist, large)


def compress(k_raw, pe, w1, w2):
    B, T, G, dh = k_raw.shape
    n_cmp = (T - CMP_BLOCK) // CMP_STRIDE + 1
    idx = jnp.arange(n_cmp)[:, None] * CMP_STRIDE + jnp.arange(CMP_BLOCK)[None, :]
    blocks = k_raw[:, idx] + pe[None, None, :, None, :]
    flat = blocks.transpose(0, 3, 1, 2, 4).reshape(B, G, n_cmp, CMP_BLOCK * dh)
    return jax.nn.gelu(flat @ w1, approximate=False) @ w2


def nsa_attention(q, k_cmp, v_cmp, k_slc, v_slc, k_win, v_win, rel_table):
    B, G, R, T, dh = q.shape
    n_cmp = k_cmp.shape[2]
    n_slc = T // SLC_BLOCK
    k_sel = min(SLC_COUNT, n_slc)
    scale = dh ** -0.5
    cmp_start = jnp.arange(n_cmp) * CMP_STRIDE
    cmp_end = cmp_start + CMP_BLOCK - 1
    slc_start = jnp.arange(n_slc) * SLC_BLOCK
    overlap = ((cmp_start[:, None] <= slc_start[None, :] + SLC_BLOCK - 1)
               & (cmp_end[:, None] >= slc_start[None, :])).astype(jnp.float32)
    pad_k = jnp.pad(k_win, ((0, 0), (0, 0), (WINDOW, 0), (0, 0)))
    pad_v = jnp.pad(v_win, ((0, 0), (0, 0), (WINDOW, 0), (0, 0)))
    tab_g = rel_table.reshape(N_BUCKETS, G, R).transpose(1, 0, 2)
    g_idx = jnp.arange(G)[None, :, None, None]
    b_idx = jnp.arange(B)[:, None, None, None]
    j_idx = jnp.arange(n_slc)
    n_win = Q_BLOCK + WINDOW

    def head_bias(bucket):
        bias = rel_table[bucket]
        return bias.reshape(bucket.shape + (G, R)).transpose(2, 3, 0, 1).astype(jnp.float32)

    def block(qb):
        q0 = qb * Q_BLOCK
        qblk = lax.dynamic_slice_in_dim(q, q0, Q_BLOCK, axis=3)
        t = q0 + jnp.arange(Q_BLOCK)
        s = jnp.einsum('bgrqd,bgnd->bgrqn', qblk, k_cmp).astype(jnp.float32) * scale
        s = s + head_bias(rel_bucket(t[:, None] - cmp_end[None, :]))
        valid = cmp_end[None, :] <= t[:, None]
        p_cmp = jax.nn.softmax(jnp.where(valid, s, NEG), axis=-1) * valid
        o_cmp = jnp.einsum('bgrqn,bgnd->bgrqd', p_cmp.astype(v_cmp.dtype), v_cmp)
        imp = jnp.einsum('bgrqn,nj->bgqj', p_cmp, overlap)
        cur = t // SLC_BLOCK
        forced = (j_idx[None, :] == 0) | (j_idx[None, :] == cur[:, None]) | (j_idx[None, :] == cur[:, None] - 1)
        imp = jnp.where(forced, FORCE, imp)
        imp = jnp.where(slc_start[None, :] <= t[:, None], imp, NEG)
        _, sel = lax.top_k(imp, k_sel)
        pos = (sel[..., None] * SLC_BLOCK + jnp.arange(SLC_BLOCK)).reshape(B, G, Q_BLOCK, k_sel * SLC_BLOCK)
        ks = k_slc[b_idx, g_idx, pos]
        vs = v_slc[b_idx, g_idx, pos]
        s = jnp.einsum('bgrqd,bgqkd->bgrqk', qblk, ks).astype(jnp.float32) * scale
        bias = tab_g[g_idx, rel_bucket(t[None, None, :, None] - pos)]
        s = s + jnp.moveaxis(bias, -1, 2).astype(jnp.float32)
        valid = (pos <= t[None, None, :, None])[:, :, None]
        p_slc = jax.nn.softmax(jnp.where(valid, s, NEG), axis=-1)
        o_slc = jnp.einsum('bgrqk,bgqkd->bgrqd', p_slc.astype(vs.dtype), vs)
        kw = lax.dynamic_slice_in_dim(pad_k, q0, n_win, axis=2)
        vw = lax.dynamic_slice_in_dim(pad_v, q0, n_win, axis=2)
        kpos = q0 - WINDOW + jnp.arange(n_win)
        dist = t[:, None] - kpos[None, :]
        s = jnp.einsum('bgrqd,bgkd->bgrqk', qblk, kw).astype(jnp.float32) * scale
        s = s + head_bias(rel_bucket(dist))
        valid = (dist >= 0) & (dist < WINDOW) & (kpos[None, :] >= 0)
        p_win = jax.nn.softmax(jnp.where(valid, s, NEG), axis=-1)
        o_win = jnp.einsum('bgrqk,bgkd->bgrqd', p_win.astype(vw.dtype), vw)
        return o_cmp, o_slc, o_win

    outs = lax.map(block, jnp.arange(T // Q_BLOCK))
    def to_bthd(o):
        return o.transpose(1, 0, 4, 2, 3, 5).reshape(B, T, G * R, dh)
    return to_bthd(outs[0]), to_bthd(outs[1]), to_bthd(outs[2])


def pool_mixer(z, w, scale):
    B, T, _ = z.shape
    zf = z.astype(jnp.float32).reshape(B, T, POOL_GROUPS, POOL_GROUP_DIM)
    c = jnp.pad(jnp.cumsum(zf, axis=1), ((0, 0), (1, 0), (0, 0), (0, 0)))
    t = jnp.arange(T)
    outs = []
    for gi, win in enumerate(POOL_WINDOWS):
        lo = jnp.maximum(t + 1 - win, 0)
        s = c[:, 1:, gi] - c[:, lo, gi]
        cnt = (t + 1 - lo).astype(jnp.float32)
        outs.append(s / cnt[None, :, None] - zf[:, :, gi])
    y = jnp.stack(outs, axis=2).astype(z.dtype)
    y = jnp.einsum('btgc,gcd->btgd', y, w).reshape(B, T, POOL_WIDTH)
    return y * scale


def peer(h, wq, subkeys, u, v):
    B, T, D = h.shape
    n = B * T
    xf = h.reshape(n, D)
    q = (xf @ wq).reshape(n, PEER_HEADS, 2, PEER_QDIM // 2)
    s1 = jnp.einsum('nhd,kd->nhk', q[:, :, 0], subkeys[0]).astype(jnp.float32)
    s2 = jnp.einsum('nhd,kd->nhk', q[:, :, 1], subkeys[1]).astype(jnp.float32)
    v1, i1 = lax.top_k(s1, PEER_TOPK)
    v2, i2 = lax.top_k(s2, PEER_TOPK)
    cand = (v1[..., :, None] + v2[..., None, :]).reshape(n, PEER_HEADS, PEER_TOPK * PEER_TOPK)
    cand_id = (i1[..., :, None] * PEER_KEYS + i2[..., None, :]).reshape(n, PEER_HEADS, PEER_TOPK * PEER_TOPK)
    sc, ci = lax.top_k(cand, PEER_TOPK)
    eid = jnp.take_along_axis(cand_id, ci, axis=-1)
    gate = jax.nn.softmax(sc, axis=-1)
    nc = n // TOKEN_CHUNK

    def chunk(args):
        xc, ec, gc = args
        act = jax.nn.gelu(jnp.einsum('cd,chkd->chk', xc, u[ec]).astype(jnp.float32), approximate=False)
        return jnp.einsum('chk,chkd->cd', (gc * act).astype(xc.dtype), v[ec])

    out = lax.map(chunk, (xf.reshape(nc, TOKEN_CHUNK, D),
                          eid.reshape(nc, TOKEN_CHUNK, PEER_HEADS, PEER_TOPK),
                          gate.reshape(nc, TOKEN_CHUNK, PEER_HEADS, PEER_TOPK)))
    return out.reshape(B, T, D)


def setup_inputs(seed: int = 0) -> dict:
    key = jax.random.key(seed)
    ks = jax.random.split(key, 24)
    nrm = jax.random.normal
    L, D = DEPTH, D_MODEL
    f = CMP_BLOCK * HEAD_DIM
    return {
        "x": nrm(ks[0], (BATCH, SEQ, D), jnp.float32),
        "w_in": nrm(ks[1], (L, D, IN_WIDTH), jnp.float32) * D ** -0.5,
        "rel_table": nrm(ks[2], (N_BUCKETS, NSA_HEADS), jnp.float32) * 0.5,
        "cmp_pe_k": nrm(ks[3], (L, CMP_BLOCK, HEAD_DIM), jnp.float32) * 0.1,
        "cmp_pe_v": nrm(ks[4], (L, CMP_BLOCK, HEAD_DIM), jnp.float32) * 0.1,
        "cmp_k_w1": nrm(ks[5], (L, f, CMP_HIDDEN), jnp.float32) * f ** -0.5,
        "cmp_k_w2": nrm(ks[6], (L, CMP_HIDDEN, HEAD_DIM), jnp.float32) * CMP_HIDDEN ** -0.5,
        "cmp_v_w1": nrm(ks[7], (L, f, CMP_HIDDEN), jnp.float32) * f ** -0.5,
        "cmp_v_w2": nrm(ks[8], (L, CMP_HIDDEN, HEAD_DIM), jnp.float32) * CMP_HIDDEN ** -0.5,
        "pool_w": nrm(ks[9], (L, POOL_GROUPS, POOL_GROUP_DIM, POOL_GROUP_DIM), jnp.float32) * POOL_GROUP_DIM ** -0.5,
        "pool_scale": 1.0 + 0.02 * nrm(ks[10], (L, POOL_WIDTH), jnp.float32),
        "w_out": nrm(ks[11], (L, D, D), jnp.float32) * (D ** -0.5) * BETA,
        "ln1_g": 1.0 + 0.02 * nrm(ks[12], (L, D), jnp.float32),
        "ln1_b": 0.02 * nrm(ks[13], (L, D), jnp.float32),
        "peer_wq": nrm(ks[14], (L, D, PEER_HEADS * PEER_QDIM), jnp.float32) * D ** -0.5,
        "peer_subkeys": nrm(ks[15], (L, 2, PEER_KEYS, PEER_QDIM // 2), jnp.float32) * (PEER_QDIM // 2) ** -0.5,
        "peer_u": nrm(ks[16], (L, PEER_EXPERTS, D), jnp.float32) * D ** -0.5,
        "peer_v": nrm(ks[17], (L, PEER_EXPERTS, D), jnp.float32) * BETA,
        "ln2_g": 1.0 + 0.02 * nrm(ks[18], (L, D), jnp.float32),
        "ln2_b": 0.02 * nrm(ks[19], (L, D), jnp.float32),
    }


def reference(x, w_in, rel_table, cmp_pe_k, cmp_pe_v, cmp_k_w1, cmp_k_w2, cmp_v_w1, cmp_v_w2,
              pool_w, pool_scale, w_out, ln1_g, ln1_b, peer_wq, peer_subkeys, peer_u, peer_v,
              ln2_g, ln2_b):
    B, T, _ = x.shape
    G, R = NSA_KV_HEADS, NSA_HEADS // NSA_KV_HEADS
    splits = np.cumsum([NSA_WIDTH] + [KV_WIDTH] * 6 + [N_GATES]).tolist()
    h = x
    for l in range(DEPTH):
        proj = h @ w_in[l]
        q, kc, vc, kslc, vslc, kwin, vwin, gates, z = jnp.split(proj, splits, axis=-1)
        q = q.reshape(B, T, G, R, HEAD_DIM).transpose(0, 2, 3, 1, 4)
        kv = lambda a: a.reshape(B, T, G, HEAD_DIM)
        k_cmp = compress(kv(kc), cmp_pe_k[l], cmp_k_w1[l], cmp_k_w2[l])
        v_cmp = compress(kv(vc), cmp_pe_v[l], cmp_v_w1[l], cmp_v_w2[l])
        heads = lambda a: kv(a).transpose(0, 2, 1, 3)
        o_cmp, o_slc, o_win = nsa_attention(q, k_cmp, v_cmp, heads(kslc), heads(vslc),
                                            heads(kwin), heads(vwin), rel_table)
        g = jax.nn.sigmoid(gates.astype(jnp.float32)).astype(x.dtype).reshape(B, T, 3, NSA_HEADS, 1)
        nsa_out = (g[:, :, 0] * o_cmp + g[:, :, 1] * o_slc + g[:, :, 2] * o_win).reshape(B, T, NSA_WIDTH)
        pool_out = pool_mixer(z, pool_w[l], pool_scale[l])
        mix = jnp.concatenate([nsa_out, pool_out], axis=-1) @ w_out[l]
        h = layer_norm(ALPHA * h + mix, ln1_g[l], ln1_b[l])
        ffn = peer(h, peer_wq[l], peer_subkeys[l], peer_u[l], peer_v[l])
        h = layer_norm(ALPHA * h + ffn, ln2_g[l], ln2_b[l])
    return h
```

```cpp
#include <hip/hip_runtime.h>
#include <hip/hip_cooperative_groups.h>
#include <cstdint>
#include <cstdio>
namespace cg = cooperative_groups;

#ifndef N_LAUNCH_MODE
#define N_LAUNCH_MODE 1
#endif

typedef unsigned short bf16_t;
typedef short bf16x8 __attribute__((ext_vector_type(8)));
typedef short s16x4 __attribute__((ext_vector_type(4)));
typedef float f32x16 __attribute__((ext_vector_type(16)));
typedef float f32x4 __attribute__((ext_vector_type(4)));
typedef unsigned u32x4 __attribute__((ext_vector_type(4)));
typedef unsigned u32x2 __attribute__((ext_vector_type(2)));
typedef float f32x2 __attribute__((ext_vector_type(2)));
typedef __bf16 bf16x2_t __attribute__((ext_vector_type(2)));

#define DI __device__ __forceinline__
#define MFMA32(a, b, c) __builtin_amdgcn_mfma_f32_32x32x16_bf16((a), (b), (c), 0, 0, 0)

constexpr int NTOK = 16384, SEQ = 4096, DM = 1024;
constexpr int NINP = 1920;
constexpr float ALPHA = 1.189207115002721f;
constexpr float LN_EPS = 1e-5f;
constexpr float LOG2E = 1.4426950408889634f;
constexpr float QSCALE = 0.125f * LOG2E;
constexpr int NTHREADS = 256;
constexpr int LDS_MAIN = 73728;
constexpr int LDS_BYTES = LDS_MAIN + 64;
constexpr int ROWB = 144;

constexpr size_t MiB = 1u << 20;
constexpr size_t WS_BAR = 0;
constexpr size_t WS_BAR_BYTES = 16384;
constexpr size_t WS_KCMP = 1 * MiB;
constexpr size_t WS_VCMP = 1 * MiB + 512 * 1024;
constexpr size_t WS_W2TK = 2 * MiB;
constexpr size_t WS_W2TV = 2 * MiB + 32 * 1024;
constexpr size_t WS_POOLWT = 2 * MiB + 64 * 1024;
constexpr size_t WS_SUBK = 2 * MiB + 192 * 1024;
constexpr size_t WS_PEBK = 2 * MiB + 256 * 1024;
constexpr size_t WS_PEBV = 2 * MiB + 257 * 1024;
constexpr size_t WS_BUCK = 2 * MiB + 258 * 1024;
constexpr size_t WS_USCALE = 2 * MiB + 320 * 1024;
constexpr size_t WS_VSCALE = 2 * MiB + 384 * 1024;
constexpr size_t WS_W1TK = 3 * MiB;
constexpr size_t WS_W1TV = 4 * MiB;
constexpr size_t WS_WINT = 5 * MiB;
constexpr size_t WS_WOUTT = 9 * MiB;
constexpr size_t WS_WQT = 11 * MiB;
constexpr size_t WS_UB = 16 * MiB;
constexpr size_t WS_VB = 48 * MiB;
constexpr size_t WS_XB = 80 * MiB;
constexpr size_t WS_MIXIN = WS_XB;
constexpr size_t WS_Q = 112 * MiB;
constexpr size_t WS_KC = 128 * MiB;
constexpr size_t WS_VC = 132 * MiB;
constexpr size_t WS_KSLC = 136 * MiB;
constexpr size_t WS_KWIN = 140 * MiB;
constexpr size_t WS_VSLCT = 144 * MiB;
constexpr size_t WS_VWINT = 148 * MiB;
constexpr size_t WS_GATES = 152 * MiB;
constexpr size_t WS_Z = 154 * MiB;
constexpr size_t WS_YPOOL = 170 * MiB;
constexpr size_t WS_OWIN = 186 * MiB;
#ifndef DIAG
#define DIAG 0
#endif
#if DIAG
constexpr size_t WS_H1 = 202 * MiB;
constexpr size_t WS_TOPK = 234 * MiB;
constexpr size_t WS_END = 256 * MiB;
constexpr size_t WS_FLAG = 32768;
constexpr size_t WS_DSCR = 250 * MiB;
#else
constexpr size_t WS_H1 = 112 * MiB;
constexpr size_t WS_TOPK = 154 * MiB;
constexpr size_t WS_END = 202 * MiB;
#endif

struct Params { const float* in[20]; float* out; unsigned char* ws; int ph_lo, ph_hi; };

DI unsigned f2bf(float f) { unsigned u = __float_as_uint(f); return (u + 0x7fffu + ((u >> 16) & 1u)) >> 16; }
DI unsigned pk2(float lo, float hi) { bf16x2_t v = {(__bf16)lo, (__bf16)hi}; return __builtin_bit_cast(unsigned, v); }
DI float bflo(unsigned x) { return __uint_as_float(x << 16); }
DI float bfhi(unsigned x) { return __uint_as_float(x & 0xffff0000u); }
DI float dot2bf(unsigned a, unsigned b, float acc) {
    asm("v_dot2c_f32_bf16 %0, %1, %2" : "+v"(acc) : "v"(a), "v"(b));
    return acc;
}
DI int dot4i8(unsigned a, unsigned b, int acc) {
    return __builtin_amdgcn_sdot4((int)a, (int)b, acc, false);
}
DI float gelu_erf(float x) { return 0.5f * x * (1.0f + erff(x * 0.70710678118654752f)); }
DI float gelu_fast(float v) {
    const float av = fabsf(v), t = __builtin_amdgcn_rcpf(av * 0.2316418882f + 1.0f);
    float q = t * 0.5307027145f + (-0.7265760135f); q = q * t + 0.7107068705f; q = q * t + (-0.142248368f); q = q * t + 0.127414796f; q = q * t;
    const float e = __builtin_amdgcn_exp2f((v * v) * (-0.72134752044f));
    const float m = v * (q * e);
    return v < 0.f ? m : v - m;
}
DI float wave_sum(float v) {
#pragma unroll
    for (int o = 32; o >= 1; o >>= 1) v += __shfl_xor(v, o);
    return v;
}
DI int rel_bucket_dev(int dist) {
    if (dist < 0) dist = 0;
    if (dist < 16) return dist;
    int v = 16 + (int)(logf((float)dist / 16.0f) / logf(8.0f) * 16.0f);
    return v < 31 ? v : 31;
}
DI int make_key(float f, int idx) { int b = __float_as_int(f); b ^= (b >> 31) & 0x7fffffff; return (b & ~127) | idx; }
DI float key_val(int k) { int b = k & ~127; b ^= (b >> 31) & 0x7fffffff; return __int_as_float(b); }


#define LAS __attribute__((address_space(3)))
#define XB_TMO      128
#define XB_XCNT(j)  (256  + 64 * (j))
#define XB_XSUB(j)  (1280 + 64 * (j))
#define XB_XGEN(j)  (2304 + 64 * (j))
#define XB_TOP      3328
#define XB_TOPGEN   3392
#define XCD_BAR_WORDS 3456
#define XB_SPIN_CAP (1u << 20)
DI unsigned xb_ld(unsigned* p)              { return __hip_atomic_load(p, __ATOMIC_RELAXED, __HIP_MEMORY_SCOPE_AGENT); }
DI unsigned xb_add(unsigned* p, unsigned v) { return __hip_atomic_fetch_add(p, v, __ATOMIC_RELAXED, __HIP_MEMORY_SCOPE_AGENT); }
DI unsigned xb_xcc_id() { return (unsigned)__builtin_amdgcn_s_getreg((3 << 11) | 20) & 0xFu; }
#define XB_SPIN(cond, bar) do { unsigned _sp = 0; while (cond) { __builtin_amdgcn_s_sleep(1); \
    if ((++_sp & 255u) == 0u) { if (xb_ld(&(bar)[XB_TMO])) break; if (_sp > XB_SPIN_CAP) { atomicAdd(&(bar)[XB_TMO], 1u); break; } } } } while (0)
struct XcdBarrier { unsigned* bar; unsigned x; volatile unsigned* st; };
DI XcdBarrier xcd_barrier_post(unsigned* bar, volatile unsigned* st) {
    XcdBarrier b; b.bar = bar; b.x = xb_xcc_id(); b.st = st;
    if (threadIdx.x == 0) (void)xb_add(&bar[XB_XCNT(b.x)], 1u);
    return b;
}
DI void xcd_barrier_complete(unsigned* bar, unsigned x, unsigned& nloc, unsigned& nx) {
    const unsigned G = gridDim.x * gridDim.y * gridDim.z;
    unsigned sum, cnt, mine, sp = 0u;
    for (;;) {
        sum = 0u; cnt = 0u; mine = 0u;
#pragma unroll
        for (unsigned j = 0; j < 16; ++j) { const unsigned c = xb_ld(&bar[XB_XCNT(j)]); sum += c; cnt += (c > 0u) ? 1u : 0u; mine = (j == x) ? c : mine; }
        if (sum == G) break;
        __builtin_amdgcn_s_sleep(1);
        if ((++sp & 255u) == 0u) { if (xb_ld(&bar[XB_TMO])) break; if (sp > XB_SPIN_CAP) { atomicAdd(&bar[XB_TMO], 1u); break; } }
    }
    nloc = mine > 0u ? mine : 1u; nx = cnt > 0u ? cnt : 1u;
}
DI void xcd_barrier(const XcdBarrier& b) {
    asm volatile("s_waitcnt vmcnt(0)" ::: "memory");
    __syncthreads();
    if (threadIdx.x == 0) {
        unsigned* bar = b.bar;
        __builtin_amdgcn_s_waitcnt(0);
        unsigned nloc = b.st[0], nx = b.st[1];
        if (nloc == 0u) { xcd_barrier_complete(bar, b.x, nloc, nx); b.st[0] = nloc; b.st[1] = nx; }
        const unsigned old = xb_add(&bar[XB_XSUB(b.x)], 1u);
        const unsigned gen = old / nloc;
        if (old + 1u == (gen + 1u) * nloc) {
            __builtin_amdgcn_fence(__ATOMIC_RELEASE, "agent");
            asm volatile("s_waitcnt vmcnt(0)" ::: "memory");
            const unsigned og = xb_add(&bar[XB_TOP], 1u);
            const unsigned tg = og / nx;
            if (og + 1u == (tg + 1u) * nx) xb_add(&bar[XB_TOPGEN], 1u);
            else XB_SPIN(xb_ld(&bar[XB_TOPGEN]) == tg, bar);
            __builtin_amdgcn_fence(__ATOMIC_ACQUIRE, "agent");
            xb_add(&bar[XB_XGEN(b.x)], 1u);
            asm volatile("s_waitcnt vmcnt(0)" ::: "memory");
        } else {
            XB_SPIN(xb_ld(&bar[XB_XGEN(b.x)]) == gen, bar);
            __builtin_amdgcn_fence(__ATOMIC_ACQUIRE, "agent");
            asm volatile("s_waitcnt vmcnt(0)" ::: "memory");
        }
    }
    __syncthreads();
}

template <int MI>
DI void gemm_mainloop_t(const bf16_t* __restrict__ A, int lda, const bf16_t* __restrict__ Bt, int ldb, int K,
                        f32x16 (&acc)[MI][2], unsigned char* lds) {
    const int tid = threadIdx.x, lane = tid & 63, wid = __builtin_amdgcn_readfirstlane(tid >> 6);
    const int wr = wid >> 1, wc = wid & 1, r = lane & 31, h = lane >> 5;
    LAS unsigned char* As = (LAS unsigned char*)lds;
    LAS unsigned char* Bs = (LAS unsigned char*)lds + 2 * 16384;
#pragma unroll
    for (int mi = 0; mi < MI; ++mi)
#pragma unroll
        for (int ni = 0; ni < 2; ++ni)
#pragma unroll
            for (int i = 0; i < 16; ++i) acc[mi][ni][i] = 0.f;
    const int nk = K >> 6;
    const int prow = 8 * wid + (lane >> 3);
    const int pchunk = (lane & 7) ^ ((prow >> 1) & 7);
    const bf16_t* Ap = A + (size_t)prow * lda + pchunk * 8;
    const bf16_t* Bp = Bt + (size_t)prow * ldb + pchunk * 8;
    const int pl = wid * 1024;
#define GEMM_STAGE(buf, kt) do { \
        _Pragma("unroll") for (int i = 0; i < 2 * MI; ++i) __builtin_amdgcn_global_load_lds((const unsigned*)(Ap + (size_t)(32 * i) * lda + (kt) * 64), (LAS unsigned*)(As + (buf) * 16384 + i * 4096 + pl), 16, 0, 0); \
        _Pragma("unroll") for (int i = 0; i < 4; ++i) __builtin_amdgcn_global_load_lds((const unsigned*)(Bp + (size_t)(32 * i) * ldb + (kt) * 64), (LAS unsigned*)(Bs + (buf) * 16384 + i * 4096 + pl), 16, 0, 0); } while (0)
    GEMM_STAGE(0, 0);
    asm volatile("s_waitcnt vmcnt(0)" ::: "memory");
    __syncthreads();
    const int swz = (r >> 1) & 7;
    for (int kt = 0; kt < nk; ++kt) {
        const int cur = kt & 1;
        if (kt + 1 < nk) GEMM_STAGE(cur ^ 1, kt + 1);
        const LAS unsigned char* Ac = As + cur * 16384 + (wr * 32 * MI + r) * 128;
        const LAS unsigned char* Bc = Bs + cur * 16384 + (wc * 64 + r) * 128;
        __builtin_amdgcn_s_setprio(1);
#pragma unroll
        for (int ks = 0; ks < 4; ++ks) {
            const int co = ((ks * 2 + h) ^ swz) * 16;
            bf16x8 fa[MI], fb[2];
#pragma unroll
            for (int mi = 0; mi < MI; ++mi) fa[mi] = *(const LAS bf16x8*)(Ac + mi * 32 * 128 + co);
#pragma unroll
            for (int ni = 0; ni < 2; ++ni) fb[ni] = *(const LAS bf16x8*)(Bc + ni * 32 * 128 + co);
#pragma unroll
            for (int mi = 0; mi < MI; ++mi)
#pragma unroll
                for (int ni = 0; ni < 2; ++ni) acc[mi][ni] = MFMA32(fb[ni], fa[mi], acc[mi][ni]);
        }
        __builtin_amdgcn_s_setprio(0);
        asm volatile("s_waitcnt vmcnt(0)" ::: "memory");
        __syncthreads();
    }
#undef GEMM_STAGE
}
DI void gemm_mainloop(const bf16_t* __restrict__ A, int lda, const bf16_t* __restrict__ Bt, int ldb, int K,
                      f32x16 (&acc)[2][2], unsigned char* lds) { gemm_mainloop_t<2>(A, lda, Bt, ldb, K, acc, lds); }

template <int MI, class F> DI void epi_foreach_t(const f32x16 (&acc)[MI][2], F f) {
    const int tid = threadIdx.x, lane = tid & 63, wid = tid >> 6;
    const int wr = wid >> 1, wc = wid & 1, r = lane & 31, h = lane >> 5;
#pragma unroll
    for (int mi = 0; mi < MI; ++mi)
#pragma unroll
        for (int ni = 0; ni < 2; ++ni)
#pragma unroll
            for (int grp = 0; grp < 4; ++grp) {
                f32x4 v = {acc[mi][ni][4 * grp], acc[mi][ni][4 * grp + 1], acc[mi][ni][4 * grp + 2], acc[mi][ni][4 * grp + 3]};
                f(wr * 32 * MI + mi * 32 + r, wc * 64 + ni * 32 + 8 * grp + 4 * h, v);
            }
}
template <class F> DI void epi_foreach(const f32x16 (&acc)[2][2], F f) { epi_foreach_t<2>(acc, f); }

template <class S> DI void epi_stage_rows(const f32x16 (&acc)[2][2], unsigned char* lds, S colscale) {
    epi_foreach(acc, [&](int m, int n, f32x4 v) {
        const f32x4 s = colscale(n);
        u32x2 o = {pk2(v.x * s.x, v.y * s.y), pk2(v.z * s.z, v.w * s.w)};
        *(u32x2*)(lds + m * 272 + n * 2) = o;
    });
}
DI void epi_stage_cols(const f32x16 (&acc)[2][2], unsigned char* lds) {
    epi_foreach(acc, [&](int m, int n, f32x4 v) {
        *(bf16_t*)(lds + (n + 0) * 272 + m * 2) = (bf16_t)f2bf(v.x); *(bf16_t*)(lds + (n + 1) * 272 + m * 2) = (bf16_t)f2bf(v.y);
        *(bf16_t*)(lds + (n + 2) * 272 + m * 2) = (bf16_t)f2bf(v.z); *(bf16_t*)(lds + (n + 3) * 272 + m * 2) = (bf16_t)f2bf(v.w);
    });
}
template <class F> DI void rows_foreach(const unsigned char* lds, F f) {
    const int tid = threadIdx.x;
#pragma unroll
    for (int i = 0; i < 8; ++i) {
        const int c = tid + 256 * i, m = c >> 4, cc = c & 15;
        f(m, cc, *(const u32x4*)(lds + m * 272 + cc * 16));
    }
}

DI void cvt_rows(const float* __restrict__ src, bf16_t* __restrict__ dst, size_t n8, size_t gtid, size_t gstride) {
    for (size_t i = gtid; i < n8; i += gstride) {
        f32x4 a = ((const f32x4*)src)[2 * i], b = ((const f32x4*)src)[2 * i + 1];
        u32x4 o = {pk2(a.x, a.y), pk2(a.z, a.w), pk2(b.x, b.y), pk2(b.z, b.w)};
        ((u32x4*)dst)[i] = o;
    }
}
template <class F> DI void transpose_cvt(const float* __restrict__ in, int K, int Nin, bf16_t* __restrict__ out, int Nout, F src,
                                         size_t gtid, size_t gstride) {
    const size_t total = (size_t)Nout * (K / 8);
    for (size_t i = gtid; i < total; i += gstride) {
        const int n = (int)(i % Nout), k8 = (int)(i / Nout);
        const int s = src(n);
        float v[8];
#pragma unroll
        for (int j = 0; j < 8; ++j) v[j] = s >= 0 ? in[(size_t)(k8 * 8 + j) * Nin + s] : 0.f;
        u32x4 o = {pk2(v[0], v[1]), pk2(v[2], v[3]), pk2(v[4], v[5]), pk2(v[6], v[7])};
        *(u32x4*)(out + (size_t)n * K + k8 * 8) = o;
    }
}

DI void convert_tables(const Params& p) {
    unsigned char* ws = p.ws;
    const size_t gtid = (size_t)blockIdx.x * NTHREADS + threadIdx.x, gstride = (size_t)gridDim.x * NTHREADS;
    {
        const int lane = threadIdx.x & 63, gw = (int)(gtid >> 6), ngw = (int)(gstride >> 6);
        for (int rr = gw; rr < 2 * 16384; rr += ngw) {
            const int which = rr >> 14, row = rr & 16383;
            const f32x4* src = (const f32x4*)((which ? p.in[17] : p.in[16]) + (size_t)row * 1024) + lane * 4;
            f32x4 v[4];
            float am = 0.f;
#pragma unroll
            for (int j = 0; j < 4; ++j) { v[j] = src[j]; am = fmaxf(am, fmaxf(fmaxf(fabsf(v[j].x), fabsf(v[j].y)), fmaxf(fabsf(v[j].z), fabsf(v[j].w)))); }
#pragma unroll
            for (int o = 32; o >= 1; o >>= 1) am = fmaxf(am, __shfl_xor(am, o));
            u32x4 o4;
            if (which) {
                const float sc = am > 0.f ? 448.0f / am : 1.0f;
#pragma unroll
                for (int j = 0; j < 4; ++j) {
                    int w = __builtin_amdgcn_cvt_pk_fp8_f32(v[j].x * sc, v[j].y * sc, 0, false);
                    w = __builtin_amdgcn_cvt_pk_fp8_f32(v[j].z * sc, v[j].w * sc, w, true);
                    o4[j] = (unsigned)w;
                }
            } else {
                const float sc = am > 0.f ? 127.0f / am : 1.0f;
#pragma unroll
                for (int j = 0; j < 4; ++j) {
                    const int q0 = (int)rintf(v[j].x * sc), q1 = (int)rintf(v[j].y * sc), q2 = (int)rintf(v[j].z * sc), q3 = (int)rintf(v[j].w * sc);
                    o4[j] = (unsigned)(q0 & 255) | ((unsigned)(q1 & 255) << 8) | ((unsigned)(q2 & 255) << 16) | ((unsigned)(q3 & 255) << 24);
                }
            }
            *(u32x4*)(ws + (which ? WS_VB : WS_UB) + (size_t)row * 1024 + lane * 16) = o4;
            if (lane == 0) ((float*)(ws + (which ? WS_VSCALE : WS_USCALE)))[row] = am > 0.f ? am / (which ? 448.0f : 127.0f) : 1.0f;
        }
    }
}

DI void phase0(const Params& p) {
    unsigned char* ws = p.ws;
    const size_t gtid = (size_t)blockIdx.x * NTHREADS + threadIdx.x, gstride = (size_t)gridDim.x * NTHREADS;
    cvt_rows(p.in[0], (bf16_t*)(ws + WS_XB), (size_t)NTOK * DM / 8, gtid, gstride);
    cvt_rows(p.in[15], (bf16_t*)(ws + WS_SUBK), (size_t)2 * 128 * 128 / 8, gtid, gstride);
    transpose_cvt(p.in[1], 1024, 1816, (bf16_t*)(ws + WS_WINT), NINP,
                  [](int n) { return n < 1280 ? n : (n < 1792 ? 1304 + (n - 1280) : (n < 1816 ? 1280 + (n - 1792) : -1)); }, gtid, gstride);
    transpose_cvt(p.in[11], 1024, 1024, (bf16_t*)(ws + WS_WOUTT), 1024, [](int n) { return n; }, gtid, gstride);
    transpose_cvt(p.in[14], 1024, 2048, (bf16_t*)(ws + WS_WQT), 2048, [](int n) { return n; }, gtid, gstride);
    transpose_cvt(p.in[5], 2048, 256, (bf16_t*)(ws + WS_W1TK), 256, [](int n) { return n; }, gtid, gstride);
    transpose_cvt(p.in[7], 2048, 256, (bf16_t*)(ws + WS_W1TV), 256, [](int n) { return n; }, gtid, gstride);
    transpose_cvt(p.in[6], 256, 64, (bf16_t*)(ws + WS_W2TK), 64, [](int n) { return n; }, gtid, gstride);
    transpose_cvt(p.in[8], 256, 64, (bf16_t*)(ws + WS_W2TV), 64, [](int n) { return n; }, gtid, gstride);
    for (int g = 0; g < 4; ++g)
        transpose_cvt(p.in[9] + g * 16384, 128, 128, (bf16_t*)(ws + WS_POOLWT) + g * 16384, 128, [](int n) { return n; }, gtid, gstride);
    {
        float* z = (float*)(ws + WS_KCMP);
        for (size_t i = gtid; i < (size_t)2 * 8 * 256 * 64; i += gstride) z[i] = 0.f;
    }
    {
        const int lane = threadIdx.x & 63, gw = (int)(gtid >> 6), ngw = (int)(gstride >> 6);
        for (int o = gw; o < 512; o += ngw) {
            const int which = o >> 8, j = o & 255;
            const float* pe = which ? p.in[4] : p.in[3];
            const float* w1 = which ? p.in[7] : p.in[5];
            float s = 0.f;
#pragma unroll 8
            for (int i = lane; i < 2048; i += 64) s += pe[i] * w1[(size_t)i * 256 + j];
            s = wave_sum(s);
            if (lane == 0) ((float*)(ws + (which ? WS_PEBV : WS_PEBK)))[j] = s;
        }
    }
    if (gtid >= 512 && gtid < 768) {
        const int d = (int)(gtid - 512);
        ((int*)(ws + WS_BUCK))[d] = rel_bucket_dev(d);
    }
}

DI int cu_pair_pos(int j, int G8) { const int hlf = (G8 + 1) >> 1; return (G8 & 1) ? j : (((j % hlf) << 1) | (j / hlf)); }

DI void phase1(const Params& p, unsigned char* lds) {
    unsigned char* ws = p.ws;
    const bf16_t* xb = (const bf16_t*)(ws + WS_XB);
    const bf16_t* wt = (const bf16_t*)(ws + WS_WINT);
    const int ntiles = 128 * 15;
    const int G8 = (gridDim.x & 7) == 0 ? gridDim.x >> 3 : 0;
    for (int l0 = G8 ? 0 : (int)blockIdx.x; l0 < (G8 ? ntiles / 8 : ntiles); l0 += (G8 ? G8 : (int)gridDim.x)) {
        const int li = G8 ? l0 + cu_pair_pos((int)(blockIdx.x >> 3), G8) : l0;
        if (G8 && li >= ntiles / 8) break;
        const int tile = G8 ? (int)(blockIdx.x & 7) * (ntiles / 8) + li : li;
        const int tn = tile % 15, tm = tile / 15;
        f32x16 acc[2][2];
        gemm_mainloop(xb + (size_t)tm * 128 * DM, DM, wt + (size_t)tn * 128 * DM, DM, DM, acc, lds);
        const int m0 = tm * 128;
        if (tn < 14) {
            const bool tr = (tn == 7 || tn == 9);
            const float qs = tn < 4 ? QSCALE : 1.0f;
            if (tr) epi_stage_cols(acc, lds);
            else epi_stage_rows(acc, lds, [&](int) { return (f32x4){qs, qs, qs, qs}; });
            __syncthreads();
            const int bq = m0 >> 12, t0q = m0 & 4095;
            if (tn < 4) {
                bf16_t* Q = (bf16_t*)(ws + WS_Q);
                rows_foreach(lds, [&](int m, int cc, u32x4 d) {
                    const int hd = tn * 2 + (cc >> 3);
                    *(u32x4*)(Q + (((size_t)(bq * 8 + hd) * SEQ + t0q + m) * 64 + (cc & 7) * 8)) = d;
                });
            } else if (tr) {
                bf16_t* dst = (bf16_t*)(ws + (tn == 7 ? WS_VSLCT : WS_VWINT));
                rows_foreach(lds, [&](int n, int cc, u32x4 d) {
                    *(u32x4*)(dst + ((size_t)((bq * 2 + (n >> 6)) * 64 + (n & 63)) * SEQ + t0q + cc * 8)) = d;
                });
            } else if (tn < 10) {
                bf16_t* dst = (bf16_t*)(ws + (tn == 4 ? WS_KC : tn == 5 ? WS_VC : tn == 6 ? WS_KSLC : WS_KWIN));
                rows_foreach(lds, [&](int m, int cc, u32x4 d) {
                    *(u32x4*)(dst + (((size_t)(bq * 2 + (cc >> 3)) * SEQ + t0q + m) * 64 + (cc & 7) * 8)) = d;
                });
            } else {
                bf16_t* dst = (bf16_t*)(ws + WS_Z);
                rows_foreach(lds, [&](int m, int cc, u32x4 d) {
                    *(u32x4*)(dst + ((size_t)(m0 + m) * 512 + (tn - 10) * 128 + cc * 8)) = d;
                });
            }
            __syncthreads();
        } else {
            float* dst = (float*)(ws + WS_GATES);
            epi_foreach(acc, [&](int m, int n, f32x4 v) {
                if (n < 24) {
                    f32x4 o = {1.f / (1.f + __expf(-v.x)), 1.f / (1.f + __expf(-v.y)), 1.f / (1.f + __expf(-v.z)), 1.f / (1.f + __expf(-v.w))};
                    *(f32x4*)(dst + (size_t)(m0 + m) * 24 + n) = o;
                }
            });
        }
    }
}

DI void compress_job(const Params& p, unsigned char* lds, int cj) {
    unsigned char* ws = p.ws;
    const int kv = cj >> 6, bg = (cj >> 3) & 7, rq = (cj >> 1) & 3, hh = cj & 1;
    const bf16_t* A = (const bf16_t*)(ws + (kv ? WS_VC : WS_KC)) + ((size_t)bg * SEQ + (size_t)rq * 64 * 16) * 64;
    const bf16_t* Bt = (const bf16_t*)(ws + (kv ? WS_W1TV : WS_W1TK)) + (size_t)hh * 128 * 2048;
    const float* peb = (const float*)(ws + (kv ? WS_PEBV : WS_PEBK)) + hh * 128;
    const bf16_t* w2t = (const bf16_t*)(ws + (kv ? WS_W2TV : WS_W2TK));
    float* dst = (float*)(ws + (kv ? WS_VCMP : WS_KCMP)) + (size_t)bg * 256 * 64;
    f32x16 acc[1][2];
    gemm_mainloop_t<1>(A, 1024, Bt, 2048, 2048, acc, lds);
    epi_foreach_t<1>(acc, [&](int m, int n, f32x4 v) {
        f32x4 bb = *(const f32x4*)(peb + n);
        u32x2 o = {pk2(gelu_erf(v.x + bb.x), gelu_erf(v.y + bb.y)), pk2(gelu_erf(v.z + bb.z), gelu_erf(v.w + bb.w))};
        *(u32x2*)(lds + m * 272 + n * 2) = o;
    });
    __syncthreads();
    const int tid = threadIdx.x, lane = tid & 63, wid = tid >> 6, r = lane & 31, h = lane >> 5;
    const int wr2 = wid >> 1, wd = wid & 1;
    f32x16 a2;
#pragma unroll
    for (int i = 0; i < 16; ++i) a2[i] = 0.f;
#pragma unroll
    for (int ks = 0; ks < 8; ++ks) {
        bf16x8 fb = *(const bf16x8*)(lds + (wr2 * 32 + r) * 272 + ks * 32 + h * 16);
        bf16x8 fa = *(const bf16x8*)(w2t + (size_t)(wd * 32 + r) * 256 + hh * 128 + ks * 16 + h * 8);
        a2 = MFMA32(fa, fb, a2);
    }
    const int row = rq * 64 + wr2 * 32 + r;
    if (row < 255) {
#pragma unroll
        for (int i = 0; i < 16; ++i) {
            const int d = wd * 32 + (i & 3) + 8 * (i >> 2) + 4 * h;
            atomicAdd(dst + (size_t)row * 64 + d, a2[i]);
        }
    }
    __syncthreads();
}

constexpr int AT_K0 = 0, AT_V0 = 18432, AT_TB = 36864, AT_IMP = 40960, AT_SEL = 49152;

DI void attn_stage_load(const bf16_t* __restrict__ Kg, const bf16_t* __restrict__ Vtg, u32x4 (&st)[4], int tid) {
#pragma unroll
    for (int i = 0; i < 2; ++i) {
        const int c = tid + 256 * i, row = c >> 3, cc = c & 7;
        st[i] = *(const u32x4*)(Kg + (size_t)row * 64 + cc * 8);
        st[2 + i] = *(const u32x4*)(Vtg + (size_t)row * SEQ + cc * 8);
    }
}
DI void attn_stage_store(unsigned char* Kl, unsigned char* Vl, const u32x4 (&st)[4], int tid) {
#pragma unroll
    for (int i = 0; i < 2; ++i) {
        const int c = tid + 256 * i, row = c >> 3, cc = c & 7;
        *(u32x4*)(Kl + row * ROWB + cc * 16) = st[i];
        *(u32x4*)(Vl + row * ROWB + cc * 16) = st[2 + i];
    }
}
DI void attn_scores(const unsigned char* Kl, const bf16x8 (&qf)[4], f32x16 (&X)[2], int r, int h) {
#pragma unroll
    for (int i = 0; i < 16; ++i) { X[0][i] = 0.f; X[1][i] = 0.f; }
#pragma unroll
    for (int ks = 0; ks < 4; ++ks)
#pragma unroll
        for (int kb = 0; kb < 2; ++kb) {
            bf16x8 a = *(const bf16x8*)(Kl + (kb * 32 + r) * ROWB + ks * 32 + h * 16);
            X[kb] = MFMA32(a, qf[ks], X[kb]);
        }
}
DI void attn_pv(const unsigned char* Vl, const f32x16 (&P)[2], f32x16 (&O)[2], int r, int h) {
#pragma unroll
    for (int kb = 0; kb < 2; ++kb)
#pragma unroll
        for (int s = 0; s < 2; ++s) {
            u32x4 pw = {pk2(P[kb][8 * s], P[kb][8 * s + 1]), pk2(P[kb][8 * s + 2], P[kb][8 * s + 3]),
                        pk2(P[kb][8 * s + 4], P[kb][8 * s + 5]), pk2(P[kb][8 * s + 6], P[kb][8 * s + 7])};
            bf16x8 pb = __builtin_bit_cast(bf16x8, pw);
#pragma unroll
            for (int db = 0; db < 2; ++db) {
                const unsigned char* q = Vl + (db * 32 + r) * ROWB + (kb * 32 + 16 * s + 4 * h) * 2;
                s16x4 lo = *(const s16x4*)q, hi = *(const s16x4*)(q + 16);
                bf16x8 a = __builtin_shufflevector(lo, hi, 0, 1, 2, 3, 4, 5, 6, 7);
                O[db] = MFMA32(a, pb, O[db]);
            }
        }
}
DI void softmax_update(f32x16 (&X)[2], float& m, float& l, f32x16 (&O)[2]) {
    float mloc = -1e30f;
#pragma unroll
    for (int kb = 0; kb < 2; ++kb)
#pragma unroll
        for (int i = 0; i < 16; ++i) mloc = fmaxf(mloc, X[kb][i]);
    mloc = fmaxf(mloc, __shfl_xor(mloc, 32));
    const float mnew = fmaxf(m, mloc);
    const float alpha = __builtin_amdgcn_exp2f(m - mnew);
    m = mnew;
    float ls = 0.f;
#pragma unroll
    for (int kb = 0; kb < 2; ++kb)
#pragma unroll
        for (int i = 0; i < 16; ++i) {
            const float x = X[kb][i];
            const float pv = x > -1e29f ? __builtin_amdgcn_exp2f(x - mnew) : 0.f;
            X[kb][i] = pv; ls += pv;
        }
    l = l * alpha + ls;
#pragma unroll
    for (int db = 0; db < 2; ++db)
#pragma unroll
        for (int i = 0; i < 16; ++i) O[db][i] *= alpha;
}
DI void softmax_far(f32x16 (&X)[2], float cb, float& m, float& l, f32x16 (&O)[2]) {
    float mloc = -3e38f;
#pragma unroll
    for (int kb = 0; kb < 2; ++kb)
#pragma unroll
        for (int i = 0; i < 16; ++i) mloc = fmaxf(mloc, X[kb][i]);
    mloc += cb;
    mloc = fmaxf(mloc, __shfl_xor(mloc, 32));
    const float mnew = fmaxf(m, mloc);
    if (__any(mnew > m)) {
        const float alpha = __builtin_amdgcn_exp2f(m - mnew);
        m = mnew; l *= alpha;
#pragma unroll
        for (int db = 0; db < 2; ++db)
#pragma unroll
            for (int i = 0; i < 16; ++i) O[db][i] *= alpha;
    }
    const float mc = m - cb;
    f32x2 ls = {0.f, 0.f};
#pragma unroll
    for (int kb = 0; kb < 2; ++kb)
#pragma unroll
        for (int i = 0; i < 16; i += 2) {
            f32x2 pv = {__builtin_amdgcn_exp2f(X[kb][i] - mc), __builtin_amdgcn_exp2f(X[kb][i + 1] - mc)};
            X[kb][i] = pv.x; X[kb][i + 1] = pv.y; ls += pv;
        }
    l += ls.x + ls.y;
}
DI void build_bias_table(const Params& p, unsigned char* lds, int g) {
    const int* buck = (const int*)(p.ws + WS_BUCK);
    float* tb = (float*)(lds + AT_TB);
    for (int i = threadIdx.x; i < 1024; i += NTHREADS) {
        const int hl = i >> 8, d = i & 255;
        tb[i] = p.in[2][buck[d] * 8 + g * 4 + hl] * LOG2E;
    }
}

DI void win_unit(const Params& p, unsigned char* lds, int u) {
    unsigned char* ws = p.ws;
    const int tid = threadIdx.x, lane = tid & 63, wid = tid >> 6, r = lane & 31, h = lane >> 5;
    const int bg = u & 7, t32 = u >> 3, b = bg >> 1, g = bg & 1, t0 = t32 * 32;
    const int hl = r >> 3, t = t0 + wid * 8 + (r & 7);
    const bf16_t* Kg = (const bf16_t*)(ws + WS_KWIN) + (size_t)bg * SEQ * 64;
    const bf16_t* Vtg = (const bf16_t*)(ws + WS_VWINT) + (size_t)bg * 64 * SEQ;
    const bf16_t* Qg = (const bf16_t*)(ws + WS_Q) + ((size_t)(b * 8 + g * 4 + hl) * SEQ + t) * 64;
    __syncthreads();
    build_bias_table(p, lds, g);
    bf16x8 qf[4];
#pragma unroll
    for (int ks = 0; ks < 4; ++ks) qf[ks] = *(const bf16x8*)(Qg + ks * 16 + h * 8);
    const int jlo = t0 < 511 ? 0 : ((t0 - 511) >> 6), jhi = t0 >> 6;
    u32x4 st[4];
    attn_stage_load(Kg + (size_t)jlo * 64 * 64, Vtg + jlo * 64, st, tid);
    attn_stage_store(lds + AT_K0, lds + AT_V0, st, tid);
    __syncthreads();
    const float* tb = (const float*)(lds + AT_TB) + hl * 256;
    const int tmin = t0 + wid * 8;
    float m = -1e30f, l = 0.f;
    f32x16 O[2];
#pragma unroll
    for (int i = 0; i < 16; ++i) { O[0][i] = 0.f; O[1][i] = 0.f; }
    for (int j = jlo; j <= jhi; ++j) {
        const int cur = (j - jlo) & 1;
        if (j < jhi) attn_stage_load(Kg + (size_t)(j + 1) * 64 * 64, Vtg + (j + 1) * 64, st, tid);
        const unsigned char* Kl = lds + AT_K0 + cur * 9216;
        const unsigned char* Vl = lds + AT_V0 + cur * 9216;
        f32x16 X[2];
        attn_scores(Kl, qf, X, r, h);
        const bool far = (tmin - (j * 64 + 63) >= 128) && (tmin + 7 - j * 64 < 512);
        if (far) {
            softmax_far(X, tb[255], m, l, O);
        } else {
#pragma unroll
            for (int kb = 0; kb < 2; ++kb)
#pragma unroll
                for (int i = 0; i < 16; ++i) {
                    const int pos = j * 64 + kb * 32 + (i & 3) + 8 * (i >> 2) + 4 * h;
                    const int dist = t - pos;
                    const bool valid = dist >= 0 && dist < 512;
                    const int di = dist < 0 ? 0 : (dist > 255 ? 255 : dist);
                    X[kb][i] = valid ? X[kb][i] + tb[di] : -1e30f;
                }
            softmax_update(X, m, l, O);
        }
        attn_pv(Vl, X, O, r, h);
        if (j < jhi) attn_stage_store(lds + AT_K0 + (cur ^ 1) * 9216, lds + AT_V0 + (cur ^ 1) * 9216, st, tid);
        __syncthreads();
    }
    const float lt = l + __shfl_xor(l, 32);
    const size_t tok = (size_t)b * SEQ + t;
    const float gate = ((const float*)(ws + WS_GATES))[tok * 24 + 16 + g * 4 + hl];
    const float sc = gate / lt;
    bf16_t* ow = (bf16_t*)(ws + WS_OWIN) + tok * 512 + (g * 4 + hl) * 64;
#pragma unroll
    for (int db = 0; db < 2; ++db)
#pragma unroll
        for (int grp = 0; grp < 4; ++grp) {
            u32x2 o = {pk2(O[db][4 * grp] * sc, O[db][4 * grp + 1] * sc), pk2(O[db][4 * grp + 2] * sc, O[db][4 * grp + 3] * sc)};
            *(u32x2*)(ow + db * 32 + 8 * grp + 4 * h) = o;
        }
}

DI void cmp_stage(const float* __restrict__ kc, const float* __restrict__ vc, int ct, unsigned char* Kl, unsigned char* Vl, bool withv, int tid) {
    {
        const int c = tid >> 2, part = tid & 3;
        const f32x4* src = (const f32x4*)(kc + (size_t)(ct * 64 + c) * 64 + part * 16);
        f32x4 a = src[0], b2 = src[1], c2 = src[2], d2 = src[3];
        u32x4 o0 = {pk2(a.x, a.y), pk2(a.z, a.w), pk2(b2.x, b2.y), pk2(b2.z, b2.w)};
        u32x4 o1 = {pk2(c2.x, c2.y), pk2(c2.z, c2.w), pk2(d2.x, d2.y), pk2(d2.z, d2.w)};
        *(u32x4*)(Kl + c * ROWB + part * 32) = o0;
        *(u32x4*)(Kl + c * ROWB + part * 32 + 16) = o1;
    }
    if (withv) {
        const int c = tid & 63, dg = tid >> 6;
        const f32x4* src = (const f32x4*)(vc + (size_t)(ct * 64 + c) * 64 + dg * 16);
#pragma unroll
        for (int q4 = 0; q4 < 4; ++q4) {
            f32x4 a = src[q4];
            const int d = dg * 16 + q4 * 4;
            *(bf16_t*)(Vl + (d + 0) * ROWB + c * 2) = (bf16_t)f2bf(a.x);
            *(bf16_t*)(Vl + (d + 1) * ROWB + c * 2) = (bf16_t)f2bf(a.y);
            *(bf16_t*)(Vl + (d + 2) * ROWB + c * 2) = (bf16_t)f2bf(a.z);
            *(bf16_t*)(Vl + (d + 3) * ROWB + c * 2) = (bf16_t)f2bf(a.w);
        }
    }
}

DI void slc_unit(const Params& p, unsigned char* lds, int u) {
    unsigned char* ws = p.ws;
    const int tid = threadIdx.x, lane = tid & 63, wid = tid >> 6, r = lane & 31, h = lane >> 5;
    const int bg = u & 7, t32 = u >> 3, b = bg >> 1, g = bg & 1, t0 = t32 * 32;
    const int hl = r >> 3, tokl = r & 7, t = t0 + wid * 8 + tokl;
    const bf16_t* Kg = (const bf16_t*)(ws + WS_KSLC) + (size_t)bg * SEQ * 64;
    const bf16_t* Vtg = (const bf16_t*)(ws + WS_VSLCT) + (size_t)bg * 64 * SEQ;
    const bf16_t* Qg = (const bf16_t*)(ws + WS_Q) + ((size_t)(b * 8 + g * 4 + hl) * SEQ + t) * 64;
    const float* kcmp = (const float*)(ws + WS_KCMP) + (size_t)bg * 256 * 64;
    const float* vcmp = (const float*)(ws + WS_VCMP) + (size_t)bg * 256 * 64;
    __syncthreads();
    build_bias_table(p, lds, g);
    unsigned* imp = (unsigned*)(lds + AT_IMP) + wid * 512;
#pragma unroll
    for (int i = 0; i < 8; ++i) imp[i * 64 + lane] = 0u;
    bf16x8 qf[4];
#pragma unroll
    for (int ks = 0; ks < 4; ++ks) qf[ks] = *(const bf16x8*)(Qg + ks * 16 + h * 8);
    const float* tb = (const float*)(lds + AT_TB) + hl * 256;
    const int cmax = t0 >> 4;
    const int nct = (t0 + 31 >= 31) ? (cmax >> 6) + 1 : 0;
    float m = -1e30f, l = 0.f;
    f32x16 Oc[2];
#pragma unroll
    for (int i = 0; i < 16; ++i) { Oc[0][i] = 0.f; Oc[1][i] = 0.f; }
    for (int ct = 0; ct < nct; ++ct) {
        __syncthreads();
        cmp_stage(kcmp, vcmp, ct, lds + AT_K0, lds + AT_V0, false, tid);
        __syncthreads();
        f32x16 X[2];
        attn_scores(lds + AT_K0, qf, X, r, h);
#pragma unroll
        for (int kb = 0; kb < 2; ++kb)
#pragma unroll
            for (int i = 0; i < 16; ++i) {
                const int c = ct * 64 + kb * 32 + (i & 3) + 8 * (i >> 2) + 4 * h;
                const int dist = t - (16 * c + 31);
                const bool valid = dist >= 0 && c < 255;
                const int di = dist < 0 ? 0 : (dist > 255 ? 255 : dist);
                X[kb][i] = valid ? X[kb][i] + tb[di] : -1e30f;
            }
        f32x16 dummy[2];
#pragma unroll
        for (int i = 0; i < 16; ++i) { dummy[0][i] = 0.f; dummy[1][i] = 0.f; }
        softmax_update(X, m, l, dummy);
    }
    const float lt = l + __shfl_xor(l, 32);
    const float invl = lt > 0.f ? 1.0f / lt : 0.f;
    for (int ct = 0; ct < nct; ++ct) {
        __syncthreads();
        cmp_stage(kcmp, vcmp, ct, lds + AT_K0, lds + AT_V0, true, tid);
        __syncthreads();
        f32x16 X[2];
        attn_scores(lds + AT_K0, qf, X, r, h);
#pragma unroll
        for (int kb = 0; kb < 2; ++kb)
#pragma unroll
            for (int i = 0; i < 16; ++i) {
                const int c = ct * 64 + kb * 32 + (i & 3) + 8 * (i >> 2) + 4 * h;
                const int dist = t - (16 * c + 31);
                const bool valid = dist >= 0 && c < 255;
                const int di = dist < 0 ? 0 : (dist > 255 ? 255 : dist);
                X[kb][i] = valid ? __builtin_amdgcn_exp2f(X[kb][i] + tb[di] - m) * invl : 0.f;
            }
#pragma unroll
        for (int kb = 0; kb < 2; ++kb)
#pragma unroll
            for (int grp = 0; grp < 4; ++grp) {
                const float s4 = (X[kb][4 * grp] + X[kb][4 * grp + 1]) + (X[kb][4 * grp + 2] + X[kb][4 * grp + 3]);
                const int jj = ct * 16 + kb * 8 + 2 * grp + h;
                atomicAdd(&imp[tokl * 64 + jj], (unsigned)(s4 * 67108864.0f + 0.5f));
                if (jj + 1 < 64) atomicAdd(&imp[tokl * 64 + jj + 1], (unsigned)(X[kb][4 * grp + 3] * 67108864.0f + 0.5f));
            }
        attn_pv(lds + AT_V0, X, Oc, r, h);
    }
    unsigned long long* selm = (unsigned long long*)(lds + AT_SEL) + wid * 8;
    for (int tk = 0; tk < 8; ++tk) {
        const int tt = t0 + wid * 8 + tk, curb = tt >> 6;
        int v = (int)imp[tk * 64 + lane];
        if (lane == 0 || lane == curb || lane == curb - 1) v = 0x7fffffff;
        if (lane > curb) v = -1;
        int cnt = 0;
#pragma unroll
        for (int k = 0; k < 64; ++k) {
            const int vk = __builtin_amdgcn_readlane(v, k);
            cnt += (vk > v || (vk == v && k < lane)) ? 1 : 0;
        }
        const unsigned long long mk = __ballot(cnt < 16);
        if (lane == 0) selm[tk] = mk;
    }
    const unsigned long long mysel = selm[tokl];
    __syncthreads();
    const int jhi = t0 >> 6;
    u32x4 st[4];
    attn_stage_load(Kg, Vtg, st, tid);
    attn_stage_store(lds + AT_K0, lds + AT_V0, st, tid);
    __syncthreads();
    float m2 = -1e30f, l2 = 0.f;
    const int tmin = t0 + wid * 8;
    f32x16 O[2];
#pragma unroll
    for (int i = 0; i < 16; ++i) { O[0][i] = 0.f; O[1][i] = 0.f; }
    for (int j = 0; j <= jhi; ++j) {
        const int cur = j & 1;
        if (j < jhi) attn_stage_load(Kg + (size_t)(j + 1) * 64 * 64, Vtg + (j + 1) * 64, st, tid);
        const unsigned char* Kl = lds + AT_K0 + cur * 9216;
        const unsigned char* Vl = lds + AT_V0 + cur * 9216;
        f32x16 X[2];
        attn_scores(Kl, qf, X, r, h);
        const bool selj = (mysel >> j) & 1ull;
        if (tmin - (j * 64 + 63) >= 128) {
            softmax_far(X, selj ? tb[255] : -1e30f, m2, l2, O);
        } else {
#pragma unroll
            for (int kb = 0; kb < 2; ++kb)
#pragma unroll
                for (int i = 0; i < 16; ++i) {
                    const int pos = j * 64 + kb * 32 + (i & 3) + 8 * (i >> 2) + 4 * h;
                    const int dist = t - pos;
                    const bool valid = dist >= 0 && selj;
                    const int di = dist < 0 ? 0 : (dist > 255 ? 255 : dist);
                    X[kb][i] = valid ? X[kb][i] + tb[di] : -1e30f;
                }
            softmax_update(X, m2, l2, O);
        }
        attn_pv(Vl, X, O, r, h);
        if (j < jhi) attn_stage_store(lds + AT_K0 + (cur ^ 1) * 9216, lds + AT_V0 + (cur ^ 1) * 9216, st, tid);
        __syncthreads();
    }
    const float lt2 = l2 + __shfl_xor(l2, 32);
    const size_t tok = (size_t)b * SEQ + t;
    const float* gt = (const float*)(ws + WS_GATES) + tok * 24;
    const float gc = gt[g * 4 + hl], gs = gt[8 + g * 4 + hl] / lt2;
    const bf16_t* ow = (const bf16_t*)(ws + WS_OWIN) + tok * 512 + (g * 4 + hl) * 64;
    bf16_t* mx = (bf16_t*)(ws + WS_MIXIN) + tok * 1024 + (g * 4 + hl) * 64;
#pragma unroll
    for (int db = 0; db < 2; ++db)
#pragma unroll
        for (int grp = 0; grp < 4; ++grp) {
            const int d = db * 32 + 8 * grp + 4 * h;
            const u32x2 w = *(const u32x2*)(ow + d);
            const float r0 = gc * Oc[db][4 * grp] + gs * O[db][4 * grp] + bflo(w.x);
            const float r1 = gc * Oc[db][4 * grp + 1] + gs * O[db][4 * grp + 1] + bfhi(w.x);
            const float r2 = gc * Oc[db][4 * grp + 2] + gs * O[db][4 * grp + 2] + bflo(w.y);
            const float r3 = gc * Oc[db][4 * grp + 3] + gs * O[db][4 * grp + 3] + bfhi(w.y);
            u32x2 o = {pk2(r0, r1), pk2(r2, r3)};
            *(u32x2*)(mx + d) = o;
        }
}

DI void pooly_job(const Params& p, int job) {
    unsigned char* ws = p.ws;
    const bf16_t* z = (const bf16_t*)(ws + WS_Z);
    bf16_t* y = (bf16_t*)(ws + WS_YPOOL);
    const int tid = threadIdx.x;
    const int tok = job * 4 + (tid >> 6), ch = tid & 63, t = tok & 4095;
    const int gi = ch >> 4, win = 2 << gi;
    const int cnt = (t + 1 < win) ? t + 1 : win;
    float s[8];
#pragma unroll
    for (int i = 0; i < 8; ++i) s[i] = 0.f;
    u32x4 rowv[16];
#pragma unroll
    for (int k = 0; k < 16; ++k) rowv[k] = *(const u32x4*)(z + (size_t)(tok - (k < cnt ? k : 0)) * 512 + ch * 8);
    const u32x4 self = rowv[0];
#pragma unroll
    for (int k = 0; k < 16; ++k) {
        const float wk = k < cnt ? 1.0f : 0.0f;
        const u32x4 v = rowv[k];
        s[0] += wk * bflo(v.x); s[1] += wk * bfhi(v.x); s[2] += wk * bflo(v.y); s[3] += wk * bfhi(v.y);
        s[4] += wk * bflo(v.z); s[5] += wk * bfhi(v.z); s[6] += wk * bflo(v.w); s[7] += wk * bfhi(v.w);
    }
    const float ic = 1.0f / (float)cnt;
    u32x4 o = {pk2(s[0] * ic - bflo(self.x), s[1] * ic - bfhi(self.x)), pk2(s[2] * ic - bflo(self.y), s[3] * ic - bfhi(self.y)),
               pk2(s[4] * ic - bflo(self.z), s[5] * ic - bfhi(self.z)), pk2(s[6] * ic - bflo(self.w), s[7] * ic - bfhi(self.w))};
    *(u32x4*)(y + (size_t)tok * 512 + ch * 8) = o;
}

DI void phase2(const Params& p, unsigned char* lds) {
    const int G = gridDim.x, bx = blockIdx.x;
    if (G == 512) {
        if (bx < 128) { compress_job(p, lds, bx); win_unit(p, lds, 768 + bx); }
        else { win_unit(p, lds, bx - 128); win_unit(p, lds, 384 + bx - 128); if (bx < 256) win_unit(p, lds, 896 + bx - 128); }
    } else {
        for (int job = bx; job < 128; job += G) compress_job(p, lds, job);
        for (int job = bx; job < 1024; job += G) win_unit(p, lds, job);
    }
    for (int job = bx; job < 4096; job += G) pooly_job(p, job);
}

DI void pool_gemm_tile(const Params& p, unsigned char* lds, int tile) {
    unsigned char* ws = p.ws;
    const int gi = tile & 3, tm = tile >> 2;
    f32x16 acc[2][2];
    __syncthreads();
    gemm_mainloop((const bf16_t*)(ws + WS_YPOOL) + (size_t)tm * 128 * 512 + gi * 128, 512,
                  (const bf16_t*)(ws + WS_POOLWT) + (size_t)gi * 16384, 128, 128, acc, lds);
    const float* sc = p.in[10] + gi * 128;
    bf16_t* mx = (bf16_t*)(ws + WS_MIXIN);
    epi_stage_rows(acc, lds, [&](int n) { return *(const f32x4*)(sc + n); });
    __syncthreads();
    rows_foreach(lds, [&](int m, int cc, u32x4 d) {
        *(u32x4*)(mx + (size_t)(tm * 128 + m) * 1024 + 512 + gi * 128 + cc * 8) = d;
    });
}

DI void phase3(const Params& p, unsigned char* lds) {
    const int G = gridDim.x, bx = blockIdx.x;
    for (int pass = 0; pass * G < 1024; ++pass) {
        const int i = pass * G + ((pass & 1) ? (G - 1 - bx) : bx);
        if (i < 1024) {
            const int u = ((127 - (i >> 3)) << 3) | (i & 7);
            slc_unit(p, lds, u);
        }
    }
    for (int tile = bx; tile < 512; tile += G) pool_gemm_tile(p, lds, tile);
}

DI void phase4(const Params& p, unsigned char* lds) {
    unsigned char* ws = p.ws;
    const float* x = p.in[0];
    bf16_t* y1 = (bf16_t*)(ws + WS_Z);
    const bool conv_first = (blockIdx.x >> 3) & 1;
    if (conv_first) convert_tables(p);
    const int G8 = (gridDim.x & 7) == 0 ? gridDim.x >> 3 : 0;
    for (int l0 = G8 ? 0 : (int)blockIdx.x; l0 < (G8 ? 128 : 1024); l0 += (G8 ? G8 : (int)gridDim.x)) {
        const int li = G8 ? l0 + cu_pair_pos((int)(blockIdx.x >> 3), G8) : l0;
        if (G8 && li >= 128) break;
        const int tile = G8 ? (int)(blockIdx.x & 7) * 128 + li : li;
        const int tn = tile & 7, tm = tile >> 3;
        f32x16 acc[2][2];
        gemm_mainloop((const bf16_t*)(ws + WS_MIXIN) + (size_t)tm * 128 * 1024, 1024,
                      (const bf16_t*)(ws + WS_WOUTT) + (size_t)tn * 128 * 1024, 1024, 1024, acc, lds);
        epi_stage_rows(acc, lds, [&](int) { return (f32x4){1.f, 1.f, 1.f, 1.f}; });
        __syncthreads();
        rows_foreach(lds, [&](int m, int cc, u32x4 d) {
            const size_t off = (size_t)(tm * 128 + m) * 1024 + tn * 128 + cc * 8;
            const f32x4 xa = *(const f32x4*)(x + off), xb = *(const f32x4*)(x + off + 4);
            u32x4 o = {pk2(ALPHA * xa.x + bflo(d.x), ALPHA * xa.y + bfhi(d.x)), pk2(ALPHA * xa.z + bflo(d.y), ALPHA * xa.w + bfhi(d.y)),
                       pk2(ALPHA * xb.x + bflo(d.z), ALPHA * xb.y + bfhi(d.z)), pk2(ALPHA * xb.z + bflo(d.w), ALPHA * xb.w + bfhi(d.w))};
            *(u32x4*)(y1 + off) = o;
        });
        __syncthreads();
    }
    if (!conv_first) convert_tables(p);
}

DI void phase5(const Params& p) {
    unsigned char* ws = p.ws;
    const int lane = threadIdx.x & 63, wid = threadIdx.x >> 6;
    const float* gg = p.in[12];
    const float* bb = p.in[13];
    bf16_t* h1 = (bf16_t*)(ws + WS_H1);
    for (int row = blockIdx.x * 4 + wid; row < NTOK; row += gridDim.x * 4) {
        const u32x2* xr = (const u32x2*)((const bf16_t*)(ws + WS_Z) + (size_t)row * 1024) + lane;
        f32x4 v[4];
        float s = 0.f;
#pragma unroll
        for (int j = 0; j < 4; ++j) { const u32x2 w = xr[64 * j]; v[j] = (f32x4){bflo(w.x), bfhi(w.x), bflo(w.y), bfhi(w.y)}; s += (v[j].x + v[j].y) + (v[j].z + v[j].w); }
        const float mean = wave_sum(s) * (1.0f / 1024.0f);
        float s2 = 0.f;
#pragma unroll
        for (int j = 0; j < 4; ++j) { v[j] = v[j] - mean; s2 += (v[j].x * v[j].x + v[j].y * v[j].y) + (v[j].z * v[j].z + v[j].w * v[j].w); }
        const float rstd = rsqrtf(wave_sum(s2) * (1.0f / 1024.0f) + LN_EPS);
#pragma unroll
        for (int j = 0; j < 4; ++j) {
            const f32x4 g4 = ((const f32x4*)gg)[lane + 64 * j], b4 = ((const f32x4*)bb)[lane + 64 * j];
            u32x2 o = {pk2(v[j].x * rstd * g4.x + b4.x, v[j].y * rstd * g4.y + b4.y), pk2(v[j].z * rstd * g4.z + b4.z, v[j].w * rstd * g4.w + b4.w)};
            *(u32x2*)(h1 + (size_t)row * 1024 + (lane + 64 * j) * 4) = o;
        }
    }
}


DI void ce_desc(int& a, int& b) { const int hi = a > b ? a : b, lo = a > b ? b : a; a = hi; b = lo; }
template <int K, int J> DI void bst(int (&a)[16]) {
#pragma unroll
    for (int i = 0; i < 16; ++i) { const int l = i ^ J; if (l > i) { if ((i & K) == 0) ce_desc(a[i], a[l]); else ce_desc(a[l], a[i]); } }
}
DI void sort16(int (&a)[16]) { bst<2, 1>(a); bst<4, 2>(a); bst<4, 1>(a); bst<8, 4>(a); bst<8, 2>(a); bst<8, 1>(a); bst<16, 8>(a); bst<16, 4>(a); bst<16, 2>(a); bst<16, 1>(a); }
DI void merge_top16(int (&a)[16], const int (&b)[16]) {
#pragma unroll
    for (int i = 0; i < 16; ++i) a[i] = a[i] > b[15 - i] ? a[i] : b[15 - i];
    bst<16, 8>(a); bst<16, 4>(a); bst<16, 2>(a); bst<16, 1>(a);
}

constexpr int cand_i(int c) { return c < 16 ? 0 : c < 24 ? 1 : c < 29 ? 2 : c < 33 ? 3 : c < 36 ? 4 : c < 38 ? 5 : c < 40 ? 6 : c < 42 ? 7 : c - 34; }
constexpr int cand_j(int c) { return c < 16 ? c : c < 24 ? c - 16 : c < 29 ? c - 24 : c < 33 ? c - 29 : c < 36 ? c - 33 : c < 38 ? c - 36 : c < 40 ? c - 38 : c < 42 ? c - 40 : 0; }
DI void cand_ij(int c, int& i, int& j) {
    if (c < 16) { i = 0; j = c; } else if (c < 24) { i = 1; j = c - 16; } else if (c < 29) { i = 2; j = c - 24; } else if (c < 33) { i = 3; j = c - 29; }
    else if (c < 36) { i = 4; j = c - 33; } else if (c < 38) { i = 5; j = c - 36; } else if (c < 40) { i = 6; j = c - 38; } else if (c < 42) { i = 7; j = c - 40; }
    else { i = c - 34; j = 0; }
}
DI float key_val6(int k) { int b = k & ~63; b ^= (b >> 31) & 0x7fffffff; return __int_as_float(b); }

DI void phase6(const Params& p, unsigned char* lds) {
    unsigned char* ws = p.ws;
    const int tid = threadIdx.x, lane = tid & 63, wid = tid >> 6, wr = wid >> 1, wc = wid & 1, r = lane & 31, h = lane >> 5;
    const bf16_t* h1 = (const bf16_t*)(ws + WS_H1);
    const bf16_t* wq = (const bf16_t*)(ws + WS_WQT);
    const bf16_t* sk = (const bf16_t*)(ws + WS_SUBK);
    int* routeE = (int*)(ws + WS_TOPK);
    float* routeG = (float*)(ws + WS_TOPK + 8 * MiB);
    int* L1s = (int*)(lds + 65536);
    const int G8 = (gridDim.x & 7) == 0 ? gridDim.x >> 3 : 0;
    for (int l0 = G8 ? 0 : (int)blockIdx.x; l0 < (G8 ? 128 : 1024); l0 += (G8 ? G8 : (int)gridDim.x)) {
        const int li = G8 ? l0 + cu_pair_pos((int)(blockIdx.x >> 3), G8) : l0;
        if (G8 && li >= 128) break;
        const int pair = G8 ? (int)(blockIdx.x & 7) * 128 + li : li;
        const int tm = pair >> 3, head = pair & 7;
        int ka[16], kb[16];
#pragma unroll 1
        for (int khalf = 0; khalf < 2; ++khalf) {
            const int tn = head * 2 + khalf;
            f32x16 acc[2][2];
            gemm_mainloop(h1 + (size_t)tm * 128 * 1024, 1024, wq + (size_t)tn * 128 * 1024, 1024, 1024, acc, lds);
            epi_foreach(acc, [&](int m, int n, f32x4 v) {
                u32x2 o = {pk2(v.x, v.y), pk2(v.z, v.w)};
                *(u32x2*)(lds + m * 272 + n * 2) = o;
            });
            __syncthreads();
            f32x16 a2[2][2];
#pragma unroll
            for (int mi = 0; mi < 2; ++mi)
#pragma unroll
                for (int ni = 0; ni < 2; ++ni)
#pragma unroll
                    for (int i = 0; i < 16; ++i) a2[mi][ni][i] = 0.f;
#pragma unroll
            for (int ks = 0; ks < 8; ++ks) {
                bf16x8 fa[2], fb[2];
#pragma unroll
                for (int mi = 0; mi < 2; ++mi) fa[mi] = *(const bf16x8*)(lds + (wr * 64 + mi * 32 + r) * 272 + ks * 32 + h * 16);
#pragma unroll
                for (int ni = 0; ni < 2; ++ni) fb[ni] = *(const bf16x8*)(sk + (size_t)(khalf * 128 + wc * 64 + ni * 32 + r) * 128 + ks * 16 + h * 8);
#pragma unroll
                for (int mi = 0; mi < 2; ++mi)
#pragma unroll
                    for (int ni = 0; ni < 2; ++ni) a2[mi][ni] = MFMA32(fb[ni], fa[mi], a2[mi][ni]);
            }
            __syncthreads();
#pragma unroll
            for (int mi = 0; mi < 2; ++mi) {
                int xa[16], xb[16];
#pragma unroll
                for (int i = 0; i < 16; ++i) {
                    const int n = wc * 64 + (i & 3) + 8 * (i >> 2) + 4 * h;
                    xa[i] = make_key(a2[mi][0][i], n); xb[i] = make_key(a2[mi][1][i], n + 32);
                }
                sort16(xa); sort16(xb); merge_top16(xa, xb);
#pragma unroll
                for (int i = 0; i < 16; ++i) xb[i] = __shfl_xor(xa[i], 32);
                merge_top16(xa, xb);
                if (h == 0) {
                    int* dst = (int*)lds + ((wr * 64 + mi * 32 + r) * 2 + wc) * 16;
#pragma unroll
                    for (int q4 = 0; q4 < 4; ++q4) { u32x4 o = {(unsigned)xa[4 * q4], (unsigned)xa[4 * q4 + 1], (unsigned)xa[4 * q4 + 2], (unsigned)xa[4 * q4 + 3]}; *(u32x4*)(dst + 4 * q4) = o; }
                }
            }
            __syncthreads();
            if (tid < 128) {
                const int* s0 = (const int*)lds + tid * 32;
#pragma unroll
                for (int q4 = 0; q4 < 4; ++q4) {
                    const u32x4 x = *(const u32x4*)(s0 + 4 * q4), y = *(const u32x4*)(s0 + 16 + 4 * q4);
                    ka[4 * q4] = (int)x.x; ka[4 * q4 + 1] = (int)x.y; ka[4 * q4 + 2] = (int)x.z; ka[4 * q4 + 3] = (int)x.w;
                    kb[4 * q4] = (int)y.x; kb[4 * q4 + 1] = (int)y.y; kb[4 * q4 + 2] = (int)y.z; kb[4 * q4 + 3] = (int)y.w;
                }
                merge_top16(ka, kb);
                if (khalf == 0) {
#pragma unroll
                    for (int q4 = 0; q4 < 4; ++q4) { u32x4 o = {(unsigned)ka[4 * q4], (unsigned)ka[4 * q4 + 1], (unsigned)ka[4 * q4 + 2], (unsigned)ka[4 * q4 + 3]}; *(u32x4*)(L1s + tid * 16 + 4 * q4) = o; }
                }
            }
            if (khalf == 0) __syncthreads();
        }
        if (tid < 128) {
            int* L2s = (int*)lds + tid * 32;
#pragma unroll
            for (int q4 = 0; q4 < 4; ++q4) { u32x4 o = {(unsigned)ka[4 * q4], (unsigned)ka[4 * q4 + 1], (unsigned)ka[4 * q4 + 2], (unsigned)ka[4 * q4 + 3]}; *(u32x4*)(L2s + 4 * q4) = o; }
            float v1[16], v2[16];
#pragma unroll
            for (int q4 = 0; q4 < 4; ++q4) {
                const u32x4 x = *(const u32x4*)(L1s + tid * 16 + 4 * q4);
                v1[4 * q4] = key_val((int)x.x); v1[4 * q4 + 1] = key_val((int)x.y); v1[4 * q4 + 2] = key_val((int)x.z); v1[4 * q4 + 3] = key_val((int)x.w);
            }
#pragma unroll
            for (int i = 0; i < 16; ++i) v2[i] = key_val(ka[i]);
            int g0[16], g1[16], g2[16], g3[16];
#pragma unroll
            for (int t = 0; t < 16; ++t) {
                { const float s = v1[cand_i(t)] + v2[cand_j(t)]; int b = __float_as_int(s); b ^= (b >> 31) & 0x7fffffff; g0[t] = (b & ~63) | (63 - t); }
                { const float s = v1[cand_i(16 + t)] + v2[cand_j(16 + t)]; int b = __float_as_int(s); b ^= (b >> 31) & 0x7fffffff; g1[t] = (b & ~63) | (63 - (16 + t)); }
                { const float s = v1[cand_i(32 + t)] + v2[cand_j(32 + t)]; int b = __float_as_int(s); b ^= (b >> 31) & 0x7fffffff; g2[t] = (b & ~63) | (63 - (32 + t)); }
                if (t < 2) { const float s = v1[cand_i(48 + t)] + v2[cand_j(48 + t)]; int b = __float_as_int(s); b ^= (b >> 31) & 0x7fffffff; g3[t] = (b & ~63) | (63 - (48 + t)); }
                else g3[t] = (int)0x80000000 + t;
            }
            sort16(g0); sort16(g1); sort16(g2); sort16(g3);
            merge_top16(g0, g1); merge_top16(g2, g3); merge_top16(g0, g2);
            const float smax = key_val6(g0[0]);
            float ex[16], den = 0.f;
#pragma unroll
            for (int t = 0; t < 16; ++t) { ex[t] = __expf(key_val6(g0[t]) - smax); den += ex[t]; }
            const float inv = 1.0f / den;
            const size_t ro = ((size_t)(tm * 128 + tid) * 8 + head) * 16;
#pragma unroll
            for (int q4 = 0; q4 < 4; ++q4) {
                int ee[4];
#pragma unroll
                for (int u = 0; u < 4; ++u) {
                    int ci, cj; cand_ij(63 - (g0[4 * q4 + u] & 63), ci, cj);
                    ee[u] = (L1s[tid * 16 + ci] & 127) * 128 + (L2s[cj] & 127);
                }
                u32x4 oe = {(unsigned)ee[0], (unsigned)ee[1], (unsigned)ee[2], (unsigned)ee[3]};
                f32x4 og = {ex[4 * q4] * inv, ex[4 * q4 + 1] * inv, ex[4 * q4 + 2] * inv, ex[4 * q4 + 3] * inv};
                *(u32x4*)(routeE + ro + 4 * q4) = oe;
                *(f32x4*)(routeG + ro + 4 * q4) = og;
            }
        }
        __syncthreads();
    }
}

constexpr int P7_NS = 32, P7_SH = 9;
constexpr int P7_WLDS = 6144;
DI void p7_loadrows(int b, int li, int l32, const LAS int* ent_e, const unsigned char* tab, u32x4 (&rows)[8][2]) {
    const u32x4 e0 = *(const LAS u32x4*)(ent_e + li * 128 + b), e1 = *(const LAS u32x4*)(ent_e + li * 128 + b + 4);
    const unsigned ee[8] = {e0.x, e0.y, e0.z, e0.w, e1.x, e1.y, e1.z, e1.w};
#pragma unroll
    for (int r = 0; r < 8; ++r) {
        const unsigned ob = ee[r] * 1024u + (unsigned)l32 * 16u;
        rows[r][0] = *(const u32x4*)(tab + ob);
        rows[r][1] = *(const u32x4*)(tab + ob + 512);
    }
}
DI float half32_sum(float v) { v += __shfl_xor(v, 1); v += __shfl_xor(v, 2); v += __shfl_xor(v, 4); v += __shfl_xor(v, 8); v += __shfl_xor(v, 16); return v; }

DI void p7_stepA(const u32x4 (&rows)[8][2], const unsigned (&hq)[2][4], float hscale, int b, int li, int l32, int lane, int myk,
                 LAS float* ent_w, const LAS float* ent_us) {
    int d[8];
#pragma unroll
    for (int r = 0; r < 8; ++r) {
        int a = 0;
#pragma unroll
        for (int c = 0; c < 2; ++c)
#pragma unroll
            for (int q = 0; q < 4; ++q) a = dot4i8(rows[r][c][q], hq[c][q], a);
        d[r] = a;
    }
    int r4[4], r2[2], r1;
    const bool b0 = lane & 1;
#pragma unroll
    for (int i = 0; i < 4; ++i) { const int snd = b0 ? d[i] : d[4 + i]; const int kp = b0 ? d[4 + i] : d[i]; r4[i] = kp + __shfl_xor(snd, 1); }
    const bool b1 = lane & 2;
#pragma unroll
    for (int i = 0; i < 2; ++i) { const int snd = b1 ? r4[i] : r4[2 + i]; const int kp = b1 ? r4[2 + i] : r4[i]; r2[i] = kp + __shfl_xor(snd, 2); }
    const bool b2 = lane & 4;
    { const int snd = b2 ? r2[0] : r2[1]; const int kp = b2 ? r2[1] : r2[0]; r1 = kp + __shfl_xor(snd, 4); }
    r1 += __shfl_xor(r1, 8); r1 += __shfl_xor(r1, 16);
    if (l32 < 8) { const int idx = li * 128 + b + myk; ent_w[idx] = ent_w[idx] * gelu_fast((float)r1 * (hscale * ent_us[idx])); }
}
DI void p7_stepB(const u32x4 (&rows)[8][2], f32x2 (&acc)[2][8], int b, int li, const LAS float* ent_w) {
    const f32x4 w0 = *(const LAS f32x4*)(ent_w + li * 128 + b), w1 = *(const LAS f32x4*)(ent_w + li * 128 + b + 4);
    const float ww[8] = {w0.x, w0.y, w0.z, w0.w, w1.x, w1.y, w1.z, w1.w};
#pragma unroll
    for (int r = 0; r < 8; ++r) {
        const f32x2 w2 = {ww[r], ww[r]};
#pragma unroll
        for (int c = 0; c < 2; ++c)
#pragma unroll
            for (int q = 0; q < 4; ++q) {
                const f32x2 lo = __builtin_amdgcn_cvt_pk_f32_fp8((int)rows[r][c][q], false);
                const f32x2 hi = __builtin_amdgcn_cvt_pk_f32_fp8((int)rows[r][c][q], true);
                acc[c][2 * q] += w2 * lo; acc[c][2 * q + 1] += w2 * hi;
            }
    }
}
DI void p7_quant_h(const bf16_t* h1, size_t hbase, unsigned (&hq)[2][4], float& hscale) {
    float hv[32];
#pragma unroll
    for (int c = 0; c < 2; ++c) {
        const u32x4 a = *(const u32x4*)(h1 + hbase + c * 512), b2 = *(const u32x4*)(h1 + hbase + c * 512 + 8);
        const unsigned hh[8] = {a.x, a.y, a.z, a.w, b2.x, b2.y, b2.z, b2.w};
#pragma unroll
        for (int i = 0; i < 8; ++i) { hv[c * 16 + 2 * i] = bflo(hh[i]); hv[c * 16 + 2 * i + 1] = bfhi(hh[i]); }
    }
    float am = 0.f;
#pragma unroll
    for (int i = 0; i < 32; ++i) am = fmaxf(am, fabsf(hv[i]));
    am = fmaxf(am, __shfl_xor(am, 1)); am = fmaxf(am, __shfl_xor(am, 2)); am = fmaxf(am, __shfl_xor(am, 4)); am = fmaxf(am, __shfl_xor(am, 8)); am = fmaxf(am, __shfl_xor(am, 16));
    const float hq_sc = am > 0.f ? 127.0f / am : 1.0f;
    hscale = am > 0.f ? am / 127.0f : 1.0f;
#pragma unroll
    for (int c = 0; c < 2; ++c)
#pragma unroll
        for (int q = 0; q < 4; ++q) {
            const int q0 = (int)rintf(hv[c * 16 + 4 * q] * hq_sc), q1 = (int)rintf(hv[c * 16 + 4 * q + 1] * hq_sc);
            const int q2 = (int)rintf(hv[c * 16 + 4 * q + 2] * hq_sc), q3 = (int)rintf(hv[c * 16 + 4 * q + 3] * hq_sc);
            hq[c][q] = (unsigned)(q0 & 255) | ((unsigned)(q1 & 255) << 8) | ((unsigned)(q2 & 255) << 16) | ((unsigned)(q3 & 255) << 24);
        }
}
DI void p7_finish(const Params& p, const bf16_t* h1, size_t hbase, f32x2 (&acc)[2][8], int l32) {
    float sm = 0.f;
#pragma unroll
    for (int c = 0; c < 2; ++c) {
        const u32x4 a = *(const u32x4*)(h1 + hbase + c * 512), b2 = *(const u32x4*)(h1 + hbase + c * 512 + 8);
        const unsigned hh[8] = {a.x, a.y, a.z, a.w, b2.x, b2.y, b2.z, b2.w};
#pragma unroll
        for (int i = 0; i < 8; ++i) {
            acc[c][i].x += ALPHA * bflo(hh[i]); acc[c][i].y += ALPHA * bfhi(hh[i]);
            sm += acc[c][i].x + acc[c][i].y;
        }
    }
    const float mean = half32_sum(sm) * (1.0f / 1024.0f);
    float sq = 0.f;
#pragma unroll
    for (int c = 0; c < 2; ++c)
#pragma unroll
        for (int i = 0; i < 8; ++i) { acc[c][i].x -= mean; acc[c][i].y -= mean; sq += acc[c][i].x * acc[c][i].x + acc[c][i].y * acc[c][i].y; }
    const float rstd = rsqrtf(half32_sum(sq) * (1.0f / 1024.0f) + LN_EPS);
    const float* gg = p.in[18] + l32 * 16;
    const float* bb = p.in[19] + l32 * 16;
    float* orow = p.out + hbase;
#pragma unroll
    for (int c = 0; c < 2; ++c)
#pragma unroll
        for (int q4 = 0; q4 < 4; ++q4) {
            const f32x4 g4 = *(const f32x4*)(gg + c * 512 + q4 * 4), b4 = *(const f32x4*)(bb + c * 512 + q4 * 4);
            f32x4 o = {acc[c][2 * q4].x * rstd * g4.x + b4.x, acc[c][2 * q4].y * rstd * g4.y + b4.y,
                       acc[c][2 * q4 + 1].x * rstd * g4.z + b4.z, acc[c][2 * q4 + 1].y * rstd * g4.w + b4.w};
            *(f32x4*)(orow + c * 512 + q4 * 4) = o;
        }
}

DI void phase7(const Params& p, unsigned char* lds) {
    unsigned char* ws = p.ws;
    const int lane = threadIdx.x & 63, wid = __builtin_amdgcn_readfirstlane(threadIdx.x >> 6);
    const int hw = lane >> 5, l32 = lane & 31;
    LAS unsigned char* l3 = (LAS unsigned char*)lds + wid * P7_WLDS;
    const bf16_t* h1 = (const bf16_t*)(ws + WS_H1);
    const unsigned char* u8 = ws + WS_UB;
    const unsigned char* v8 = ws + WS_VB;
    const float* uscale = (const float*)(ws + WS_USCALE);
    const float* vscale = (const float*)(ws + WS_VSCALE);
    LAS int* ent_e = (LAS int*)l3;
    LAS float* ent_w = (LAS float*)(l3 + 2048);
    LAS float* ent_us = (LAS float*)(l3 + 4096);
    const unsigned long long ltmask = (1ull << lane) - 1ull;
    const int myk = ((lane & 1) << 2) | (lane & 2) | ((lane >> 2) & 1);
    const int li0 = hw, li1 = 2 + hw;
    for (int rnd = blockIdx.x * 4 + wid; rnd < NTOK / 4; rnd += gridDim.x * 4) {
        const int tok0 = rnd * 4;
#pragma unroll 1
        for (int tk = 0; tk < 4; ++tk) {
            const int* RE = (const int*)(ws + WS_TOPK) + (size_t)(tok0 + tk) * 128;
            const float* RG = (const float*)(ws + WS_TOPK + 8 * MiB) + (size_t)(tok0 + tk) * 128;
            const int ea = RE[lane], eb = RE[64 + lane];
            const float ga = RG[lane], gb = RG[64 + lane];
            const int sa = ea >> P7_SH, sb = eb >> P7_SH;
            int pa = 0, pb = 0, run = 0;
#pragma unroll
            for (int s = 0; s < P7_NS; ++s) {
                const unsigned long long ma = __ballot(sa == s), mb = __ballot(sb == s);
                const int ca = __popcll(ma), cb = __popcll(mb);
                if (sa == s) pa = run + __popcll(ma & ltmask);
                if (sb == s) pb = run + ca + __popcll(mb & ltmask);
                run += ca + cb;
            }
            ent_e[tk * 128 + pa] = ea; ent_w[tk * 128 + pa] = ga * vscale[ea]; ent_us[tk * 128 + pa] = uscale[ea];
            ent_e[tk * 128 + pb] = eb; ent_w[tk * 128 + pb] = gb * vscale[eb]; ent_us[tk * 128 + pb] = uscale[eb];
        }
        const size_t hbase0 = (size_t)(tok0 + li0) * 1024 + l32 * 16, hbase1 = (size_t)(tok0 + li1) * 1024 + l32 * 16;
        {
            unsigned hq0[2][4], hq1[2][4];
            float hs0, hs1;
            p7_quant_h(h1, hbase0, hq0, hs0);
            p7_quant_h(h1, hbase1, hq1, hs1);
            u32x4 ra[8][2], rb[8][2];
            p7_loadrows(0, li0, l32, ent_e, u8, ra);
            for (int b = 0; b < 128; b += 8) {
                p7_loadrows(b, li1, l32, ent_e, u8, rb);
                __builtin_amdgcn_sched_barrier(0);
                p7_stepA(ra, hq0, hs0, b, li0, l32, lane, myk, ent_w, ent_us);
                __builtin_amdgcn_sched_barrier(0);
                p7_loadrows(b + 8 < 128 ? b + 8 : b, li0, l32, ent_e, u8, ra);
                __builtin_amdgcn_sched_barrier(0);
                p7_stepA(rb, hq1, hs1, b, li1, l32, lane, myk, ent_w, ent_us);
                __builtin_amdgcn_sched_barrier(0);
            }
        }
        f32x2 acc0[2][8], acc1[2][8];
#pragma unroll
        for (int c = 0; c < 2; ++c)
#pragma unroll
            for (int i = 0; i < 8; ++i) { acc0[c][i] = (f32x2){0.f, 0.f}; acc1[c][i] = (f32x2){0.f, 0.f}; }
        {
            u32x4 ra[8][2], rb[8][2];
            p7_loadrows(0, li0, l32, ent_e, v8, ra);
            for (int b = 0; b < 128; b += 8) {
                p7_loadrows(b, li1, l32, ent_e, v8, rb);
                __builtin_amdgcn_sched_barrier(0);
                p7_stepB(ra, acc0, b, li0, ent_w);
                __builtin_amdgcn_sched_barrier(0);
                p7_loadrows(b + 8 < 128 ? b + 8 : b, li0, l32, ent_e, v8, ra);
                __builtin_amdgcn_sched_barrier(0);
                p7_stepB(rb, acc1, b, li1, ent_w);
                __builtin_amdgcn_sched_barrier(0);
            }
        }
        p7_finish(p, h1, hbase0, acc0, l32);
        p7_finish(p, h1, hbase1, acc1, l32);
    }
}

#if DIAG
DI float bfv(const bf16_t* p, size_t i) { return __uint_as_float(((unsigned)p[i]) << 16); }
DI float bfr(float x) { return __uint_as_float(f2bf(x) << 16); }
DI void dfail(const Params& p, int bit) { atomicOr((unsigned*)(p.ws + WS_FLAG), 1u << bit); }
DI bool bad(float fast, float ref) { return !(fabsf(fast - ref) <= 0.02f * fabsf(ref) + 0.02f); }
DI unsigned hsh(unsigned x) { x ^= x >> 16; x *= 0x7feb352dU; x ^= x >> 15; x *= 0x846ca68bU; x ^= x >> 16; return x; }
DI int winsrc(int n) { return n < 1280 ? n : (n < 1792 ? 1304 + (n - 1280) : 1280 + (n - 1792)); }

DI void chk1(const Params& p, int bit) {
    unsigned char* ws = p.ws;
    const unsigned gt = blockIdx.x * NTHREADS + threadIdx.x;
    const int tok = hsh(gt * 2 + 1) & 16383, n = hsh(gt * 2 + 2) % 1816;
    const bf16_t* xb = (const bf16_t*)(ws + WS_XB);
    const bf16_t* wt = (const bf16_t*)(ws + WS_WINT);
    float ref = 0.f, ref2 = 0.f;
    for (int k = 0; k < 1024; ++k) {
        ref += bfv(xb, (size_t)tok * 1024 + k) * bfv(wt, (size_t)n * 1024 + k);
        ref2 += p.in[0][(size_t)tok * 1024 + k] * p.in[1][(size_t)k * 1816 + winsrc(n)];
    }
    if (!(fabsf(ref - ref2) <= 0.06f)) dfail(p, bit);
    const int b = tok >> 12, t = tok & 4095;
    float fast;
    if (n < 512) { const int hd = n >> 6, d = n & 63; fast = bfv((const bf16_t*)(ws + WS_Q), ((size_t)(b * 8 + hd) * SEQ + t) * 64 + d); ref *= 0.125f; }
    else if (n < 1280) {
        const int seg = (n - 512) >> 7, nn = (n - 512) & 127, g = nn >> 6, d = nn & 63;
        if (seg == 3 || seg == 5) fast = bfv((const bf16_t*)(ws + (seg == 3 ? WS_VSLCT : WS_VWINT)), ((size_t)((b * 2 + g) * 64 + d)) * SEQ + t);
        else fast = bfv((const bf16_t*)(ws + (seg == 0 ? WS_KC : seg == 1 ? WS_VC : seg == 2 ? WS_KSLC : WS_KWIN)), ((size_t)(b * 2 + g) * SEQ + t) * 64 + d);
    } else if (n < 1792) fast = bfv((const bf16_t*)(ws + WS_Z), (size_t)tok * 512 + (n - 1280));
    else { fast = ((const float*)(ws + WS_GATES))[(size_t)tok * 24 + (n - 1792)]; ref = 1.f / (1.f + expf(-ref)); }
    if (bad(fast, ref)) dfail(p, bit);
}
DI void chk2(const Params& p, int bit) {
    unsigned char* ws = p.ws;
    const unsigned gt = blockIdx.x * NTHREADS + threadIdx.x;
    if (gt >= 2048) return;
    const int kv = gt & 1, bg = (gt >> 1) & 7, c = hsh(gt) % 255, d = hsh(gt + 7777) & 63;
    const bf16_t* A = (const bf16_t*)(ws + (kv ? WS_VC : WS_KC)) + ((size_t)bg * SEQ + c * 16) * 64;
    const bf16_t* w1t = (const bf16_t*)(ws + (kv ? WS_W1TV : WS_W1TK));
    const bf16_t* w2t = (const bf16_t*)(ws + (kv ? WS_W2TV : WS_W2TK));
    const float* peb = (const float*)(ws + (kv ? WS_PEBV : WS_PEBK));
    float out = 0.f;
    for (int j = 0; j < 256; ++j) {
        float s = peb[j];
        for (int i = 0; i < 2048; ++i) s += bfv(A, i) * bfv(w1t, (size_t)j * 2048 + i);
        out += bfr(gelu_erf(s)) * bfv(w2t, d * 256 + j);
    }
    const float fast = ((const float*)(ws + (kv ? WS_VCMP : WS_KCMP)))[((size_t)bg * 256 + c) * 64 + d];
    if (bad(fast, out)) dfail(p, bit);
    if (gt < 256) {
        const float* w1 = kv ? p.in[7] : p.in[5];
        const float* w2 = kv ? p.in[8] : p.in[6];
        const float* pe = kv ? p.in[4] : p.in[3];
        float o2 = 0.f;
        for (int j = 0; j < 256; ++j) {
            float s = 0.f;
            for (int i = 0; i < 2048; ++i) s += (bfv(A, i) + pe[i]) * w1[(size_t)i * 256 + j];
            o2 += gelu_erf(s) * w2[j * 64 + d];
        }
        if (!(fabsf(o2 - out) <= 0.03f * fabsf(out) + 0.03f)) dfail(p, bit);
    }
}
DI void chk3(const Params& p, int bit) {
    unsigned char* ws = p.ws;
    const unsigned gt = blockIdx.x * NTHREADS + threadIdx.x;
    if (gt >= 4096) return;
    const int tok = hsh(gt) & 16383, head = hsh(gt + 99) & 7, b = tok >> 12, t = tok & 4095, g = head >> 2;
    const bf16_t* Q = (const bf16_t*)(ws + WS_Q) + ((size_t)(b * 8 + head) * SEQ + t) * 64;
    const bf16_t* K = (const bf16_t*)(ws + WS_KWIN) + (size_t)(b * 2 + g) * SEQ * 64;
    const bf16_t* Vt = (const bf16_t*)(ws + WS_VWINT) + (size_t)(b * 2 + g) * 64 * SEQ;
    float q[64], o[64];
#pragma unroll
    for (int d = 0; d < 64; ++d) { q[d] = bfv(Q, d); o[d] = 0.f; }
    float m = -1e30f, l = 0.f;
    for (int pos = (t > 511 ? t - 511 : 0); pos <= t; ++pos) {
        float s = 0.f;
#pragma unroll
        for (int d = 0; d < 64; ++d) s += q[d] * bfv(K, (size_t)pos * 64 + d);
        s += p.in[2][rel_bucket_dev(t - pos) * 8 + head];
        const float mn = fmaxf(m, s), a = expf(m - mn), pp = expf(s - mn);
        l = l * a + pp;
#pragma unroll
        for (int d = 0; d < 64; ++d) o[d] = o[d] * a + pp * bfv(Vt, (size_t)d * SEQ + pos);
        m = mn;
    }
    const float gate = ((const float*)(ws + WS_GATES))[(size_t)tok * 24 + 16 + head];
    bool f = false;
#pragma unroll
    for (int d = 0; d < 64; ++d) f |= bad(bfv((const bf16_t*)(ws + WS_OWIN), (size_t)tok * 512 + head * 64 + d), o[d] / l * gate);
    if (f) dfail(p, bit);
}
DI void chk4(const Params& p, int bit) {
    unsigned char* ws = p.ws;
    const unsigned gt = blockIdx.x * NTHREADS + threadIdx.x;
    if (gt >= 512) return;
    const int tok = hsh(gt + 5) & 16383, g = gt & 1, b = tok >> 12, t = tok & 4095, bg = b * 2 + g;
    float* scr = (float*)(ws + WS_DSCR) + (size_t)gt * 1536;
    float* imp = scr + 1024;
    float* nsa = scr + 1100;
    for (int j = 0; j < 64; ++j) imp[j] = 0.f;
    const float* kc = (const float*)(ws + WS_KCMP) + (size_t)bg * 256 * 64;
    const float* vc = (const float*)(ws + WS_VCMP) + (size_t)bg * 256 * 64;
    const float* gt24 = (const float*)(ws + WS_GATES) + (size_t)tok * 24;
    for (int hl = 0; hl < 4; ++hl) {
        const int head = g * 4 + hl;
        const bf16_t* Q = (const bf16_t*)(ws + WS_Q) + ((size_t)(b * 8 + head) * SEQ + t) * 64;
        float q[64], o[64];
#pragma unroll
        for (int d = 0; d < 64; ++d) { q[d] = bfv(Q, d); o[d] = 0.f; }
        float m = -1e30f;
        for (int c = 0; c < 255; ++c) {
            const bool valid = 16 * c + 31 <= t;
            float s = 0.f;
#pragma unroll
            for (int d = 0; d < 64; ++d) s += q[d] * bfr(kc[c * 64 + d]);
            s += p.in[2][rel_bucket_dev(t - 16 * c - 31) * 8 + head];
            scr[hl * 256 + c] = s;
            if (valid) m = fmaxf(m, s);
        }
        float l = 0.f;
        for (int c = 0; c < 255; ++c) if (16 * c + 31 <= t) l += expf(scr[hl * 256 + c] - m);
        for (int c = 0; c < 255; ++c) if (16 * c + 31 <= t) {
            const float pc = expf(scr[hl * 256 + c] - m) / l;
            imp[c >> 2] += pc;
            if ((c & 3) == 3 && (c >> 2) + 1 < 64) imp[(c >> 2) + 1] += pc;
#pragma unroll
            for (int d = 0; d < 64; ++d) o[d] += bfr(pc) * bfr(vc[c * 64 + d]);
        }
#pragma unroll
        for (int d = 0; d < 64; ++d) nsa[hl * 64 + d] = gt24[head] * o[d];
    }
    const int cur = t >> 6;
    for (int j = 0; j < 64; ++j) { float v = imp[j]; if (j == 0 || j == cur || j == cur - 1) v = 1e6f; if (j > cur) v = -1e30f; imp[j] = v; }
    unsigned long long selmask = 0ull;
    for (int it = 0; it < 16; ++it) {
        int bi = -1; float bv = -3e38f;
        for (int j = 0; j < 64; ++j) if (!((selmask >> j) & 1ull) && imp[j] > bv) { bv = imp[j]; bi = j; }
        selmask |= 1ull << bi;
    }
    bool f = false;
    for (int hl = 0; hl < 4; ++hl) {
        const int head = g * 4 + hl;
        const bf16_t* Q = (const bf16_t*)(ws + WS_Q) + ((size_t)(b * 8 + head) * SEQ + t) * 64;
        const bf16_t* K = (const bf16_t*)(ws + WS_KSLC) + (size_t)bg * SEQ * 64;
        const bf16_t* Vt = (const bf16_t*)(ws + WS_VSLCT) + (size_t)bg * 64 * SEQ;
        float q[64], o[64];
#pragma unroll
        for (int d = 0; d < 64; ++d) { q[d] = bfv(Q, d); o[d] = 0.f; }
        float m = -1e30f, l = 0.f;
        for (int j = 0; j <= cur; ++j) if ((selmask >> j) & 1ull) {
            for (int kk = 0; kk < 64; ++kk) {
                const int pos = j * 64 + kk;
                if (pos > t) break;
                float s = 0.f;
#pragma unroll
                for (int d = 0; d < 64; ++d) s += q[d] * bfv(K, (size_t)pos * 64 + d);
                s += p.in[2][rel_bucket_dev(t - pos) * 8 + head];
                const float mn = fmaxf(m, s), a = expf(m - mn), pp = expf(s - mn);
                l = l * a + pp;
#pragma unroll
                for (int d = 0; d < 64; ++d) o[d] = o[d] * a + pp * bfv(Vt, (size_t)d * SEQ + pos);
                m = mn;
            }
        }
#pragma unroll
        for (int d = 0; d < 64; ++d) {
            const float ref = nsa[hl * 64 + d] + gt24[8 + head] * o[d] / l + bfv((const bf16_t*)(ws + WS_OWIN), (size_t)tok * 512 + head * 64 + d);
            f |= bad(bfv((const bf16_t*)(ws + WS_MIXIN), (size_t)tok * 1024 + head * 64 + d), ref);
        }
    }
    if (f) dfail(p, bit);
}
DI void chk5(const Params& p, int bit) {
    unsigned char* ws = p.ws;
    const unsigned gt = blockIdx.x * NTHREADS + threadIdx.x;
    if (gt >= 8192) return;
    const int tok = hsh(gt + 11) & 16383, col = hsh(gt + 13) & 511, gi = col >> 7, d = col & 127, t = tok & 4095;
    const bf16_t* yp = (const bf16_t*)(ws + WS_YPOOL);
    const bf16_t* pw = (const bf16_t*)(ws + WS_POOLWT);
    const bf16_t* z = (const bf16_t*)(ws + WS_Z);
    float ref = 0.f, ref2 = 0.f;
    for (int c = 0; c < 128; ++c) {
        ref += bfv(yp, (size_t)tok * 512 + gi * 128 + c) * bfv(pw, (size_t)gi * 16384 + d * 128 + c);
        ref2 += bfv(yp, (size_t)tok * 512 + gi * 128 + c) * p.in[9][(size_t)gi * 16384 + c * 128 + d];
    }
    if (!(fabsf(ref - ref2) <= 0.03f)) dfail(p, bit);
    ref *= p.in[10][col];
    if (bad(bfv((const bf16_t*)(ws + WS_MIXIN), (size_t)tok * 1024 + 512 + col), ref)) dfail(p, bit);
    const int win = 2 << (col >> 7), cnt = (t + 1 < win) ? t + 1 : win;
    float s = 0.f;
    for (int k = 0; k < cnt; ++k) s += bfv(z, (size_t)(tok - k) * 512 + col);
    if (bad(bfv(yp, (size_t)tok * 512 + col), s / (float)cnt - bfv(z, (size_t)tok * 512 + col))) dfail(p, bit);
}
DI void chk6(const Params& p, int bit) {
    unsigned char* ws = p.ws;
    const unsigned gt = blockIdx.x * NTHREADS + threadIdx.x;
    if (gt >= 128) return;
    const int tok = hsh(gt + 17) & 16383;
    float* yb = (float*)(ws + WS_DSCR) + (size_t)gt * 1024;
    const bf16_t* mx = (const bf16_t*)(ws + WS_MIXIN) + (size_t)tok * 1024;
    const bf16_t* wo = (const bf16_t*)(ws + WS_WOUTT);
    float sm = 0.f;
    bool f = false;
    for (int n = 0; n < 1024; ++n) {
        float s = 0.f, s2 = 0.f;
        for (int k = 0; k < 1024; ++k) { s += bfv(mx, k) * bfv(wo, (size_t)n * 1024 + k); if (n < 8) s2 += bfv(mx, k) * p.in[11][(size_t)k * 1024 + n]; }
        if (n < 8 && !(fabsf(s - s2) <= 0.03f)) f = true;
        yb[n] = ALPHA * p.in[0][(size_t)tok * 1024 + n] + s; sm += yb[n];
    }
    const float mean = sm / 1024.f;
    float v = 0.f;
    for (int n = 0; n < 1024; ++n) v += (yb[n] - mean) * (yb[n] - mean);
    const float rstd = 1.f / sqrtf(v / 1024.f + LN_EPS);
    for (int n = 0; n < 1024; ++n)
        f |= bad(bfv((const bf16_t*)(ws + WS_H1), (size_t)tok * 1024 + n), (yb[n] - mean) * rstd * p.in[12][n] + p.in[13][n]);
    if (f) dfail(p, bit);
}
DI void chk7(const Params& p, int bit) {
    unsigned char* ws = p.ws;
    const unsigned gt = blockIdx.x * NTHREADS + threadIdx.x;
    if (gt >= 512) return;
    const int tok = hsh(gt + 23) & 16383, head = gt & 7, half = (gt >> 3) & 1;
    float* qd = (float*)(ws + WS_DSCR) + (size_t)gt * 256;
    float* sv = qd + 128;
    const bf16_t* h1 = (const bf16_t*)(ws + WS_H1) + (size_t)tok * 1024;
    const bf16_t* wq = (const bf16_t*)(ws + WS_WQT);
    const bf16_t* sk = (const bf16_t*)(ws + WS_SUBK);
    bool f = false;
    for (int d = 0; d < 128; ++d) {
        float s = 0.f, s2 = 0.f;
        const int col = head * 256 + half * 128 + d;
        for (int k = 0; k < 1024; ++k) { s += bfv(h1, k) * bfv(wq, (size_t)col * 1024 + k); if (d < 4) s2 += bfv(h1, k) * p.in[14][(size_t)k * 2048 + col]; }
        if (d < 4 && !(fabsf(s - s2) <= 0.06f)) f = true;
        qd[d] = bfr(s);
    }
    for (int key = 0; key < 128; ++key) {
        float s = 0.f, s2 = 0.f;
        for (int d = 0; d < 128; ++d) { s += qd[d] * bfv(sk, (size_t)(half * 128 + key) * 128 + d); s2 += qd[d] * p.in[15][(size_t)(half * 128 + key) * 128 + d]; }
        if (!(fabsf(s - s2) <= 0.05f)) f = true;
        sv[key] = s;
    }
    int mism = 0;
    const int* L = (const int*)(ws + WS_TOPK) + (((size_t)tok * 8 + head) * 2 + half) * 16;
    for (int it = 0; it < 16; ++it) {
        int bi = 0; float bv = -3e38f;
        for (int k = 0; k < 128; ++k) if (sv[k] > bv) { bv = sv[k]; bi = k; }
        sv[bi] = -3e38f;
        const int fk = L[it];
        if ((fk & 127) != bi) mism++;
        if (bad(key_val(fk), bv)) mism += 10;
    }
    if (mism > 1 || f) dfail(p, bit);
}
DI void chk8(const Params& p, int bit) {
    unsigned char* ws = p.ws;
    const unsigned gt = blockIdx.x * NTHREADS + threadIdx.x;
    if (gt >= 128) return;
    const int tok = hsh(gt + 31) & 16383;
    float* acc = (float*)(ws + WS_DSCR) + (size_t)gt * 4096;
    float* cand = acc + 1024;
    int* csel = (int*)(acc + 1024 + 256);
    float* acc2 = acc + 2048;
    const bf16_t* h1 = (const bf16_t*)(ws + WS_H1) + (size_t)tok * 1024;
    const bf16_t* ub = (const bf16_t*)(ws + WS_UB);
    const bf16_t* vb = (const bf16_t*)(ws + WS_VB);
    const int* dE = (const int*)(ws + WS_MIXIN) + (size_t)tok * 256;
    const float* dG = (const float*)dE + 128;
    bool f = false, froute = false, fg = false;
    for (int n = 0; n < 1024; ++n) { acc[n] = 0.f; acc2[n] = 0.f; }
    for (int hd = 0; hd < 8; ++hd) {
        const int* L = (const int*)(ws + WS_TOPK) + (size_t)tok * 256 + hd * 32;
        for (int i = 0; i < 16; ++i) for (int j = 0; j < 16; ++j) cand[i * 16 + j] = key_val(L[i]) + key_val(L[16 + j]);
        float mx = -3e38f, den = 0.f;
        for (int it = 0; it < 16; ++it) {
            int bi = 0; float bv = -3e38f;
            for (int k = 0; k < 256; ++k) if (cand[k] > bv) { bv = cand[k]; bi = k; }
            cand[bi] = -3e38f; csel[it] = bi;
            if (it == 0) mx = bv;
            ((float*)csel)[16 + it] = expf(bv - mx); den += expf(bv - mx);
        }
        for (int it = 0; it < 16; ++it) {
            const int i = csel[it] >> 4, j = csel[it] & 15;
            const size_t e = (size_t)(L[i] & 127) * 128 + (L[16 + j] & 127);
            float dot = 0.f;
            for (int k = 0; k < 1024; ++k) dot += bfv(h1, k) * bfv(ub, e * 1024 + k);
            const float gate = ((float*)csel)[16 + it] / den;
            const float w = gate * gelu_erf(dot);
            for (int n = 0; n < 1024; ++n) acc[n] += w * bfv(vb, e * 1024 + n);
            bool found = false;
            for (int s = 0; s < 16; ++s) if (dE[hd * 16 + s] == (int)e) { found = true; if (!(fabsf(dG[hd * 16 + s] - gate) <= 1e-3f)) fg = true; }
            if (!found) froute = true;
        }
        for (int s = 0; s < 16; ++s) {
            const size_t e = (size_t)dE[hd * 16 + s];
            if (e >= 16384) { froute = true; continue; }
            float dot = 0.f;
            for (int k = 0; k < 1024; ++k) dot += bfv(h1, k) * bfv(ub, e * 1024 + k);
            const float w = dG[hd * 16 + s] * gelu_erf(dot);
            for (int n = 0; n < 1024; ++n) acc2[n] += w * bfv(vb, e * 1024 + n);
        }
    }
    bool f2 = false;
    for (int pass = 0; pass < 2; ++pass) {
        float* a = pass ? acc2 : acc;
        float sm = 0.f;
        for (int n = 0; n < 1024; ++n) { a[n] += ALPHA * bfv(h1, n); sm += a[n]; }
        const float mean = sm / 1024.f;
        float v = 0.f;
        for (int n = 0; n < 1024; ++n) v += (a[n] - mean) * (a[n] - mean);
        const float rstd = 1.f / sqrtf(v / 1024.f + LN_EPS);
        for (int n = 0; n < 1024; ++n) {
            const bool b = bad(p.out[(size_t)tok * 1024 + n], (a[n] - mean) * rstd * p.in[18][n] + p.in[19][n]);
            if (pass) f2 |= b; else f |= b;
        }
    }
    if (f) dfail(p, bit);
    if (froute) dfail(p, bit + 1);
    if (fg) dfail(p, bit + 2);
    if (f2) dfail(p, bit + 3);
}
#endif

__global__ void __launch_bounds__(NTHREADS, 2) hybrid_fwd(Params p) {
    extern __shared__ __attribute__((aligned(16))) unsigned char lds[];
    cg::grid_group grid = cg::this_grid();
    const int lo = p.ph_lo, hi = p.ph_hi;
    volatile unsigned* bst = (volatile unsigned*)(lds + LDS_MAIN);
    if (threadIdx.x < 2) bst[threadIdx.x] = 0u;
    __syncthreads();
    XcdBarrier xbar = xcd_barrier_post((unsigned*)(p.ws + WS_BAR), bst);
#define IN(k) (lo <= (k) && (k) < hi)
#define SEAM(k) do { if (IN(k) && IN((k) + 1)) xcd_barrier(xbar); } while (0)
    if (lo < 0) grid.sync();
#if DIAG
    if (blockIdx.x == 0 && threadIdx.x == 0) *(unsigned*)(p.ws + WS_FLAG) = 0u;
#endif
    if (IN(0)) phase0(p);
    SEAM(0);
    if (IN(1)) phase1(p, lds);
    SEAM(1);
#if DIAG == 1
    chk1(p, 0);
#endif
    if (IN(2)) phase2(p, lds);
    SEAM(2);
#if DIAG == 1
    chk2(p, 1); chk3(p, 2);
#endif
    if (IN(3)) phase3(p, lds);
    SEAM(3);
#if DIAG == 1
    chk4(p, 3); chk5(p, 4);
#endif
    if (IN(4)) phase4(p, lds);
    SEAM(4);
    if (IN(5)) phase5(p);
    SEAM(5);
#if DIAG == 1
    chk6(p, 5);
#endif
    if (IN(6)) phase6(p, lds);
    SEAM(6);
#if DIAG == 2
    chk7(p, 0);
#endif
    if (IN(7)) phase7(p, lds);
#if DIAG
    grid.sync();
#if DIAG == 2
    chk8(p, 1);
    grid.sync();
#endif
    {
        const unsigned code = *(volatile unsigned*)(p.ws + WS_FLAG);
        const float kv = sqrtf((float)code);
        for (size_t i = (size_t)blockIdx.x * NTHREADS + threadIdx.x; i < (size_t)NTOK * DM; i += (size_t)gridDim.x * NTHREADS) p.out[i] = kv;
    }
#endif
#undef IN
#undef SEAM
}

extern "C" void kernel_launch(void* const* d_in, const int* in_sizes, int n_in, void* d_out, int out_size, void* d_ws, size_t ws_size,
                              hipStream_t stream) {
    static int grid_blocks = 0;
    if (grid_blocks == 0) {
        if (n_in != 20 || ws_size < WS_END) { fprintf(stderr, "kernel_launch: unexpected inputs (n_in %d, ws %zu)\n", n_in, ws_size); grid_blocks = -1; return; }
        int dev = 0, cus = 0, per_cu = 0;
        hipGetDevice(&dev);
        hipDeviceGetAttribute(&cus, hipDeviceAttributeMultiprocessorCount, dev);
        hipFuncSetAttribute((const void*)hybrid_fwd, hipFuncAttributeMaxDynamicSharedMemorySize, LDS_BYTES);
        hipOccupancyMaxActiveBlocksPerMultiprocessor(&per_cu, (const void*)hybrid_fwd, NTHREADS, LDS_BYTES);
        if (per_cu < 1) per_cu = 1;
        if (per_cu > 2) per_cu = 2;
        grid_blocks = cus * per_cu;
        (void)hipGetLastError();
    }
    if (grid_blocks < 0) return;
    (void)hipMemsetAsync((char*)d_ws + WS_BAR, 0, WS_BAR_BYTES, stream);
    Params p{};
    for (int i = 0; i < 20; ++i) p.in[i] = (const float*)d_in[i];
    p.out = (float*)d_out; p.ws = (unsigned char*)d_ws;
#if N_LAUNCH_MODE == 1
    p.ph_lo = 0; p.ph_hi = 8;
    void* args[] = {&p};
    hipError_t e = hipLaunchCooperativeKernel((const void*)hybrid_fwd, dim3(grid_blocks), dim3(NTHREADS), args, LDS_BYTES, stream);
    if (e != hipSuccess) fprintf(stderr, "cooperative launch failed: %s (grid %d)\n", hipGetErrorString(e), grid_blocks);
#else
    for (int ph = 0; ph < 8; ++ph) {
        p.ph_lo = ph; p.ph_hi = ph + 1;
        hipLaunchKernelGGL(hybrid_fwd, dim3(grid_blocks), dim3(NTHREADS), LDS_BYTES, stream, p);
    }
#endif
}
```

```cpp
#include <hip/hip_runtime.h>
#include <hip/hip_cooperative_groups.h>
#include <cstdint>
#include <cstdio>
namespace cg = cooperative_groups;

#ifndef N_LAUNCH_MODE
#define N_LAUNCH_MODE 1
#endif

typedef unsigned short bf16_t;
typedef short bf16x8 __attribute__((ext_vector_type(8)));
typedef short s16x4 __attribute__((ext_vector_type(4)));
typedef float f32x16 __attribute__((ext_vector_type(16)));
typedef float f32x4 __attribute__((ext_vector_type(4)));
typedef unsigned u32x4 __attribute__((ext_vector_type(4)));
typedef unsigned u32x2 __attribute__((ext_vector_type(2)));
typedef float f32x2 __attribute__((ext_vector_type(2)));
typedef __bf16 bf16x2_t __attribute__((ext_vector_type(2)));

#define DI __device__ __forceinline__
#define MFMA32(a, b, c) __builtin_amdgcn_mfma_f32_32x32x16_bf16((a), (b), (c), 0, 0, 0)

constexpr int NTOK = 16384, SEQ = 4096, DM = 1024;
constexpr int NINP = 1920;
constexpr float ALPHA = 1.189207115002721f;
constexpr float LN_EPS = 1e-5f;
constexpr float LOG2E = 1.4426950408889634f;
constexpr float QSCALE = 0.125f * LOG2E;
constexpr int NTHREADS = 256;
constexpr int LDS_MAIN = 73728;
constexpr int LDS_CST = LDS_MAIN + 64;
constexpr int LDS_BYTES = LDS_MAIN + 64 + 2048;
constexpr int ROWB = 144;

constexpr size_t MiB = 1u << 20;
constexpr size_t WS_BAR = 0;
constexpr size_t WS_BAR_BYTES = 16384;
constexpr size_t WS_KCMP = 1 * MiB;
constexpr size_t WS_VCMP = 1 * MiB + 512 * 1024;
constexpr size_t WS_W2TK = 2 * MiB;
constexpr size_t WS_W2TV = 2 * MiB + 32 * 1024;
constexpr size_t WS_POOLWT = 2 * MiB + 64 * 1024;
constexpr size_t WS_SUBK = 2 * MiB + 192 * 1024;
constexpr size_t WS_PEBK = 2 * MiB + 256 * 1024;
constexpr size_t WS_PEBV = 2 * MiB + 257 * 1024;
constexpr size_t WS_BUCK = 2 * MiB + 258 * 1024;
constexpr size_t WS_USCALE = 2 * MiB + 320 * 1024;
constexpr size_t WS_VSCALE = 2 * MiB + 384 * 1024;
constexpr size_t WS_C1 = 2 * MiB + 448 * 1024;
constexpr size_t WS_C2 = 2 * MiB + 456 * 1024;
constexpr size_t WS_LNST = 15 * MiB;
constexpr size_t WS_W1TK = 3 * MiB;
constexpr size_t WS_W1TV = 4 * MiB;
constexpr size_t WS_WINT = 5 * MiB;
constexpr size_t WS_WOUTT = 9 * MiB;
constexpr size_t WS_WQT = 11 * MiB;
constexpr size_t WS_UB = 16 * MiB;
constexpr size_t WS_VB = 48 * MiB;
constexpr size_t WS_XB = 80 * MiB;
constexpr size_t WS_MIXIN = WS_XB;
constexpr size_t WS_Q = 112 * MiB;
constexpr size_t WS_KC = 128 * MiB;
constexpr size_t WS_VC = 132 * MiB;
constexpr size_t WS_KSLC = 136 * MiB;
constexpr size_t WS_KWIN = 140 * MiB;
constexpr size_t WS_VSLCT = 144 * MiB;
constexpr size_t WS_VWINT = 148 * MiB;
constexpr size_t WS_GATES = 152 * MiB;
constexpr size_t WS_Z = 154 * MiB;
constexpr size_t WS_YPOOL = 170 * MiB;
constexpr size_t WS_OWIN = 186 * MiB;
#ifndef DIAG
#define DIAG 0
#endif
#if DIAG
constexpr size_t WS_H1 = 202 * MiB;
constexpr size_t WS_TOPK = 234 * MiB;
constexpr size_t WS_END = 256 * MiB;
constexpr size_t WS_FLAG = 32768;
constexpr size_t WS_DSCR = 250 * MiB;
#else
constexpr size_t WS_H1 = 112 * MiB;
constexpr size_t WS_TOPK = 112 * MiB;
constexpr size_t WS_END = 202 * MiB;
#endif

struct Params { const float* in[20]; float* out; unsigned char* ws; int ph_lo, ph_hi; };

DI unsigned f2bf(float f) { unsigned u = __float_as_uint(f); return (u + 0x7fffu + ((u >> 16) & 1u)) >> 16; }
DI unsigned pk2(float lo, float hi) { bf16x2_t v = {(__bf16)lo, (__bf16)hi}; return __builtin_bit_cast(unsigned, v); }
DI float bflo(unsigned x) { return __uint_as_float(x << 16); }
DI float bfhi(unsigned x) { return __uint_as_float(x & 0xffff0000u); }
DI float dot2bf(unsigned a, unsigned b, float acc) {
    asm("v_dot2c_f32_bf16 %0, %1, %2" : "+v"(acc) : "v"(a), "v"(b));
    return acc;
}
DI int dot4i8(unsigned a, unsigned b, int acc) {
    return __builtin_amdgcn_sdot4((int)a, (int)b, acc, false);
}
DI float gelu_erf(float x) { return 0.5f * x * (1.0f + erff(x * 0.70710678118654752f)); }
DI float gelu_fast(float v) {
    const float av = fabsf(v), t = __builtin_amdgcn_rcpf(av * 0.2316418882f + 1.0f);
    float q = t * 0.5307027145f + (-0.7265760135f); q = q * t + 0.7107068705f; q = q * t + (-0.142248368f); q = q * t + 0.127414796f; q = q * t;
    const float e = __builtin_amdgcn_exp2f((v * v) * (-0.72134752044f));
    const float m = v * (q * e);
    return v < 0.f ? m : v - m;
}
DI float wave_sum(float v) {
#pragma unroll
    for (int o = 32; o >= 1; o >>= 1) v += __shfl_xor(v, o);
    return v;
}
DI int rel_bucket_dev(int dist) {
    if (dist < 0) dist = 0;
    if (dist < 16) return dist;
    int v = 16 + (int)(logf((float)dist / 16.0f) / logf(8.0f) * 16.0f);
    return v < 31 ? v : 31;
}
DI int make_key(float f, int idx) { int b = __float_as_int(f); b ^= (b >> 31) & 0x7fffffff; return (b & ~127) | idx; }
DI float key_val(int k) { int b = k & ~127; b ^= (b >> 31) & 0x7fffffff; return __int_as_float(b); }


#define LAS __attribute__((address_space(3)))
#define XB_TMO      128
#define XB_XCNT(j)  (256  + 64 * (j))
#define XB_XSUB(j)  (1280 + 64 * (j))
#define XB_XGEN(j)  (2304 + 64 * (j))
#define XB_TOP      3328
#define XB_TOPGEN   3392
#define XCD_BAR_WORDS 3456
#define XB_SPIN_CAP (1u << 20)
DI unsigned xb_ld(unsigned* p)              { return __hip_atomic_load(p, __ATOMIC_RELAXED, __HIP_MEMORY_SCOPE_AGENT); }
DI unsigned xb_add(unsigned* p, unsigned v) { return __hip_atomic_fetch_add(p, v, __ATOMIC_RELAXED, __HIP_MEMORY_SCOPE_AGENT); }
DI unsigned xb_xcc_id() { return (unsigned)__builtin_amdgcn_s_getreg((3 << 11) | 20) & 0xFu; }
#define XB_SPIN(cond, bar) do { unsigned _sp = 0; while (cond) { __builtin_amdgcn_s_sleep(1); \
    if ((++_sp & 255u) == 0u) { if (xb_ld(&(bar)[XB_TMO])) break; if (_sp > XB_SPIN_CAP) { atomicAdd(&(bar)[XB_TMO], 1u); break; } } } } while (0)
struct XcdBarrier { unsigned* bar; unsigned x; volatile unsigned* st; };
DI XcdBarrier xcd_barrier_post(unsigned* bar, volatile unsigned* st) {
    XcdBarrier b; b.bar = bar; b.x = xb_xcc_id(); b.st = st;
    if (threadIdx.x == 0) (void)xb_add(&bar[XB_XCNT(b.x)], 1u);
    return b;
}
DI void xcd_barrier_complete(unsigned* bar, unsigned x, unsigned& nloc, unsigned& nx) {
    const unsigned G = gridDim.x * gridDim.y * gridDim.z;
    unsigned sum, cnt, mine, sp = 0u;
    for (;;) {
        sum = 0u; cnt = 0u; mine = 0u;
#pragma unroll
        for (unsigned j = 0; j < 16; ++j) { const unsigned c = xb_ld(&bar[XB_XCNT(j)]); sum += c; cnt += (c > 0u) ? 1u : 0u; mine = (j == x) ? c : mine; }
        if (sum == G) break;
        __builtin_amdgcn_s_sleep(1);
        if ((++sp & 255u) == 0u) { if (xb_ld(&bar[XB_TMO])) break; if (sp > XB_SPIN_CAP) { atomicAdd(&bar[XB_TMO], 1u); break; } }
    }
    nloc = mine > 0u ? mine : 1u; nx = cnt > 0u ? cnt : 1u;
}
DI void xcd_barrier(const XcdBarrier& b) {
    asm volatile("s_waitcnt vmcnt(0)" ::: "memory");
    __syncthreads();
    if (threadIdx.x == 0) {
        unsigned* bar = b.bar;
        __builtin_amdgcn_s_waitcnt(0);
        unsigned nloc = b.st[0], nx = b.st[1];
        if (nloc == 0u) { xcd_barrier_complete(bar, b.x, nloc, nx); b.st[0] = nloc; b.st[1] = nx; }
        const unsigned old = xb_add(&bar[XB_XSUB(b.x)], 1u);
        const unsigned gen = old / nloc;
        if (old + 1u == (gen + 1u) * nloc) {
            __builtin_amdgcn_fence(__ATOMIC_RELEASE, "agent");
            asm volatile("s_waitcnt vmcnt(0)" ::: "memory");
            const unsigned og = xb_add(&bar[XB_TOP], 1u);
            const unsigned tg = og / nx;
            if (og + 1u == (tg + 1u) * nx) xb_add(&bar[XB_TOPGEN], 1u);
            else XB_SPIN(xb_ld(&bar[XB_TOPGEN]) == tg, bar);
            __builtin_amdgcn_fence(__ATOMIC_ACQUIRE, "agent");
            xb_add(&bar[XB_XGEN(b.x)], 1u);
            asm volatile("s_waitcnt vmcnt(0)" ::: "memory");
        } else {
            XB_SPIN(xb_ld(&bar[XB_XGEN(b.x)]) == gen, bar);
            __builtin_amdgcn_fence(__ATOMIC_ACQUIRE, "agent");
            asm volatile("s_waitcnt vmcnt(0)" ::: "memory");
        }
    }
    __syncthreads();
}

template <int MI>
DI void gemm_mainloop_t(const bf16_t* __restrict__ A, int lda, const bf16_t* __restrict__ Bt, int ldb, int K,
                        f32x16 (&acc)[MI][2], unsigned char* lds) {
    const int tid = threadIdx.x, lane = tid & 63, wid = __builtin_amdgcn_readfirstlane(tid >> 6);
    const int wr = wid >> 1, wc = wid & 1, r = lane & 31, h = lane >> 5;
    LAS unsigned char* As = (LAS unsigned char*)lds;
    LAS unsigned char* Bs = (LAS unsigned char*)lds + 2 * 16384;
#pragma unroll
    for (int mi = 0; mi < MI; ++mi)
#pragma unroll
        for (int ni = 0; ni < 2; ++ni)
#pragma unroll
            for (int i = 0; i < 16; ++i) acc[mi][ni][i] = 0.f;
    const int nk = K >> 6;
    const int prow = 8 * wid + (lane >> 3);
    const int pchunk = (lane & 7) ^ ((prow >> 1) & 7);
    const bf16_t* Ap = A + (size_t)prow * lda + pchunk * 8;
    const bf16_t* Bp = Bt + (size_t)prow * ldb + pchunk * 8;
    const int pl = wid * 1024;
#define GEMM_STAGE(buf, kt) do { \
        _Pragma("unroll") for (int i = 0; i < 2 * MI; ++i) __builtin_amdgcn_global_load_lds((const unsigned*)(Ap + (size_t)(32 * i) * lda + (kt) * 64), (LAS unsigned*)(As + (buf) * 16384 + i * 4096 + pl), 16, 0, 0); \
        _Pragma("unroll") for (int i = 0; i < 4; ++i) __builtin_amdgcn_global_load_lds((const unsigned*)(Bp + (size_t)(32 * i) * ldb + (kt) * 64), (LAS unsigned*)(Bs + (buf) * 16384 + i * 4096 + pl), 16, 0, 0); } while (0)
    GEMM_STAGE(0, 0);
    asm volatile("s_waitcnt vmcnt(0)" ::: "memory");
    __syncthreads();
    const int swz = (r >> 1) & 7;
    for (int kt = 0; kt < nk; ++kt) {
        const int cur = kt & 1;
        if (kt + 1 < nk) GEMM_STAGE(cur ^ 1, kt + 1);
        const LAS unsigned char* Ac = As + cur * 16384 + (wr * 32 * MI + r) * 128;
        const LAS unsigned char* Bc = Bs + cur * 16384 + (wc * 64 + r) * 128;
        __builtin_amdgcn_s_setprio(1);
#pragma unroll
        for (int ks = 0; ks < 4; ++ks) {
            const int co = ((ks * 2 + h) ^ swz) * 16;
            bf16x8 fa[MI], fb[2];
#pragma unroll
            for (int mi = 0; mi < MI; ++mi) fa[mi] = *(const LAS bf16x8*)(Ac + mi * 32 * 128 + co);
#pragma unroll
            for (int ni = 0; ni < 2; ++ni) fb[ni] = *(const LAS bf16x8*)(Bc + ni * 32 * 128 + co);
#pragma unroll
            for (int mi = 0; mi < MI; ++mi)
#pragma unroll
                for (int ni = 0; ni < 2; ++ni) acc[mi][ni] = MFMA32(fb[ni], fa[mi], acc[mi][ni]);
        }
        __builtin_amdgcn_s_setprio(0);
        asm volatile("s_waitcnt vmcnt(0)" ::: "memory");
        __syncthreads();
    }
#undef GEMM_STAGE
}
DI void gemm_mainloop(const bf16_t* __restrict__ A, int lda, const bf16_t* __restrict__ Bt, int ldb, int K,
                      f32x16 (&acc)[2][2], unsigned char* lds) { gemm_mainloop_t<2>(A, lda, Bt, ldb, K, acc, lds); }

template <int MI, class F> DI void epi_foreach_t(const f32x16 (&acc)[MI][2], F f) {
    const int tid = threadIdx.x, lane = tid & 63, wid = tid >> 6;
    const int wr = wid >> 1, wc = wid & 1, r = lane & 31, h = lane >> 5;
#pragma unroll
    for (int mi = 0; mi < MI; ++mi)
#pragma unroll
        for (int ni = 0; ni < 2; ++ni)
#pragma unroll
            for (int grp = 0; grp < 4; ++grp) {
                f32x4 v = {acc[mi][ni][4 * grp], acc[mi][ni][4 * grp + 1], acc[mi][ni][4 * grp + 2], acc[mi][ni][4 * grp + 3]};
                f(wr * 32 * MI + mi * 32 + r, wc * 64 + ni * 32 + 8 * grp + 4 * h, v);
            }
}
template <class F> DI void epi_foreach(const f32x16 (&acc)[2][2], F f) { epi_foreach_t<2>(acc, f); }

template <class S> DI void epi_stage_rows(const f32x16 (&acc)[2][2], unsigned char* lds, S colscale) {
    epi_foreach(acc, [&](int m, int n, f32x4 v) {
        const f32x4 s = colscale(n);
        u32x2 o = {pk2(v.x * s.x, v.y * s.y), pk2(v.z * s.z, v.w * s.w)};
        *(u32x2*)(lds + m * 272 + n * 2) = o;
    });
}
DI void epi_stage_cols(const f32x16 (&acc)[2][2], unsigned char* lds) {
    epi_foreach(acc, [&](int m, int n, f32x4 v) {
        *(bf16_t*)(lds + (n + 0) * 272 + m * 2) = (bf16_t)f2bf(v.x); *(bf16_t*)(lds + (n + 1) * 272 + m * 2) = (bf16_t)f2bf(v.y);
        *(bf16_t*)(lds + (n + 2) * 272 + m * 2) = (bf16_t)f2bf(v.z); *(bf16_t*)(lds + (n + 3) * 272 + m * 2) = (bf16_t)f2bf(v.w);
    });
}
template <class F> DI void rows_foreach(const unsigned char* lds, F f) {
    const int tid = threadIdx.x;
#pragma unroll
    for (int i = 0; i < 8; ++i) {
        const int c = tid + 256 * i, m = c >> 4, cc = c & 15;
        f(m, cc, *(const u32x4*)(lds + m * 272 + cc * 16));
    }
}

DI void cvt_rows(const float* __restrict__ src, bf16_t* __restrict__ dst, size_t n8, size_t gtid, size_t gstride) {
    for (size_t i = gtid; i < n8; i += gstride) {
        f32x4 a = ((const f32x4*)src)[2 * i], b = ((const f32x4*)src)[2 * i + 1];
        u32x4 o = {pk2(a.x, a.y), pk2(a.z, a.w), pk2(b.x, b.y), pk2(b.z, b.w)};
        ((u32x4*)dst)[i] = o;
    }
}
template <class F> DI void transpose_cvt(const float* __restrict__ in, int K, int Nin, bf16_t* __restrict__ out, int Nout, F src,
                                         size_t gtid, size_t gstride) {
    const size_t total = (size_t)Nout * (K / 8);
    for (size_t i = gtid; i < total; i += gstride) {
        const int n = (int)(i % Nout), k8 = (int)(i / Nout);
        const int s = src(n);
        float v[8];
#pragma unroll
        for (int j = 0; j < 8; ++j) v[j] = s >= 0 ? in[(size_t)(k8 * 8 + j) * Nin + s] : 0.f;
        u32x4 o = {pk2(v[0], v[1]), pk2(v[2], v[3]), pk2(v[4], v[5]), pk2(v[6], v[7])};
        *(u32x4*)(out + (size_t)n * K + k8 * 8) = o;
    }
}

DI void transpose_cvt_scaled(const float* __restrict__ in, int K, int N, bf16_t* __restrict__ out, const float* __restrict__ scale, size_t gtid, size_t gstride) {
    const size_t total = (size_t)N * (K / 8);
    for (size_t i = gtid; i < total; i += gstride) {
        const int n = (int)(i % N), k8 = (int)(i / N);
        float v[8];
#pragma unroll
        for (int j = 0; j < 8; ++j) v[j] = in[(size_t)(k8 * 8 + j) * N + n] * scale[k8 * 8 + j];
        u32x4 o = {pk2(v[0], v[1]), pk2(v[2], v[3]), pk2(v[4], v[5]), pk2(v[6], v[7])};
        *(u32x4*)(out + (size_t)n * K + k8 * 8) = o;
    }
}

DI void convert_tables(const Params& p) {
    unsigned char* ws = p.ws;
    const size_t gtid = (size_t)blockIdx.x * NTHREADS + threadIdx.x, gstride = (size_t)gridDim.x * NTHREADS;
    {
        const int lane = threadIdx.x & 63, gw = (int)(gtid >> 6), ngw = (int)(gstride >> 6);
        for (int rr = gw; rr < 2 * 16384; rr += ngw) {
            const int which = rr >> 14, row = rr & 16383;
            const f32x4* src = (const f32x4*)((which ? p.in[17] : p.in[16]) + (size_t)row * 1024) + lane * 4;
            f32x4 v[4];
            float am = 0.f;
#pragma unroll
            for (int j = 0; j < 4; ++j) { v[j] = src[j]; am = fmaxf(am, fmaxf(fmaxf(fabsf(v[j].x), fabsf(v[j].y)), fmaxf(fabsf(v[j].z), fabsf(v[j].w)))); }
#pragma unroll
            for (int o = 32; o >= 1; o >>= 1) am = fmaxf(am, __shfl_xor(am, o));
            u32x4 o4;
            if (which) {
                const float sc = am > 0.f ? 448.0f / am : 1.0f;
#pragma unroll
                for (int j = 0; j < 4; ++j) {
                    int w = __builtin_amdgcn_cvt_pk_fp8_f32(v[j].x * sc, v[j].y * sc, 0, false);
                    w = __builtin_amdgcn_cvt_pk_fp8_f32(v[j].z * sc, v[j].w * sc, w, true);
                    o4[j] = (unsigned)w;
                }
            } else {
                const float sc = am > 0.f ? 127.0f / am : 1.0f;
#pragma unroll
                for (int j = 0; j < 4; ++j) {
                    const int q0 = (int)rintf(v[j].x * sc), q1 = (int)rintf(v[j].y * sc), q2 = (int)rintf(v[j].z * sc), q3 = (int)rintf(v[j].w * sc);
                    o4[j] = (unsigned)(q0 & 255) | ((unsigned)(q1 & 255) << 8) | ((unsigned)(q2 & 255) << 16) | ((unsigned)(q3 & 255) << 24);
                }
            }
            *(u32x4*)(ws + (which ? WS_VB : WS_UB) + (size_t)row * 1024 + lane * 16) = o4;
            if (lane == 0) ((float*)(ws + (which ? WS_VSCALE : WS_USCALE)))[row] = am > 0.f ? am / (which ? 448.0f : 127.0f) : 1.0f;
        }
    }
}

DI void phase0(const Params& p) {
    unsigned char* ws = p.ws;
    const size_t gtid = (size_t)blockIdx.x * NTHREADS + threadIdx.x, gstride = (size_t)gridDim.x * NTHREADS;
    cvt_rows(p.in[0], (bf16_t*)(ws + WS_XB), (size_t)NTOK * DM / 8, gtid, gstride);
    cvt_rows(p.in[15], (bf16_t*)(ws + WS_SUBK), (size_t)2 * 128 * 128 / 8, gtid, gstride);
    transpose_cvt(p.in[1], 1024, 1816, (bf16_t*)(ws + WS_WINT), NINP,
                  [](int n) { return n < 1280 ? n : (n < 1792 ? 1304 + (n - 1280) : (n < 1816 ? 1280 + (n - 1792) : -1)); }, gtid, gstride);
    transpose_cvt(p.in[11], 1024, 1024, (bf16_t*)(ws + WS_WOUTT), 1024, [](int n) { return n; }, gtid, gstride);
    transpose_cvt_scaled(p.in[14], 1024, 2048, (bf16_t*)(ws + WS_WQT), p.in[12], gtid, gstride);
    transpose_cvt(p.in[5], 2048, 256, (bf16_t*)(ws + WS_W1TK), 256, [](int n) { return n; }, gtid, gstride);
    transpose_cvt(p.in[7], 2048, 256, (bf16_t*)(ws + WS_W1TV), 256, [](int n) { return n; }, gtid, gstride);
    transpose_cvt(p.in[6], 256, 64, (bf16_t*)(ws + WS_W2TK), 64, [](int n) { return n; }, gtid, gstride);
    transpose_cvt(p.in[8], 256, 64, (bf16_t*)(ws + WS_W2TV), 64, [](int n) { return n; }, gtid, gstride);
    for (int g = 0; g < 4; ++g)
        transpose_cvt(p.in[9] + g * 16384, 128, 128, (bf16_t*)(ws + WS_POOLWT) + g * 16384, 128, [](int n) { return n; }, gtid, gstride);
    {
        float* z = (float*)(ws + WS_KCMP);
        for (size_t i = gtid; i < (size_t)2 * 8 * 256 * 64; i += gstride) z[i] = 0.f;
    }
    {
        const int lane = threadIdx.x & 63, gw = (int)(gtid >> 6), ngw = (int)(gstride >> 6);
        for (int o = gw; o < 512; o += ngw) {
            const int which = o >> 8, j = o & 255;
            const float* pe = which ? p.in[4] : p.in[3];
            const float* w1 = which ? p.in[7] : p.in[5];
            float s = 0.f;
#pragma unroll 8
            for (int i = lane; i < 2048; i += 64) s += pe[i] * w1[(size_t)i * 256 + j];
            s = wave_sum(s);
            if (lane == 0) ((float*)(ws + (which ? WS_PEBV : WS_PEBK)))[j] = s;
        }
    }
    if (gtid >= 512 && gtid < 768) {
        const int d = (int)(gtid - 512);
        ((int*)(ws + WS_BUCK))[d] = rel_bucket_dev(d);
    }
}

DI int cu_pair_pos(int j, int G8) { const int hlf = (G8 + 1) >> 1; return (G8 & 1) ? j : (((j % hlf) << 1) | (j / hlf)); }

DI void phase1(const Params& p, unsigned char* lds) {
    unsigned char* ws = p.ws;
    const bf16_t* xb = (const bf16_t*)(ws + WS_XB);
    const bf16_t* wt = (const bf16_t*)(ws + WS_WINT);
    const int ntiles = 128 * 15;
    const int G8 = (gridDim.x & 7) == 0 ? gridDim.x >> 3 : 0;
    for (int l0 = G8 ? 0 : (int)blockIdx.x; l0 < (G8 ? ntiles / 8 : ntiles); l0 += (G8 ? G8 : (int)gridDim.x)) {
        const int li = G8 ? l0 + cu_pair_pos((int)(blockIdx.x >> 3), G8) : l0;
        if (G8 && li >= ntiles / 8) break;
        const int tile = G8 ? (int)(blockIdx.x & 7) * (ntiles / 8) + li : li;
        const int tn = tile % 15, tm = tile / 15;
        f32x16 acc[2][2];
        gemm_mainloop(xb + (size_t)tm * 128 * DM, DM, wt + (size_t)tn * 128 * DM, DM, DM, acc, lds);
        const int m0 = tm * 128;
        if (tn < 14) {
            const bool tr = (tn == 7 || tn == 9);
            const float qs = tn < 4 ? QSCALE : 1.0f;
            if (tr) epi_stage_cols(acc, lds);
            else epi_stage_rows(acc, lds, [&](int) { return (f32x4){qs, qs, qs, qs}; });
            __syncthreads();
            const int bq = m0 >> 12, t0q = m0 & 4095;
            if (tn < 4) {
                bf16_t* Q = (bf16_t*)(ws + WS_Q);
                rows_foreach(lds, [&](int m, int cc, u32x4 d) {
                    const int hd = tn * 2 + (cc >> 3);
                    *(u32x4*)(Q + (((size_t)(bq * 8 + hd) * SEQ + t0q + m) * 64 + (cc & 7) * 8)) = d;
                });
            } else if (tr) {
                bf16_t* dst = (bf16_t*)(ws + (tn == 7 ? WS_VSLCT : WS_VWINT));
                rows_foreach(lds, [&](int n, int cc, u32x4 d) {
                    *(u32x4*)(dst + ((size_t)((bq * 2 + (n >> 6)) * 64 + (n & 63)) * SEQ + t0q + cc * 8)) = d;
                });
            } else if (tn < 10) {
                bf16_t* dst = (bf16_t*)(ws + (tn == 4 ? WS_KC : tn == 5 ? WS_VC : tn == 6 ? WS_KSLC : WS_KWIN));
                rows_foreach(lds, [&](int m, int cc, u32x4 d) {
                    *(u32x4*)(dst + (((size_t)(bq * 2 + (cc >> 3)) * SEQ + t0q + m) * 64 + (cc & 7) * 8)) = d;
                });
            } else {
                bf16_t* dst = (bf16_t*)(ws + WS_Z);
                rows_foreach(lds, [&](int m, int cc, u32x4 d) {
                    *(u32x4*)(dst + ((size_t)(m0 + m) * 512 + (tn - 10) * 128 + cc * 8)) = d;
                });
            }
            __syncthreads();
        } else {
            float* dst = (float*)(ws + WS_GATES);
            epi_foreach(acc, [&](int m, int n, f32x4 v) {
                if (n < 24) {
                    f32x4 o = {1.f / (1.f + __expf(-v.x)), 1.f / (1.f + __expf(-v.y)), 1.f / (1.f + __expf(-v.z)), 1.f / (1.f + __expf(-v.w))};
                    *(f32x4*)(dst + (size_t)(m0 + m) * 24 + n) = o;
                }
            });
        }
    }
}

DI void compress_job(const Params& p, unsigned char* lds, int cj) {
    unsigned char* ws = p.ws;
    const int kv = cj >> 6, bg = (cj >> 3) & 7, rq = (cj >> 1) & 3, hh = cj & 1;
    const bf16_t* A = (const bf16_t*)(ws + (kv ? WS_VC : WS_KC)) + ((size_t)bg * SEQ + (size_t)rq * 64 * 16) * 64;
    const bf16_t* Bt = (const bf16_t*)(ws + (kv ? WS_W1TV : WS_W1TK)) + (size_t)hh * 128 * 2048;
    const float* peb = (const float*)(ws + (kv ? WS_PEBV : WS_PEBK)) + hh * 128;
    const bf16_t* w2t = (const bf16_t*)(ws + (kv ? WS_W2TV : WS_W2TK));
    float* dst = (float*)(ws + (kv ? WS_VCMP : WS_KCMP)) + (size_t)bg * 256 * 64;
    f32x16 acc[1][2];
    gemm_mainloop_t<1>(A, 1024, Bt, 2048, 2048, acc, lds);
    epi_foreach_t<1>(acc, [&](int m, int n, f32x4 v) {
        f32x4 bb = *(const f32x4*)(peb + n);
        u32x2 o = {pk2(gelu_erf(v.x + bb.x), gelu_erf(v.y + bb.y)), pk2(gelu_erf(v.z + bb.z), gelu_erf(v.w + bb.w))};
        *(u32x2*)(lds + m * 272 + n * 2) = o;
    });
    __syncthreads();
    const int tid = threadIdx.x, lane = tid & 63, wid = tid >> 6, r = lane & 31, h = lane >> 5;
    const int wr2 = wid >> 1, wd = wid & 1;
    f32x16 a2;
#pragma unroll
    for (int i = 0; i < 16; ++i) a2[i] = 0.f;
#pragma unroll
    for (int ks = 0; ks < 8; ++ks) {
        bf16x8 fb = *(const bf16x8*)(lds + (wr2 * 32 + r) * 272 + ks * 32 + h * 16);
        bf16x8 fa = *(const bf16x8*)(w2t + (size_t)(wd * 32 + r) * 256 + hh * 128 + ks * 16 + h * 8);
        a2 = MFMA32(fa, fb, a2);
    }
    const int row = rq * 64 + wr2 * 32 + r;
    if (row < 255) {
#pragma unroll
        for (int i = 0; i < 16; ++i) {
            const int d = wd * 32 + (i & 3) + 8 * (i >> 2) + 4 * h;
            atomicAdd(dst + (size_t)row * 64 + d, a2[i]);
        }
    }
    __syncthreads();
}

constexpr int AT_K0 = 0, AT_V0 = 18432, AT_TB = 36864, AT_IMP = 40960, AT_SEL = 49152;

DI void attn_stage_load(const bf16_t* __restrict__ Kg, const bf16_t* __restrict__ Vtg, u32x4 (&st)[4], int tid) {
#pragma unroll
    for (int i = 0; i < 2; ++i) {
        const int c = tid + 256 * i, row = c >> 3, cc = c & 7;
        st[i] = *(const u32x4*)(Kg + (size_t)row * 64 + cc * 8);
        st[2 + i] = *(const u32x4*)(Vtg + (size_t)row * SEQ + cc * 8);
    }
}
DI void attn_stage_store(unsigned char* Kl, unsigned char* Vl, const u32x4 (&st)[4], int tid) {
#pragma unroll
    for (int i = 0; i < 2; ++i) {
        const int c = tid + 256 * i, row = c >> 3, cc = c & 7;
        *(u32x4*)(Kl + row * ROWB + cc * 16) = st[i];
        *(u32x4*)(Vl + row * ROWB + cc * 16) = st[2 + i];
    }
}
DI void attn_scores(const unsigned char* Kl, const bf16x8 (&qf)[4], f32x16 (&X)[2], int r, int h) {
#pragma unroll
    for (int i = 0; i < 16; ++i) { X[0][i] = 0.f; X[1][i] = 0.f; }
#pragma unroll
    for (int ks = 0; ks < 4; ++ks)
#pragma unroll
        for (int kb = 0; kb < 2; ++kb) {
            bf16x8 a = *(const bf16x8*)(Kl + (kb * 32 + r) * ROWB + ks * 32 + h * 16);
            X[kb] = MFMA32(a, qf[ks], X[kb]);
        }
}
DI void attn_pv(const unsigned char* Vl, const f32x16 (&P)[2], f32x16 (&O)[2], int r, int h) {
#pragma unroll
    for (int kb = 0; kb < 2; ++kb)
#pragma unroll
        for (int s = 0; s < 2; ++s) {
            u32x4 pw = {pk2(P[kb][8 * s], P[kb][8 * s + 1]), pk2(P[kb][8 * s + 2], P[kb][8 * s + 3]),
                        pk2(P[kb][8 * s + 4], P[kb][8 * s + 5]), pk2(P[kb][8 * s + 6], P[kb][8 * s + 7])};
            bf16x8 pb = __builtin_bit_cast(bf16x8, pw);
#pragma unroll
            for (int db = 0; db < 2; ++db) {
                const unsigned char* q = Vl + (db * 32 + r) * ROWB + (kb * 32 + 16 * s + 4 * h) * 2;
                s16x4 lo = *(const s16x4*)q, hi = *(const s16x4*)(q + 16);
                bf16x8 a = __builtin_shufflevector(lo, hi, 0, 1, 2, 3, 4, 5, 6, 7);
                O[db] = MFMA32(a, pb, O[db]);
            }
        }
}
DI void softmax_update(f32x16 (&X)[2], float& m, float& l, f32x16 (&O)[2]) {
    float mloc = -1e30f;
#pragma unroll
    for (int kb = 0; kb < 2; ++kb)
#pragma unroll
        for (int i = 0; i < 16; ++i) mloc = fmaxf(mloc, X[kb][i]);
    mloc = fmaxf(mloc, __shfl_xor(mloc, 32));
    const float mnew = fmaxf(m, mloc);
    const float alpha = __builtin_amdgcn_exp2f(m - mnew);
    m = mnew;
    float ls = 0.f;
#pragma unroll
    for (int kb = 0; kb < 2; ++kb)
#pragma unroll
        for (int i = 0; i < 16; ++i) {
            const float x = X[kb][i];
            const float pv = x > -1e29f ? __builtin_amdgcn_exp2f(x - mnew) : 0.f;
            X[kb][i] = pv; ls += pv;
        }
    l = l * alpha + ls;
#pragma unroll
    for (int db = 0; db < 2; ++db)
#pragma unroll
        for (int i = 0; i < 16; ++i) O[db][i] *= alpha;
}
DI void softmax_far(f32x16 (&X)[2], float cb, float& m, float& l, f32x16 (&O)[2]) {
    float mloc = -3e38f;
#pragma unroll
    for (int kb = 0; kb < 2; ++kb)
#pragma unroll
        for (int i = 0; i < 16; ++i) mloc = fmaxf(mloc, X[kb][i]);
    mloc += cb;
    mloc = fmaxf(mloc, __shfl_xor(mloc, 32));
    const float mnew = fmaxf(m, mloc);
    if (__any(mnew > m)) {
        const float alpha = __builtin_amdgcn_exp2f(m - mnew);
        m = mnew; l *= alpha;
#pragma unroll
        for (int db = 0; db < 2; ++db)
#pragma unroll
            for (int i = 0; i < 16; ++i) O[db][i] *= alpha;
    }
    const float mc = m - cb;
    f32x2 ls = {0.f, 0.f};
#pragma unroll
    for (int kb = 0; kb < 2; ++kb)
#pragma unroll
        for (int i = 0; i < 16; i += 2) {
            f32x2 pv = {__builtin_amdgcn_exp2f(X[kb][i] - mc), __builtin_amdgcn_exp2f(X[kb][i + 1] - mc)};
            X[kb][i] = pv.x; X[kb][i + 1] = pv.y; ls += pv;
        }
    l += ls.x + ls.y;
}
DI void build_bias_table(const Params& p, unsigned char* lds, int g) {
    const int* buck = (const int*)(p.ws + WS_BUCK);
    float* tb = (float*)(lds + AT_TB);
    for (int i = threadIdx.x; i < 1024; i += NTHREADS) {
        const int hl = i >> 8, d = i & 255;
        tb[i] = p.in[2][buck[d] * 8 + g * 4 + hl] * LOG2E;
    }
}

DI void win_unit(const Params& p, unsigned char* lds, int u) {
    unsigned char* ws = p.ws;
    const int tid = threadIdx.x, lane = tid & 63, wid = tid >> 6, r = lane & 31, h = lane >> 5;
    const int bg = u & 7, t32 = u >> 3, b = bg >> 1, g = bg & 1, t0 = t32 * 32;
    const int hl = r >> 3, t = t0 + wid * 8 + (r & 7);
    const bf16_t* Kg = (const bf16_t*)(ws + WS_KWIN) + (size_t)bg * SEQ * 64;
    const bf16_t* Vtg = (const bf16_t*)(ws + WS_VWINT) + (size_t)bg * 64 * SEQ;
    const bf16_t* Qg = (const bf16_t*)(ws + WS_Q) + ((size_t)(b * 8 + g * 4 + hl) * SEQ + t) * 64;
    __syncthreads();
    build_bias_table(p, lds, g);
    bf16x8 qf[4];
#pragma unroll
    for (int ks = 0; ks < 4; ++ks) qf[ks] = *(const bf16x8*)(Qg + ks * 16 + h * 8);
    const int jlo = t0 < 511 ? 0 : ((t0 - 511) >> 6), jhi = t0 >> 6;
    u32x4 st[4];
    attn_stage_load(Kg + (size_t)jlo * 64 * 64, Vtg + jlo * 64, st, tid);
    attn_stage_store(lds + AT_K0, lds + AT_V0, st, tid);
    __syncthreads();
    const float* tb = (const float*)(lds + AT_TB) + hl * 256;
    const int tmin = t0 + wid * 8;
    float m = -1e30f, l = 0.f;
    f32x16 O[2];
#pragma unroll
    for (int i = 0; i < 16; ++i) { O[0][i] = 0.f; O[1][i] = 0.f; }
    for (int j = jlo; j <= jhi; ++j) {
        const int cur = (j - jlo) & 1;
        if (j < jhi) attn_stage_load(Kg + (size_t)(j + 1) * 64 * 64, Vtg + (j + 1) * 64, st, tid);
        const unsigned char* Kl = lds + AT_K0 + cur * 9216;
        const unsigned char* Vl = lds + AT_V0 + cur * 9216;
        f32x16 X[2];
        attn_scores(Kl, qf, X, r, h);
        const bool far = (tmin - (j * 64 + 63) >= 128) && (tmin + 7 - j * 64 < 512);
        if (far) {
            softmax_far(X, tb[255], m, l, O);
        } else {
#pragma unroll
            for (int kb = 0; kb < 2; ++kb)
#pragma unroll
                for (int i = 0; i < 16; ++i) {
                    const int pos = j * 64 + kb * 32 + (i & 3) + 8 * (i >> 2) + 4 * h;
                    const int dist = t - pos;
                    const bool valid = dist >= 0 && dist < 512;
                    const int di = dist < 0 ? 0 : (dist > 255 ? 255 : dist);
                    X[kb][i] = valid ? X[kb][i] + tb[di] : -1e30f;
                }
            softmax_update(X, m, l, O);
        }
        attn_pv(Vl, X, O, r, h);
        if (j < jhi) attn_stage_store(lds + AT_K0 + (cur ^ 1) * 9216, lds + AT_V0 + (cur ^ 1) * 9216, st, tid);
        __syncthreads();
    }
    const float lt = l + __shfl_xor(l, 32);
    const size_t tok = (size_t)b * SEQ + t;
    const float gate = ((const float*)(ws + WS_GATES))[tok * 24 + 16 + g * 4 + hl];
    const float sc = gate / lt;
    bf16_t* ow = (bf16_t*)(ws + WS_OWIN) + tok * 512 + (g * 4 + hl) * 64;
#pragma unroll
    for (int db = 0; db < 2; ++db)
#pragma unroll
        for (int grp = 0; grp < 4; ++grp) {
            u32x2 o = {pk2(O[db][4 * grp] * sc, O[db][4 * grp + 1] * sc), pk2(O[db][4 * grp + 2] * sc, O[db][4 * grp + 3] * sc)};
            *(u32x2*)(ow + db * 32 + 8 * grp + 4 * h) = o;
        }
}

DI void cmp_stage(const float* __restrict__ kc, const float* __restrict__ vc, int ct, unsigned char* Kl, unsigned char* Vl, bool withv, int tid) {
    {
        const int c = tid >> 2, part = tid & 3;
        const f32x4* src = (const f32x4*)(kc + (size_t)(ct * 64 + c) * 64 + part * 16);
        f32x4 a = src[0], b2 = src[1], c2 = src[2], d2 = src[3];
        u32x4 o0 = {pk2(a.x, a.y), pk2(a.z, a.w), pk2(b2.x, b2.y), pk2(b2.z, b2.w)};
        u32x4 o1 = {pk2(c2.x, c2.y), pk2(c2.z, c2.w), pk2(d2.x, d2.y), pk2(d2.z, d2.w)};
        *(u32x4*)(Kl + c * ROWB + part * 32) = o0;
        *(u32x4*)(Kl + c * ROWB + part * 32 + 16) = o1;
    }
    if (withv) {
        const int c = tid & 63, dg = tid >> 6;
        const f32x4* src = (const f32x4*)(vc + (size_t)(ct * 64 + c) * 64 + dg * 16);
#pragma unroll
        for (int q4 = 0; q4 < 4; ++q4) {
            f32x4 a = src[q4];
            const int d = dg * 16 + q4 * 4;
            *(bf16_t*)(Vl + (d + 0) * ROWB + c * 2) = (bf16_t)f2bf(a.x);
            *(bf16_t*)(Vl + (d + 1) * ROWB + c * 2) = (bf16_t)f2bf(a.y);
            *(bf16_t*)(Vl + (d + 2) * ROWB + c * 2) = (bf16_t)f2bf(a.z);
            *(bf16_t*)(Vl + (d + 3) * ROWB + c * 2) = (bf16_t)f2bf(a.w);
        }
    }
}

DI void slc_unit(const Params& p, unsigned char* lds, int u) {
    unsigned char* ws = p.ws;
    const int tid = threadIdx.x, lane = tid & 63, wid = tid >> 6, r = lane & 31, h = lane >> 5;
    const int bg = u & 7, t32 = u >> 3, b = bg >> 1, g = bg & 1, t0 = t32 * 32;
    const int hl = r >> 3, tokl = r & 7, t = t0 + wid * 8 + tokl;
    const bf16_t* Kg = (const bf16_t*)(ws + WS_KSLC) + (size_t)bg * SEQ * 64;
    const bf16_t* Vtg = (const bf16_t*)(ws + WS_VSLCT) + (size_t)bg * 64 * SEQ;
    const bf16_t* Qg = (const bf16_t*)(ws + WS_Q) + ((size_t)(b * 8 + g * 4 + hl) * SEQ + t) * 64;
    const float* kcmp = (const float*)(ws + WS_KCMP) + (size_t)bg * 256 * 64;
    const float* vcmp = (const float*)(ws + WS_VCMP) + (size_t)bg * 256 * 64;
    __syncthreads();
    build_bias_table(p, lds, g);
    unsigned* imp = (unsigned*)(lds + AT_IMP) + wid * 512;
#pragma unroll
    for (int i = 0; i < 8; ++i) imp[i * 64 + lane] = 0u;
    bf16x8 qf[4];
#pragma unroll
    for (int ks = 0; ks < 4; ++ks) qf[ks] = *(const bf16x8*)(Qg + ks * 16 + h * 8);
    const float* tb = (const float*)(lds + AT_TB) + hl * 256;
    const int cmax = t0 >> 4;
    const int nct = (t0 + 31 >= 31) ? (cmax >> 6) + 1 : 0;
    float m = -1e30f, l = 0.f;
    f32x16 Oc[2];
#pragma unroll
    for (int i = 0; i < 16; ++i) { Oc[0][i] = 0.f; Oc[1][i] = 0.f; }
    for (int ct = 0; ct < nct; ++ct) {
        __syncthreads();
        cmp_stage(kcmp, vcmp, ct, lds + AT_K0, lds + AT_V0, false, tid);
        __syncthreads();
        f32x16 X[2];
        attn_scores(lds + AT_K0, qf, X, r, h);
#pragma unroll
        for (int kb = 0; kb < 2; ++kb)
#pragma unroll
            for (int i = 0; i < 16; ++i) {
                const int c = ct * 64 + kb * 32 + (i & 3) + 8 * (i >> 2) + 4 * h;
                const int dist = t - (16 * c + 31);
                const bool valid = dist >= 0 && c < 255;
                const int di = dist < 0 ? 0 : (dist > 255 ? 255 : dist);
                X[kb][i] = valid ? X[kb][i] + tb[di] : -1e30f;
            }
        f32x16 dummy[2];
#pragma unroll
        for (int i = 0; i < 16; ++i) { dummy[0][i] = 0.f; dummy[1][i] = 0.f; }
        softmax_update(X, m, l, dummy);
    }
    const float lt = l + __shfl_xor(l, 32);
    const float invl = lt > 0.f ? 1.0f / lt : 0.f;
    for (int ct = 0; ct < nct; ++ct) {
        __syncthreads();
        cmp_stage(kcmp, vcmp, ct, lds + AT_K0, lds + AT_V0, true, tid);
        __syncthreads();
        f32x16 X[2];
        attn_scores(lds + AT_K0, qf, X, r, h);
#pragma unroll
        for (int kb = 0; kb < 2; ++kb)
#pragma unroll
            for (int i = 0; i < 16; ++i) {
                const int c = ct * 64 + kb * 32 + (i & 3) + 8 * (i >> 2) + 4 * h;
                const int dist = t - (16 * c + 31);
                const bool valid = dist >= 0 && c < 255;
                const int di = dist < 0 ? 0 : (dist > 255 ? 255 : dist);
                X[kb][i] = valid ? __builtin_amdgcn_exp2f(X[kb][i] + tb[di] - m) * invl : 0.f;
            }
#pragma unroll
        for (int kb = 0; kb < 2; ++kb)
#pragma unroll
            for (int grp = 0; grp < 4; ++grp) {
                const float s4 = (X[kb][4 * grp] + X[kb][4 * grp + 1]) + (X[kb][4 * grp + 2] + X[kb][4 * grp + 3]);
                const int jj = ct * 16 + kb * 8 + 2 * grp + h;
                atomicAdd(&imp[tokl * 64 + jj], (unsigned)(s4 * 67108864.0f + 0.5f));
                if (jj + 1 < 64) atomicAdd(&imp[tokl * 64 + jj + 1], (unsigned)(X[kb][4 * grp + 3] * 67108864.0f + 0.5f));
            }
        attn_pv(lds + AT_V0, X, Oc, r, h);
    }
    unsigned long long* selm = (unsigned long long*)(lds + AT_SEL) + wid * 8;
    for (int tk = 0; tk < 8; ++tk) {
        const int tt = t0 + wid * 8 + tk, curb = tt >> 6;
        int v = (int)imp[tk * 64 + lane];
        if (lane == 0 || lane == curb || lane == curb - 1) v = 0x7fffffff;
        if (lane > curb) v = -1;
        int cnt = 0;
#pragma unroll
        for (int k = 0; k < 64; ++k) {
            const int vk = __builtin_amdgcn_readlane(v, k);
            cnt += (vk > v || (vk == v && k < lane)) ? 1 : 0;
        }
        const unsigned long long mk = __ballot(cnt < 16);
        if (lane == 0) selm[tk] = mk;
    }
    const unsigned long long mysel = selm[tokl];
    __syncthreads();
    const int jhi = t0 >> 6;
    u32x4 st[4];
    attn_stage_load(Kg, Vtg, st, tid);
    attn_stage_store(lds + AT_K0, lds + AT_V0, st, tid);
    __syncthreads();
    float m2 = -1e30f, l2 = 0.f;
    const int tmin = t0 + wid * 8;
    f32x16 O[2];
#pragma unroll
    for (int i = 0; i < 16; ++i) { O[0][i] = 0.f; O[1][i] = 0.f; }
    for (int j = 0; j <= jhi; ++j) {
        const int cur = j & 1;
        if (j < jhi) attn_stage_load(Kg + (size_t)(j + 1) * 64 * 64, Vtg + (j + 1) * 64, st, tid);
        const unsigned char* Kl = lds + AT_K0 + cur * 9216;
        const unsigned char* Vl = lds + AT_V0 + cur * 9216;
        f32x16 X[2];
        attn_scores(Kl, qf, X, r, h);
        const bool selj = (mysel >> j) & 1ull;
        if (tmin - (j * 64 + 63) >= 128) {
            softmax_far(X, selj ? tb[255] : -1e30f, m2, l2, O);
        } else {
#pragma unroll
            for (int kb = 0; kb < 2; ++kb)
#pragma unroll
                for (int i = 0; i < 16; ++i) {
                    const int pos = j * 64 + kb * 32 + (i & 3) + 8 * (i >> 2) + 4 * h;
                    const int dist = t - pos;
                    const bool valid = dist >= 0 && selj;
                    const int di = dist < 0 ? 0 : (dist > 255 ? 255 : dist);
                    X[kb][i] = valid ? X[kb][i] + tb[di] : -1e30f;
                }
            softmax_update(X, m2, l2, O);
        }
        attn_pv(Vl, X, O, r, h);
        if (j < jhi) attn_stage_store(lds + AT_K0 + (cur ^ 1) * 9216, lds + AT_V0 + (cur ^ 1) * 9216, st, tid);
        __syncthreads();
    }
    const float lt2 = l2 + __shfl_xor(l2, 32);
    const size_t tok = (size_t)b * SEQ + t;
    const float* gt = (const float*)(ws + WS_GATES) + tok * 24;
    const float gc = gt[g * 4 + hl], gs = gt[8 + g * 4 + hl] / lt2;
    const bf16_t* ow = (const bf16_t*)(ws + WS_OWIN) + tok * 512 + (g * 4 + hl) * 64;
    bf16_t* mx = (bf16_t*)(ws + WS_MIXIN) + tok * 1024 + (g * 4 + hl) * 64;
#pragma unroll
    for (int db = 0; db < 2; ++db)
#pragma unroll
        for (int grp = 0; grp < 4; ++grp) {
            const int d = db * 32 + 8 * grp + 4 * h;
            const u32x2 w = *(const u32x2*)(ow + d);
            const float r0 = gc * Oc[db][4 * grp] + gs * O[db][4 * grp] + bflo(w.x);
            const float r1 = gc * Oc[db][4 * grp + 1] + gs * O[db][4 * grp + 1] + bfhi(w.x);
            const float r2 = gc * Oc[db][4 * grp + 2] + gs * O[db][4 * grp + 2] + bflo(w.y);
            const float r3 = gc * Oc[db][4 * grp + 3] + gs * O[db][4 * grp + 3] + bfhi(w.y);
            u32x2 o = {pk2(r0, r1), pk2(r2, r3)};
            *(u32x2*)(mx + d) = o;
        }
}

DI void pooly_job(const Params& p, int job) {
    unsigned char* ws = p.ws;
    const bf16_t* z = (const bf16_t*)(ws + WS_Z);
    bf16_t* y = (bf16_t*)(ws + WS_YPOOL);
    const int tid = threadIdx.x;
    const int tok = job * 4 + (tid >> 6), ch = tid & 63, t = tok & 4095;
    const int gi = ch >> 4, win = 2 << gi;
    const int cnt = (t + 1 < win) ? t + 1 : win;
    float s[8];
#pragma unroll
    for (int i = 0; i < 8; ++i) s[i] = 0.f;
    u32x4 rowv[16];
#pragma unroll
    for (int k = 0; k < 16; ++k) rowv[k] = *(const u32x4*)(z + (size_t)(tok - (k < cnt ? k : 0)) * 512 + ch * 8);
    const u32x4 self = rowv[0];
#pragma unroll
    for (int k = 0; k < 16; ++k) {
        const float wk = k < cnt ? 1.0f : 0.0f;
        const u32x4 v = rowv[k];
        s[0] += wk * bflo(v.x); s[1] += wk * bfhi(v.x); s[2] += wk * bflo(v.y); s[3] += wk * bfhi(v.y);
        s[4] += wk * bflo(v.z); s[5] += wk * bfhi(v.z); s[6] += wk * bflo(v.w); s[7] += wk * bfhi(v.w);
    }
    const float ic = 1.0f / (float)cnt;
    u32x4 o = {pk2(s[0] * ic - bflo(self.x), s[1] * ic - bfhi(self.x)), pk2(s[2] * ic - bflo(self.y), s[3] * ic - bfhi(self.y)),
               pk2(s[4] * ic - bflo(self.z), s[5] * ic - bfhi(self.z)), pk2(s[6] * ic - bflo(self.w), s[7] * ic - bfhi(self.w))};
    *(u32x4*)(y + (size_t)tok * 512 + ch * 8) = o;
}

DI void lnfold_consts(const Params& p, int n0, int cnt) {
    unsigned char* ws = p.ws;
    const int lane = threadIdx.x & 63, wid = threadIdx.x >> 6;
    const bf16_t* wqt = (const bf16_t*)(ws + WS_WQT);
    const float* wq = p.in[14];
    const float* bb = p.in[13];
    for (int n = n0 + wid; n < n0 + cnt; n += 4) {
        float s1 = 0.f, s2 = 0.f;
#pragma unroll
        for (int j = 0; j < 2; ++j) {
            const u32x4 w = *(const u32x4*)(wqt + (size_t)n * 1024 + (j * 64 + lane) * 8);
            s1 += (bflo(w.x) + bfhi(w.x)) + (bflo(w.y) + bfhi(w.y)) + (bflo(w.z) + bfhi(w.z)) + (bflo(w.w) + bfhi(w.w));
        }
#pragma unroll 8
        for (int k = lane; k < 1024; k += 64) s2 += bb[k] * wq[(size_t)k * 2048 + n];
        s1 = wave_sum(s1); s2 = wave_sum(s2);
        if (lane == 0) { ((float*)(ws + WS_C1))[n] = s1; ((float*)(ws + WS_C2))[n] = s2; }
    }
}

DI void phase2(const Params& p, unsigned char* lds) {
    const int G = gridDim.x, bx = blockIdx.x;
    if (G == 512) {
        if (bx < 128) { compress_job(p, lds, bx); win_unit(p, lds, 768 + bx); }
        else {
            win_unit(p, lds, bx - 128); win_unit(p, lds, 384 + bx - 128);
            if (bx < 256) win_unit(p, lds, 896 + bx - 128);
            else lnfold_consts(p, (bx - 256) * 8, 8);
        }
    } else {
        for (int job = bx; job < 128; job += G) compress_job(p, lds, job);
        for (int job = bx; job < 1024; job += G) win_unit(p, lds, job);
        for (int n0 = bx * 8; n0 < 2048; n0 += G * 8) lnfold_consts(p, n0, 8);
    }
    for (int job = bx; job < 4096; job += G) pooly_job(p, job);
}

DI void pool_gemm_tile(const Params& p, unsigned char* lds, int tile) {
    unsigned char* ws = p.ws;
    const int gi = tile & 3, tm = tile >> 2;
    f32x16 acc[2][2];
    __syncthreads();
    gemm_mainloop((const bf16_t*)(ws + WS_YPOOL) + (size_t)tm * 128 * 512 + gi * 128, 512,
                  (const bf16_t*)(ws + WS_POOLWT) + (size_t)gi * 16384, 128, 128, acc, lds);
    const float* sc = p.in[10] + gi * 128;
    bf16_t* mx = (bf16_t*)(ws + WS_MIXIN);
    epi_stage_rows(acc, lds, [&](int n) { return *(const f32x4*)(sc + n); });
    __syncthreads();
    rows_foreach(lds, [&](int m, int cc, u32x4 d) {
        *(u32x4*)(mx + (size_t)(tm * 128 + m) * 1024 + 512 + gi * 128 + cc * 8) = d;
    });
}

DI void phase3(const Params& p, unsigned char* lds) {
    const int G = gridDim.x, bx = blockIdx.x;
    for (int pass = 0; pass * G < 1024; ++pass) {
        const int i = pass * G + ((pass & 1) ? (G - 1 - bx) : bx);
        if (i < 1024) {
            const int u = ((127 - (i >> 3)) << 3) | (i & 7);
            slc_unit(p, lds, u);
        }
    }
    for (int tile = bx; tile < 512; tile += G) pool_gemm_tile(p, lds, tile);
}

DI void phase4(const Params& p, unsigned char* lds) {
    unsigned char* ws = p.ws;
    const float* x = p.in[0];
    bf16_t* y1 = (bf16_t*)(ws + WS_Z);
    const bool conv_first = (blockIdx.x >> 3) & 1;
    if (conv_first) convert_tables(p);
    const int G8 = (gridDim.x & 7) == 0 ? gridDim.x >> 3 : 0;
    for (int l0 = G8 ? 0 : (int)blockIdx.x; l0 < (G8 ? 128 : 1024); l0 += (G8 ? G8 : (int)gridDim.x)) {
        const int li = G8 ? l0 + cu_pair_pos((int)(blockIdx.x >> 3), G8) : l0;
        if (G8 && li >= 128) break;
        const int tile = G8 ? (int)(blockIdx.x & 7) * 128 + li : li;
        const int tn = tile & 7, tm = tile >> 3;
        f32x16 acc[2][2];
        gemm_mainloop((const bf16_t*)(ws + WS_MIXIN) + (size_t)tm * 128 * 1024, 1024,
                      (const bf16_t*)(ws + WS_WOUTT) + (size_t)tn * 128 * 1024, 1024, 1024, acc, lds);
        epi_stage_rows(acc, lds, [&](int) { return (f32x4){1.f, 1.f, 1.f, 1.f}; });
        __syncthreads();
        rows_foreach(lds, [&](int m, int cc, u32x4 d) {
            const size_t off = (size_t)(tm * 128 + m) * 1024 + tn * 128 + cc * 8;
            const f32x4 xa = *(const f32x4*)(x + off), xb = *(const f32x4*)(x + off + 4);
            u32x4 o = {pk2(ALPHA * xa.x + bflo(d.x), ALPHA * xa.y + bfhi(d.x)), pk2(ALPHA * xa.z + bflo(d.y), ALPHA * xa.w + bfhi(d.y)),
                       pk2(ALPHA * xb.x + bflo(d.z), ALPHA * xb.y + bfhi(d.z)), pk2(ALPHA * xb.z + bflo(d.w), ALPHA * xb.w + bfhi(d.w))};
            *(u32x4*)(y1 + off) = o;
            float s = ((bflo(o.x) + bfhi(o.x)) + (bflo(o.y) + bfhi(o.y))) + ((bflo(o.z) + bfhi(o.z)) + (bflo(o.w) + bfhi(o.w)));
            float q = ((bflo(o.x) * bflo(o.x) + bfhi(o.x) * bfhi(o.x)) + (bflo(o.y) * bflo(o.y) + bfhi(o.y) * bfhi(o.y)))
                    + ((bflo(o.z) * bflo(o.z) + bfhi(o.z) * bfhi(o.z)) + (bflo(o.w) * bflo(o.w) + bfhi(o.w) * bfhi(o.w)));
#pragma unroll
            for (int sh = 1; sh < 16; sh <<= 1) { s += __shfl_xor(s, sh); q += __shfl_xor(q, sh); }
            if (cc == 0) *(f32x2*)((float*)(ws + WS_LNST) + (size_t)(tm * 128 + m) * 16 + tn * 2) = (f32x2){s, q};
        });
        __syncthreads();
    }
    if (!conv_first) convert_tables(p);
}

DI void ln1_stats(const unsigned char* ws, int row, float& mean, float& rstd) {
    const f32x4* st = (const f32x4*)((const float*)(ws + WS_LNST) + (size_t)row * 16);
    const f32x4 a = st[0], b = st[1], c = st[2], d = st[3];
    const float s = ((a.x + a.z) + (b.x + b.z)) + ((c.x + c.z) + (d.x + d.z));
    const float q = ((a.y + a.w) + (b.y + b.w)) + ((c.y + c.w) + (d.y + d.w));
    mean = s * (1.0f / 1024.0f);
    const float var = fmaxf(q * (1.0f / 1024.0f) - mean * mean, 0.f);
    rstd = rsqrtf(var + LN_EPS);
}

DI void phase5(const Params& p) {
    unsigned char* ws = p.ws;
    const int lane = threadIdx.x & 63, wid = threadIdx.x >> 6;
    const float* gg = p.in[12];
    const float* bb = p.in[13];
    bf16_t* h1 = (bf16_t*)(ws + WS_H1);
    for (int row = blockIdx.x * 4 + wid; row < NTOK; row += gridDim.x * 4) {
        const u32x2* xr = (const u32x2*)((const bf16_t*)(ws + WS_Z) + (size_t)row * 1024) + lane;
        f32x4 v[4];
        float s = 0.f;
#pragma unroll
        for (int j = 0; j < 4; ++j) { const u32x2 w = xr[64 * j]; v[j] = (f32x4){bflo(w.x), bfhi(w.x), bflo(w.y), bfhi(w.y)}; s += (v[j].x + v[j].y) + (v[j].z + v[j].w); }
        const float mean = wave_sum(s) * (1.0f / 1024.0f);
        float s2 = 0.f;
#pragma unroll
        for (int j = 0; j < 4; ++j) { v[j] = v[j] - mean; s2 += (v[j].x * v[j].x + v[j].y * v[j].y) + (v[j].z * v[j].z + v[j].w * v[j].w); }
        const float rstd = rsqrtf(wave_sum(s2) * (1.0f / 1024.0f) + LN_EPS);
#pragma unroll
        for (int j = 0; j < 4; ++j) {
            const f32x4 g4 = ((const f32x4*)gg)[lane + 64 * j], b4 = ((const f32x4*)bb)[lane + 64 * j];
            u32x2 o = {pk2(v[j].x * rstd * g4.x + b4.x, v[j].y * rstd * g4.y + b4.y), pk2(v[j].z * rstd * g4.z + b4.z, v[j].w * rstd * g4.w + b4.w)};
            *(u32x2*)(h1 + (size_t)row * 1024 + (lane + 64 * j) * 4) = o;
        }
    }
}


DI void ce_desc(int& a, int& b) { const int hi = a > b ? a : b, lo = a > b ? b : a; a = hi; b = lo; }
template <int K, int J> DI void bst(int (&a)[16]) {
#pragma unroll
    for (int i = 0; i < 16; ++i) { const int l = i ^ J; if (l > i) { if ((i & K) == 0) ce_desc(a[i], a[l]); else ce_desc(a[l], a[i]); } }
}
DI void sort16(int (&a)[16]) { bst<2, 1>(a); bst<4, 2>(a); bst<4, 1>(a); bst<8, 4>(a); bst<8, 2>(a); bst<8, 1>(a); bst<16, 8>(a); bst<16, 4>(a); bst<16, 2>(a); bst<16, 1>(a); }
DI void merge_top16(int (&a)[16], const int (&b)[16]) {
#pragma unroll
    for (int i = 0; i < 16; ++i) a[i] = a[i] > b[15 - i] ? a[i] : b[15 - i];
    bst<16, 8>(a); bst<16, 4>(a); bst<16, 2>(a); bst<16, 1>(a);
}

constexpr int cand_i(int c) { return c < 16 ? 0 : c < 24 ? 1 : c < 29 ? 2 : c < 33 ? 3 : c < 36 ? 4 : c < 38 ? 5 : c < 40 ? 6 : c < 42 ? 7 : c - 34; }
constexpr int cand_j(int c) { return c < 16 ? c : c < 24 ? c - 16 : c < 29 ? c - 24 : c < 33 ? c - 29 : c < 36 ? c - 33 : c < 38 ? c - 36 : c < 40 ? c - 38 : c < 42 ? c - 40 : 0; }
DI void cand_ij(int c, int& i, int& j) {
    if (c < 16) { i = 0; j = c; } else if (c < 24) { i = 1; j = c - 16; } else if (c < 29) { i = 2; j = c - 24; } else if (c < 33) { i = 3; j = c - 29; }
    else if (c < 36) { i = 4; j = c - 33; } else if (c < 38) { i = 5; j = c - 36; } else if (c < 40) { i = 6; j = c - 38; } else if (c < 42) { i = 7; j = c - 40; }
    else { i = c - 34; j = 0; }
}
DI float key_val6(int k) { int b = k & ~63; b ^= (b >> 31) & 0x7fffffff; return __int_as_float(b); }

DI void phase6(const Params& p, unsigned char* lds) {
    unsigned char* ws = p.ws;
    const int tid = threadIdx.x, lane = tid & 63, wid = tid >> 6, wr = wid >> 1, wc = wid & 1, r = lane & 31, h = lane >> 5;
    const bf16_t* h1 = (const bf16_t*)(ws + WS_Z);
    const bf16_t* wq = (const bf16_t*)(ws + WS_WQT);
    const bf16_t* sk = (const bf16_t*)(ws + WS_SUBK);
    const float* c1 = (const float*)(ws + WS_C1);
    const float* c2 = (const float*)(ws + WS_C2);
    int* routeE = (int*)(ws + WS_TOPK);
    float* routeG = (float*)(ws + WS_TOPK + 8 * MiB);
    int* L1s = (int*)(lds + 65536);
    const int G8 = (gridDim.x & 7) == 0 ? gridDim.x >> 3 : 0;
    for (int l0 = G8 ? 0 : (int)blockIdx.x; l0 < (G8 ? 128 : 1024); l0 += (G8 ? G8 : (int)gridDim.x)) {
        const int li = G8 ? l0 + cu_pair_pos((int)(blockIdx.x >> 3), G8) : l0;
        if (G8 && li >= 128) break;
        const int pair = G8 ? (int)(blockIdx.x & 7) * 128 + li : li;
        const int tm = pair >> 3, head = pair & 7;
        int ka[16], kb[16];
        float rmean[2], rrstd[2];
#pragma unroll
        for (int mi = 0; mi < 2; ++mi) ln1_stats(ws, tm * 128 + wr * 64 + mi * 32 + r, rmean[mi], rrstd[mi]);
        if (tid < 128) {
            const int kh = tid >> 6, wh = (tid >> 5) & 1, q4 = tid & 31;
            *(f32x4*)(lds + LDS_CST + kh * 1024 + wh * 512 + q4 * 16) = *(const f32x4*)((wh ? c2 : c1) + (head * 2 + kh) * 128 + q4 * 4);
        }
#pragma unroll 1
        for (int khalf = 0; khalf < 2; ++khalf) {
            const int tn = head * 2 + khalf;
            f32x16 acc[2][2];
            gemm_mainloop(h1 + (size_t)tm * 128 * 1024, 1024, wq + (size_t)tn * 128 * 1024, 1024, 1024, acc, lds);
            epi_foreach(acc, [&](int m, int n, f32x4 v) {
                const int mi = (m >> 5) & 1;
                const float mu = mi ? rmean[1] : rmean[0], rs = mi ? rrstd[1] : rrstd[0];
                const f32x4 k1 = *(const f32x4*)(lds + LDS_CST + khalf * 1024 + n * 4), k2 = *(const f32x4*)(lds + LDS_CST + khalf * 1024 + 512 + n * 4);
                u32x2 o = {pk2(rs * (v.x - mu * k1.x) + k2.x, rs * (v.y - mu * k1.y) + k2.y), pk2(rs * (v.z - mu * k1.z) + k2.z, rs * (v.w - mu * k1.w) + k2.w)};
                *(u32x2*)(lds + m * 272 + n * 2) = o;
            });
            __syncthreads();
            f32x16 a2[2][2];
#pragma unroll
            for (int mi = 0; mi < 2; ++mi)
#pragma unroll
                for (int ni = 0; ni < 2; ++ni)
#pragma unroll
                    for (int i = 0; i < 16; ++i) a2[mi][ni][i] = 0.f;
#pragma unroll
            for (int ks = 0; ks < 8; ++ks) {
                bf16x8 fa[2], fb[2];
#pragma unroll
                for (int mi = 0; mi < 2; ++mi) fa[mi] = *(const bf16x8*)(lds + (wr * 64 + mi * 32 + r) * 272 + ks * 32 + h * 16);
#pragma unroll
                for (int ni = 0; ni < 2; ++ni) fb[ni] = *(const bf16x8*)(sk + (size_t)(khalf * 128 + wc * 64 + ni * 32 + r) * 128 + ks * 16 + h * 8);
#pragma unroll
                for (int mi = 0; mi < 2; ++mi)
#pragma unroll
                    for (int ni = 0; ni < 2; ++ni) a2[mi][ni] = MFMA32(fb[ni], fa[mi], a2[mi][ni]);
            }
            __syncthreads();
#pragma unroll
            for (int mi = 0; mi < 2; ++mi) {
                int xa[16], xb[16];
#pragma unroll
                for (int i = 0; i < 16; ++i) {
                    const int n = wc * 64 + (i & 3) + 8 * (i >> 2) + 4 * h;
                    xa[i] = make_key(a2[mi][0][i], n); xb[i] = make_key(a2[mi][1][i], n + 32);
                }
                sort16(xa); sort16(xb); merge_top16(xa, xb);
#pragma unroll
                for (int i = 0; i < 16; ++i) xb[i] = __shfl_xor(xa[i], 32);
                merge_top16(xa, xb);
                if (h == 0) {
                    int* dst = (int*)lds + ((wr * 64 + mi * 32 + r) * 2 + wc) * 16;
#pragma unroll
                    for (int q4 = 0; q4 < 4; ++q4) { u32x4 o = {(unsigned)xa[4 * q4], (unsigned)xa[4 * q4 + 1], (unsigned)xa[4 * q4 + 2], (unsigned)xa[4 * q4 + 3]}; *(u32x4*)(dst + 4 * q4) = o; }
                }
            }
            __syncthreads();
            if (tid < 128) {
                const int* s0 = (const int*)lds + tid * 32;
#pragma unroll
                for (int q4 = 0; q4 < 4; ++q4) {
                    const u32x4 x = *(const u32x4*)(s0 + 4 * q4), y = *(const u32x4*)(s0 + 16 + 4 * q4);
                    ka[4 * q4] = (int)x.x; ka[4 * q4 + 1] = (int)x.y; ka[4 * q4 + 2] = (int)x.z; ka[4 * q4 + 3] = (int)x.w;
                    kb[4 * q4] = (int)y.x; kb[4 * q4 + 1] = (int)y.y; kb[4 * q4 + 2] = (int)y.z; kb[4 * q4 + 3] = (int)y.w;
                }
                merge_top16(ka, kb);
                if (khalf == 0) {
#pragma unroll
                    for (int q4 = 0; q4 < 4; ++q4) { u32x4 o = {(unsigned)ka[4 * q4], (unsigned)ka[4 * q4 + 1], (unsigned)ka[4 * q4 + 2], (unsigned)ka[4 * q4 + 3]}; *(u32x4*)(L1s + tid * 16 + 4 * q4) = o; }
                }
            }
            if (khalf == 0) __syncthreads();
        }
        if (tid < 128) {
            int* L2s = (int*)lds + tid * 32;
#pragma unroll
            for (int q4 = 0; q4 < 4; ++q4) { u32x4 o = {(unsigned)ka[4 * q4], (unsigned)ka[4 * q4 + 1], (unsigned)ka[4 * q4 + 2], (unsigned)ka[4 * q4 + 3]}; *(u32x4*)(L2s + 4 * q4) = o; }
            float v1[16], v2[16];
#pragma unroll
            for (int q4 = 0; q4 < 4; ++q4) {
                const u32x4 x = *(const u32x4*)(L1s + tid * 16 + 4 * q4);
                v1[4 * q4] = key_val((int)x.x); v1[4 * q4 + 1] = key_val((int)x.y); v1[4 * q4 + 2] = key_val((int)x.z); v1[4 * q4 + 3] = key_val((int)x.w);
            }
#pragma unroll
            for (int i = 0; i < 16; ++i) v2[i] = key_val(ka[i]);
            int g0[16], g1[16], g2[16], g3[16];
#pragma unroll
            for (int t = 0; t < 16; ++t) {
                { const float s = v1[cand_i(t)] + v2[cand_j(t)]; int b = __float_as_int(s); b ^= (b >> 31) & 0x7fffffff; g0[t] = (b & ~63) | (63 - t); }
                { const float s = v1[cand_i(16 + t)] + v2[cand_j(16 + t)]; int b = __float_as_int(s); b ^= (b >> 31) & 0x7fffffff; g1[t] = (b & ~63) | (63 - (16 + t)); }
                { const float s = v1[cand_i(32 + t)] + v2[cand_j(32 + t)]; int b = __float_as_int(s); b ^= (b >> 31) & 0x7fffffff; g2[t] = (b & ~63) | (63 - (32 + t)); }
                if (t < 2) { const float s = v1[cand_i(48 + t)] + v2[cand_j(48 + t)]; int b = __float_as_int(s); b ^= (b >> 31) & 0x7fffffff; g3[t] = (b & ~63) | (63 - (48 + t)); }
                else g3[t] = (int)0x80000000 + t;
            }
            sort16(g0); sort16(g1); sort16(g2); sort16(g3);
            merge_top16(g0, g1); merge_top16(g2, g3); merge_top16(g0, g2);
            const float smax = key_val6(g0[0]);
            float ex[16], den = 0.f;
#pragma unroll
            for (int t = 0; t < 16; ++t) { ex[t] = __expf(key_val6(g0[t]) - smax); den += ex[t]; }
            const float inv = 1.0f / den;
            const size_t ro = ((size_t)(tm * 128 + tid) * 8 + head) * 16;
#pragma unroll
            for (int q4 = 0; q4 < 4; ++q4) {
                int ee[4];
#pragma unroll
                for (int u = 0; u < 4; ++u) {
                    int ci, cj; cand_ij(63 - (g0[4 * q4 + u] & 63), ci, cj);
                    ee[u] = (L1s[tid * 16 + ci] & 127) * 128 + (L2s[cj] & 127);
                }
                u32x4 oe = {(unsigned)ee[0], (unsigned)ee[1], (unsigned)ee[2], (unsigned)ee[3]};
                f32x4 og = {ex[4 * q4] * inv, ex[4 * q4 + 1] * inv, ex[4 * q4 + 2] * inv, ex[4 * q4 + 3] * inv};
                *(u32x4*)(routeE + ro + 4 * q4) = oe;
                *(f32x4*)(routeG + ro + 4 * q4) = og;
            }
        }
        __syncthreads();
    }
}

constexpr int P7_NS = 32, P7_SH = 9;
constexpr int P7_WLDS = 6144;
DI void p7_loadrows(int b, int li, int l32, const LAS int* ent_e, const unsigned char* tab, u32x4 (&rows)[8][2]) {
    const u32x4 e0 = *(const LAS u32x4*)(ent_e + li * 128 + b), e1 = *(const LAS u32x4*)(ent_e + li * 128 + b + 4);
    const unsigned ee[8] = {e0.x, e0.y, e0.z, e0.w, e1.x, e1.y, e1.z, e1.w};
#pragma unroll
    for (int r = 0; r < 8; ++r) {
        const unsigned ob = ee[r] * 1024u + (unsigned)l32 * 16u;
        rows[r][0] = *(const u32x4*)(tab + ob);
        rows[r][1] = *(const u32x4*)(tab + ob + 512);
    }
}
DI float half32_sum(float v) { v += __shfl_xor(v, 1); v += __shfl_xor(v, 2); v += __shfl_xor(v, 4); v += __shfl_xor(v, 8); v += __shfl_xor(v, 16); return v; }

DI void p7_stepA(const u32x4 (&rows)[8][2], const unsigned (&hq)[2][4], float hscale, int b, int li, int l32, int lane, int myk,
                 LAS float* ent_w, const LAS float* ent_us) {
    int d[8];
#pragma unroll
    for (int r = 0; r < 8; ++r) {
        int a = 0;
#pragma unroll
        for (int c = 0; c < 2; ++c)
#pragma unroll
            for (int q = 0; q < 4; ++q) a = dot4i8(rows[r][c][q], hq[c][q], a);
        d[r] = a;
    }
    int r4[4], r2[2], r1;
    const bool b0 = lane & 1;
#pragma unroll
    for (int i = 0; i < 4; ++i) { const int snd = b0 ? d[i] : d[4 + i]; const int kp = b0 ? d[4 + i] : d[i]; r4[i] = kp + __shfl_xor(snd, 1); }
    const bool b1 = lane & 2;
#pragma unroll
    for (int i = 0; i < 2; ++i) { const int snd = b1 ? r4[i] : r4[2 + i]; const int kp = b1 ? r4[2 + i] : r4[i]; r2[i] = kp + __shfl_xor(snd, 2); }
    const bool b2 = lane & 4;
    { const int snd = b2 ? r2[0] : r2[1]; const int kp = b2 ? r2[1] : r2[0]; r1 = kp + __shfl_xor(snd, 4); }
    r1 += __shfl_xor(r1, 8); r1 += __shfl_xor(r1, 16);
    if (l32 < 8) { const int idx = li * 128 + b + myk; ent_w[idx] = ent_w[idx] * gelu_fast((float)r1 * (hscale * ent_us[idx])); }
}
DI void p7_stepB(const u32x4 (&rows)[8][2], f32x2 (&acc)[2][8], int b, int li, const LAS float* ent_w) {
    const f32x4 w0 = *(const LAS f32x4*)(ent_w + li * 128 + b), w1 = *(const LAS f32x4*)(ent_w + li * 128 + b + 4);
    const float ww[8] = {w0.x, w0.y, w0.z, w0.w, w1.x, w1.y, w1.z, w1.w};
#pragma unroll
    for (int r = 0; r < 8; ++r) {
        const f32x2 w2 = {ww[r], ww[r]};
#pragma unroll
        for (int c = 0; c < 2; ++c)
#pragma unroll
            for (int q = 0; q < 4; ++q) {
                const f32x2 lo = __builtin_amdgcn_cvt_pk_f32_fp8((int)rows[r][c][q], false);
                const f32x2 hi = __builtin_amdgcn_cvt_pk_f32_fp8((int)rows[r][c][q], true);
                acc[c][2 * q] += w2 * lo; acc[c][2 * q + 1] += w2 * hi;
            }
    }
}
constexpr int P7_GB = 32768;
DI void p7_load_h(const Params& p, const LAS unsigned char* gb, int tok, int l32, float (&hv)[32]) {
    const unsigned char* ws = p.ws;
    float mean, rstd;
    ln1_stats(ws, tok, mean, rstd);
    const bf16_t* y1 = (const bf16_t*)(ws + WS_Z) + (size_t)tok * 1024 + l32 * 16;
    const LAS float* gg = (const LAS float*)(gb + P7_GB) + l32 * 16;
    const LAS float* bb = gg + 1024;
#pragma unroll
    for (int c = 0; c < 2; ++c) {
        const u32x4 a = *(const u32x4*)(y1 + c * 512), b2 = *(const u32x4*)(y1 + c * 512 + 8);
        const unsigned hh[8] = {a.x, a.y, a.z, a.w, b2.x, b2.y, b2.z, b2.w};
#pragma unroll
        for (int i4 = 0; i4 < 4; ++i4) {
            const f32x4 g4 = *(const LAS f32x4*)(gg + c * 512 + i4 * 4), b4 = *(const LAS f32x4*)(bb + c * 512 + i4 * 4);
            hv[c * 16 + 4 * i4 + 0] = (bflo(hh[2 * i4]) - mean) * rstd * g4.x + b4.x;
            hv[c * 16 + 4 * i4 + 1] = (bfhi(hh[2 * i4]) - mean) * rstd * g4.y + b4.y;
            hv[c * 16 + 4 * i4 + 2] = (bflo(hh[2 * i4 + 1]) - mean) * rstd * g4.z + b4.z;
            hv[c * 16 + 4 * i4 + 3] = (bfhi(hh[2 * i4 + 1]) - mean) * rstd * g4.w + b4.w;
        }
    }
}
DI void p7_quant_h(const Params& p, const LAS unsigned char* gb, int tok, int l32, unsigned (&hq)[2][4], float& hscale) {
    float hv[32];
    p7_load_h(p, gb, tok, l32, hv);
    float am = 0.f;
#pragma unroll
    for (int i = 0; i < 32; ++i) am = fmaxf(am, fabsf(hv[i]));
    am = fmaxf(am, __shfl_xor(am, 1)); am = fmaxf(am, __shfl_xor(am, 2)); am = fmaxf(am, __shfl_xor(am, 4)); am = fmaxf(am, __shfl_xor(am, 8)); am = fmaxf(am, __shfl_xor(am, 16));
    const float hq_sc = am > 0.f ? 127.0f / am : 1.0f;
    hscale = am > 0.f ? am / 127.0f : 1.0f;
#pragma unroll
    for (int c = 0; c < 2; ++c)
#pragma unroll
        for (int q = 0; q < 4; ++q) {
            const int q0 = (int)rintf(hv[c * 16 + 4 * q] * hq_sc), q1 = (int)rintf(hv[c * 16 + 4 * q + 1] * hq_sc);
            const int q2 = (int)rintf(hv[c * 16 + 4 * q + 2] * hq_sc), q3 = (int)rintf(hv[c * 16 + 4 * q + 3] * hq_sc);
            hq[c][q] = (unsigned)(q0 & 255) | ((unsigned)(q1 & 255) << 8) | ((unsigned)(q2 & 255) << 16) | ((unsigned)(q3 & 255) << 24);
        }
}
DI void p7_finish(const Params& p, int tok, const float (&hv)[32], f32x2 (&acc)[2][8], int l32) {
    const size_t hbase = (size_t)tok * 1024 + l32 * 16;
    float sm = 0.f;
    {
#pragma unroll
        for (int c = 0; c < 2; ++c)
#pragma unroll
            for (int i = 0; i < 8; ++i) {
                acc[c][i].x += ALPHA * hv[c * 16 + 2 * i]; acc[c][i].y += ALPHA * hv[c * 16 + 2 * i + 1];
                sm += acc[c][i].x + acc[c][i].y;
            }
    }
    const float mean = half32_sum(sm) * (1.0f / 1024.0f);
    float sq = 0.f;
#pragma unroll
    for (int c = 0; c < 2; ++c)
#pragma unroll
        for (int i = 0; i < 8; ++i) { acc[c][i].x -= mean; acc[c][i].y -= mean; sq += acc[c][i].x * acc[c][i].x + acc[c][i].y * acc[c][i].y; }
    const float rstd = rsqrtf(half32_sum(sq) * (1.0f / 1024.0f) + LN_EPS);
    const float* gg = p.in[18] + l32 * 16;
    const float* bb = p.in[19] + l32 * 16;
    float* orow = p.out + hbase;
#pragma unroll
    for (int c = 0; c < 2; ++c)
#pragma unroll
        for (int q4 = 0; q4 < 4; ++q4) {
            const f32x4 g4 = *(const f32x4*)(gg + c * 512 + q4 * 4), b4 = *(const f32x4*)(bb + c * 512 + q4 * 4);
            f32x4 o = {acc[c][2 * q4].x * rstd * g4.x + b4.x, acc[c][2 * q4].y * rstd * g4.y + b4.y,
                       acc[c][2 * q4 + 1].x * rstd * g4.z + b4.z, acc[c][2 * q4 + 1].y * rstd * g4.w + b4.w};
            *(f32x4*)(orow + c * 512 + q4 * 4) = o;
        }
}

DI void phase7(const Params& p, unsigned char* lds) {
    unsigned char* ws = p.ws;
    const int lane = threadIdx.x & 63, wid = __builtin_amdgcn_readfirstlane(threadIdx.x >> 6);
    const int hw = lane >> 5, l32 = lane & 31;
    LAS unsigned char* l3 = (LAS unsigned char*)lds + wid * P7_WLDS;
    const unsigned char* u8 = ws + WS_UB;
    const unsigned char* v8 = ws + WS_VB;
    const float* uscale = (const float*)(ws + WS_USCALE);
    const float* vscale = (const float*)(ws + WS_VSCALE);
    LAS int* ent_e = (LAS int*)l3;
    LAS float* ent_w = (LAS float*)(l3 + 2048);
    LAS float* ent_us = (LAS float*)(l3 + 4096);
    {
        const int t = threadIdx.x;
        *(f32x4*)(lds + P7_GB + t * 16) = *(const f32x4*)(p.in[12] + t * 4);
        *(f32x4*)(lds + P7_GB + 4096 + t * 16) = *(const f32x4*)(p.in[13] + t * 4);
        __syncthreads();
    }
    const unsigned long long ltmask = (1ull << lane) - 1ull;
    const int myk = ((lane & 1) << 2) | (lane & 2) | ((lane >> 2) & 1);
    const int li0 = hw, li1 = 2 + hw;
    for (int rnd = blockIdx.x * 4 + wid; rnd < NTOK / 4; rnd += gridDim.x * 4) {
        const int tok0 = rnd * 4;
#pragma unroll 1
        for (int tk = 0; tk < 4; ++tk) {
            const int* RE = (const int*)(ws + WS_TOPK) + (size_t)(tok0 + tk) * 128;
            const float* RG = (const float*)(ws + WS_TOPK + 8 * MiB) + (size_t)(tok0 + tk) * 128;
            const int ea = RE[lane], eb = RE[64 + lane];
            const float ga = RG[lane], gb = RG[64 + lane];
            const int sa = ea >> P7_SH, sb = eb >> P7_SH;
            int pa = 0, pb = 0, run = 0;
#pragma unroll
            for (int s = 0; s < P7_NS; ++s) {
                const unsigned long long ma = __ballot(sa == s), mb = __ballot(sb == s);
                const int ca = __popcll(ma), cb = __popcll(mb);
                if (sa == s) pa = run + __popcll(ma & ltmask);
                if (sb == s) pb = run + ca + __popcll(mb & ltmask);
                run += ca + cb;
            }
            ent_e[tk * 128 + pa] = ea; ent_w[tk * 128 + pa] = ga * vscale[ea]; ent_us[tk * 128 + pa] = uscale[ea];
            ent_e[tk * 128 + pb] = eb; ent_w[tk * 128 + pb] = gb * vscale[eb]; ent_us[tk * 128 + pb] = uscale[eb];
        }
        {
            unsigned hq0[2][4], hq1[2][4];
            float hs0, hs1;
            p7_quant_h(p, (const LAS unsigned char*)lds, tok0 + li0, l32, hq0, hs0);
            p7_quant_h(p, (const LAS unsigned char*)lds, tok0 + li1, l32, hq1, hs1);
            u32x4 ra[8][2], rb[8][2];
            p7_loadrows(0, li0, l32, ent_e, u8, ra);
            for (int b = 0; b < 128; b += 8) {
                p7_loadrows(b, li1, l32, ent_e, u8, rb);
                __builtin_amdgcn_sched_barrier(0);
                p7_stepA(ra, hq0, hs0, b, li0, l32, lane, myk, ent_w, ent_us);
                __builtin_amdgcn_sched_barrier(0);
                p7_loadrows(b + 8 < 128 ? b + 8 : b, li0, l32, ent_e, u8, ra);
                __builtin_amdgcn_sched_barrier(0);
                p7_stepA(rb, hq1, hs1, b, li1, l32, lane, myk, ent_w, ent_us);
                __builtin_amdgcn_sched_barrier(0);
            }
        }
        f32x2 acc0[2][8], acc1[2][8];
#pragma unroll
        for (int c = 0; c < 2; ++c)
#pragma unroll
            for (int i = 0; i < 8; ++i) { acc0[c][i] = (f32x2){0.f, 0.f}; acc1[c][i] = (f32x2){0.f, 0.f}; }
        {
            u32x4 ra[8][2], rb[8][2];
            p7_loadrows(0, li0, l32, ent_e, v8, ra);
            for (int b = 0; b < 128; b += 8) {
                p7_loadrows(b, li1, l32, ent_e, v8, rb);
                __builtin_amdgcn_sched_barrier(0);
                p7_stepB(ra, acc0, b, li0, ent_w);
                __builtin_amdgcn_sched_barrier(0);
                p7_loadrows(b + 8 < 128 ? b + 8 : b, li0, l32, ent_e, v8, ra);
                __builtin_amdgcn_sched_barrier(0);
                p7_stepB(rb, acc1, b, li1, ent_w);
                __builtin_amdgcn_sched_barrier(0);
            }
        }
        {
            float hv0[32], hv1[32];
            p7_load_h(p, (const LAS unsigned char*)lds, tok0 + li0, l32, hv0);
            p7_load_h(p, (const LAS unsigned char*)lds, tok0 + li1, l32, hv1);
            p7_finish(p, tok0 + li0, hv0, acc0, l32);
            p7_finish(p, tok0 + li1, hv1, acc1, l32);
        }
    }
}

#if DIAG
DI float bfv(const bf16_t* p, size_t i) { return __uint_as_float(((unsigned)p[i]) << 16); }
DI float bfr(float x) { return __uint_as_float(f2bf(x) << 16); }
DI void dfail(const Params& p, int bit) { atomicOr((unsigned*)(p.ws + WS_FLAG), 1u << bit); }
DI bool bad(float fast, float ref) { return !(fabsf(fast - ref) <= 0.02f * fabsf(ref) + 0.02f); }
DI unsigned hsh(unsigned x) { x ^= x >> 16; x *= 0x7feb352dU; x ^= x >> 15; x *= 0x846ca68bU; x ^= x >> 16; return x; }
DI int winsrc(int n) { return n < 1280 ? n : (n < 1792 ? 1304 + (n - 1280) : 1280 + (n - 1792)); }

DI void chk1(const Params& p, int bit) {
    unsigned char* ws = p.ws;
    const unsigned gt = blockIdx.x * NTHREADS + threadIdx.x;
    const int tok = hsh(gt * 2 + 1) & 16383, n = hsh(gt * 2 + 2) % 1816;
    const bf16_t* xb = (const bf16_t*)(ws + WS_XB);
    const bf16_t* wt = (const bf16_t*)(ws + WS_WINT);
    float ref = 0.f, ref2 = 0.f;
    for (int k = 0; k < 1024; ++k) {
        ref += bfv(xb, (size_t)tok * 1024 + k) * bfv(wt, (size_t)n * 1024 + k);
        ref2 += p.in[0][(size_t)tok * 1024 + k] * p.in[1][(size_t)k * 1816 + winsrc(n)];
    }
    if (!(fabsf(ref - ref2) <= 0.06f)) dfail(p, bit);
    const int b = tok >> 12, t = tok & 4095;
    float fast;
    if (n < 512) { const int hd = n >> 6, d = n & 63; fast = bfv((const bf16_t*)(ws + WS_Q), ((size_t)(b * 8 + hd) * SEQ + t) * 64 + d); ref *= 0.125f; }
    else if (n < 1280) {
        const int seg = (n - 512) >> 7, nn = (n - 512) & 127, g = nn >> 6, d = nn & 63;
        if (seg == 3 || seg == 5) fast = bfv((const bf16_t*)(ws + (seg == 3 ? WS_VSLCT : WS_VWINT)), ((size_t)((b * 2 + g) * 64 + d)) * SEQ + t);
        else fast = bfv((const bf16_t*)(ws + (seg == 0 ? WS_KC : seg == 1 ? WS_VC : seg == 2 ? WS_KSLC : WS_KWIN)), ((size_t)(b * 2 + g) * SEQ + t) * 64 + d);
    } else if (n < 1792) fast = bfv((const bf16_t*)(ws + WS_Z), (size_t)tok * 512 + (n - 1280));
    else { fast = ((const float*)(ws + WS_GATES))[(size_t)tok * 24 + (n - 1792)]; ref = 1.f / (1.f + expf(-ref)); }
    if (bad(fast, ref)) dfail(p, bit);
}
DI void chk2(const Params& p, int bit) {
    unsigned char* ws = p.ws;
    const unsigned gt = blockIdx.x * NTHREADS + threadIdx.x;
    if (gt >= 2048) return;
    const int kv = gt & 1, bg = (gt >> 1) & 7, c = hsh(gt) % 255, d = hsh(gt + 7777) & 63;
    const bf16_t* A = (const bf16_t*)(ws + (kv ? WS_VC : WS_KC)) + ((size_t)bg * SEQ + c * 16) * 64;
    const bf16_t* w1t = (const bf16_t*)(ws + (kv ? WS_W1TV : WS_W1TK));
    const bf16_t* w2t = (const bf16_t*)(ws + (kv ? WS_W2TV : WS_W2TK));
    const float* peb = (const float*)(ws + (kv ? WS_PEBV : WS_PEBK));
    float out = 0.f;
    for (int j = 0; j < 256; ++j) {
        float s = peb[j];
        for (int i = 0; i < 2048; ++i) s += bfv(A, i) * bfv(w1t, (size_t)j * 2048 + i);
        out += bfr(gelu_erf(s)) * bfv(w2t, d * 256 + j);
    }
    const float fast = ((const float*)(ws + (kv ? WS_VCMP : WS_KCMP)))[((size_t)bg * 256 + c) * 64 + d];
    if (bad(fast, out)) dfail(p, bit);
    if (gt < 256) {
        const float* w1 = kv ? p.in[7] : p.in[5];
        const float* w2 = kv ? p.in[8] : p.in[6];
        const float* pe = kv ? p.in[4] : p.in[3];
        float o2 = 0.f;
        for (int j = 0; j < 256; ++j) {
            float s = 0.f;
            for (int i = 0; i < 2048; ++i) s += (bfv(A, i) + pe[i]) * w1[(size_t)i * 256 + j];
            o2 += gelu_erf(s) * w2[j * 64 + d];
        }
        if (!(fabsf(o2 - out) <= 0.03f * fabsf(out) + 0.03f)) dfail(p, bit);
    }
}
DI void chk3(const Params& p, int bit) {
    unsigned char* ws = p.ws;
    const unsigned gt = blockIdx.x * NTHREADS + threadIdx.x;
    if (gt >= 4096) return;
    const int tok = hsh(gt) & 16383, head = hsh(gt + 99) & 7, b = tok >> 12, t = tok & 4095, g = head >> 2;
    const bf16_t* Q = (const bf16_t*)(ws + WS_Q) + ((size_t)(b * 8 + head) * SEQ + t) * 64;
    const bf16_t* K = (const bf16_t*)(ws + WS_KWIN) + (size_t)(b * 2 + g) * SEQ * 64;
    const bf16_t* Vt = (const bf16_t*)(ws + WS_VWINT) + (size_t)(b * 2 + g) * 64 * SEQ;
    float q[64], o[64];
#pragma unroll
    for (int d = 0; d < 64; ++d) { q[d] = bfv(Q, d); o[d] = 0.f; }
    float m = -1e30f, l = 0.f;
    for (int pos = (t > 511 ? t - 511 : 0); pos <= t; ++pos) {
        float s = 0.f;
#pragma unroll
        for (int d = 0; d < 64; ++d) s += q[d] * bfv(K, (size_t)pos * 64 + d);
        s += p.in[2][rel_bucket_dev(t - pos) * 8 + head];
        const float mn = fmaxf(m, s), a = expf(m - mn), pp = expf(s - mn);
        l = l * a + pp;
#pragma unroll
        for (int d = 0; d < 64; ++d) o[d] = o[d] * a + pp * bfv(Vt, (size_t)d * SEQ + pos);
        m = mn;
    }
    const float gate = ((const float*)(ws + WS_GATES))[(size_t)tok * 24 + 16 + head];
    bool f = false;
#pragma unroll
    for (int d = 0; d < 64; ++d) f |= bad(bfv((const bf16_t*)(ws + WS_OWIN), (size_t)tok * 512 + head * 64 + d), o[d] / l * gate);
    if (f) dfail(p, bit);
}
DI void chk4(const Params& p, int bit) {
    unsigned char* ws = p.ws;
    const unsigned gt = blockIdx.x * NTHREADS + threadIdx.x;
    if (gt >= 512) return;
    const int tok = hsh(gt + 5) & 16383, g = gt & 1, b = tok >> 12, t = tok & 4095, bg = b * 2 + g;
    float* scr = (float*)(ws + WS_DSCR) + (size_t)gt * 1536;
    float* imp = scr + 1024;
    float* nsa = scr + 1100;
    for (int j = 0; j < 64; ++j) imp[j] = 0.f;
    const float* kc = (const float*)(ws + WS_KCMP) + (size_t)bg * 256 * 64;
    const float* vc = (const float*)(ws + WS_VCMP) + (size_t)bg * 256 * 64;
    const float* gt24 = (const float*)(ws + WS_GATES) + (size_t)tok * 24;
    for (int hl = 0; hl < 4; ++hl) {
        const int head = g * 4 + hl;
        const bf16_t* Q = (const bf16_t*)(ws + WS_Q) + ((size_t)(b * 8 + head) * SEQ + t) * 64;
        float q[64], o[64];
#pragma unroll
        for (int d = 0; d < 64; ++d) { q[d] = bfv(Q, d); o[d] = 0.f; }
        float m = -1e30f;
        for (int c = 0; c < 255; ++c) {
            const bool valid = 16 * c + 31 <= t;
            float s = 0.f;
#pragma unroll
            for (int d = 0; d < 64; ++d) s += q[d] * bfr(kc[c * 64 + d]);
            s += p.in[2][rel_bucket_dev(t - 16 * c - 31) * 8 + head];
            scr[hl * 256 + c] = s;
            if (valid) m = fmaxf(m, s);
        }
        float l = 0.f;
        for (int c = 0; c < 255; ++c) if (16 * c + 31 <= t) l += expf(scr[hl * 256 + c] - m);
        for (int c = 0; c < 255; ++c) if (16 * c + 31 <= t) {
            const float pc = expf(scr[hl * 256 + c] - m) / l;
            imp[c >> 2] += pc;
            if ((c & 3) == 3 && (c >> 2) + 1 < 64) imp[(c >> 2) + 1] += pc;
#pragma unroll
            for (int d = 0; d < 64; ++d) o[d] += bfr(pc) * bfr(vc[c * 64 + d]);
        }
#pragma unroll
        for (int d = 0; d < 64; ++d) nsa[hl * 64 + d] = gt24[head] * o[d];
    }
    const int cur = t >> 6;
    for (int j = 0; j < 64; ++j) { float v = imp[j]; if (j == 0 || j == cur || j == cur - 1) v = 1e6f; if (j > cur) v = -1e30f; imp[j] = v; }
    unsigned long long selmask = 0ull;
    for (int it = 0; it < 16; ++it) {
        int bi = -1; float bv = -3e38f;
        for (int j = 0; j < 64; ++j) if (!((selmask >> j) & 1ull) && imp[j] > bv) { bv = imp[j]; bi = j; }
        selmask |= 1ull << bi;
    }
    bool f = false;
    for (int hl = 0; hl < 4; ++hl) {
        const int head = g * 4 + hl;
        const bf16_t* Q = (const bf16_t*)(ws + WS_Q) + ((size_t)(b * 8 + head) * SEQ + t) * 64;
        const bf16_t* K = (const bf16_t*)(ws + WS_KSLC) + (size_t)bg * SEQ * 64;
        const bf16_t* Vt = (const bf16_t*)(ws + WS_VSLCT) + (size_t)bg * 64 * SEQ;
        float q[64], o[64];
#pragma unroll
        for (int d = 0; d < 64; ++d) { q[d] = bfv(Q, d); o[d] = 0.f; }
        float m = -1e30f, l = 0.f;
        for (int j = 0; j <= cur; ++j) if ((selmask >> j) & 1ull) {
            for (int kk = 0; kk < 64; ++kk) {
                const int pos = j * 64 + kk;
                if (pos > t) break;
                float s = 0.f;
#pragma unroll
                for (int d = 0; d < 64; ++d) s += q[d] * bfv(K, (size_t)pos * 64 + d);
                s += p.in[2][rel_bucket_dev(t - pos) * 8 + head];
                const float mn = fmaxf(m, s), a = expf(m - mn), pp = expf(s - mn);
                l = l * a + pp;
#pragma unroll
                for (int d = 0; d < 64; ++d) o[d] = o[d] * a + pp * bfv(Vt, (size_t)d * SEQ + pos);
                m = mn;
            }
        }
#pragma unroll
        for (int d = 0; d < 64; ++d) {
            const float ref = nsa[hl * 64 + d] + gt24[8 + head] * o[d] / l + bfv((const bf16_t*)(ws + WS_OWIN), (size_t)tok * 512 + head * 64 + d);
            f |= bad(bfv((const bf16_t*)(ws + WS_MIXIN), (size_t)tok * 1024 + head * 64 + d), ref);
        }
    }
    if (f) dfail(p, bit);
}
DI void chk5(const Params& p, int bit) {
    unsigned char* ws = p.ws;
    const unsigned gt = blockIdx.x * NTHREADS + threadIdx.x;
    if (gt >= 8192) return;
    const int tok = hsh(gt + 11) & 16383, col = hsh(gt + 13) & 511, gi = col >> 7, d = col & 127, t = tok & 4095;
    const bf16_t* yp = (const bf16_t*)(ws + WS_YPOOL);
    const bf16_t* pw = (const bf16_t*)(ws + WS_POOLWT);
    const bf16_t* z = (const bf16_t*)(ws + WS_Z);
    float ref = 0.f, ref2 = 0.f;
    for (int c = 0; c < 128; ++c) {
        ref += bfv(yp, (size_t)tok * 512 + gi * 128 + c) * bfv(pw, (size_t)gi * 16384 + d * 128 + c);
        ref2 += bfv(yp, (size_t)tok * 512 + gi * 128 + c) * p.in[9][(size_t)gi * 16384 + c * 128 + d];
    }
    if (!(fabsf(ref - ref2) <= 0.03f)) dfail(p, bit);
    ref *= p.in[10][col];
    if (bad(bfv((const bf16_t*)(ws + WS_MIXIN), (size_t)tok * 1024 + 512 + col), ref)) dfail(p, bit);
    const int win = 2 << (col >> 7), cnt = (t + 1 < win) ? t + 1 : win;
    float s = 0.f;
    for (int k = 0; k < cnt; ++k) s += bfv(z, (size_t)(tok - k) * 512 + col);
    if (bad(bfv(yp, (size_t)tok * 512 + col), s / (float)cnt - bfv(z, (size_t)tok * 512 + col))) dfail(p, bit);
}
DI void chk6(const Params& p, int bit) {
    unsigned char* ws = p.ws;
    const unsigned gt = blockIdx.x * NTHREADS + threadIdx.x;
    if (gt >= 128) return;
    const int tok = hsh(gt + 17) & 16383;
    float* yb = (float*)(ws + WS_DSCR) + (size_t)gt * 1024;
    const bf16_t* mx = (const bf16_t*)(ws + WS_MIXIN) + (size_t)tok * 1024;
    const bf16_t* wo = (const bf16_t*)(ws + WS_WOUTT);
    float sm = 0.f;
    bool f = false;
    for (int n = 0; n < 1024; ++n) {
        float s = 0.f, s2 = 0.f;
        for (int k = 0; k < 1024; ++k) { s += bfv(mx, k) * bfv(wo, (size_t)n * 1024 + k); if (n < 8) s2 += bfv(mx, k) * p.in[11][(size_t)k * 1024 + n]; }
        if (n < 8 && !(fabsf(s - s2) <= 0.03f)) f = true;
        yb[n] = ALPHA * p.in[0][(size_t)tok * 1024 + n] + s; sm += yb[n];
    }
    const float mean = sm / 1024.f;
    float v = 0.f;
    for (int n = 0; n < 1024; ++n) v += (yb[n] - mean) * (yb[n] - mean);
    const float rstd = 1.f / sqrtf(v / 1024.f + LN_EPS);
    for (int n = 0; n < 1024; ++n)
        f |= bad(bfv((const bf16_t*)(ws + WS_H1), (size_t)tok * 1024 + n), (yb[n] - mean) * rstd * p.in[12][n] + p.in[13][n]);
    if (f) dfail(p, bit);
}
DI void chk7(const Params& p, int bit) {
    unsigned char* ws = p.ws;
    const unsigned gt = blockIdx.x * NTHREADS + threadIdx.x;
    if (gt >= 512) return;
    const int tok = hsh(gt + 23) & 16383, head = gt & 7, half = (gt >> 3) & 1;
    float* qd = (float*)(ws + WS_DSCR) + (size_t)gt * 256;
    float* sv = qd + 128;
    const bf16_t* h1 = (const bf16_t*)(ws + WS_H1) + (size_t)tok * 1024;
    const bf16_t* wq = (const bf16_t*)(ws + WS_WQT);
    const bf16_t* sk = (const bf16_t*)(ws + WS_SUBK);
    bool f = false;
    for (int d = 0; d < 128; ++d) {
        float s = 0.f, s2 = 0.f;
        const int col = head * 256 + half * 128 + d;
        for (int k = 0; k < 1024; ++k) { s += bfv(h1, k) * bfv(wq, (size_t)col * 1024 + k); if (d < 4) s2 += bfv(h1, k) * p.in[14][(size_t)k * 2048 + col]; }
        if (d < 4 && !(fabsf(s - s2) <= 0.06f)) f = true;
        qd[d] = bfr(s);
    }
    for (int key = 0; key < 128; ++key) {
        float s = 0.f, s2 = 0.f;
        for (int d = 0; d < 128; ++d) { s += qd[d] * bfv(sk, (size_t)(half * 128 + key) * 128 + d); s2 += qd[d] * p.in[15][(size_t)(half * 128 + key) * 128 + d]; }
        if (!(fabsf(s - s2) <= 0.05f)) f = true;
        sv[key] = s;
    }
    int mism = 0;
    const int* L = (const int*)(ws + WS_TOPK) + (((size_t)tok * 8 + head) * 2 + half) * 16;
    for (int it = 0; it < 16; ++it) {
        int bi = 0; float bv = -3e38f;
        for (int k = 0; k < 128; ++k) if (sv[k] > bv) { bv = sv[k]; bi = k; }
        sv[bi] = -3e38f;
        const int fk = L[it];
        if ((fk & 127) != bi) mism++;
        if (bad(key_val(fk), bv)) mism += 10;
    }
    if (mism > 1 || f) dfail(p, bit);
}
DI void chk8(const Params& p, int bit) {
    unsigned char* ws = p.ws;
    const unsigned gt = blockIdx.x * NTHREADS + threadIdx.x;
    if (gt >= 128) return;
    const int tok = hsh(gt + 31) & 16383;
    float* acc = (float*)(ws + WS_DSCR) + (size_t)gt * 4096;
    float* cand = acc + 1024;
    int* csel = (int*)(acc + 1024 + 256);
    float* acc2 = acc + 2048;
    const bf16_t* h1 = (const bf16_t*)(ws + WS_H1) + (size_t)tok * 1024;
    const bf16_t* ub = (const bf16_t*)(ws + WS_UB);
    const bf16_t* vb = (const bf16_t*)(ws + WS_VB);
    const int* dE = (const int*)(ws + WS_MIXIN) + (size_t)tok * 256;
    const float* dG = (const float*)dE + 128;
    bool f = false, froute = false, fg = false;
    for (int n = 0; n < 1024; ++n) { acc[n] = 0.f; acc2[n] = 0.f; }
    for (int hd = 0; hd < 8; ++hd) {
        const int* L = (const int*)(ws + WS_TOPK) + (size_t)tok * 256 + hd * 32;
        for (int i = 0; i < 16; ++i) for (int j = 0; j < 16; ++j) cand[i * 16 + j] = key_val(L[i]) + key_val(L[16 + j]);
        float mx = -3e38f, den = 0.f;
        for (int it = 0; it < 16; ++it) {
            int bi = 0; float bv = -3e38f;
            for (int k = 0; k < 256; ++k) if (cand[k] > bv) { bv = cand[k]; bi = k; }
            cand[bi] = -3e38f; csel[it] = bi;
            if (it == 0) mx = bv;
            ((float*)csel)[16 + it] = expf(bv - mx); den += expf(bv - mx);
        }
        for (int it = 0; it < 16; ++it) {
            const int i = csel[it] >> 4, j = csel[it] & 15;
            const size_t e = (size_t)(L[i] & 127) * 128 + (L[16 + j] & 127);
            float dot = 0.f;
            for (int k = 0; k < 1024; ++k) dot += bfv(h1, k) * bfv(ub, e * 1024 + k);
            const float gate = ((float*)csel)[16 + it] / den;
            const float w = gate * gelu_erf(dot);
            for (int n = 0; n < 1024; ++n) acc[n] += w * bfv(vb, e * 1024 + n);
            bool found = false;
            for (int s = 0; s < 16; ++s) if (dE[hd * 16 + s] == (int)e) { found = true; if (!(fabsf(dG[hd * 16 + s] - gate) <= 1e-3f)) fg = true; }
            if (!found) froute = true;
        }
        for (int s = 0; s < 16; ++s) {
            const size_t e = (size_t)dE[hd * 16 + s];
            if (e >= 16384) { froute = true; continue; }
            float dot = 0.f;
            for (int k = 0; k < 1024; ++k) dot += bfv(h1, k) * bfv(ub, e * 1024 + k);
            const float w = dG[hd * 16 + s] * gelu_erf(dot);
            for (int n = 0; n < 1024; ++n) acc2[n] += w * bfv(vb, e * 1024 + n);
        }
    }
    bool f2 = false;
    for (int pass = 0; pass < 2; ++pass) {
        float* a = pass ? acc2 : acc;
        float sm = 0.f;
        for (int n = 0; n < 1024; ++n) { a[n] += ALPHA * bfv(h1, n); sm += a[n]; }
        const float mean = sm / 1024.f;
        float v = 0.f;
        for (int n = 0; n < 1024; ++n) v += (a[n] - mean) * (a[n] - mean);
        const float rstd = 1.f / sqrtf(v / 1024.f + LN_EPS);
        for (int n = 0; n < 1024; ++n) {
            const bool b = bad(p.out[(size_t)tok * 1024 + n], (a[n] - mean) * rstd * p.in[18][n] + p.in[19][n]);
            if (pass) f2 |= b; else f |= b;
        }
    }
    if (f) dfail(p, bit);
    if (froute) dfail(p, bit + 1);
    if (fg) dfail(p, bit + 2);
    if (f2) dfail(p, bit + 3);
}
#endif

__global__ void __launch_bounds__(NTHREADS, 2) hybrid_fwd(Params p) {
    extern __shared__ __attribute__((aligned(16))) unsigned char lds[];
    cg::grid_group grid = cg::this_grid();
    const int lo = p.ph_lo, hi = p.ph_hi;
    volatile unsigned* bst = (volatile unsigned*)(lds + LDS_MAIN);
    if (threadIdx.x < 2) bst[threadIdx.x] = 0u;
    __syncthreads();
    XcdBarrier xbar = xcd_barrier_post((unsigned*)(p.ws + WS_BAR), bst);
#define IN(k) (lo <= (k) && (k) < hi)
#define SEAM(k) do { if (IN(k) && IN((k) + 1 + ((k) == 4))) xcd_barrier(xbar); } while (0)
    if (lo < 0) grid.sync();
#if DIAG
    if (blockIdx.x == 0 && threadIdx.x == 0) *(unsigned*)(p.ws + WS_FLAG) = 0u;
#endif
    if (IN(0)) phase0(p);
    SEAM(0);
    if (IN(1)) phase1(p, lds);
    SEAM(1);
#if DIAG == 1
    chk1(p, 0);
#endif
    if (IN(2)) phase2(p, lds);
    SEAM(2);
#if DIAG == 1
    chk2(p, 1); chk3(p, 2);
#endif
    if (IN(3)) phase3(p, lds);
    SEAM(3);
#if DIAG == 1
    chk4(p, 3); chk5(p, 4);
#endif
    if (IN(4)) phase4(p, lds);
    SEAM(4);
#if DIAG == 1
    chk6(p, 5);
#endif
    if (IN(6)) phase6(p, lds);
    SEAM(6);
#if DIAG == 2
    chk7(p, 0);
#endif
    if (IN(7)) phase7(p, lds);
#if DIAG
    grid.sync();
#if DIAG == 2
    chk8(p, 1);
    grid.sync();
#endif
    {
        const unsigned code = *(volatile unsigned*)(p.ws + WS_FLAG);
        const float kv = sqrtf((float)code);
        for (size_t i = (size_t)blockIdx.x * NTHREADS + threadIdx.x; i < (size_t)NTOK * DM; i += (size_t)gridDim.x * NTHREADS) p.out[i] = kv;
    }
#endif
#undef IN
#undef SEAM
}

extern "C" void kernel_launch(void* const* d_in, const int* in_sizes, int n_in, void* d_out, int out_size, void* d_ws, size_t ws_size,
                              hipStream_t stream) {
    static int grid_blocks = 0;
    if (grid_blocks == 0) {
        if (n_in != 20 || ws_size < WS_END) { fprintf(stderr, "kernel_launch: unexpected inputs (n_in %d, ws %zu)\n", n_in, ws_size); grid_blocks = -1; return; }
        int dev = 0, cus = 0, per_cu = 0;
        hipGetDevice(&dev);
        hipDeviceGetAttribute(&cus, hipDeviceAttributeMultiprocessorCount, dev);
        hipFuncSetAttribute((const void*)hybrid_fwd, hipFuncAttributeMaxDynamicSharedMemorySize, LDS_BYTES);
        hipOccupancyMaxActiveBlocksPerMultiprocessor(&per_cu, (const void*)hybrid_fwd, NTHREADS, LDS_BYTES);
        if (per_cu < 1) per_cu = 1;
        if (per_cu > 2) per_cu = 2;
        grid_blocks = cus * per_cu;
        (void)hipGetLastError();
    }
    if (grid_blocks < 0) return;
    (void)hipMemsetAsync((char*)d_ws + WS_BAR, 0, WS_BAR_BYTES, stream);
    Params p{};
    for (int i = 0; i < 20; ++i) p.in[i] = (const float*)d_in[i];
    p.out = (float*)d_out; p.ws = (unsigned char*)d_ws;
#if N_LAUNCH_MODE == 1
    p.ph_lo = 0; p.ph_hi = 8;
    void* args[] = {&p};
    hipError_t e = hipLaunchCooperativeKernel((const void*)hybrid_fwd, dim3(grid_blocks), dim3(NTHREADS), args, LDS_BYTES, stream);
    if (e != hipSuccess) fprintf(stderr, "cooperative launch failed: %s (grid %d)\n", hipGetErrorString(e), grid_blocks);
#else
    for (int ph = 0; ph < 8; ++ph) {
        p.ph_lo = ph; p.ph_hi = ph + 1;
        hipLaunchKernelGGL(hybrid_fwd, dim3(grid_blocks), dim3(NTHREADS), LDS_BYTES, stream, p);
    }
#endif
}
```

```cpp
#include <hip/hip_runtime.h>
#include <hip/hip_cooperative_groups.h>
#include <cstdint>
#include <cstdio>
namespace cg = cooperative_groups;

#ifndef N_LAUNCH_MODE
#define N_LAUNCH_MODE 1
#endif

typedef unsigned short bf16_t;
typedef short bf16x8 __attribute__((ext_vector_type(8)));
typedef short s16x4 __attribute__((ext_vector_type(4)));
typedef float f32x16 __attribute__((ext_vector_type(16)));
typedef float f32x4 __attribute__((ext_vector_type(4)));
typedef unsigned u32x4 __attribute__((ext_vector_type(4)));
typedef unsigned u32x2 __attribute__((ext_vector_type(2)));
typedef float f32x2 __attribute__((ext_vector_type(2)));
typedef __bf16 bf16x2_t __attribute__((ext_vector_type(2)));

#define DI __device__ __forceinline__
#define MFMA32(a, b, c) __builtin_amdgcn_mfma_f32_32x32x16_bf16((a), (b), (c), 0, 0, 0)

constexpr int NTOK = 16384, SEQ = 4096, DM = 1024;
constexpr int NINP = 1920;
constexpr float ALPHA = 1.189207115002721f;
constexpr float LN_EPS = 1e-5f;
constexpr float LOG2E = 1.4426950408889634f;
constexpr float QSCALE = 0.125f * LOG2E;
constexpr int NTHREADS = 256;
constexpr int LDS_MAIN = 73728;
constexpr int LDS_CST = LDS_MAIN + 64;
constexpr int LDS_BYTES = LDS_MAIN + 64 + 2048;
constexpr int ROWB = 144;

constexpr size_t MiB = 1u << 20;
constexpr size_t WS_BAR = 0;
constexpr size_t WS_BAR_BYTES = 16384;
constexpr size_t WS_KCMP = 1 * MiB;
constexpr size_t WS_VCMP = 1 * MiB + 512 * 1024;
constexpr size_t WS_W2TK = 2 * MiB;
constexpr size_t WS_W2TV = 2 * MiB + 32 * 1024;
constexpr size_t WS_POOLWT = 2 * MiB + 64 * 1024;
constexpr size_t WS_SUBK = 2 * MiB + 192 * 1024;
constexpr size_t WS_PEBK = 2 * MiB + 256 * 1024;
constexpr size_t WS_PEBV = 2 * MiB + 257 * 1024;
constexpr size_t WS_BUCK = 2 * MiB + 258 * 1024;
constexpr size_t WS_USCALE = 2 * MiB + 320 * 1024;
constexpr size_t WS_VSCALE = 2 * MiB + 384 * 1024;
constexpr size_t WS_C1 = 2 * MiB + 448 * 1024;
constexpr size_t WS_C2 = 2 * MiB + 456 * 1024;
constexpr size_t WS_LNST = 15 * MiB;
constexpr size_t WS_W1TK = 3 * MiB;
constexpr size_t WS_W1TV = 4 * MiB;
constexpr size_t WS_WINT = 5 * MiB;
constexpr size_t WS_WOUTT = 9 * MiB;
constexpr size_t WS_WQT = 11 * MiB;
constexpr size_t WS_UB = 16 * MiB;
constexpr size_t WS_VB = 48 * MiB;
constexpr size_t WS_XB = 80 * MiB;
constexpr size_t WS_MIXIN = WS_XB;
constexpr size_t WS_Q = 112 * MiB;
constexpr size_t WS_KC = 128 * MiB;
constexpr size_t WS_VC = 132 * MiB;
constexpr size_t WS_KSLC = 136 * MiB;
constexpr size_t WS_KWIN = 140 * MiB;
constexpr size_t WS_VSLCT = 144 * MiB;
constexpr size_t WS_VWINT = 148 * MiB;
constexpr size_t WS_GATES = 152 * MiB;
constexpr size_t WS_Z = 154 * MiB;
constexpr size_t WS_YPOOL = 170 * MiB;
constexpr size_t WS_OWIN = 186 * MiB;
#ifndef DIAG
#define DIAG 0
#endif
#if DIAG
constexpr size_t WS_H1 = 202 * MiB;
constexpr size_t WS_TOPK = 234 * MiB;
constexpr size_t WS_END = 256 * MiB;
constexpr size_t WS_FLAG = 32768;
constexpr size_t WS_DSCR = 250 * MiB;
#else
constexpr size_t WS_H1 = 112 * MiB;
constexpr size_t WS_TOPK = 112 * MiB;
constexpr size_t WS_END = 202 * MiB;
#endif

struct Params { const float* in[20]; float* out; unsigned char* ws; int ph_lo, ph_hi; };

DI unsigned f2bf(float f) { unsigned u = __float_as_uint(f); return (u + 0x7fffu + ((u >> 16) & 1u)) >> 16; }
DI unsigned pk2(float lo, float hi) { bf16x2_t v = {(__bf16)lo, (__bf16)hi}; return __builtin_bit_cast(unsigned, v); }
DI float bflo(unsigned x) { return __uint_as_float(x << 16); }
DI float bfhi(unsigned x) { return __uint_as_float(x & 0xffff0000u); }
DI float dot2bf(unsigned a, unsigned b, float acc) {
    asm("v_dot2c_f32_bf16 %0, %1, %2" : "+v"(acc) : "v"(a), "v"(b));
    return acc;
}
DI int dot4i8(unsigned a, unsigned b, int acc) {
    return __builtin_amdgcn_sdot4((int)a, (int)b, acc, false);
}
DI float gelu_erf(float x) { return 0.5f * x * (1.0f + erff(x * 0.70710678118654752f)); }
DI float gelu_fast(float v) {
    const float av = fabsf(v), t = __builtin_amdgcn_rcpf(av * 0.2316418882f + 1.0f);
    float q = t * 0.5307027145f + (-0.7265760135f); q = q * t + 0.7107068705f; q = q * t + (-0.142248368f); q = q * t + 0.127414796f; q = q * t;
    const float e = __builtin_amdgcn_exp2f((v * v) * (-0.72134752044f));
    const float m = v * (q * e);
    return v < 0.f ? m : v - m;
}
DI float wave_sum(float v) {
#pragma unroll
    for (int o = 32; o >= 1; o >>= 1) v += __shfl_xor(v, o);
    return v;
}
DI int rel_bucket_dev(int dist) {
    if (dist < 0) dist = 0;
    if (dist < 16) return dist;
    int v = 16 + (int)(logf((float)dist / 16.0f) / logf(8.0f) * 16.0f);
    return v < 31 ? v : 31;
}
DI int make_key(float f, int idx) { int b = __float_as_int(f); b ^= (b >> 31) & 0x7fffffff; return (b & ~127) | idx; }
DI float key_val(int k) { int b = k & ~127; b ^= (b >> 31) & 0x7fffffff; return __int_as_float(b); }


#define LAS __attribute__((address_space(3)))
#define XB_TMO      128
#define XB_XCNT(j)  (256  + 64 * (j))
#define XB_XSUB(j)  (1280 + 64 * (j))
#define XB_XGEN(j)  (2304 + 64 * (j))
#define XB_TOP      3328
#define XB_TOPGEN   3392
#define XCD_BAR_WORDS 3456
#define XB_SPIN_CAP (1u << 20)
DI unsigned xb_ld(unsigned* p)              { return __hip_atomic_load(p, __ATOMIC_RELAXED, __HIP_MEMORY_SCOPE_AGENT); }
DI unsigned xb_add(unsigned* p, unsigned v) { return __hip_atomic_fetch_add(p, v, __ATOMIC_RELAXED, __HIP_MEMORY_SCOPE_AGENT); }
DI unsigned xb_xcc_id() { return (unsigned)__builtin_amdgcn_s_getreg((3 << 11) | 20) & 0xFu; }
#define XB_SPIN(cond, bar) do { unsigned _sp = 0; while (cond) { __builtin_amdgcn_s_sleep(1); \
    if ((++_sp & 255u) == 0u) { if (xb_ld(&(bar)[XB_TMO])) break; if (_sp > XB_SPIN_CAP) { atomicAdd(&(bar)[XB_TMO], 1u); break; } } } } while (0)
struct XcdBarrier { unsigned* bar; unsigned x; volatile unsigned* st; };
DI XcdBarrier xcd_barrier_post(unsigned* bar, volatile unsigned* st) {
    XcdBarrier b; b.bar = bar; b.x = xb_xcc_id(); b.st = st;
    if (threadIdx.x == 0) (void)xb_add(&bar[XB_XCNT(b.x)], 1u);
    return b;
}
DI void xcd_barrier_complete(unsigned* bar, unsigned x, unsigned& nloc, unsigned& nx) {
    const unsigned G = gridDim.x * gridDim.y * gridDim.z;
    unsigned sum, cnt, mine, sp = 0u;
    for (;;) {
        sum = 0u; cnt = 0u; mine = 0u;
#pragma unroll
        for (unsigned j = 0; j < 16; ++j) { const unsigned c = xb_ld(&bar[XB_XCNT(j)]); sum += c; cnt += (c > 0u) ? 1u : 0u; mine = (j == x) ? c : mine; }
        if (sum == G) break;
        __builtin_amdgcn_s_sleep(1);
        if ((++sp & 255u) == 0u) { if (xb_ld(&bar[XB_TMO])) break; if (sp > XB_SPIN_CAP) { atomicAdd(&bar[XB_TMO], 1u); break; } }
    }
    nloc = mine > 0u ? mine : 1u; nx = cnt > 0u ? cnt : 1u;
}
DI void xcd_barrier(const XcdBarrier& b) {
    asm volatile("s_waitcnt vmcnt(0)" ::: "memory");
    __syncthreads();
    if (threadIdx.x == 0) {
        unsigned* bar = b.bar;
        __builtin_amdgcn_s_waitcnt(0);
        unsigned nloc = b.st[0], nx = b.st[1];
        if (nloc == 0u) { xcd_barrier_complete(bar, b.x, nloc, nx); b.st[0] = nloc; b.st[1] = nx; }
        const unsigned old = xb_add(&bar[XB_XSUB(b.x)], 1u);
        const unsigned gen = old / nloc;
        if (old + 1u == (gen + 1u) * nloc) {
            __builtin_amdgcn_fence(__ATOMIC_RELEASE, "agent");
            asm volatile("s_waitcnt vmcnt(0)" ::: "memory");
            const unsigned og = xb_add(&bar[XB_TOP], 1u);
            const unsigned tg = og / nx;
            if (og + 1u == (tg + 1u) * nx) xb_add(&bar[XB_TOPGEN], 1u);
            else XB_SPIN(xb_ld(&bar[XB_TOPGEN]) == tg, bar);
            __builtin_amdgcn_fence(__ATOMIC_ACQUIRE, "agent");
            xb_add(&bar[XB_XGEN(b.x)], 1u);
            asm volatile("s_waitcnt vmcnt(0)" ::: "memory");
        } else {
            XB_SPIN(xb_ld(&bar[XB_XGEN(b.x)]) == gen, bar);
            __builtin_amdgcn_fence(__ATOMIC_ACQUIRE, "agent");
            asm volatile("s_waitcnt vmcnt(0)" ::: "memory");
        }
    }
    __syncthreads();
}

template <int MI>
DI void gemm_mainloop_t(const bf16_t* __restrict__ A, int lda, const bf16_t* __restrict__ Bt, int ldb, int K,
                        f32x16 (&acc)[MI][2], unsigned char* lds) {
    const int tid = threadIdx.x, lane = tid & 63, wid = __builtin_amdgcn_readfirstlane(tid >> 6);
    const int wr = wid >> 1, wc = wid & 1, r = lane & 31, h = lane >> 5;
    LAS unsigned char* As = (LAS unsigned char*)lds;
    LAS unsigned char* Bs = (LAS unsigned char*)lds + 2 * 16384;
#pragma unroll
    for (int mi = 0; mi < MI; ++mi)
#pragma unroll
        for (int ni = 0; ni < 2; ++ni)
#pragma unroll
            for (int i = 0; i < 16; ++i) acc[mi][ni][i] = 0.f;
    const int nk = K >> 6;
    const int prow = 8 * wid + (lane >> 3);
    const int pchunk = (lane & 7) ^ ((prow >> 1) & 7);
    const bf16_t* Ap = A + (size_t)prow * lda + pchunk * 8;
    const bf16_t* Bp = Bt + (size_t)prow * ldb + pchunk * 8;
    const int pl = wid * 1024;
#define GEMM_STAGE(buf, kt) do { \
        _Pragma("unroll") for (int i = 0; i < 2 * MI; ++i) __builtin_amdgcn_global_load_lds((const unsigned*)(Ap + (size_t)(32 * i) * lda + (kt) * 64), (LAS unsigned*)(As + (buf) * 16384 + i * 4096 + pl), 16, 0, 0); \
        _Pragma("unroll") for (int i = 0; i < 4; ++i) __builtin_amdgcn_global_load_lds((const unsigned*)(Bp + (size_t)(32 * i) * ldb + (kt) * 64), (LAS unsigned*)(Bs + (buf) * 16384 + i * 4096 + pl), 16, 0, 0); } while (0)
    GEMM_STAGE(0, 0);
    asm volatile("s_waitcnt vmcnt(0)" ::: "memory");
    __syncthreads();
    const int swz = (r >> 1) & 7;
    for (int kt = 0; kt < nk; ++kt) {
        const int cur = kt & 1;
        if (kt + 1 < nk) GEMM_STAGE(cur ^ 1, kt + 1);
        const LAS unsigned char* Ac = As + cur * 16384 + (wr * 32 * MI + r) * 128;
        const LAS unsigned char* Bc = Bs + cur * 16384 + (wc * 64 + r) * 128;
        __builtin_amdgcn_s_setprio(1);
#pragma unroll
        for (int ks = 0; ks < 4; ++ks) {
            const int co = ((ks * 2 + h) ^ swz) * 16;
            bf16x8 fa[MI], fb[2];
#pragma unroll
            for (int mi = 0; mi < MI; ++mi) fa[mi] = *(const LAS bf16x8*)(Ac + mi * 32 * 128 + co);
#pragma unroll
            for (int ni = 0; ni < 2; ++ni) fb[ni] = *(const LAS bf16x8*)(Bc + ni * 32 * 128 + co);
#pragma unroll
            for (int mi = 0; mi < MI; ++mi)
#pragma unroll
                for (int ni = 0; ni < 2; ++ni) acc[mi][ni] = MFMA32(fb[ni], fa[mi], acc[mi][ni]);
        }
        __builtin_amdgcn_s_setprio(0);
        asm volatile("s_waitcnt vmcnt(0)" ::: "memory");
        __syncthreads();
    }
#undef GEMM_STAGE
}
DI void gemm_mainloop(const bf16_t* __restrict__ A, int lda, const bf16_t* __restrict__ Bt, int ldb, int K,
                      f32x16 (&acc)[2][2], unsigned char* lds) { gemm_mainloop_t<2>(A, lda, Bt, ldb, K, acc, lds); }

template <int MI, class F> DI void epi_foreach_t(const f32x16 (&acc)[MI][2], F f) {
    const int tid = threadIdx.x, lane = tid & 63, wid = tid >> 6;
    const int wr = wid >> 1, wc = wid & 1, r = lane & 31, h = lane >> 5;
#pragma unroll
    for (int mi = 0; mi < MI; ++mi)
#pragma unroll
        for (int ni = 0; ni < 2; ++ni)
#pragma unroll
            for (int grp = 0; grp < 4; ++grp) {
                f32x4 v = {acc[mi][ni][4 * grp], acc[mi][ni][4 * grp + 1], acc[mi][ni][4 * grp + 2], acc[mi][ni][4 * grp + 3]};
                f(wr * 32 * MI + mi * 32 + r, wc * 64 + ni * 32 + 8 * grp + 4 * h, v);
            }
}
template <class F> DI void epi_foreach(const f32x16 (&acc)[2][2], F f) { epi_foreach_t<2>(acc, f); }

template <class S> DI void epi_stage_rows(const f32x16 (&acc)[2][2], unsigned char* lds, S colscale) {
    epi_foreach(acc, [&](int m, int n, f32x4 v) {
        const f32x4 s = colscale(n);
        u32x2 o = {pk2(v.x * s.x, v.y * s.y), pk2(v.z * s.z, v.w * s.w)};
        *(u32x2*)(lds + m * 272 + n * 2) = o;
    });
}
DI void epi_stage_cols(const f32x16 (&acc)[2][2], unsigned char* lds) {
    epi_foreach(acc, [&](int m, int n, f32x4 v) {
        *(bf16_t*)(lds + (n + 0) * 272 + m * 2) = (bf16_t)f2bf(v.x); *(bf16_t*)(lds + (n + 1) * 272 + m * 2) = (bf16_t)f2bf(v.y);
        *(bf16_t*)(lds + (n + 2) * 272 + m * 2) = (bf16_t)f2bf(v.z); *(bf16_t*)(lds + (n + 3) * 272 + m * 2) = (bf16_t)f2bf(v.w);
    });
}
template <class F> DI void rows_foreach(const unsigned char* lds, F f) {
    const int tid = threadIdx.x;
#pragma unroll
    for (int i = 0; i < 8; ++i) {
        const int c = tid + 256 * i, m = c >> 4, cc = c & 15;
        f(m, cc, *(const u32x4*)(lds + m * 272 + cc * 16));
    }
}

DI void cvt_rows(const float* __restrict__ src, bf16_t* __restrict__ dst, size_t n8, size_t gtid, size_t gstride) {
    for (size_t i = gtid; i < n8; i += gstride) {
        f32x4 a = ((const f32x4*)src)[2 * i], b = ((const f32x4*)src)[2 * i + 1];
        u32x4 o = {pk2(a.x, a.y), pk2(a.z, a.w), pk2(b.x, b.y), pk2(b.z, b.w)};
        ((u32x4*)dst)[i] = o;
    }
}
template <class F> DI void transpose_cvt(const float* __restrict__ in, int K, int Nin, bf16_t* __restrict__ out, int Nout, F src,
                                         size_t gtid, size_t gstride) {
    const size_t total = (size_t)Nout * (K / 8);
    for (size_t i = gtid; i < total; i += gstride) {
        const int n = (int)(i % Nout), k8 = (int)(i / Nout);
        const int s = src(n);
        float v[8];
#pragma unroll
        for (int j = 0; j < 8; ++j) v[j] = s >= 0 ? in[(size_t)(k8 * 8 + j) * Nin + s] : 0.f;
        u32x4 o = {pk2(v[0], v[1]), pk2(v[2], v[3]), pk2(v[4], v[5]), pk2(v[6], v[7])};
        *(u32x4*)(out + (size_t)n * K + k8 * 8) = o;
    }
}

DI void transpose_cvt_scaled(const float* __restrict__ in, int K, int N, bf16_t* __restrict__ out, const float* __restrict__ scale, size_t gtid, size_t gstride) {
    const size_t total = (size_t)N * (K / 8);
    for (size_t i = gtid; i < total; i += gstride) {
        const int n = (int)(i % N), k8 = (int)(i / N);
        float v[8];
#pragma unroll
        for (int j = 0; j < 8; ++j) v[j] = in[(size_t)(k8 * 8 + j) * N + n] * scale[k8 * 8 + j];
        u32x4 o = {pk2(v[0], v[1]), pk2(v[2], v[3]), pk2(v[4], v[5]), pk2(v[6], v[7])};
        *(u32x4*)(out + (size_t)n * K + k8 * 8) = o;
    }
}

DI void convert_tables(const Params& p) {
    unsigned char* ws = p.ws;
    const size_t gtid = (size_t)blockIdx.x * NTHREADS + threadIdx.x, gstride = (size_t)gridDim.x * NTHREADS;
    {
        const int lane = threadIdx.x & 63, gw = (int)(gtid >> 6), ngw = (int)(gstride >> 6);
        for (int rr = gw; rr < 2 * 16384; rr += ngw) {
            const int which = rr >> 14, row = rr & 16383;
            const f32x4* src = (const f32x4*)((which ? p.in[17] : p.in[16]) + (size_t)row * 1024) + lane * 4;
            f32x4 v[4];
            float am = 0.f;
#pragma unroll
            for (int j = 0; j < 4; ++j) { v[j] = src[j]; am = fmaxf(am, fmaxf(fmaxf(fabsf(v[j].x), fabsf(v[j].y)), fmaxf(fabsf(v[j].z), fabsf(v[j].w)))); }
#pragma unroll
            for (int o = 32; o >= 1; o >>= 1) am = fmaxf(am, __shfl_xor(am, o));
            u32x4 o4;
            if (which) {
                const float sc = am > 0.f ? 448.0f / am : 1.0f;
#pragma unroll
                for (int j = 0; j < 4; ++j) {
                    int w = __builtin_amdgcn_cvt_pk_fp8_f32(v[j].x * sc, v[j].y * sc, 0, false);
                    w = __builtin_amdgcn_cvt_pk_fp8_f32(v[j].z * sc, v[j].w * sc, w, true);
                    o4[j] = (unsigned)w;
                }
            } else {
                const float sc = am > 0.f ? 127.0f / am : 1.0f;
#pragma unroll
                for (int j = 0; j < 4; ++j) {
                    const int q0 = (int)rintf(v[j].x * sc), q1 = (int)rintf(v[j].y * sc), q2 = (int)rintf(v[j].z * sc), q3 = (int)rintf(v[j].w * sc);
                    o4[j] = (unsigned)(q0 & 255) | ((unsigned)(q1 & 255) << 8) | ((unsigned)(q2 & 255) << 16) | ((unsigned)(q3 & 255) << 24);
                }
            }
            *(u32x4*)(ws + (which ? WS_VB : WS_UB) + (size_t)row * 1024 + lane * 16) = o4;
            if (lane == 0) ((float*)(ws + (which ? WS_VSCALE : WS_USCALE)))[row] = am > 0.f ? am / (which ? 448.0f : 127.0f) : 1.0f;
        }
    }
}

DI void phase0(const Params& p) {
    unsigned char* ws = p.ws;
    const size_t gtid = (size_t)blockIdx.x * NTHREADS + threadIdx.x, gstride = (size_t)gridDim.x * NTHREADS;
    cvt_rows(p.in[0], (bf16_t*)(ws + WS_XB), (size_t)NTOK * DM / 8, gtid, gstride);
    cvt_rows(p.in[15], (bf16_t*)(ws + WS_SUBK), (size_t)2 * 128 * 128 / 8, gtid, gstride);
    transpose_cvt(p.in[1], 1024, 1816, (bf16_t*)(ws + WS_WINT), NINP,
                  [](int n) { return n < 1280 ? n : (n < 1792 ? 1304 + (n - 1280) : (n < 1816 ? 1280 + (n - 1792) : -1)); }, gtid, gstride);
    transpose_cvt(p.in[11], 1024, 1024, (bf16_t*)(ws + WS_WOUTT), 1024, [](int n) { return n; }, gtid, gstride);
    transpose_cvt_scaled(p.in[14], 1024, 2048, (bf16_t*)(ws + WS_WQT), p.in[12], gtid, gstride);
    transpose_cvt(p.in[5], 2048, 256, (bf16_t*)(ws + WS_W1TK), 256, [](int n) { return n; }, gtid, gstride);
    transpose_cvt(p.in[7], 2048, 256, (bf16_t*)(ws + WS_W1TV), 256, [](int n) { return n; }, gtid, gstride);
    transpose_cvt(p.in[6], 256, 64, (bf16_t*)(ws + WS_W2TK), 64, [](int n) { return n; }, gtid, gstride);
    transpose_cvt(p.in[8], 256, 64, (bf16_t*)(ws + WS_W2TV), 64, [](int n) { return n; }, gtid, gstride);
    for (int g = 0; g < 4; ++g)
        transpose_cvt(p.in[9] + g * 16384, 128, 128, (bf16_t*)(ws + WS_POOLWT) + g * 16384, 128, [](int n) { return n; }, gtid, gstride);
    {
        float* z = (float*)(ws + WS_KCMP);
        for (size_t i = gtid; i < (size_t)2 * 8 * 256 * 64; i += gstride) z[i] = 0.f;
    }
    {
        const int lane = threadIdx.x & 63, gw = (int)(gtid >> 6), ngw = (int)(gstride >> 6);
        for (int o = gw; o < 512; o += ngw) {
            const int which = o >> 8, j = o & 255;
            const float* pe = which ? p.in[4] : p.in[3];
            const float* w1 = which ? p.in[7] : p.in[5];
            float s = 0.f;
#pragma unroll 8
            for (int i = lane; i < 2048; i += 64) s += pe[i] * w1[(size_t)i * 256 + j];
            s = wave_sum(s);
            if (lane == 0) ((float*)(ws + (which ? WS_PEBV : WS_PEBK)))[j] = s;
        }
    }
    if (gtid >= 512 && gtid < 768) {
        const int d = (int)(gtid - 512);
        ((int*)(ws + WS_BUCK))[d] = rel_bucket_dev(d);
    }
}

DI int cu_pair_pos(int j, int G8) { const int hlf = (G8 + 1) >> 1; return (G8 & 1) ? j : (((j % hlf) << 1) | (j / hlf)); }

DI void phase1(const Params& p, unsigned char* lds) {
    unsigned char* ws = p.ws;
    const bf16_t* xb = (const bf16_t*)(ws + WS_XB);
    const bf16_t* wt = (const bf16_t*)(ws + WS_WINT);
    const int ntiles = 128 * 15;
    const int G8 = (gridDim.x & 7) == 0 ? gridDim.x >> 3 : 0;
    for (int l0 = G8 ? 0 : (int)blockIdx.x; l0 < (G8 ? ntiles / 8 : ntiles); l0 += (G8 ? G8 : (int)gridDim.x)) {
        const int li = G8 ? l0 + cu_pair_pos((int)(blockIdx.x >> 3), G8) : l0;
        if (G8 && li >= ntiles / 8) break;
        const int tile = G8 ? (int)(blockIdx.x & 7) * (ntiles / 8) + li : li;
        const int tn = tile % 15, tm = tile / 15;
        f32x16 acc[2][2];
        gemm_mainloop(xb + (size_t)tm * 128 * DM, DM, wt + (size_t)tn * 128 * DM, DM, DM, acc, lds);
        const int m0 = tm * 128;
        if (tn < 14) {
            const bool tr = (tn == 7 || tn == 9);
            const float qs = tn < 4 ? QSCALE : 1.0f;
            if (tr) epi_stage_cols(acc, lds);
            else epi_stage_rows(acc, lds, [&](int) { return (f32x4){qs, qs, qs, qs}; });
            __syncthreads();
            const int bq = m0 >> 12, t0q = m0 & 4095;
            if (tn < 4) {
                bf16_t* Q = (bf16_t*)(ws + WS_Q);
                rows_foreach(lds, [&](int m, int cc, u32x4 d) {
                    const int hd = tn * 2 + (cc >> 3);
                    *(u32x4*)(Q + (((size_t)(bq * 8 + hd) * SEQ + t0q + m) * 64 + (cc & 7) * 8)) = d;
                });
            } else if (tr) {
                bf16_t* dst = (bf16_t*)(ws + (tn == 7 ? WS_VSLCT : WS_VWINT));
                rows_foreach(lds, [&](int n, int cc, u32x4 d) {
                    *(u32x4*)(dst + ((size_t)((bq * 2 + (n >> 6)) * 64 + (n & 63)) * SEQ + t0q + cc * 8)) = d;
                });
            } else if (tn < 10) {
                bf16_t* dst = (bf16_t*)(ws + (tn == 4 ? WS_KC : tn == 5 ? WS_VC : tn == 6 ? WS_KSLC : WS_KWIN));
                rows_foreach(lds, [&](int m, int cc, u32x4 d) {
                    *(u32x4*)(dst + (((size_t)(bq * 2 + (cc >> 3)) * SEQ + t0q + m) * 64 + (cc & 7) * 8)) = d;
                });
            } else {
                bf16_t* dst = (bf16_t*)(ws + WS_Z);
                rows_foreach(lds, [&](int m, int cc, u32x4 d) {
                    *(u32x4*)(dst + ((size_t)(m0 + m) * 512 + (tn - 10) * 128 + cc * 8)) = d;
                });
            }
            __syncthreads();
        } else {
            float* dst = (float*)(ws + WS_GATES);
            epi_foreach(acc, [&](int m, int n, f32x4 v) {
                if (n < 24) {
                    f32x4 o = {1.f / (1.f + __expf(-v.x)), 1.f / (1.f + __expf(-v.y)), 1.f / (1.f + __expf(-v.z)), 1.f / (1.f + __expf(-v.w))};
                    *(f32x4*)(dst + (size_t)(m0 + m) * 24 + n) = o;
                }
            });
        }
    }
}

DI void compress_job(const Params& p, unsigned char* lds, int cj) {
    unsigned char* ws = p.ws;
    const int kv = cj >> 6, bg = (cj >> 3) & 7, rq = (cj >> 1) & 3, hh = cj & 1;
    const bf16_t* A = (const bf16_t*)(ws + (kv ? WS_VC : WS_KC)) + ((size_t)bg * SEQ + (size_t)rq * 64 * 16) * 64;
    const bf16_t* Bt = (const bf16_t*)(ws + (kv ? WS_W1TV : WS_W1TK)) + (size_t)hh * 128 * 2048;
    const float* peb = (const float*)(ws + (kv ? WS_PEBV : WS_PEBK)) + hh * 128;
    const bf16_t* w2t = (const bf16_t*)(ws + (kv ? WS_W2TV : WS_W2TK));
    float* dst = (float*)(ws + (kv ? WS_VCMP : WS_KCMP)) + (size_t)bg * 256 * 64;
    f32x16 acc[1][2];
    gemm_mainloop_t<1>(A, 1024, Bt, 2048, 2048, acc, lds);
    epi_foreach_t<1>(acc, [&](int m, int n, f32x4 v) {
        f32x4 bb = *(const f32x4*)(peb + n);
        u32x2 o = {pk2(gelu_erf(v.x + bb.x), gelu_erf(v.y + bb.y)), pk2(gelu_erf(v.z + bb.z), gelu_erf(v.w + bb.w))};
        *(u32x2*)(lds + m * 272 + n * 2) = o;
    });
    __syncthreads();
    const int tid = threadIdx.x, lane = tid & 63, wid = tid >> 6, r = lane & 31, h = lane >> 5;
    const int wr2 = wid >> 1, wd = wid & 1;
    f32x16 a2;
#pragma unroll
    for (int i = 0; i < 16; ++i) a2[i] = 0.f;
#pragma unroll
    for (int ks = 0; ks < 8; ++ks) {
        bf16x8 fb = *(const bf16x8*)(lds + (wr2 * 32 + r) * 272 + ks * 32 + h * 16);
        bf16x8 fa = *(const bf16x8*)(w2t + (size_t)(wd * 32 + r) * 256 + hh * 128 + ks * 16 + h * 8);
        a2 = MFMA32(fa, fb, a2);
    }
    const int row = rq * 64 + wr2 * 32 + r;
    if (row < 255) {
#pragma unroll
        for (int i = 0; i < 16; ++i) {
            const int d = wd * 32 + (i & 3) + 8 * (i >> 2) + 4 * h;
            atomicAdd(dst + (size_t)row * 64 + d, a2[i]);
        }
    }
    __syncthreads();
}

constexpr int AT_K0 = 0, AT_V0 = 18432, AT_TB = 36864, AT_IMP = 40960, AT_SEL = 49152;

DI void attn_stage_load(const bf16_t* __restrict__ Kg, const bf16_t* __restrict__ Vtg, u32x4 (&st)[4], int tid) {
#pragma unroll
    for (int i = 0; i < 2; ++i) {
        const int c = tid + 256 * i, row = c >> 3, cc = c & 7;
        st[i] = *(const u32x4*)(Kg + (size_t)row * 64 + cc * 8);
        st[2 + i] = *(const u32x4*)(Vtg + (size_t)row * SEQ + cc * 8);
    }
}
DI void attn_stage_store(unsigned char* Kl, unsigned char* Vl, const u32x4 (&st)[4], int tid) {
#pragma unroll
    for (int i = 0; i < 2; ++i) {
        const int c = tid + 256 * i, row = c >> 3, cc = c & 7;
        *(u32x4*)(Kl + row * ROWB + cc * 16) = st[i];
        *(u32x4*)(Vl + row * ROWB + cc * 16) = st[2 + i];
    }
}
DI void attn_scores(const unsigned char* Kl, const bf16x8 (&qf)[4], f32x16 (&X)[2], int r, int h) {
#pragma unroll
    for (int i = 0; i < 16; ++i) { X[0][i] = 0.f; X[1][i] = 0.f; }
#pragma unroll
    for (int ks = 0; ks < 4; ++ks)
#pragma unroll
        for (int kb = 0; kb < 2; ++kb) {
            bf16x8 a = *(const bf16x8*)(Kl + (kb * 32 + r) * ROWB + ks * 32 + h * 16);
            X[kb] = MFMA32(a, qf[ks], X[kb]);
        }
}
DI void attn_pv(const unsigned char* Vl, const f32x16 (&P)[2], f32x16 (&O)[2], int r, int h) {
#pragma unroll
    for (int kb = 0; kb < 2; ++kb)
#pragma unroll
        for (int s = 0; s < 2; ++s) {
            u32x4 pw = {pk2(P[kb][8 * s], P[kb][8 * s + 1]), pk2(P[kb][8 * s + 2], P[kb][8 * s + 3]),
                        pk2(P[kb][8 * s + 4], P[kb][8 * s + 5]), pk2(P[kb][8 * s + 6], P[kb][8 * s + 7])};
            bf16x8 pb = __builtin_bit_cast(bf16x8, pw);
#pragma unroll
            for (int db = 0; db < 2; ++db) {
                const unsigned char* q = Vl + (db * 32 + r) * ROWB + (kb * 32 + 16 * s + 4 * h) * 2;
                s16x4 lo = *(const s16x4*)q, hi = *(const s16x4*)(q + 16);
                bf16x8 a = __builtin_shufflevector(lo, hi, 0, 1, 2, 3, 4, 5, 6, 7);
                O[db] = MFMA32(a, pb, O[db]);
            }
        }
}
DI void softmax_update(f32x16 (&X)[2], float& m, float& l, f32x16 (&O)[2]) {
    float mloc = -1e30f;
#pragma unroll
    for (int kb = 0; kb < 2; ++kb)
#pragma unroll
        for (int i = 0; i < 16; ++i) mloc = fmaxf(mloc, X[kb][i]);
    mloc = fmaxf(mloc, __shfl_xor(mloc, 32));
    const float mnew = fmaxf(m, mloc);
    const float alpha = __builtin_amdgcn_exp2f(m - mnew);
    m = mnew;
    float ls = 0.f;
#pragma unroll
    for (int kb = 0; kb < 2; ++kb)
#pragma unroll
        for (int i = 0; i < 16; ++i) {
            const float x = X[kb][i];
            const float pv = x > -1e29f ? __builtin_amdgcn_exp2f(x - mnew) : 0.f;
            X[kb][i] = pv; ls += pv;
        }
    l = l * alpha + ls;
#pragma unroll
    for (int db = 0; db < 2; ++db)
#pragma unroll
        for (int i = 0; i < 16; ++i) O[db][i] *= alpha;
}
DI void softmax_far(f32x16 (&X)[2], float cb, float& m, float& l, f32x16 (&O)[2]) {
    float mloc = -3e38f;
#pragma unroll
    for (int kb = 0; kb < 2; ++kb)
#pragma unroll
        for (int i = 0; i < 16; ++i) mloc = fmaxf(mloc, X[kb][i]);
    mloc += cb;
    mloc = fmaxf(mloc, __shfl_xor(mloc, 32));
    const float mnew = fmaxf(m, mloc);
    if (__any(mnew > m)) {
        const float alpha = __builtin_amdgcn_exp2f(m - mnew);
        m = mnew; l *= alpha;
#pragma unroll
        for (int db = 0; db < 2; ++db)
#pragma unroll
            for (int i = 0; i < 16; ++i) O[db][i] *= alpha;
    }
    const float mc = m - cb;
    f32x2 ls = {0.f, 0.f};
#pragma unroll
    for (int kb = 0; kb < 2; ++kb)
#pragma unroll
        for (int i = 0; i < 16; i += 2) {
            f32x2 pv = {__builtin_amdgcn_exp2f(X[kb][i] - mc), __builtin_amdgcn_exp2f(X[kb][i + 1] - mc)};
            X[kb][i] = pv.x; X[kb][i + 1] = pv.y; ls += pv;
        }
    l += ls.x + ls.y;
}
DI void build_bias_table(const Params& p, unsigned char* lds, int g) {
    const int* buck = (const int*)(p.ws + WS_BUCK);
    float* tb = (float*)(lds + AT_TB);
    for (int i = threadIdx.x; i < 1024; i += NTHREADS) {
        const int hl = i >> 8, d = i & 255;
        tb[i] = p.in[2][buck[d] * 8 + g * 4 + hl] * LOG2E;
    }
}

DI void win_unit(const Params& p, unsigned char* lds, int u) {
    unsigned char* ws = p.ws;
    const int tid = threadIdx.x, lane = tid & 63, wid = tid >> 6, r = lane & 31, h = lane >> 5;
    const int bg = u & 7, t32 = u >> 3, b = bg >> 1, g = bg & 1, t0 = t32 * 32;
    const int hl = r >> 3, t = t0 + wid * 8 + (r & 7);
    const bf16_t* Kg = (const bf16_t*)(ws + WS_KWIN) + (size_t)bg * SEQ * 64;
    const bf16_t* Vtg = (const bf16_t*)(ws + WS_VWINT) + (size_t)bg * 64 * SEQ;
    const bf16_t* Qg = (const bf16_t*)(ws + WS_Q) + ((size_t)(b * 8 + g * 4 + hl) * SEQ + t) * 64;
    __syncthreads();
    build_bias_table(p, lds, g);
    bf16x8 qf[4];
#pragma unroll
    for (int ks = 0; ks < 4; ++ks) qf[ks] = *(const bf16x8*)(Qg + ks * 16 + h * 8);
    const int jlo = t0 < 511 ? 0 : ((t0 - 511) >> 6), jhi = t0 >> 6;
    u32x4 st[4];
    attn_stage_load(Kg + (size_t)jlo * 64 * 64, Vtg + jlo * 64, st, tid);
    attn_stage_store(lds + AT_K0, lds + AT_V0, st, tid);
    __syncthreads();
    const float* tb = (const float*)(lds + AT_TB) + hl * 256;
    const int tmin = t0 + wid * 8;
    float m = -1e30f, l = 0.f;
    f32x16 O[2];
#pragma unroll
    for (int i = 0; i < 16; ++i) { O[0][i] = 0.f; O[1][i] = 0.f; }
    for (int j = jlo; j <= jhi; ++j) {
        const int cur = (j - jlo) & 1;
        if (j < jhi) attn_stage_load(Kg + (size_t)(j + 1) * 64 * 64, Vtg + (j + 1) * 64, st, tid);
        const unsigned char* Kl = lds + AT_K0 + cur * 9216;
        const unsigned char* Vl = lds + AT_V0 + cur * 9216;
        f32x16 X[2];
        attn_scores(Kl, qf, X, r, h);
        const bool far = (tmin - (j * 64 + 63) >= 128) && (tmin + 7 - j * 64 < 512);
        if (far) {
            softmax_far(X, tb[255], m, l, O);
        } else {
#pragma unroll
            for (int kb = 0; kb < 2; ++kb)
#pragma unroll
                for (int i = 0; i < 16; ++i) {
                    const int pos = j * 64 + kb * 32 + (i & 3) + 8 * (i >> 2) + 4 * h;
                    const int dist = t - pos;
                    const bool valid = dist >= 0 && dist < 512;
                    const int di = dist < 0 ? 0 : (dist > 255 ? 255 : dist);
                    X[kb][i] = valid ? X[kb][i] + tb[di] : -1e30f;
                }
            softmax_update(X, m, l, O);
        }
        attn_pv(Vl, X, O, r, h);
        if (j < jhi) attn_stage_store(lds + AT_K0 + (cur ^ 1) * 9216, lds + AT_V0 + (cur ^ 1) * 9216, st, tid);
        __syncthreads();
    }
    const float lt = l + __shfl_xor(l, 32);
    const size_t tok = (size_t)b * SEQ + t;
    const float gate = ((const float*)(ws + WS_GATES))[tok * 24 + 16 + g * 4 + hl];
    const float sc = gate / lt;
    bf16_t* ow = (bf16_t*)(ws + WS_OWIN) + tok * 512 + (g * 4 + hl) * 64;
#pragma unroll
    for (int db = 0; db < 2; ++db)
#pragma unroll
        for (int grp = 0; grp < 4; ++grp) {
            u32x2 o = {pk2(O[db][4 * grp] * sc, O[db][4 * grp + 1] * sc), pk2(O[db][4 * grp + 2] * sc, O[db][4 * grp + 3] * sc)};
            *(u32x2*)(ow + db * 32 + 8 * grp + 4 * h) = o;
        }
}

DI void cmp_stage(const float* __restrict__ kc, const float* __restrict__ vc, int ct, unsigned char* Kl, unsigned char* Vl, bool withv, int tid) {
    {
        const int c = tid >> 2, part = tid & 3;
        const f32x4* src = (const f32x4*)(kc + (size_t)(ct * 64 + c) * 64 + part * 16);
        f32x4 a = src[0], b2 = src[1], c2 = src[2], d2 = src[3];
        u32x4 o0 = {pk2(a.x, a.y), pk2(a.z, a.w), pk2(b2.x, b2.y), pk2(b2.z, b2.w)};
        u32x4 o1 = {pk2(c2.x, c2.y), pk2(c2.z, c2.w), pk2(d2.x, d2.y), pk2(d2.z, d2.w)};
        *(u32x4*)(Kl + c * ROWB + part * 32) = o0;
        *(u32x4*)(Kl + c * ROWB + part * 32 + 16) = o1;
    }
    if (withv) {
        const int c = tid & 63, dg = tid >> 6;
        const f32x4* src = (const f32x4*)(vc + (size_t)(ct * 64 + c) * 64 + dg * 16);
#pragma unroll
        for (int q4 = 0; q4 < 4; ++q4) {
            f32x4 a = src[q4];
            const int d = dg * 16 + q4 * 4;
            *(bf16_t*)(Vl + (d + 0) * ROWB + c * 2) = (bf16_t)f2bf(a.x);
            *(bf16_t*)(Vl + (d + 1) * ROWB + c * 2) = (bf16_t)f2bf(a.y);
            *(bf16_t*)(Vl + (d + 2) * ROWB + c * 2) = (bf16_t)f2bf(a.z);
            *(bf16_t*)(Vl + (d + 3) * ROWB + c * 2) = (bf16_t)f2bf(a.w);
        }
    }
}

DI void slc_unit(const Params& p, unsigned char* lds, int u) {
    unsigned char* ws = p.ws;
    const int tid = threadIdx.x, lane = tid & 63, wid = tid >> 6, r = lane & 31, h = lane >> 5;
    const int bg = u & 7, t32 = u >> 3, b = bg >> 1, g = bg & 1, t0 = t32 * 32;
    const int hl = r >> 3, tokl = r & 7, t = t0 + wid * 8 + tokl;
    const bf16_t* Kg = (const bf16_t*)(ws + WS_KSLC) + (size_t)bg * SEQ * 64;
    const bf16_t* Vtg = (const bf16_t*)(ws + WS_VSLCT) + (size_t)bg * 64 * SEQ;
    const bf16_t* Qg = (const bf16_t*)(ws + WS_Q) + ((size_t)(b * 8 + g * 4 + hl) * SEQ + t) * 64;
    const float* kcmp = (const float*)(ws + WS_KCMP) + (size_t)bg * 256 * 64;
    const float* vcmp = (const float*)(ws + WS_VCMP) + (size_t)bg * 256 * 64;
    __syncthreads();
    build_bias_table(p, lds, g);
    unsigned* imp = (unsigned*)(lds + AT_IMP) + wid * 512;
#pragma unroll
    for (int i = 0; i < 8; ++i) imp[i * 64 + lane] = 0u;
    bf16x8 qf[4];
#pragma unroll
    for (int ks = 0; ks < 4; ++ks) qf[ks] = *(const bf16x8*)(Qg + ks * 16 + h * 8);
    const float* tb = (const float*)(lds + AT_TB) + hl * 256;
    const int cmax = t0 >> 4;
    const int nct = (t0 + 31 >= 31) ? (cmax >> 6) + 1 : 0;
    float m = -1e30f, l = 0.f;
    f32x16 Oc[2];
#pragma unroll
    for (int i = 0; i < 16; ++i) { Oc[0][i] = 0.f; Oc[1][i] = 0.f; }
    for (int ct = 0; ct < nct; ++ct) {
        __syncthreads();
        cmp_stage(kcmp, vcmp, ct, lds + AT_K0, lds + AT_V0, false, tid);
        __syncthreads();
        f32x16 X[2];
        attn_scores(lds + AT_K0, qf, X, r, h);
#pragma unroll
        for (int kb = 0; kb < 2; ++kb)
#pragma unroll
            for (int i = 0; i < 16; ++i) {
                const int c = ct * 64 + kb * 32 + (i & 3) + 8 * (i >> 2) + 4 * h;
                const int dist = t - (16 * c + 31);
                const bool valid = dist >= 0 && c < 255;
                const int di = dist < 0 ? 0 : (dist > 255 ? 255 : dist);
                X[kb][i] = valid ? X[kb][i] + tb[di] : -1e30f;
            }
        f32x16 dummy[2];
#pragma unroll
        for (int i = 0; i < 16; ++i) { dummy[0][i] = 0.f; dummy[1][i] = 0.f; }
        softmax_update(X, m, l, dummy);
    }
    const float lt = l + __shfl_xor(l, 32);
    const float invl = lt > 0.f ? 1.0f / lt : 0.f;
    for (int ct = 0; ct < nct; ++ct) {
        __syncthreads();
        cmp_stage(kcmp, vcmp, ct, lds + AT_K0, lds + AT_V0, true, tid);
        __syncthreads();
        f32x16 X[2];
        attn_scores(lds + AT_K0, qf, X, r, h);
#pragma unroll
        for (int kb = 0; kb < 2; ++kb)
#pragma unroll
            for (int i = 0; i < 16; ++i) {
                const int c = ct * 64 + kb * 32 + (i & 3) + 8 * (i >> 2) + 4 * h;
                const int dist = t - (16 * c + 31);
                const bool valid = dist >= 0 && c < 255;
                const int di = dist < 0 ? 0 : (dist > 255 ? 255 : dist);
                X[kb][i] = valid ? __builtin_amdgcn_exp2f(X[kb][i] + tb[di] - m) * invl : 0.f;
            }
#pragma unroll
        for (int kb = 0; kb < 2; ++kb)
#pragma unroll
            for (int grp = 0; grp < 4; ++grp) {
                const float s4 = (X[kb][4 * grp] + X[kb][4 * grp + 1]) + (X[kb][4 * grp + 2] + X[kb][4 * grp + 3]);
                const int jj = ct * 16 + kb * 8 + 2 * grp + h;
                atomicAdd(&imp[tokl * 64 + jj], (unsigned)(s4 * 67108864.0f + 0.5f));
                if (jj + 1 < 64) atomicAdd(&imp[tokl * 64 + jj + 1], (unsigned)(X[kb][4 * grp + 3] * 67108864.0f + 0.5f));
            }
        attn_pv(lds + AT_V0, X, Oc, r, h);
    }
    unsigned long long* selm = (unsigned long long*)(lds + AT_SEL) + wid * 8;
    for (int tk = 0; tk < 8; ++tk) {
        const int tt = t0 + wid * 8 + tk, curb = tt >> 6;
        int v = (int)imp[tk * 64 + lane];
        if (lane == 0 || lane == curb || lane == curb - 1) v = 0x7fffffff;
        if (lane > curb) v = -1;
        int cnt = 0;
#pragma unroll
        for (int k = 0; k < 64; ++k) {
            const int vk = __builtin_amdgcn_readlane(v, k);
            cnt += (vk > v || (vk == v && k < lane)) ? 1 : 0;
        }
        const unsigned long long mk = __ballot(cnt < 16);
        if (lane == 0) selm[tk] = mk;
    }
    const unsigned long long mysel = selm[tokl];
    __syncthreads();
    const int jhi = t0 >> 6;
    u32x4 st[4];
    attn_stage_load(Kg, Vtg, st, tid);
    attn_stage_store(lds + AT_K0, lds + AT_V0, st, tid);
    __syncthreads();
    float m2 = -1e30f, l2 = 0.f;
    const int tmin = t0 + wid * 8;
    f32x16 O[2];
#pragma unroll
    for (int i = 0; i < 16; ++i) { O[0][i] = 0.f; O[1][i] = 0.f; }
    for (int j = 0; j <= jhi; ++j) {
        const int cur = j & 1;
        if (j < jhi) attn_stage_load(Kg + (size_t)(j + 1) * 64 * 64, Vtg + (j + 1) * 64, st, tid);
        const unsigned char* Kl = lds + AT_K0 + cur * 9216;
        const unsigned char* Vl = lds + AT_V0 + cur * 9216;
        f32x16 X[2];
        attn_scores(Kl, qf, X, r, h);
        const bool selj = (mysel >> j) & 1ull;
        if (tmin - (j * 64 + 63) >= 128) {
            softmax_far(X, selj ? tb[255] : -1e30f, m2, l2, O);
        } else {
#pragma unroll
            for (int kb = 0; kb < 2; ++kb)
#pragma unroll
                for (int i = 0; i < 16; ++i) {
                    const int pos = j * 64 + kb * 32 + (i & 3) + 8 * (i >> 2) + 4 * h;
                    const int dist = t - pos;
                    const bool valid = dist >= 0 && selj;
                    const int di = dist < 0 ? 0 : (dist > 255 ? 255 : dist);
                    X[kb][i] = valid ? X[kb][i] + tb[di] : -1e30f;
                }
            softmax_update(X, m2, l2, O);
        }
        attn_pv(Vl, X, O, r, h);
        if (j < jhi) attn_stage_store(lds + AT_K0 + (cur ^ 1) * 9216, lds + AT_V0 + (cur ^ 1) * 9216, st, tid);
        __syncthreads();
    }
    const float lt2 = l2 + __shfl_xor(l2, 32);
    const size_t tok = (size_t)b * SEQ + t;
    const float* gt = (const float*)(ws + WS_GATES) + tok * 24;
    const float gc = gt[g * 4 + hl], gs = gt[8 + g * 4 + hl] / lt2;
    const bf16_t* ow = (const bf16_t*)(ws + WS_OWIN) + tok * 512 + (g * 4 + hl) * 64;
    bf16_t* mx = (bf16_t*)(ws + WS_MIXIN) + tok * 1024 + (g * 4 + hl) * 64;
#pragma unroll
    for (int db = 0; db < 2; ++db)
#pragma unroll
        for (int grp = 0; grp < 4; ++grp) {
            const int d = db * 32 + 8 * grp + 4 * h;
            const u32x2 w = *(const u32x2*)(ow + d);
            const float r0 = gc * Oc[db][4 * grp] + gs * O[db][4 * grp] + bflo(w.x);
            const float r1 = gc * Oc[db][4 * grp + 1] + gs * O[db][4 * grp + 1] + bfhi(w.x);
            const float r2 = gc * Oc[db][4 * grp + 2] + gs * O[db][4 * grp + 2] + bflo(w.y);
            const float r3 = gc * Oc[db][4 * grp + 3] + gs * O[db][4 * grp + 3] + bfhi(w.y);
            u32x2 o = {pk2(r0, r1), pk2(r2, r3)};
            *(u32x2*)(mx + d) = o;
        }
}

DI void pooly_job(const Params& p, int job) {
    unsigned char* ws = p.ws;
    const bf16_t* z = (const bf16_t*)(ws + WS_Z);
    bf16_t* y = (bf16_t*)(ws + WS_YPOOL);
    const int tid = threadIdx.x;
    const int tokb = job * 16 + (tid >> 6) * 4, ch = tid & 63, tb = tokb & 4095;
    const int gi = ch >> 4, win = 2 << gi;
    u32x4 rowv[19];
#pragma unroll
    for (int i = 0; i < 19; ++i) {
        const int dt = i - 15;
        const bool need = dt > -win && tb + dt >= 0;
        rowv[i] = *(const u32x4*)(z + (size_t)(need ? tokb + dt : tokb) * 512 + ch * 8);
    }
    float f[19][8];
#pragma unroll
    for (int i = 0; i < 19; ++i) {
        f[i][0] = bflo(rowv[i].x); f[i][1] = bfhi(rowv[i].x); f[i][2] = bflo(rowv[i].y); f[i][3] = bfhi(rowv[i].y);
        f[i][4] = bflo(rowv[i].z); f[i][5] = bfhi(rowv[i].z); f[i][6] = bflo(rowv[i].w); f[i][7] = bfhi(rowv[i].w);
    }
#pragma unroll
    for (int o = 0; o < 4; ++o) {
        const int t = tb + o;
        const int cnt = (t + 1 < win) ? t + 1 : win;
        float s[8];
#pragma unroll
        for (int c = 0; c < 8; ++c) s[c] = 0.f;
#pragma unroll
        for (int k = 0; k < 16; ++k) {
            const float wk = k < cnt ? 1.0f : 0.0f;
#pragma unroll
            for (int c = 0; c < 8; ++c) s[c] += wk * f[15 + o - k][c];
        }
        const float ic = 1.0f / (float)cnt;
        u32x4 ov = {pk2(s[0] * ic - f[15 + o][0], s[1] * ic - f[15 + o][1]), pk2(s[2] * ic - f[15 + o][2], s[3] * ic - f[15 + o][3]),
                    pk2(s[4] * ic - f[15 + o][4], s[5] * ic - f[15 + o][5]), pk2(s[6] * ic - f[15 + o][6], s[7] * ic - f[15 + o][7])};
        *(u32x4*)(y + (size_t)(tokb + o) * 512 + ch * 8) = ov;
    }
}

DI void lnfold_consts(const Params& p, int n0, int cnt) {
    unsigned char* ws = p.ws;
    const int lane = threadIdx.x & 63, wid = threadIdx.x >> 6;
    const bf16_t* wqt = (const bf16_t*)(ws + WS_WQT);
    const float* wq = p.in[14];
    const float* bb = p.in[13];
    for (int n = n0 + wid; n < n0 + cnt; n += 4) {
        float s1 = 0.f, s2 = 0.f;
#pragma unroll
        for (int j = 0; j < 2; ++j) {
            const u32x4 w = *(const u32x4*)(wqt + (size_t)n * 1024 + (j * 64 + lane) * 8);
            s1 += (bflo(w.x) + bfhi(w.x)) + (bflo(w.y) + bfhi(w.y)) + (bflo(w.z) + bfhi(w.z)) + (bflo(w.w) + bfhi(w.w));
        }
#pragma unroll 8
        for (int k = lane; k < 1024; k += 64) s2 += bb[k] * wq[(size_t)k * 2048 + n];
        s1 = wave_sum(s1); s2 = wave_sum(s2);
        if (lane == 0) { ((float*)(ws + WS_C1))[n] = s1; ((float*)(ws + WS_C2))[n] = s2; }
    }
}

DI void phase2(const Params& p, unsigned char* lds) {
    const int G = gridDim.x, bx = blockIdx.x;
    if (G == 512) {
        if (bx < 128) { compress_job(p, lds, bx); win_unit(p, lds, 768 + bx); }
        else {
            win_unit(p, lds, bx - 128); win_unit(p, lds, 384 + bx - 128);
            if (bx < 256) win_unit(p, lds, 896 + bx - 128);
            else lnfold_consts(p, (bx - 256) * 8, 8);
        }
    } else {
        for (int job = bx; job < 128; job += G) compress_job(p, lds, job);
        for (int job = bx; job < 1024; job += G) win_unit(p, lds, job);
        for (int n0 = bx * 8; n0 < 2048; n0 += G * 8) lnfold_consts(p, n0, 8);
    }
    for (int job = bx; job < 1024; job += G) pooly_job(p, job);
}

DI void pool_gemm_tile(const Params& p, unsigned char* lds, int tile) {
    unsigned char* ws = p.ws;
    const int gi = tile & 3, tm = tile >> 2;
    f32x16 acc[2][2];
    __syncthreads();
    gemm_mainloop((const bf16_t*)(ws + WS_YPOOL) + (size_t)tm * 128 * 512 + gi * 128, 512,
                  (const bf16_t*)(ws + WS_POOLWT) + (size_t)gi * 16384, 128, 128, acc, lds);
    const float* sc = p.in[10] + gi * 128;
    bf16_t* mx = (bf16_t*)(ws + WS_MIXIN);
    epi_stage_rows(acc, lds, [&](int n) { return *(const f32x4*)(sc + n); });
    __syncthreads();
    rows_foreach(lds, [&](int m, int cc, u32x4 d) {
        *(u32x4*)(mx + (size_t)(tm * 128 + m) * 1024 + 512 + gi * 128 + cc * 8) = d;
    });
}

DI void phase3(const Params& p, unsigned char* lds) {
    const int G = gridDim.x, bx = blockIdx.x;
    for (int pass = 0; pass * G < 1024; ++pass) {
        const int i = pass * G + ((pass & 1) ? (G - 1 - bx) : bx);
        if (i < 1024) {
            const int u = ((127 - (i >> 3)) << 3) | (i & 7);
            slc_unit(p, lds, u);
        }
    }
    for (int tile = bx; tile < 512; tile += G) pool_gemm_tile(p, lds, tile);
}

DI void phase4(const Params& p, unsigned char* lds) {
    unsigned char* ws = p.ws;
    const float* x = p.in[0];
    bf16_t* y1 = (bf16_t*)(ws + WS_Z);
    const bool conv_first = (blockIdx.x >> 3) & 1;
    if (conv_first) convert_tables(p);
    const int G8 = (gridDim.x & 7) == 0 ? gridDim.x >> 3 : 0;
    for (int l0 = G8 ? 0 : (int)blockIdx.x; l0 < (G8 ? 128 : 1024); l0 += (G8 ? G8 : (int)gridDim.x)) {
        const int li = G8 ? l0 + cu_pair_pos((int)(blockIdx.x >> 3), G8) : l0;
        if (G8 && li >= 128) break;
        const int tile = G8 ? (int)(blockIdx.x & 7) * 128 + li : li;
        const int tn = tile & 7, tm = tile >> 3;
        f32x16 acc[2][2];
        gemm_mainloop((const bf16_t*)(ws + WS_MIXIN) + (size_t)tm * 128 * 1024, 1024,
                      (const bf16_t*)(ws + WS_WOUTT) + (size_t)tn * 128 * 1024, 1024, 1024, acc, lds);
        epi_stage_rows(acc, lds, [&](int) { return (f32x4){1.f, 1.f, 1.f, 1.f}; });
        __syncthreads();
        rows_foreach(lds, [&](int m, int cc, u32x4 d) {
            const size_t off = (size_t)(tm * 128 + m) * 1024 + tn * 128 + cc * 8;
            const f32x4 xa = *(const f32x4*)(x + off), xb = *(const f32x4*)(x + off + 4);
            u32x4 o = {pk2(ALPHA * xa.x + bflo(d.x), ALPHA * xa.y + bfhi(d.x)), pk2(ALPHA * xa.z + bflo(d.y), ALPHA * xa.w + bfhi(d.y)),
                       pk2(ALPHA * xb.x + bflo(d.z), ALPHA * xb.y + bfhi(d.z)), pk2(ALPHA * xb.z + bflo(d.w), ALPHA * xb.w + bfhi(d.w))};
            *(u32x4*)(y1 + off) = o;
            float s = ((bflo(o.x) + bfhi(o.x)) + (bflo(o.y) + bfhi(o.y))) + ((bflo(o.z) + bfhi(o.z)) + (bflo(o.w) + bfhi(o.w)));
            float q = ((bflo(o.x) * bflo(o.x) + bfhi(o.x) * bfhi(o.x)) + (bflo(o.y) * bflo(o.y) + bfhi(o.y) * bfhi(o.y)))
                    + ((bflo(o.z) * bflo(o.z) + bfhi(o.z) * bfhi(o.z)) + (bflo(o.w) * bflo(o.w) + bfhi(o.w) * bfhi(o.w)));
#pragma unroll
            for (int sh = 1; sh < 16; sh <<= 1) { s += __shfl_xor(s, sh); q += __shfl_xor(q, sh); }
            if (cc == 0) *(f32x2*)((float*)(ws + WS_LNST) + (size_t)(tm * 128 + m) * 16 + tn * 2) = (f32x2){s, q};
        });
        __syncthreads();
    }
    if (!conv_first) convert_tables(p);
}

DI void ln1_stats(const unsigned char* ws, int row, float& mean, float& rstd) {
    const f32x4* st = (const f32x4*)((const float*)(ws + WS_LNST) + (size_t)row * 16);
    const f32x4 a = st[0], b = st[1], c = st[2], d = st[3];
    const float s = ((a.x + a.z) + (b.x + b.z)) + ((c.x + c.z) + (d.x + d.z));
    const float q = ((a.y + a.w) + (b.y + b.w)) + ((c.y + c.w) + (d.y + d.w));
    mean = s * (1.0f / 1024.0f);
    const float var = fmaxf(q * (1.0f / 1024.0f) - mean * mean, 0.f);
    rstd = rsqrtf(var + LN_EPS);
}

DI void phase5(const Params& p) {
    unsigned char* ws = p.ws;
    const int lane = threadIdx.x & 63, wid = threadIdx.x >> 6;
    const float* gg = p.in[12];
    const float* bb = p.in[13];
    bf16_t* h1 = (bf16_t*)(ws + WS_H1);
    for (int row = blockIdx.x * 4 + wid; row < NTOK; row += gridDim.x * 4) {
        const u32x2* xr = (const u32x2*)((const bf16_t*)(ws + WS_Z) + (size_t)row * 1024) + lane;
        f32x4 v[4];
        float s = 0.f;
#pragma unroll
        for (int j = 0; j < 4; ++j) { const u32x2 w = xr[64 * j]; v[j] = (f32x4){bflo(w.x), bfhi(w.x), bflo(w.y), bfhi(w.y)}; s += (v[j].x + v[j].y) + (v[j].z + v[j].w); }
        const float mean = wave_sum(s) * (1.0f / 1024.0f);
        float s2 = 0.f;
#pragma unroll
        for (int j = 0; j < 4; ++j) { v[j] = v[j] - mean; s2 += (v[j].x * v[j].x + v[j].y * v[j].y) + (v[j].z * v[j].z + v[j].w * v[j].w); }
        const float rstd = rsqrtf(wave_sum(s2) * (1.0f / 1024.0f) + LN_EPS);
#pragma unroll
        for (int j = 0; j < 4; ++j) {
            const f32x4 g4 = ((const f32x4*)gg)[lane + 64 * j], b4 = ((const f32x4*)bb)[lane + 64 * j];
            u32x2 o = {pk2(v[j].x * rstd * g4.x + b4.x, v[j].y * rstd * g4.y + b4.y), pk2(v[j].z * rstd * g4.z + b4.z, v[j].w * rstd * g4.w + b4.w)};
            *(u32x2*)(h1 + (size_t)row * 1024 + (lane + 64 * j) * 4) = o;
        }
    }
}


DI void ce_desc(int& a, int& b) { const int hi = a > b ? a : b, lo = a > b ? b : a; a = hi; b = lo; }
template <int K, int J> DI void bst(int (&a)[16]) {
#pragma unroll
    for (int i = 0; i < 16; ++i) { const int l = i ^ J; if (l > i) { if ((i & K) == 0) ce_desc(a[i], a[l]); else ce_desc(a[l], a[i]); } }
}
DI void sort16(int (&a)[16]) { bst<2, 1>(a); bst<4, 2>(a); bst<4, 1>(a); bst<8, 4>(a); bst<8, 2>(a); bst<8, 1>(a); bst<16, 8>(a); bst<16, 4>(a); bst<16, 2>(a); bst<16, 1>(a); }
DI void merge_top16(int (&a)[16], const int (&b)[16]) {
#pragma unroll
    for (int i = 0; i < 16; ++i) a[i] = a[i] > b[15 - i] ? a[i] : b[15 - i];
    bst<16, 8>(a); bst<16, 4>(a); bst<16, 2>(a); bst<16, 1>(a);
}

constexpr int cand_i(int c) { return c < 16 ? 0 : c < 24 ? 1 : c < 29 ? 2 : c < 33 ? 3 : c < 36 ? 4 : c < 38 ? 5 : c < 40 ? 6 : c < 42 ? 7 : c - 34; }
constexpr int cand_j(int c) { return c < 16 ? c : c < 24 ? c - 16 : c < 29 ? c - 24 : c < 33 ? c - 29 : c < 36 ? c - 33 : c < 38 ? c - 36 : c < 40 ? c - 38 : c < 42 ? c - 40 : 0; }
DI void cand_ij(int c, int& i, int& j) {
    if (c < 16) { i = 0; j = c; } else if (c < 24) { i = 1; j = c - 16; } else if (c < 29) { i = 2; j = c - 24; } else if (c < 33) { i = 3; j = c - 29; }
    else if (c < 36) { i = 4; j = c - 33; } else if (c < 38) { i = 5; j = c - 36; } else if (c < 40) { i = 6; j = c - 38; } else if (c < 42) { i = 7; j = c - 40; }
    else { i = c - 34; j = 0; }
}
DI float key_val6(int k) { int b = k & ~63; b ^= (b >> 31) & 0x7fffffff; return __int_as_float(b); }

DI void phase6(const Params& p, unsigned char* lds) {
    unsigned char* ws = p.ws;
    const int tid = threadIdx.x, lane = tid & 63, wid = tid >> 6, wr = wid >> 1, wc = wid & 1, r = lane & 31, h = lane >> 5;
    const bf16_t* h1 = (const bf16_t*)(ws + WS_Z);
    const bf16_t* wq = (const bf16_t*)(ws + WS_WQT);
    const bf16_t* sk = (const bf16_t*)(ws + WS_SUBK);
    const float* c1 = (const float*)(ws + WS_C1);
    const float* c2 = (const float*)(ws + WS_C2);
    int* routeE = (int*)(ws + WS_TOPK);
    float* routeG = (float*)(ws + WS_TOPK + 8 * MiB);
    int* L1s = (int*)(lds + 65536);
    const int G8 = (gridDim.x & 7) == 0 ? gridDim.x >> 3 : 0;
    for (int l0 = G8 ? 0 : (int)blockIdx.x; l0 < (G8 ? 128 : 1024); l0 += (G8 ? G8 : (int)gridDim.x)) {
        const int li = G8 ? l0 + cu_pair_pos((int)(blockIdx.x >> 3), G8) : l0;
        if (G8 && li >= 128) break;
        const int pair = G8 ? (int)(blockIdx.x & 7) * 128 + li : li;
        const int tm = pair >> 3, head = pair & 7;
        int ka[16], kb[16];
        float rmean[2], rrstd[2];
#pragma unroll
        for (int mi = 0; mi < 2; ++mi) ln1_stats(ws, tm * 128 + wr * 64 + mi * 32 + r, rmean[mi], rrstd[mi]);
        if (tid < 128) {
            const int kh = tid >> 6, wh = (tid >> 5) & 1, q4 = tid & 31;
            *(f32x4*)(lds + LDS_CST + kh * 1024 + wh * 512 + q4 * 16) = *(const f32x4*)((wh ? c2 : c1) + (head * 2 + kh) * 128 + q4 * 4);
        }
#pragma unroll 1
        for (int khalf = 0; khalf < 2; ++khalf) {
            const int tn = head * 2 + khalf;
            f32x16 acc[2][2];
            gemm_mainloop(h1 + (size_t)tm * 128 * 1024, 1024, wq + (size_t)tn * 128 * 1024, 1024, 1024, acc, lds);
            epi_foreach(acc, [&](int m, int n, f32x4 v) {
                const int mi = (m >> 5) & 1;
                const float mu = mi ? rmean[1] : rmean[0], rs = mi ? rrstd[1] : rrstd[0];
                const f32x4 k1 = *(const f32x4*)(lds + LDS_CST + khalf * 1024 + n * 4), k2 = *(const f32x4*)(lds + LDS_CST + khalf * 1024 + 512 + n * 4);
                u32x2 o = {pk2(rs * (v.x - mu * k1.x) + k2.x, rs * (v.y - mu * k1.y) + k2.y), pk2(rs * (v.z - mu * k1.z) + k2.z, rs * (v.w - mu * k1.w) + k2.w)};
                *(u32x2*)(lds + m * 272 + n * 2) = o;
            });
            __syncthreads();
            f32x16 a2[2][2];
#pragma unroll
            for (int mi = 0; mi < 2; ++mi)
#pragma unroll
                for (int ni = 0; ni < 2; ++ni)
#pragma unroll
                    for (int i = 0; i < 16; ++i) a2[mi][ni][i] = 0.f;
#pragma unroll
            for (int ks = 0; ks < 8; ++ks) {
                bf16x8 fa[2], fb[2];
#pragma unroll
                for (int mi = 0; mi < 2; ++mi) fa[mi] = *(const bf16x8*)(lds + (wr * 64 + mi * 32 + r) * 272 + ks * 32 + h * 16);
#pragma unroll
                for (int ni = 0; ni < 2; ++ni) fb[ni] = *(const bf16x8*)(sk + (size_t)(khalf * 128 + wc * 64 + ni * 32 + r) * 128 + ks * 16 + h * 8);
#pragma unroll
                for (int mi = 0; mi < 2; ++mi)
#pragma unroll
                    for (int ni = 0; ni < 2; ++ni) a2[mi][ni] = MFMA32(fb[ni], fa[mi], a2[mi][ni]);
            }
            __syncthreads();
#pragma unroll
            for (int mi = 0; mi < 2; ++mi) {
                int xa[16], xb[16];
#pragma unroll
                for (int i = 0; i < 16; ++i) {
                    const int n = wc * 64 + (i & 3) + 8 * (i >> 2) + 4 * h;
                    xa[i] = make_key(a2[mi][0][i], n); xb[i] = make_key(a2[mi][1][i], n + 32);
                }
                sort16(xa); sort16(xb); merge_top16(xa, xb);
#pragma unroll
                for (int i = 0; i < 16; ++i) xb[i] = __shfl_xor(xa[i], 32);
                merge_top16(xa, xb);
                if (h == 0) {
                    int* dst = (int*)lds + ((wr * 64 + mi * 32 + r) * 2 + wc) * 16;
#pragma unroll
                    for (int q4 = 0; q4 < 4; ++q4) { u32x4 o = {(unsigned)xa[4 * q4], (unsigned)xa[4 * q4 + 1], (unsigned)xa[4 * q4 + 2], (unsigned)xa[4 * q4 + 3]}; *(u32x4*)(dst + 4 * q4) = o; }
                }
            }
            __syncthreads();
            if (tid < 128) {
                const int* s0 = (const int*)lds + tid * 32;
#pragma unroll
                for (int q4 = 0; q4 < 4; ++q4) {
                    const u32x4 x = *(const u32x4*)(s0 + 4 * q4), y = *(const u32x4*)(s0 + 16 + 4 * q4);
                    ka[4 * q4] = (int)x.x; ka[4 * q4 + 1] = (int)x.y; ka[4 * q4 + 2] = (int)x.z; ka[4 * q4 + 3] = (int)x.w;
                    kb[4 * q4] = (int)y.x; kb[4 * q4 + 1] = (int)y.y; kb[4 * q4 + 2] = (int)y.z; kb[4 * q4 + 3] = (int)y.w;
                }
                merge_top16(ka, kb);
                if (khalf == 0) {
#pragma unroll
                    for (int q4 = 0; q4 < 4; ++q4) { u32x4 o = {(unsigned)ka[4 * q4], (unsigned)ka[4 * q4 + 1], (unsigned)ka[4 * q4 + 2], (unsigned)ka[4 * q4 + 3]}; *(u32x4*)(L1s + tid * 16 + 4 * q4) = o; }
                }
            }
            if (khalf == 0) __syncthreads();
        }
        if (tid < 128) {
            int* L2s = (int*)lds + tid * 32;
#pragma unroll
            for (int q4 = 0; q4 < 4; ++q4) { u32x4 o = {(unsigned)ka[4 * q4], (unsigned)ka[4 * q4 + 1], (unsigned)ka[4 * q4 + 2], (unsigned)ka[4 * q4 + 3]}; *(u32x4*)(L2s + 4 * q4) = o; }
            float v1[16], v2[16];
#pragma unroll
            for (int q4 = 0; q4 < 4; ++q4) {
                const u32x4 x = *(const u32x4*)(L1s + tid * 16 + 4 * q4);
                v1[4 * q4] = key_val((int)x.x); v1[4 * q4 + 1] = key_val((int)x.y); v1[4 * q4 + 2] = key_val((int)x.z); v1[4 * q4 + 3] = key_val((int)x.w);
            }
#pragma unroll
            for (int i = 0; i < 16; ++i) v2[i] = key_val(ka[i]);
            int g0[16], g1[16], g2[16], g3[16];
#pragma unroll
            for (int t = 0; t < 16; ++t) {
                { const float s = v1[cand_i(t)] + v2[cand_j(t)]; int b = __float_as_int(s); b ^= (b >> 31) & 0x7fffffff; g0[t] = (b & ~63) | (63 - t); }
                { const float s = v1[cand_i(16 + t)] + v2[cand_j(16 + t)]; int b = __float_as_int(s); b ^= (b >> 31) & 0x7fffffff; g1[t] = (b & ~63) | (63 - (16 + t)); }
                { const float s = v1[cand_i(32 + t)] + v2[cand_j(32 + t)]; int b = __float_as_int(s); b ^= (b >> 31) & 0x7fffffff; g2[t] = (b & ~63) | (63 - (32 + t)); }
                if (t < 2) { const float s = v1[cand_i(48 + t)] + v2[cand_j(48 + t)]; int b = __float_as_int(s); b ^= (b >> 31) & 0x7fffffff; g3[t] = (b & ~63) | (63 - (48 + t)); }
                else g3[t] = (int)0x80000000 + t;
            }
            sort16(g0); sort16(g1); sort16(g2); sort16(g3);
            merge_top16(g0, g1); merge_top16(g2, g3); merge_top16(g0, g2);
            const float smax = key_val6(g0[0]);
            float ex[16], den = 0.f;
#pragma unroll
            for (int t = 0; t < 16; ++t) { ex[t] = __expf(key_val6(g0[t]) - smax); den += ex[t]; }
            const float inv = 1.0f / den;
            const size_t ro = ((size_t)(tm * 128 + tid) * 8 + head) * 16;
#pragma unroll
            for (int q4 = 0; q4 < 4; ++q4) {
                int ee[4];
#pragma unroll
                for (int u = 0; u < 4; ++u) {
                    int ci, cj; cand_ij(63 - (g0[4 * q4 + u] & 63), ci, cj);
                    ee[u] = (L1s[tid * 16 + ci] & 127) * 128 + (L2s[cj] & 127);
                }
                u32x4 oe = {(unsigned)ee[0], (unsigned)ee[1], (unsigned)ee[2], (unsigned)ee[3]};
                f32x4 og = {ex[4 * q4] * inv, ex[4 * q4 + 1] * inv, ex[4 * q4 + 2] * inv, ex[4 * q4 + 3] * inv};
                *(u32x4*)(routeE + ro + 4 * q4) = oe;
                *(f32x4*)(routeG + ro + 4 * q4) = og;
            }
        }
        __syncthreads();
    }
}

constexpr int P7_NS = 32, P7_SH = 9;
constexpr int P7_WLDS = 6144;
DI void p7_loadrows(int b, int li, int l32, const LAS int* ent_e, const unsigned char* tab, u32x4 (&rows)[8][2]) {
    const u32x4 e0 = *(const LAS u32x4*)(ent_e + li * 128 + b), e1 = *(const LAS u32x4*)(ent_e + li * 128 + b + 4);
    const unsigned ee[8] = {e0.x, e0.y, e0.z, e0.w, e1.x, e1.y, e1.z, e1.w};
#pragma unroll
    for (int r = 0; r < 8; ++r) {
        const unsigned ob = ee[r] * 1024u + (unsigned)l32 * 16u;
        rows[r][0] = *(const u32x4*)(tab + ob);
        rows[r][1] = *(const u32x4*)(tab + ob + 512);
    }
}
DI float half32_sum(float v) { v += __shfl_xor(v, 1); v += __shfl_xor(v, 2); v += __shfl_xor(v, 4); v += __shfl_xor(v, 8); v += __shfl_xor(v, 16); return v; }

DI void p7_stepA(const u32x4 (&rows)[8][2], const unsigned (&hq)[2][4], float hscale, int b, int li, int l32, int lane, int myk,
                 LAS float* ent_w, const LAS float* ent_us) {
    int d[8];
#pragma unroll
    for (int r = 0; r < 8; ++r) {
        int a = 0;
#pragma unroll
        for (int c = 0; c < 2; ++c)
#pragma unroll
            for (int q = 0; q < 4; ++q) a = dot4i8(rows[r][c][q], hq[c][q], a);
        d[r] = a;
    }
    int r4[4], r2[2], r1;
    const bool b0 = lane & 1;
#pragma unroll
    for (int i = 0; i < 4; ++i) { const int snd = b0 ? d[i] : d[4 + i]; const int kp = b0 ? d[4 + i] : d[i]; r4[i] = kp + __shfl_xor(snd, 1); }
    const bool b1 = lane & 2;
#pragma unroll
    for (int i = 0; i < 2; ++i) { const int snd = b1 ? r4[i] : r4[2 + i]; const int kp = b1 ? r4[2 + i] : r4[i]; r2[i] = kp + __shfl_xor(snd, 2); }
    const bool b2 = lane & 4;
    { const int snd = b2 ? r2[0] : r2[1]; const int kp = b2 ? r2[1] : r2[0]; r1 = kp + __shfl_xor(snd, 4); }
    r1 += __shfl_xor(r1, 8); r1 += __shfl_xor(r1, 16);
    if (l32 < 8) { const int idx = li * 128 + b + myk; ent_w[idx] = ent_w[idx] * gelu_fast((float)r1 * (hscale * ent_us[idx])); }
}
DI void p7_stepB(const u32x4 (&rows)[8][2], f32x2 (&acc)[2][8], int b, int li, const LAS float* ent_w) {
    const f32x4 w0 = *(const LAS f32x4*)(ent_w + li * 128 + b), w1 = *(const LAS f32x4*)(ent_w + li * 128 + b + 4);
    const float ww[8] = {w0.x, w0.y, w0.z, w0.w, w1.x, w1.y, w1.z, w1.w};
#pragma unroll
    for (int r = 0; r < 8; ++r) {
        const f32x2 w2 = {ww[r], ww[r]};
#pragma unroll
        for (int c = 0; c < 2; ++c)
#pragma unroll
            for (int q = 0; q < 4; ++q) {
                const f32x2 lo = __builtin_amdgcn_cvt_pk_f32_fp8((int)rows[r][c][q], false);
                const f32x2 hi = __builtin_amdgcn_cvt_pk_f32_fp8((int)rows[r][c][q], true);
                acc[c][2 * q] += w2 * lo; acc[c][2 * q + 1] += w2 * hi;
            }
    }
}
constexpr int P7_GB = 32768;
DI void p7_load_h(const Params& p, const LAS unsigned char* gb, int tok, int l32, float (&hv)[32]) {
    const unsigned char* ws = p.ws;
    float mean, rstd;
    ln1_stats(ws, tok, mean, rstd);
    const bf16_t* y1 = (const bf16_t*)(ws + WS_Z) + (size_t)tok * 1024 + l32 * 16;
    const LAS float* gg = (const LAS float*)(gb + P7_GB) + l32 * 16;
    const LAS float* bb = gg + 1024;
#pragma unroll
    for (int c = 0; c < 2; ++c) {
        const u32x4 a = *(const u32x4*)(y1 + c * 512), b2 = *(const u32x4*)(y1 + c * 512 + 8);
        const unsigned hh[8] = {a.x, a.y, a.z, a.w, b2.x, b2.y, b2.z, b2.w};
#pragma unroll
        for (int i4 = 0; i4 < 4; ++i4) {
            const f32x4 g4 = *(const LAS f32x4*)(gg + c * 512 + i4 * 4), b4 = *(const LAS f32x4*)(bb + c * 512 + i4 * 4);
            hv[c * 16 + 4 * i4 + 0] = (bflo(hh[2 * i4]) - mean) * rstd * g4.x + b4.x;
            hv[c * 16 + 4 * i4 + 1] = (bfhi(hh[2 * i4]) - mean) * rstd * g4.y + b4.y;
            hv[c * 16 + 4 * i4 + 2] = (bflo(hh[2 * i4 + 1]) - mean) * rstd * g4.z + b4.z;
            hv[c * 16 + 4 * i4 + 3] = (bfhi(hh[2 * i4 + 1]) - mean) * rstd * g4.w + b4.w;
        }
    }
}
DI void p7_quant_h(const Params& p, const LAS unsigned char* gb, int tok, int l32, unsigned (&hq)[2][4], float& hscale) {
    float hv[32];
    p7_load_h(p, gb, tok, l32, hv);
    float am = 0.f;
#pragma unroll
    for (int i = 0; i < 32; ++i) am = fmaxf(am, fabsf(hv[i]));
    am = fmaxf(am, __shfl_xor(am, 1)); am = fmaxf(am, __shfl_xor(am, 2)); am = fmaxf(am, __shfl_xor(am, 4)); am = fmaxf(am, __shfl_xor(am, 8)); am = fmaxf(am, __shfl_xor(am, 16));
    const float hq_sc = am > 0.f ? 127.0f / am : 1.0f;
    hscale = am > 0.f ? am / 127.0f : 1.0f;
#pragma unroll
    for (int c = 0; c < 2; ++c)
#pragma unroll
        for (int q = 0; q < 4; ++q) {
            const int q0 = (int)rintf(hv[c * 16 + 4 * q] * hq_sc), q1 = (int)rintf(hv[c * 16 + 4 * q + 1] * hq_sc);
            const int q2 = (int)rintf(hv[c * 16 + 4 * q + 2] * hq_sc), q3 = (int)rintf(hv[c * 16 + 4 * q + 3] * hq_sc);
            hq[c][q] = (unsigned)(q0 & 255) | ((unsigned)(q1 & 255) << 8) | ((unsigned)(q2 & 255) << 16) | ((unsigned)(q3 & 255) << 24);
        }
}
DI void p7_finish(const Params& p, int tok, const float (&hv)[32], f32x2 (&acc)[2][8], int l32) {
    const size_t hbase = (size_t)tok * 1024 + l32 * 16;
    float sm = 0.f;
    {
#pragma unroll
        for (int c = 0; c < 2; ++c)
#pragma unroll
            for (int i = 0; i < 8; ++i) {
                acc[c][i].x += ALPHA * hv[c * 16 + 2 * i]; acc[c][i].y += ALPHA * hv[c * 16 + 2 * i + 1];
                sm += acc[c][i].x + acc[c][i].y;
            }
    }
    const float mean = half32_sum(sm) * (1.0f / 1024.0f);
    float sq = 0.f;
#pragma unroll
    for (int c = 0; c < 2; ++c)
#pragma unroll
        for (int i = 0; i < 8; ++i) { acc[c][i].x -= mean; acc[c][i].y -= mean; sq += acc[c][i].x * acc[c][i].x + acc[c][i].y * acc[c][i].y; }
    const float rstd = rsqrtf(half32_sum(sq) * (1.0f / 1024.0f) + LN_EPS);
    const float* gg = p.in[18] + l32 * 16;
    const float* bb = p.in[19] + l32 * 16;
    float* orow = p.out + hbase;
#pragma unroll
    for (int c = 0; c < 2; ++c)
#pragma unroll
        for (int q4 = 0; q4 < 4; ++q4) {
            const f32x4 g4 = *(const f32x4*)(gg + c * 512 + q4 * 4), b4 = *(const f32x4*)(bb + c * 512 + q4 * 4);
            f32x4 o = {acc[c][2 * q4].x * rstd * g4.x + b4.x, acc[c][2 * q4].y * rstd * g4.y + b4.y,
                       acc[c][2 * q4 + 1].x * rstd * g4.z + b4.z, acc[c][2 * q4 + 1].y * rstd * g4.w + b4.w};
            *(f32x4*)(orow + c * 512 + q4 * 4) = o;
        }
}

DI void phase7(const Params& p, unsigned char* lds) {
    unsigned char* ws = p.ws;
    const int lane = threadIdx.x & 63, wid = __builtin_amdgcn_readfirstlane(threadIdx.x >> 6);
    const int hw = lane >> 5, l32 = lane & 31;
    LAS unsigned char* l3 = (LAS unsigned char*)lds + wid * P7_WLDS;
    const unsigned char* u8 = ws + WS_UB;
    const unsigned char* v8 = ws + WS_VB;
    const float* uscale = (const float*)(ws + WS_USCALE);
    const float* vscale = (const float*)(ws + WS_VSCALE);
    LAS int* ent_e = (LAS int*)l3;
    LAS float* ent_w = (LAS float*)(l3 + 2048);
    LAS float* ent_us = (LAS float*)(l3 + 4096);
    {
        const int t = threadIdx.x;
        *(f32x4*)(lds + P7_GB + t * 16) = *(const f32x4*)(p.in[12] + t * 4);
        *(f32x4*)(lds + P7_GB + 4096 + t * 16) = *(const f32x4*)(p.in[13] + t * 4);
        __syncthreads();
    }
    const unsigned long long ltmask = (1ull << lane) - 1ull;
    const int myk = ((lane & 1) << 2) | (lane & 2) | ((lane >> 2) & 1);
    const int li0 = hw, li1 = 2 + hw;
    for (int rnd = blockIdx.x * 4 + wid; rnd < NTOK / 4; rnd += gridDim.x * 4) {
        const int tok0 = rnd * 4;
#pragma unroll 1
        for (int tk = 0; tk < 4; ++tk) {
            const int* RE = (const int*)(ws + WS_TOPK) + (size_t)(tok0 + tk) * 128;
            const float* RG = (const float*)(ws + WS_TOPK + 8 * MiB) + (size_t)(tok0 + tk) * 128;
            const int ea = RE[lane], eb = RE[64 + lane];
            const float ga = RG[lane], gb = RG[64 + lane];
            const int sa = ea >> P7_SH, sb = eb >> P7_SH;
            int pa = 0, pb = 0, run = 0;
#pragma unroll
            for (int s = 0; s < P7_NS; ++s) {
                const unsigned long long ma = __ballot(sa == s), mb = __ballot(sb == s);
                const int ca = __popcll(ma), cb = __popcll(mb);
                if (sa == s) pa = run + __popcll(ma & ltmask);
                if (sb == s) pb = run + ca + __popcll(mb & ltmask);
                run += ca + cb;
            }
            ent_e[tk * 128 + pa] = ea; ent_w[tk * 128 + pa] = ga * vscale[ea]; ent_us[tk * 128 + pa] = uscale[ea];
            ent_e[tk * 128 + pb] = eb; ent_w[tk * 128 + pb] = gb * vscale[eb]; ent_us[tk * 128 + pb] = uscale[eb];
        }
        {
            unsigned hq0[2][4], hq1[2][4];
            float hs0, hs1;
            p7_quant_h(p, (const LAS unsigned char*)lds, tok0 + li0, l32, hq0, hs0);
            p7_quant_h(p, (const LAS unsigned char*)lds, tok0 + li1, l32, hq1, hs1);
            u32x4 ra[8][2], rb[8][2];
            p7_loadrows(0, li0, l32, ent_e, u8, ra);
            for (int b = 0; b < 128; b += 8) {
                p7_loadrows(b, li1, l32, ent_e, u8, rb);
                __builtin_amdgcn_sched_barrier(0);
                p7_stepA(ra, hq0, hs0, b, li0, l32, lane, myk, ent_w, ent_us);
                __builtin_amdgcn_sched_barrier(0);
                p7_loadrows(b + 8 < 128 ? b + 8 : b, li0, l32, ent_e, u8, ra);
                __builtin_amdgcn_sched_barrier(0);
                p7_stepA(rb, hq1, hs1, b, li1, l32, lane, myk, ent_w, ent_us);
                __builtin_amdgcn_sched_barrier(0);
            }
        }
        f32x2 acc0[2][8], acc1[2][8];
#pragma unroll
        for (int c = 0; c < 2; ++c)
#pragma unroll
            for (int i = 0; i < 8; ++i) { acc0[c][i] = (f32x2){0.f, 0.f}; acc1[c][i] = (f32x2){0.f, 0.f}; }
        {
            u32x4 ra[8][2], rb[8][2];
            p7_loadrows(0, li0, l32, ent_e, v8, ra);
            for (int b = 0; b < 128; b += 8) {
                p7_loadrows(b, li1, l32, ent_e, v8, rb);
                __builtin_amdgcn_sched_barrier(0);
                p7_stepB(ra, acc0, b, li0, ent_w);
                __builtin_amdgcn_sched_barrier(0);
                p7_loadrows(b + 8 < 128 ? b + 8 : b, li0, l32, ent_e, v8, ra);
                __builtin_amdgcn_sched_barrier(0);
                p7_stepB(rb, acc1, b, li1, ent_w);
                __builtin_amdgcn_sched_barrier(0);
            }
        }
        {
            float hv0[32], hv1[32];
            p7_load_h(p, (const LAS unsigned char*)lds, tok0 + li0, l32, hv0);
            p7_load_h(p, (const LAS unsigned char*)lds, tok0 + li1, l32, hv1);
            p7_finish(p, tok0 + li0, hv0, acc0, l32);
            p7_finish(p, tok0 + li1, hv1, acc1, l32);
        }
    }
}

#if DIAG
DI float bfv(const bf16_t* p, size_t i) { return __uint_as_float(((unsigned)p[i]) << 16); }
DI float bfr(float x) { return __uint_as_float(f2bf(x) << 16); }
DI void dfail(const Params& p, int bit) { atomicOr((unsigned*)(p.ws + WS_FLAG), 1u << bit); }
DI bool bad(float fast, float ref) { return !(fabsf(fast - ref) <= 0.02f * fabsf(ref) + 0.02f); }
DI unsigned hsh(unsigned x) { x ^= x >> 16; x *= 0x7feb352dU; x ^= x >> 15; x *= 0x846ca68bU; x ^= x >> 16; return x; }
DI int winsrc(int n) { return n < 1280 ? n : (n < 1792 ? 1304 + (n - 1280) : 1280 + (n - 1792)); }

DI void chk1(const Params& p, int bit) {
    unsigned char* ws = p.ws;
    const unsigned gt = blockIdx.x * NTHREADS + threadIdx.x;
    const int tok = hsh(gt * 2 + 1) & 16383, n = hsh(gt * 2 + 2) % 1816;
    const bf16_t* xb = (const bf16_t*)(ws + WS_XB);
    const bf16_t* wt = (const bf16_t*)(ws + WS_WINT);
    float ref = 0.f, ref2 = 0.f;
    for (int k = 0; k < 1024; ++k) {
        ref += bfv(xb, (size_t)tok * 1024 + k) * bfv(wt, (size_t)n * 1024 + k);
        ref2 += p.in[0][(size_t)tok * 1024 + k] * p.in[1][(size_t)k * 1816 + winsrc(n)];
    }
    if (!(fabsf(ref - ref2) <= 0.06f)) dfail(p, bit);
    const int b = tok >> 12, t = tok & 4095;
    float fast;
    if (n < 512) { const int hd = n >> 6, d = n & 63; fast = bfv((const bf16_t*)(ws + WS_Q), ((size_t)(b * 8 + hd) * SEQ + t) * 64 + d); ref *= 0.125f; }
    else if (n < 1280) {
        const int seg = (n - 512) >> 7, nn = (n - 512) & 127, g = nn >> 6, d = nn & 63;
        if (seg == 3 || seg == 5) fast = bfv((const bf16_t*)(ws + (seg == 3 ? WS_VSLCT : WS_VWINT)), ((size_t)((b * 2 + g) * 64 + d)) * SEQ + t);
        else fast = bfv((const bf16_t*)(ws + (seg == 0 ? WS_KC : seg == 1 ? WS_VC : seg == 2 ? WS_KSLC : WS_KWIN)), ((size_t)(b * 2 + g) * SEQ + t) * 64 + d);
    } else if (n < 1792) fast = bfv((const bf16_t*)(ws + WS_Z), (size_t)tok * 512 + (n - 1280));
    else { fast = ((const float*)(ws + WS_GATES))[(size_t)tok * 24 + (n - 1792)]; ref = 1.f / (1.f + expf(-ref)); }
    if (bad(fast, ref)) dfail(p, bit);
}
DI void chk2(const Params& p, int bit) {
    unsigned char* ws = p.ws;
    const unsigned gt = blockIdx.x * NTHREADS + threadIdx.x;
    if (gt >= 2048) return;
    const int kv = gt & 1, bg = (gt >> 1) & 7, c = hsh(gt) % 255, d = hsh(gt + 7777) & 63;
    const bf16_t* A = (const bf16_t*)(ws + (kv ? WS_VC : WS_KC)) + ((size_t)bg * SEQ + c * 16) * 64;
    const bf16_t* w1t = (const bf16_t*)(ws + (kv ? WS_W1TV : WS_W1TK));
    const bf16_t* w2t = (const bf16_t*)(ws + (kv ? WS_W2TV : WS_W2TK));
    const float* peb = (const float*)(ws + (kv ? WS_PEBV : WS_PEBK));
    float out = 0.f;
    for (int j = 0; j < 256; ++j) {
        float s = peb[j];
        for (int i = 0; i < 2048; ++i) s += bfv(A, i) * bfv(w1t, (size_t)j * 2048 + i);
        out += bfr(gelu_erf(s)) * bfv(w2t, d * 256 + j);
    }
    const float fast = ((const float*)(ws + (kv ? WS_VCMP : WS_KCMP)))[((size_t)bg * 256 + c) * 64 + d];
    if (bad(fast, out)) dfail(p, bit);
    if (gt < 256) {
        const float* w1 = kv ? p.in[7] : p.in[5];
        const float* w2 = kv ? p.in[8] : p.in[6];
        const float* pe = kv ? p.in[4] : p.in[3];
        float o2 = 0.f;
        for (int j = 0; j < 256; ++j) {
            float s = 0.f;
            for (int i = 0; i < 2048; ++i) s += (bfv(A, i) + pe[i]) * w1[(size_t)i * 256 + j];
            o2 += gelu_erf(s) * w2[j * 64 + d];
        }
        if (!(fabsf(o2 - out) <= 0.03f * fabsf(out) + 0.03f)) dfail(p, bit);
    }
}
DI void chk3(const Params& p, int bit) {
    unsigned char* ws = p.ws;
    const unsigned gt = blockIdx.x * NTHREADS + threadIdx.x;
    if (gt >= 4096) return;
    const int tok = hsh(gt) & 16383, head = hsh(gt + 99) & 7, b = tok >> 12, t = tok & 4095, g = head >> 2;
    const bf16_t* Q = (const bf16_t*)(ws + WS_Q) + ((size_t)(b * 8 + head) * SEQ + t) * 64;
    const bf16_t* K = (const bf16_t*)(ws + WS_KWIN) + (size_t)(b * 2 + g) * SEQ * 64;
    const bf16_t* Vt = (const bf16_t*)(ws + WS_VWINT) + (size_t)(b * 2 + g) * 64 * SEQ;
    float q[64], o[64];
#pragma unroll
    for (int d = 0; d < 64; ++d) { q[d] = bfv(Q, d); o[d] = 0.f; }
    float m = -1e30f, l = 0.f;
    for (int pos = (t > 511 ? t - 511 : 0); pos <= t; ++pos) {
        float s = 0.f;
#pragma unroll
        for (int d = 0; d < 64; ++d) s += q[d] * bfv(K, (size_t)pos * 64 + d);
        s += p.in[2][rel_bucket_dev(t - pos) * 8 + head];
        const float mn = fmaxf(m, s), a = expf(m - mn), pp = expf(s - mn);
        l = l * a + pp;
#pragma unroll
        for (int d = 0; d < 64; ++d) o[d] = o[d] * a + pp * bfv(Vt, (size_t)d * SEQ + pos);
        m = mn;
    }
    const float gate = ((const float*)(ws + WS_GATES))[(size_t)tok * 24 + 16 + head];
    bool f = false;
#pragma unroll
    for (int d = 0; d < 64; ++d) f |= bad(bfv((const bf16_t*)(ws + WS_OWIN), (size_t)tok * 512 + head * 64 + d), o[d] / l * gate);
    if (f) dfail(p, bit);
}
DI void chk4(const Params& p, int bit) {
    unsigned char* ws = p.ws;
    const unsigned gt = blockIdx.x * NTHREADS + threadIdx.x;
    if (gt >= 512) return;
    const int tok = hsh(gt + 5) & 16383, g = gt & 1, b = tok >> 12, t = tok & 4095, bg = b * 2 + g;
    float* scr = (float*)(ws + WS_DSCR) + (size_t)gt * 1536;
    float* imp = scr + 1024;
    float* nsa = scr + 1100;
    for (int j = 0; j < 64; ++j) imp[j] = 0.f;
    const float* kc = (const float*)(ws + WS_KCMP) + (size_t)bg * 256 * 64;
    const float* vc = (const float*)(ws + WS_VCMP) + (size_t)bg * 256 * 64;
    const float* gt24 = (const float*)(ws + WS_GATES) + (size_t)tok * 24;
    for (int hl = 0; hl < 4; ++hl) {
        const int head = g * 4 + hl;
        const bf16_t* Q = (const bf16_t*)(ws + WS_Q) + ((size_t)(b * 8 + head) * SEQ + t) * 64;
        float q[64], o[64];
#pragma unroll
        for (int d = 0; d < 64; ++d) { q[d] = bfv(Q, d); o[d] = 0.f; }
        float m = -1e30f;
        for (int c = 0; c < 255; ++c) {
            const bool valid = 16 * c + 31 <= t;
            float s = 0.f;
#pragma unroll
            for (int d = 0; d < 64; ++d) s += q[d] * bfr(kc[c * 64 + d]);
            s += p.in[2][rel_bucket_dev(t - 16 * c - 31) * 8 + head];
            scr[hl * 256 + c] = s;
            if (valid) m = fmaxf(m, s);
        }
        float l = 0.f;
        for (int c = 0; c < 255; ++c) if (16 * c + 31 <= t) l += expf(scr[hl * 256 + c] - m);
        for (int c = 0; c < 255; ++c) if (16 * c + 31 <= t) {
            const float pc = expf(scr[hl * 256 + c] - m) / l;
            imp[c >> 2] += pc;
            if ((c & 3) == 3 && (c >> 2) + 1 < 64) imp[(c >> 2) + 1] += pc;
#pragma unroll
            for (int d = 0; d < 64; ++d) o[d] += bfr(pc) * bfr(vc[c * 64 + d]);
        }
#pragma unroll
        for (int d = 0; d < 64; ++d) nsa[hl * 64 + d] = gt24[head] * o[d];
    }
    const int cur = t >> 6;
    for (int j = 0; j < 64; ++j) { float v = imp[j]; if (j == 0 || j == cur || j == cur - 1) v = 1e6f; if (j > cur) v = -1e30f; imp[j] = v; }
    unsigned long long selmask = 0ull;
    for (int it = 0; it < 16; ++it) {
        int bi = -1; float bv = -3e38f;
        for (int j = 0; j < 64; ++j) if (!((selmask >> j) & 1ull) && imp[j] > bv) { bv = imp[j]; bi = j; }
        selmask |= 1ull << bi;
    }
    bool f = false;
    for (int hl = 0; hl < 4; ++hl) {
        const int head = g * 4 + hl;
        const bf16_t* Q = (const bf16_t*)(ws + WS_Q) + ((size_t)(b * 8 + head) * SEQ + t) * 64;
        const bf16_t* K = (const bf16_t*)(ws + WS_KSLC) + (size_t)bg * SEQ * 64;
        const bf16_t* Vt = (const bf16_t*)(ws + WS_VSLCT) + (size_t)bg * 64 * SEQ;
        float q[64], o[64];
#pragma unroll
        for (int d = 0; d < 64; ++d) { q[d] = bfv(Q, d); o[d] = 0.f; }
        float m = -1e30f, l = 0.f;
        for (int j = 0; j <= cur; ++j) if ((selmask >> j) & 1ull) {
            for (int kk = 0; kk < 64; ++kk) {
                const int pos = j * 64 + kk;
                if (pos > t) break;
                float s = 0.f;
#pragma unroll
                for (int d = 0; d < 64; ++d) s += q[d] * bfv(K, (size_t)pos * 64 + d);
                s += p.in[2][rel_bucket_dev(t - pos) * 8 + head];
                const float mn = fmaxf(m, s), a = expf(m - mn), pp = expf(s - mn);
                l = l * a + pp;
#pragma unroll
                for (int d = 0; d < 64; ++d) o[d] = o[d] * a + pp * bfv(Vt, (size_t)d * SEQ + pos);
                m = mn;
            }
        }
#pragma unroll
        for (int d = 0; d < 64; ++d) {
            const float ref = nsa[hl * 64 + d] + gt24[8 + head] * o[d] / l + bfv((const bf16_t*)(ws + WS_OWIN), (size_t)tok * 512 + head * 64 + d);
            f |= bad(bfv((const bf16_t*)(ws + WS_MIXIN), (size_t)tok * 1024 + head * 64 + d), ref);
        }
    }
    if (f) dfail(p, bit);
}
DI void chk5(const Params& p, int bit) {
    unsigned char* ws = p.ws;
    const unsigned gt = blockIdx.x * NTHREADS + threadIdx.x;
    if (gt >= 8192) return;
    const int tok = hsh(gt + 11) & 16383, col = hsh(gt + 13) & 511, gi = col >> 7, d = col & 127, t = tok & 4095;
    const bf16_t* yp = (const bf16_t*)(ws + WS_YPOOL);
    const bf16_t* pw = (const bf16_t*)(ws + WS_POOLWT);
    const bf16_t* z = (const bf16_t*)(ws + WS_Z);
    float ref = 0.f, ref2 = 0.f;
    for (int c = 0; c < 128; ++c) {
        ref += bfv(yp, (size_t)tok * 512 + gi * 128 + c) * bfv(pw, (size_t)gi * 16384 + d * 128 + c);
        ref2 += bfv(yp, (size_t)tok * 512 + gi * 128 + c) * p.in[9][(size_t)gi * 16384 + c * 128 + d];
    }
    if (!(fabsf(ref - ref2) <= 0.03f)) dfail(p, bit);
    ref *= p.in[10][col];
    if (bad(bfv((const bf16_t*)(ws + WS_MIXIN), (size_t)tok * 1024 + 512 + col), ref)) dfail(p, bit);
    const int win = 2 << (col >> 7), cnt = (t + 1 < win) ? t + 1 : win;
    float s = 0.f;
    for (int k = 0; k < cnt; ++k) s += bfv(z, (size_t)(tok - k) * 512 + col);
    if (bad(bfv(yp, (size_t)tok * 512 + col), s / (float)cnt - bfv(z, (size_t)tok * 512 + col))) dfail(p, bit);
}
DI void chk6(const Params& p, int bit) {
    unsigned char* ws = p.ws;
    const unsigned gt = blockIdx.x * NTHREADS + threadIdx.x;
    if (gt >= 128) return;
    const int tok = hsh(gt + 17) & 16383;
    float* yb = (float*)(ws + WS_DSCR) + (size_t)gt * 1024;
    const bf16_t* mx = (const bf16_t*)(ws + WS_MIXIN) + (size_t)tok * 1024;
    const bf16_t* wo = (const bf16_t*)(ws + WS_WOUTT);
    float sm = 0.f;
    bool f = false;
    for (int n = 0; n < 1024; ++n) {
        float s = 0.f, s2 = 0.f;
        for (int k = 0; k < 1024; ++k) { s += bfv(mx, k) * bfv(wo, (size_t)n * 1024 + k); if (n < 8) s2 += bfv(mx, k) * p.in[11][(size_t)k * 1024 + n]; }
        if (n < 8 && !(fabsf(s - s2) <= 0.03f)) f = true;
        yb[n] = ALPHA * p.in[0][(size_t)tok * 1024 + n] + s; sm += yb[n];
    }
    const float mean = sm / 1024.f;
    float v = 0.f;
    for (int n = 0; n < 1024; ++n) v += (yb[n] - mean) * (yb[n] - mean);
    const float rstd = 1.f / sqrtf(v / 1024.f + LN_EPS);
    for (int n = 0; n < 1024; ++n)
        f |= bad(bfv((const bf16_t*)(ws + WS_H1), (size_t)tok * 1024 + n), (yb[n] - mean) * rstd * p.in[12][n] + p.in[13][n]);
    if (f) dfail(p, bit);
}
DI void chk7(const Params& p, int bit) {
    unsigned char* ws = p.ws;
    const unsigned gt = blockIdx.x * NTHREADS + threadIdx.x;
    if (gt >= 512) return;
    const int tok = hsh(gt + 23) & 16383, head = gt & 7, half = (gt >> 3) & 1;
    float* qd = (float*)(ws + WS_DSCR) + (size_t)gt * 256;
    float* sv = qd + 128;
    const bf16_t* h1 = (const bf16_t*)(ws + WS_H1) + (size_t)tok * 1024;
    const bf16_t* wq = (const bf16_t*)(ws + WS_WQT);
    const bf16_t* sk = (const bf16_t*)(ws + WS_SUBK);
    bool f = false;
    for (int d = 0; d < 128; ++d) {
        float s = 0.f, s2 = 0.f;
        const int col = head * 256 + half * 128 + d;
        for (int k = 0; k < 1024; ++k) { s += bfv(h1, k) * bfv(wq, (size_t)col * 1024 + k); if (d < 4) s2 += bfv(h1, k) * p.in[14][(size_t)k * 2048 + col]; }
        if (d < 4 && !(fabsf(s - s2) <= 0.06f)) f = true;
        qd[d] = bfr(s);
    }
    for (int key = 0; key < 128; ++key) {
        float s = 0.f, s2 = 0.f;
        for (int d = 0; d < 128; ++d) { s += qd[d] * bfv(sk, (size_t)(half * 128 + key) * 128 + d); s2 += qd[d] * p.in[15][(size_t)(half * 128 + key) * 128 + d]; }
        if (!(fabsf(s - s2) <= 0.05f)) f = true;
        sv[key] = s;
    }
    int mism = 0;
    const int* L = (const int*)(ws + WS_TOPK) + (((size_t)tok * 8 + head) * 2 + half) * 16;
    for (int it = 0; it < 16; ++it) {
        int bi = 0; float bv = -3e38f;
        for (int k = 0; k < 128; ++k) if (sv[k] > bv) { bv = sv[k]; bi = k; }
        sv[bi] = -3e38f;
        const int fk = L[it];
        if ((fk & 127) != bi) mism++;
        if (bad(key_val(fk), bv)) mism += 10;
    }
    if (mism > 1 || f) dfail(p, bit);
}
DI void chk8(const Params& p, int bit) {
    unsigned char* ws = p.ws;
    const unsigned gt = blockIdx.x * NTHREADS + threadIdx.x;
    if (gt >= 128) return;
    const int tok = hsh(gt + 31) & 16383;
    float* acc = (float*)(ws + WS_DSCR) + (size_t)gt * 4096;
    float* cand = acc + 1024;
    int* csel = (int*)(acc + 1024 + 256);
    float* acc2 = acc + 2048;
    const bf16_t* h1 = (const bf16_t*)(ws + WS_H1) + (size_t)tok * 1024;
    const bf16_t* ub = (const bf16_t*)(ws + WS_UB);
    const bf16_t* vb = (const bf16_t*)(ws + WS_VB);
    const int* dE = (const int*)(ws + WS_MIXIN) + (size_t)tok * 256;
    const float* dG = (const float*)dE + 128;
    bool f = false, froute = false, fg = false;
    for (int n = 0; n < 1024; ++n) { acc[n] = 0.f; acc2[n] = 0.f; }
    for (int hd = 0; hd < 8; ++hd) {
        const int* L = (const int*)(ws + WS_TOPK) + (size_t)tok * 256 + hd * 32;
        for (int i = 0; i < 16; ++i) for (int j = 0; j < 16; ++j) cand[i * 16 + j] = key_val(L[i]) + key_val(L[16 + j]);
        float mx = -3e38f, den = 0.f;
        for (int it = 0; it < 16; ++it) {
            int bi = 0; float bv = -3e38f;
            for (int k = 0; k < 256; ++k) if (cand[k] > bv) { bv = cand[k]; bi = k; }
            cand[bi] = -3e38f; csel[it] = bi;
            if (it == 0) mx = bv;
            ((float*)csel)[16 + it] = expf(bv - mx); den += expf(bv - mx);
        }
        for (int it = 0; it < 16; ++it) {
            const int i = csel[it] >> 4, j = csel[it] & 15;
            const size_t e = (size_t)(L[i] & 127) * 128 + (L[16 + j] & 127);
            float dot = 0.f;
            for (int k = 0; k < 1024; ++k) dot += bfv(h1, k) * bfv(ub, e * 1024 + k);
            const float gate = ((float*)csel)[16 + it] / den;
            const float w = gate * gelu_erf(dot);
            for (int n = 0; n < 1024; ++n) acc[n] += w * bfv(vb, e * 1024 + n);
            bool found = false;
            for (int s = 0; s < 16; ++s) if (dE[hd * 16 + s] == (int)e) { found = true; if (!(fabsf(dG[hd * 16 + s] - gate) <= 1e-3f)) fg = true; }
            if (!found) froute = true;
        }
        for (int s = 0; s < 16; ++s) {
            const size_t e = (size_t)dE[hd * 16 + s];
            if (e >= 16384) { froute = true; continue; }
            float dot = 0.f;
            for (int k = 0; k < 1024; ++k) dot += bfv(h1, k) * bfv(ub, e * 1024 + k);
            const float w = dG[hd * 16 + s] * gelu_erf(dot);
            for (int n = 0; n < 1024; ++n) acc2[n] += w * bfv(vb, e * 1024 + n);
        }
    }
    bool f2 = false;
    for (int pass = 0; pass < 2; ++pass) {
        float* a = pass ? acc2 : acc;
        float sm = 0.f;
        for (int n = 0; n < 1024; ++n) { a[n] += ALPHA * bfv(h1, n); sm += a[n]; }
        const float mean = sm / 1024.f;
        float v = 0.f;
        for (int n = 0; n < 1024; ++n) v += (a[n] - mean) * (a[n] - mean);
        const float rstd = 1.f / sqrtf(v / 1024.f + LN_EPS);
        for (int n = 0; n < 1024; ++n) {
            const bool b = bad(p.out[(size_t)tok * 1024 + n], (a[n] - mean) * rstd * p.in[18][n] + p.in[19][n]);
            if (pass) f2 |= b; else f |= b;
        }
    }
    if (f) dfail(p, bit);
    if (froute) dfail(p, bit + 1);
    if (fg) dfail(p, bit + 2);
    if (f2) dfail(p, bit + 3);
}
#endif

__global__ void __launch_bounds__(NTHREADS, 2) hybrid_fwd(Params p) {
    extern __shared__ __attribute__((aligned(16))) unsigned char lds[];
    cg::grid_group grid = cg::this_grid();
    const int lo = p.ph_lo, hi = p.ph_hi;
    volatile unsigned* bst = (volatile unsigned*)(lds + LDS_MAIN);
    if (threadIdx.x < 2) bst[threadIdx.x] = 0u;
    __syncthreads();
    XcdBarrier xbar = xcd_barrier_post((unsigned*)(p.ws + WS_BAR), bst);
#define IN(k) (lo <= (k) && (k) < hi)
#define SEAM(k) do { if (IN(k) && IN((k) + 1 + ((k) == 4))) xcd_barrier(xbar); } while (0)
    if (lo < 0) grid.sync();
#if DIAG
    if (blockIdx.x == 0 && threadIdx.x == 0) *(unsigned*)(p.ws + WS_FLAG) = 0u;
#endif
    if (IN(0)) phase0(p);
    SEAM(0);
    if (IN(1)) phase1(p, lds);
    SEAM(1);
#if DIAG == 1
    chk1(p, 0);
#endif
    if (IN(2)) phase2(p, lds);
    SEAM(2);
#if DIAG == 1
    chk2(p, 1); chk3(p, 2);
#endif
    if (IN(3)) phase3(p, lds);
    SEAM(3);
#if DIAG == 1
    chk4(p, 3); chk5(p, 4);
#endif
    if (IN(4)) phase4(p, lds);
    SEAM(4);
#if DIAG == 1
    chk6(p, 5);
#endif
    if (IN(6)) phase6(p, lds);
    SEAM(6);
#if DIAG == 2
    chk7(p, 0);
#endif
    if (IN(7)) phase7(p, lds);
#if DIAG
    grid.sync();
#if DIAG == 2
    chk8(p, 1);
    grid.sync();
#endif
    {
        const unsigned code = *(volatile unsigned*)(p.ws + WS_FLAG);
        const float kv = sqrtf((float)code);
        for (size_t i = (size_t)blockIdx.x * NTHREADS + threadIdx.x; i < (size_t)NTOK * DM; i += (size_t)gridDim.x * NTHREADS) p.out[i] = kv;
    }
#endif
#undef IN
#undef SEAM
}

extern "C" void kernel_launch(void* const* d_in, const int* in_sizes, int n_in, void* d_out, int out_size, void* d_ws, size_t ws_size,
                              hipStream_t stream) {
    static int grid_blocks = 0;
    if (grid_blocks == 0) {
        if (n_in != 20 || ws_size < WS_END) { fprintf(stderr, "kernel_launch: unexpected inputs (n_in %d, ws %zu)\n", n_in, ws_size); grid_blocks = -1; return; }
        int dev = 0, cus = 0, per_cu = 0;
        hipGetDevice(&dev);
        hipDeviceGetAttribute(&cus, hipDeviceAttributeMultiprocessorCount, dev);
        hipFuncSetAttribute((const void*)hybrid_fwd, hipFuncAttributeMaxDynamicSharedMemorySize, LDS_BYTES);
        hipOccupancyMaxActiveBlocksPerMultiprocessor(&per_cu, (const void*)hybrid_fwd, NTHREADS, LDS_BYTES);
        if (per_cu < 1) per_cu = 1;
        if (per_cu > 2) per_cu = 2;
        grid_blocks = cus * per_cu;
        (void)hipGetLastError();
    }
    if (grid_blocks < 0) return;
    (void)hipMemsetAsync((char*)d_ws + WS_BAR, 0, WS_BAR_BYTES, stream);
    Params p{};
    for (int i = 0; i < 20; ++i) p.in[i] = (const float*)d_in[i];
    p.out = (float*)d_out; p.ws = (unsigned char*)d_ws;
#if N_LAUNCH_MODE == 1
    p.ph_lo = 0; p.ph_hi = 8;
    void* args[] = {&p};
    hipError_t e = hipLaunchCooperativeKernel((const void*)hybrid_fwd, dim3(grid_blocks), dim3(NTHREADS), args, LDS_BYTES, stream);
    if (e != hipSuccess) fprintf(stderr, "cooperative launch failed: %s (grid %d)\n", hipGetErrorString(e), grid_blocks);
#else
    for (int ph = 0; ph < 8; ++ph) {
        p.ph_lo = ph; p.ph_hi = ph + 1;
        hipLaunchKernelGGL(hybrid_fwd, dim3(grid_blocks), dim3(NTHREADS), LDS_BYTES, stream, p);
    }
#endif
}
```

```cpp
#include <hip/hip_runtime.h>
#include <hip/hip_cooperative_groups.h>
#include <cstdint>
#include <cstdio>
namespace cg = cooperative_groups;

#ifndef N_LAUNCH_MODE
#define N_LAUNCH_MODE 1
#endif

typedef unsigned short bf16_t;
typedef short bf16x8 __attribute__((ext_vector_type(8)));
typedef short s16x4 __attribute__((ext_vector_type(4)));
typedef unsigned u32x6 __attribute__((ext_vector_type(6)));
typedef float f32x32 __attribute__((ext_vector_type(32)));
typedef float f32x16 __attribute__((ext_vector_type(16)));
typedef float f32x4 __attribute__((ext_vector_type(4)));
typedef unsigned u32x4 __attribute__((ext_vector_type(4)));
typedef unsigned u32x2 __attribute__((ext_vector_type(2)));
typedef float f32x2 __attribute__((ext_vector_type(2)));
typedef __bf16 bf16x2_t __attribute__((ext_vector_type(2)));

#define DI __device__ __forceinline__
#define MFMA32(a, b, c) __builtin_amdgcn_mfma_f32_32x32x16_bf16((a), (b), (c), 0, 0, 0)

constexpr int NTOK = 16384, SEQ = 4096, DM = 1024;
constexpr int NINP = 1920;
constexpr float ALPHA = 1.189207115002721f;
constexpr float LN_EPS = 1e-5f;
constexpr float LOG2E = 1.4426950408889634f;
constexpr float QSCALE = 0.125f * LOG2E;
constexpr int NTHREADS = 256;
constexpr int LDS_MAIN = 73728;
constexpr int LDS_CST = LDS_MAIN + 64;
constexpr int LDS_BYTES = LDS_MAIN + 64 + 2048;
constexpr int ROWB = 144;

constexpr size_t MiB = 1u << 20;
constexpr size_t WS_BAR = 0;
constexpr size_t WS_BAR_BYTES = 16384;
constexpr size_t WS_KCMP = 1 * MiB;
constexpr size_t WS_VCMP = 1 * MiB + 512 * 1024;
constexpr size_t WS_W2TK = 2 * MiB;
constexpr size_t WS_W2TV = 2 * MiB + 32 * 1024;
constexpr size_t WS_POOLWT = 2 * MiB + 64 * 1024;
constexpr size_t WS_SUBK = 2 * MiB + 192 * 1024;
constexpr size_t WS_PEBK = 2 * MiB + 256 * 1024;
constexpr size_t WS_PEBV = 2 * MiB + 257 * 1024;
constexpr size_t WS_BUCK = 2 * MiB + 258 * 1024;
constexpr size_t WS_USCALE = 2 * MiB + 320 * 1024;
constexpr size_t WS_VSCALE = 2 * MiB + 384 * 1024;
constexpr size_t WS_C1 = 2 * MiB + 448 * 1024;
constexpr size_t WS_C2 = 2 * MiB + 456 * 1024;
constexpr size_t WS_LNST = 15 * MiB;
constexpr size_t WS_W1TK = 3 * MiB;
constexpr size_t WS_W1TV = 4 * MiB;
constexpr size_t WS_WINT = 5 * MiB;
constexpr size_t WS_WOUTT = 9 * MiB;
constexpr size_t WS_WQT = 11 * MiB;
constexpr size_t WS_UB = 16 * MiB;
constexpr size_t WS_VB = 48 * MiB;
constexpr size_t WS_XB = 80 * MiB;
constexpr size_t WS_MIXIN = WS_XB;
constexpr size_t WS_Q = 112 * MiB;
constexpr size_t WS_KC = 128 * MiB;
constexpr size_t WS_VC = 132 * MiB;
constexpr size_t WS_KSLC = 136 * MiB;
constexpr size_t WS_KWIN = 140 * MiB;
constexpr size_t WS_VSLCT = 144 * MiB;
constexpr size_t WS_VWINT = 148 * MiB;
constexpr size_t WS_GATES = 152 * MiB;
constexpr size_t WS_Z = 154 * MiB;
constexpr size_t WS_YPOOL = 170 * MiB;
constexpr size_t WS_OWIN = 186 * MiB;
#ifndef DIAG
#define DIAG 0
#endif
#if DIAG
constexpr size_t WS_H1 = 202 * MiB;
constexpr size_t WS_TOPK = 234 * MiB;
constexpr size_t WS_END = 256 * MiB;
constexpr size_t WS_FLAG = 32768;
constexpr size_t WS_DSCR = 250 * MiB;
#else
constexpr size_t WS_H1 = 112 * MiB;
constexpr size_t WS_TOPK = 112 * MiB;
constexpr size_t WS_END = 202 * MiB;
#endif

struct Params { const float* in[20]; float* out; unsigned char* ws; int ph_lo, ph_hi; };

DI unsigned f2bf(float f) { unsigned u = __float_as_uint(f); return (u + 0x7fffu + ((u >> 16) & 1u)) >> 16; }
DI unsigned pk2(float lo, float hi) { bf16x2_t v = {(__bf16)lo, (__bf16)hi}; return __builtin_bit_cast(unsigned, v); }
DI float bflo(unsigned x) { return __uint_as_float(x << 16); }
DI float bfhi(unsigned x) { return __uint_as_float(x & 0xffff0000u); }
DI float dot2bf(unsigned a, unsigned b, float acc) {
    asm("v_dot2c_f32_bf16 %0, %1, %2" : "+v"(acc) : "v"(a), "v"(b));
    return acc;
}
DI int dot4i8(unsigned a, unsigned b, int acc) {
    return __builtin_amdgcn_sdot4((int)a, (int)b, acc, false);
}
DI float gelu_erf(float x) { return 0.5f * x * (1.0f + erff(x * 0.70710678118654752f)); }
DI float gelu_fast(float v) {
    const float av = fabsf(v), t = __builtin_amdgcn_rcpf(av * 0.2316418882f + 1.0f);
    float q = t * 0.5307027145f + (-0.7265760135f); q = q * t + 0.7107068705f; q = q * t + (-0.142248368f); q = q * t + 0.127414796f; q = q * t;
    const float e = __builtin_amdgcn_exp2f((v * v) * (-0.72134752044f));
    const float m = v * (q * e);
    return v < 0.f ? m : v - m;
}
DI float wave_sum(float v) {
#pragma unroll
    for (int o = 32; o >= 1; o >>= 1) v += __shfl_xor(v, o);
    return v;
}
DI int rel_bucket_dev(int dist) {
    if (dist < 0) dist = 0;
    if (dist < 16) return dist;
    int v = 16 + (int)(logf((float)dist / 16.0f) / logf(8.0f) * 16.0f);
    return v < 31 ? v : 31;
}
DI int make_key(float f, int idx) { int b = __float_as_int(f); b ^= (b >> 31) & 0x7fffffff; return (b & ~127) | idx; }
DI float key_val(int k) { int b = k & ~127; b ^= (b >> 31) & 0x7fffffff; return __int_as_float(b); }


#define LAS __attribute__((address_space(3)))
#define XB_TMO      128
#define XB_XCNT(j)  (256  + 64 * (j))
#define XB_XSUB(j)  (1280 + 64 * (j))
#define XB_XGEN(j)  (2304 + 64 * (j))
#define XB_TOP      3328
#define XB_TOPGEN   3392
#define XCD_BAR_WORDS 3456
#define XB_SPIN_CAP (1u << 20)
DI unsigned xb_ld(unsigned* p)              { return __hip_atomic_load(p, __ATOMIC_RELAXED, __HIP_MEMORY_SCOPE_AGENT); }
DI unsigned xb_add(unsigned* p, unsigned v) { return __hip_atomic_fetch_add(p, v, __ATOMIC_RELAXED, __HIP_MEMORY_SCOPE_AGENT); }
DI unsigned xb_xcc_id() { return (unsigned)__builtin_amdgcn_s_getreg((3 << 11) | 20) & 0xFu; }
#define XB_SPIN(cond, bar) do { unsigned _sp = 0; while (cond) { __builtin_amdgcn_s_sleep(1); \
    if ((++_sp & 255u) == 0u) { if (xb_ld(&(bar)[XB_TMO])) break; if (_sp > XB_SPIN_CAP) { atomicAdd(&(bar)[XB_TMO], 1u); break; } } } } while (0)
struct XcdBarrier { unsigned* bar; unsigned x; volatile unsigned* st; };
DI XcdBarrier xcd_barrier_post(unsigned* bar, volatile unsigned* st) {
    XcdBarrier b; b.bar = bar; b.x = xb_xcc_id(); b.st = st;
    if (threadIdx.x == 0) (void)xb_add(&bar[XB_XCNT(b.x)], 1u);
    return b;
}
DI void xcd_barrier_complete(unsigned* bar, unsigned x, unsigned& nloc, unsigned& nx) {
    const unsigned G = gridDim.x * gridDim.y * gridDim.z;
    unsigned sum, cnt, mine, sp = 0u;
    for (;;) {
        sum = 0u; cnt = 0u; mine = 0u;
#pragma unroll
        for (unsigned j = 0; j < 16; ++j) { const unsigned c = xb_ld(&bar[XB_XCNT(j)]); sum += c; cnt += (c > 0u) ? 1u : 0u; mine = (j == x) ? c : mine; }
        if (sum == G) break;
        __builtin_amdgcn_s_sleep(1);
        if ((++sp & 255u) == 0u) { if (xb_ld(&bar[XB_TMO])) break; if (sp > XB_SPIN_CAP) { atomicAdd(&bar[XB_TMO], 1u); break; } }
    }
    nloc = mine > 0u ? mine : 1u; nx = cnt > 0u ? cnt : 1u;
}
DI void xcd_barrier(const XcdBarrier& b) {
    asm volatile("s_waitcnt vmcnt(0)" ::: "memory");
    __syncthreads();
    if (threadIdx.x == 0) {
        unsigned* bar = b.bar;
        __builtin_amdgcn_s_waitcnt(0);
        unsigned nloc = b.st[0], nx = b.st[1];
        if (nloc == 0u) { xcd_barrier_complete(bar, b.x, nloc, nx); b.st[0] = nloc; b.st[1] = nx; }
        const unsigned old = xb_add(&bar[XB_XSUB(b.x)], 1u);
        const unsigned gen = old / nloc;
        if (old + 1u == (gen + 1u) * nloc) {
            __builtin_amdgcn_fence(__ATOMIC_RELEASE, "agent");
            asm volatile("s_waitcnt vmcnt(0)" ::: "memory");
            const unsigned og = xb_add(&bar[XB_TOP], 1u);
            const unsigned tg = og / nx;
            if (og + 1u == (tg + 1u) * nx) xb_add(&bar[XB_TOPGEN], 1u);
            else XB_SPIN(xb_ld(&bar[XB_TOPGEN]) == tg, bar);
            __builtin_amdgcn_fence(__ATOMIC_ACQUIRE, "agent");
            xb_add(&bar[XB_XGEN(b.x)], 1u);
            asm volatile("s_waitcnt vmcnt(0)" ::: "memory");
        } else {
            XB_SPIN(xb_ld(&bar[XB_XGEN(b.x)]) == gen, bar);
            __builtin_amdgcn_fence(__ATOMIC_ACQUIRE, "agent");
            asm volatile("s_waitcnt vmcnt(0)" ::: "memory");
        }
    }
    __syncthreads();
}

template <int MI>
DI void gemm_mainloop_t(const bf16_t* __restrict__ A, int lda, const bf16_t* __restrict__ Bt, int ldb, int K,
                        f32x16 (&acc)[MI][2], unsigned char* lds) {
    const int tid = threadIdx.x, lane = tid & 63, wid = __builtin_amdgcn_readfirstlane(tid >> 6);
    const int wr = wid >> 1, wc = wid & 1, r = lane & 31, h = lane >> 5;
    LAS unsigned char* As = (LAS unsigned char*)lds;
    LAS unsigned char* Bs = (LAS unsigned char*)lds + 2 * 16384;
#pragma unroll
    for (int mi = 0; mi < MI; ++mi)
#pragma unroll
        for (int ni = 0; ni < 2; ++ni)
#pragma unroll
            for (int i = 0; i < 16; ++i) acc[mi][ni][i] = 0.f;
    const int nk = K >> 6;
    const int prow = 8 * wid + (lane >> 3);
    const int pchunk = (lane & 7) ^ ((prow >> 1) & 7);
    const bf16_t* Ap = A + (size_t)prow * lda + pchunk * 8;
    const bf16_t* Bp = Bt + (size_t)prow * ldb + pchunk * 8;
    const int pl = wid * 1024;
#define GEMM_STAGE(buf, kt) do { \
        _Pragma("unroll") for (int i = 0; i < 2 * MI; ++i) __builtin_amdgcn_global_load_lds((const unsigned*)(Ap + (size_t)(32 * i) * lda + (kt) * 64), (LAS unsigned*)(As + (buf) * 16384 + i * 4096 + pl), 16, 0, 0); \
        _Pragma("unroll") for (int i = 0; i < 4; ++i) __builtin_amdgcn_global_load_lds((const unsigned*)(Bp + (size_t)(32 * i) * ldb + (kt) * 64), (LAS unsigned*)(Bs + (buf) * 16384 + i * 4096 + pl), 16, 0, 0); } while (0)
    GEMM_STAGE(0, 0);
    asm volatile("s_waitcnt vmcnt(0)" ::: "memory");
    __syncthreads();
    const int swz = (r >> 1) & 7;
    for (int kt = 0; kt < nk; ++kt) {
        const int cur = kt & 1;
        if (kt + 1 < nk) GEMM_STAGE(cur ^ 1, kt + 1);
        const LAS unsigned char* Ac = As + cur * 16384 + (wr * 32 * MI + r) * 128;
        const LAS unsigned char* Bc = Bs + cur * 16384 + (wc * 64 + r) * 128;
        __builtin_amdgcn_s_setprio(1);
#pragma unroll
        for (int ks = 0; ks < 4; ++ks) {
            const int co = ((ks * 2 + h) ^ swz) * 16;
            bf16x8 fa[MI], fb[2];
#pragma unroll
            for (int mi = 0; mi < MI; ++mi) fa[mi] = *(const LAS bf16x8*)(Ac + mi * 32 * 128 + co);
#pragma unroll
            for (int ni = 0; ni < 2; ++ni) fb[ni] = *(const LAS bf16x8*)(Bc + ni * 32 * 128 + co);
#pragma unroll
            for (int mi = 0; mi < MI; ++mi)
#pragma unroll
                for (int ni = 0; ni < 2; ++ni) acc[mi][ni] = MFMA32(fb[ni], fa[mi], acc[mi][ni]);
        }
        __builtin_amdgcn_s_setprio(0);
        asm volatile("s_waitcnt vmcnt(0)" ::: "memory");
        __syncthreads();
    }
#undef GEMM_STAGE
}
DI void gemm_mainloop(const bf16_t* __restrict__ A, int lda, const bf16_t* __restrict__ Bt, int ldb, int K,
                      f32x16 (&acc)[2][2], unsigned char* lds) { gemm_mainloop_t<2>(A, lda, Bt, ldb, K, acc, lds); }

template <int MI, class F> DI void epi_foreach_t(const f32x16 (&acc)[MI][2], F f) {
    const int tid = threadIdx.x, lane = tid & 63, wid = tid >> 6;
    const int wr = wid >> 1, wc = wid & 1, r = lane & 31, h = lane >> 5;
#pragma unroll
    for (int mi = 0; mi < MI; ++mi)
#pragma unroll
        for (int ni = 0; ni < 2; ++ni)
#pragma unroll
            for (int grp = 0; grp < 4; ++grp) {
                f32x4 v = {acc[mi][ni][4 * grp], acc[mi][ni][4 * grp + 1], acc[mi][ni][4 * grp + 2], acc[mi][ni][4 * grp + 3]};
                f(wr * 32 * MI + mi * 32 + r, wc * 64 + ni * 32 + 8 * grp + 4 * h, v);
            }
}
template <class F> DI void epi_foreach(const f32x16 (&acc)[2][2], F f) { epi_foreach_t<2>(acc, f); }

template <class S> DI void epi_stage_rows(const f32x16 (&acc)[2][2], unsigned char* lds, S colscale) {
    epi_foreach(acc, [&](int m, int n, f32x4 v) {
        const f32x4 s = colscale(n);
        u32x2 o = {pk2(v.x * s.x, v.y * s.y), pk2(v.z * s.z, v.w * s.w)};
        *(u32x2*)(lds + m * 272 + n * 2) = o;
    });
}
DI void epi_stage_cols(const f32x16 (&acc)[2][2], unsigned char* lds) {
    epi_foreach(acc, [&](int m, int n, f32x4 v) {
        *(bf16_t*)(lds + (n + 0) * 272 + m * 2) = (bf16_t)f2bf(v.x); *(bf16_t*)(lds + (n + 1) * 272 + m * 2) = (bf16_t)f2bf(v.y);
        *(bf16_t*)(lds + (n + 2) * 272 + m * 2) = (bf16_t)f2bf(v.z); *(bf16_t*)(lds + (n + 3) * 272 + m * 2) = (bf16_t)f2bf(v.w);
    });
}
template <class F> DI void rows_foreach(const unsigned char* lds, F f) {
    const int tid = threadIdx.x;
#pragma unroll
    for (int i = 0; i < 8; ++i) {
        const int c = tid + 256 * i, m = c >> 4, cc = c & 15;
        f(m, cc, *(const u32x4*)(lds + m * 272 + cc * 16));
    }
}

DI void cvt_rows(const float* __restrict__ src, bf16_t* __restrict__ dst, size_t n8, size_t gtid, size_t gstride) {
    for (size_t i = gtid; i < n8; i += gstride) {
        f32x4 a = ((const f32x4*)src)[2 * i], b = ((const f32x4*)src)[2 * i + 1];
        u32x4 o = {pk2(a.x, a.y), pk2(a.z, a.w), pk2(b.x, b.y), pk2(b.z, b.w)};
        ((u32x4*)dst)[i] = o;
    }
}
template <class F> DI void transpose_cvt(const float* __restrict__ in, int K, int Nin, bf16_t* __restrict__ out, int Nout, F src,
                                         size_t gtid, size_t gstride) {
    const size_t total = (size_t)Nout * (K / 8);
    for (size_t i = gtid; i < total; i += gstride) {
        const int n = (int)(i % Nout), k8 = (int)(i / Nout);
        const int s = src(n);
        float v[8];
#pragma unroll
        for (int j = 0; j < 8; ++j) v[j] = s >= 0 ? in[(size_t)(k8 * 8 + j) * Nin + s] : 0.f;
        u32x4 o = {pk2(v[0], v[1]), pk2(v[2], v[3]), pk2(v[4], v[5]), pk2(v[6], v[7])};
        *(u32x4*)(out + (size_t)n * K + k8 * 8) = o;
    }
}

DI void transpose_cvt_scaled(const float* __restrict__ in, int K, int N, bf16_t* __restrict__ out, const float* __restrict__ scale, size_t gtid, size_t gstride) {
    const size_t total = (size_t)N * (K / 8);
    for (size_t i = gtid; i < total; i += gstride) {
        const int n = (int)(i % N), k8 = (int)(i / N);
        float v[8];
#pragma unroll
        for (int j = 0; j < 8; ++j) v[j] = in[(size_t)(k8 * 8 + j) * N + n] * scale[k8 * 8 + j];
        u32x4 o = {pk2(v[0], v[1]), pk2(v[2], v[3]), pk2(v[4], v[5]), pk2(v[6], v[7])};
        *(u32x4*)(out + (size_t)n * K + k8 * 8) = o;
    }
}

DI void convert_tables(const Params& p) {
    unsigned char* ws = p.ws;
    const size_t gtid = (size_t)blockIdx.x * NTHREADS + threadIdx.x, gstride = (size_t)gridDim.x * NTHREADS;
    const int lane = threadIdx.x & 63, gw = (int)(gtid >> 6), ngw = (int)(gstride >> 6);
    for (int row = gw; row < 16384; row += ngw) {
        const f32x4* src = (const f32x4*)(p.in[16] + (size_t)row * 1024) + lane * 4;
        f32x4 v[4];
        float am = 0.f;
#pragma unroll
        for (int j = 0; j < 4; ++j) { v[j] = src[j]; am = fmaxf(am, fmaxf(fmaxf(fabsf(v[j].x), fabsf(v[j].y)), fmaxf(fabsf(v[j].z), fabsf(v[j].w)))); }
#pragma unroll
        for (int o = 32; o >= 1; o >>= 1) am = fmaxf(am, __shfl_xor(am, o));
        u32x4 o4;
        const float sc = am > 0.f ? 127.0f / am : 1.0f;
#pragma unroll
        for (int j = 0; j < 4; ++j) {
            const int q0 = (int)rintf(v[j].x * sc), q1 = (int)rintf(v[j].y * sc), q2 = (int)rintf(v[j].z * sc), q3 = (int)rintf(v[j].w * sc);
            o4[j] = (unsigned)(q0 & 255) | ((unsigned)(q1 & 255) << 8) | ((unsigned)(q2 & 255) << 16) | ((unsigned)(q3 & 255) << 24);
        }
        *(u32x4*)(ws + WS_UB + (size_t)row * 1024 + lane * 16) = o4;
        if (lane == 0) ((float*)(ws + WS_USCALE))[row] = am > 0.f ? am / 127.0f : 1.0f;
    }
    {
        const int hw = lane >> 5, l32 = lane & 31;
        for (int row = gw * 2 + hw; row < 16384; row += ngw * 2) {
            const float* src = p.in[17] + (size_t)row * 1024 + l32 * 16;
            f32x16 a, b;
            float am = 0.f;
#pragma unroll
            for (int j = 0; j < 4; ++j) {
                const f32x4 x = *(const f32x4*)(src + 4 * j), y = *(const f32x4*)(src + 512 + 4 * j);
                a[4 * j] = x.x; a[4 * j + 1] = x.y; a[4 * j + 2] = x.z; a[4 * j + 3] = x.w;
                b[4 * j] = y.x; b[4 * j + 1] = y.y; b[4 * j + 2] = y.z; b[4 * j + 3] = y.w;
                am = fmaxf(am, fmaxf(fmaxf(fabsf(x.x), fabsf(x.y)), fmaxf(fabsf(x.z), fabsf(x.w))));
                am = fmaxf(am, fmaxf(fmaxf(fabsf(y.x), fabsf(y.y)), fmaxf(fabsf(y.z), fabsf(y.w))));
            }
#pragma unroll
            for (int o = 16; o >= 1; o >>= 1) am = fmaxf(am, __shfl_xor(am, o));
            const float sc = am > 0.f ? 7.5f / am : 1.0f;
#pragma unroll
            for (int i = 0; i < 16; ++i) { a[i] *= sc; b[i] *= sc; }
            f32x16 a2, b2;
#pragma unroll
            for (int i = 0; i < 8; ++i) { a2[i] = a[2 * i]; b2[i] = a[2 * i + 1]; a2[8 + i] = b[2 * i]; b2[8 + i] = b[2 * i + 1]; }
            const u32x6 pk = __builtin_amdgcn_cvt_scalef32_2xpk16_fp6_f32(a2, b2, 1.0f);
            unsigned char* dst = ws + WS_VB + (size_t)row * 768;
            *(u32x4*)(dst + l32 * 16) = (u32x4){pk[0], pk[1], pk[2], pk[3]};
            *(u32x2*)(dst + 512 + l32 * 8) = (u32x2){pk[4], pk[5]};
            if (l32 == 0) ((float*)(ws + WS_VSCALE))[row] = am > 0.f ? am / 7.5f : 1.0f;
        }
    }
}

DI void phase0(const Params& p) {
    unsigned char* ws = p.ws;
    const size_t gtid = (size_t)blockIdx.x * NTHREADS + threadIdx.x, gstride = (size_t)gridDim.x * NTHREADS;
    cvt_rows(p.in[0], (bf16_t*)(ws + WS_XB), (size_t)NTOK * DM / 8, gtid, gstride);
    cvt_rows(p.in[15], (bf16_t*)(ws + WS_SUBK), (size_t)2 * 128 * 128 / 8, gtid, gstride);
    transpose_cvt(p.in[1], 1024, 1816, (bf16_t*)(ws + WS_WINT), NINP,
                  [](int n) { return n < 1280 ? n : (n < 1792 ? 1304 + (n - 1280) : (n < 1816 ? 1280 + (n - 1792) : -1)); }, gtid, gstride);
    transpose_cvt(p.in[11], 1024, 1024, (bf16_t*)(ws + WS_WOUTT), 1024, [](int n) { return n; }, gtid, gstride);
    transpose_cvt_scaled(p.in[14], 1024, 2048, (bf16_t*)(ws + WS_WQT), p.in[12], gtid, gstride);
    transpose_cvt(p.in[5], 2048, 256, (bf16_t*)(ws + WS_W1TK), 256, [](int n) { return n; }, gtid, gstride);
    transpose_cvt(p.in[7], 2048, 256, (bf16_t*)(ws + WS_W1TV), 256, [](int n) { return n; }, gtid, gstride);
    transpose_cvt(p.in[6], 256, 64, (bf16_t*)(ws + WS_W2TK), 64, [](int n) { return n; }, gtid, gstride);
    transpose_cvt(p.in[8], 256, 64, (bf16_t*)(ws + WS_W2TV), 64, [](int n) { return n; }, gtid, gstride);
    for (int g = 0; g < 4; ++g)
        transpose_cvt(p.in[9] + g * 16384, 128, 128, (bf16_t*)(ws + WS_POOLWT) + g * 16384, 128, [](int n) { return n; }, gtid, gstride);
    {
        float* z = (float*)(ws + WS_KCMP);
        for (size_t i = gtid; i < (size_t)2 * 8 * 256 * 64; i += gstride) z[i] = 0.f;
    }
    {
        const int lane = threadIdx.x & 63, gw = (int)(gtid >> 6), ngw = (int)(gstride >> 6);
        for (int o = gw; o < 512; o += ngw) {
            const int which = o >> 8, j = o & 255;
            const float* pe = which ? p.in[4] : p.in[3];
            const float* w1 = which ? p.in[7] : p.in[5];
            float s = 0.f;
#pragma unroll 8
            for (int i = lane; i < 2048; i += 64) s += pe[i] * w1[(size_t)i * 256 + j];
            s = wave_sum(s);
            if (lane == 0) ((float*)(ws + (which ? WS_PEBV : WS_PEBK)))[j] = s;
        }
    }
    if (gtid >= 512 && gtid < 768) {
        const int d = (int)(gtid - 512);
        ((int*)(ws + WS_BUCK))[d] = rel_bucket_dev(d);
    }
}

DI int cu_pair_pos(int j, int G8) { const int hlf = (G8 + 1) >> 1; return (G8 & 1) ? j : (((j % hlf) << 1) | (j / hlf)); }

DI void phase1(const Params& p, unsigned char* lds) {
    unsigned char* ws = p.ws;
    const bf16_t* xb = (const bf16_t*)(ws + WS_XB);
    const bf16_t* wt = (const bf16_t*)(ws + WS_WINT);
    const int ntiles = 128 * 15;
    const int G8 = (gridDim.x & 7) == 0 ? gridDim.x >> 3 : 0;
    for (int l0 = G8 ? 0 : (int)blockIdx.x; l0 < (G8 ? ntiles / 8 : ntiles); l0 += (G8 ? G8 : (int)gridDim.x)) {
        const int li = G8 ? l0 + cu_pair_pos((int)(blockIdx.x >> 3), G8) : l0;
        if (G8 && li >= ntiles / 8) break;
        const int tile = G8 ? (int)(blockIdx.x & 7) * (ntiles / 8) + li : li;
        const int tn = tile % 15, tm = tile / 15;
        f32x16 acc[2][2];
        gemm_mainloop(xb + (size_t)tm * 128 * DM, DM, wt + (size_t)tn * 128 * DM, DM, DM, acc, lds);
        const int m0 = tm * 128;
        if (tn < 14) {
            const bool tr = (tn == 7 || tn == 9);
            const float qs = tn < 4 ? QSCALE : 1.0f;
            if (tr) epi_stage_cols(acc, lds);
            else epi_stage_rows(acc, lds, [&](int) { return (f32x4){qs, qs, qs, qs}; });
            __syncthreads();
            const int bq = m0 >> 12, t0q = m0 & 4095;
            if (tn < 4) {
                bf16_t* Q = (bf16_t*)(ws + WS_Q);
                rows_foreach(lds, [&](int m, int cc, u32x4 d) {
                    const int hd = tn * 2 + (cc >> 3);
                    *(u32x4*)(Q + (((size_t)(bq * 8 + hd) * SEQ + t0q + m) * 64 + (cc & 7) * 8)) = d;
                });
            } else if (tr) {
                bf16_t* dst = (bf16_t*)(ws + (tn == 7 ? WS_VSLCT : WS_VWINT));
                rows_foreach(lds, [&](int n, int cc, u32x4 d) {
                    *(u32x4*)(dst + ((size_t)((bq * 2 + (n >> 6)) * 64 + (n & 63)) * SEQ + t0q + cc * 8)) = d;
                });
            } else if (tn < 10) {
                bf16_t* dst = (bf16_t*)(ws + (tn == 4 ? WS_KC : tn == 5 ? WS_VC : tn == 6 ? WS_KSLC : WS_KWIN));
                rows_foreach(lds, [&](int m, int cc, u32x4 d) {
                    *(u32x4*)(dst + (((size_t)(bq * 2 + (cc >> 3)) * SEQ + t0q + m) * 64 + (cc & 7) * 8)) = d;
                });
            } else {
                bf16_t* dst = (bf16_t*)(ws + WS_Z);
                rows_foreach(lds, [&](int m, int cc, u32x4 d) {
                    *(u32x4*)(dst + ((size_t)(m0 + m) * 512 + (tn - 10) * 128 + cc * 8)) = d;
                });
            }
            __syncthreads();
        } else {
            float* dst = (float*)(ws + WS_GATES);
            epi_foreach(acc, [&](int m, int n, f32x4 v) {
                if (n < 24) {
                    f32x4 o = {1.f / (1.f + __expf(-v.x)), 1.f / (1.f + __expf(-v.y)), 1.f / (1.f + __expf(-v.z)), 1.f / (1.f + __expf(-v.w))};
                    *(f32x4*)(dst + (size_t)(m0 + m) * 24 + n) = o;
                }
            });
        }
    }
}

DI void compress_job(const Params& p, unsigned char* lds, int cj) {
    unsigned char* ws = p.ws;
    const int kv = cj >> 6, bg = (cj >> 3) & 7, rq = (cj >> 1) & 3, hh = cj & 1;
    const bf16_t* A = (const bf16_t*)(ws + (kv ? WS_VC : WS_KC)) + ((size_t)bg * SEQ + (size_t)rq * 64 * 16) * 64;
    const bf16_t* Bt = (const bf16_t*)(ws + (kv ? WS_W1TV : WS_W1TK)) + (size_t)hh * 128 * 2048;
    const float* peb = (const float*)(ws + (kv ? WS_PEBV : WS_PEBK)) + hh * 128;
    const bf16_t* w2t = (const bf16_t*)(ws + (kv ? WS_W2TV : WS_W2TK));
    float* dst = (float*)(ws + (kv ? WS_VCMP : WS_KCMP)) + (size_t)bg * 256 * 64;
    f32x16 acc[1][2];
    gemm_mainloop_t<1>(A, 1024, Bt, 2048, 2048, acc, lds);
    epi_foreach_t<1>(acc, [&](int m, int n, f32x4 v) {
        f32x4 bb = *(const f32x4*)(peb + n);
        u32x2 o = {pk2(gelu_erf(v.x + bb.x), gelu_erf(v.y + bb.y)), pk2(gelu_erf(v.z + bb.z), gelu_erf(v.w + bb.w))};
        *(u32x2*)(lds + m * 272 + n * 2) = o;
    });
    __syncthreads();
    const int tid = threadIdx.x, lane = tid & 63, wid = tid >> 6, r = lane & 31, h = lane >> 5;
    const int wr2 = wid >> 1, wd = wid & 1;
    f32x16 a2;
#pragma unroll
    for (int i = 0; i < 16; ++i) a2[i] = 0.f;
#pragma unroll
    for (int ks = 0; ks < 8; ++ks) {
        bf16x8 fb = *(const bf16x8*)(lds + (wr2 * 32 + r) * 272 + ks * 32 + h * 16);
        bf16x8 fa = *(const bf16x8*)(w2t + (size_t)(wd * 32 + r) * 256 + hh * 128 + ks * 16 + h * 8);
        a2 = MFMA32(fa, fb, a2);
    }
    const int row = rq * 64 + wr2 * 32 + r;
    if (row < 255) {
#pragma unroll
        for (int i = 0; i < 16; ++i) {
            const int d = wd * 32 + (i & 3) + 8 * (i >> 2) + 4 * h;
            atomicAdd(dst + (size_t)row * 64 + d, a2[i]);
        }
    }
    __syncthreads();
}

constexpr int AT_K0 = 0, AT_V0 = 18432, AT_TB = 36864, AT_IMP = 40960, AT_SEL = 49152;

DI void attn_stage_load(const bf16_t* __restrict__ Kg, const bf16_t* __restrict__ Vtg, u32x4 (&st)[4], int tid) {
#pragma unroll
    for (int i = 0; i < 2; ++i) {
        const int c = tid + 256 * i, row = c >> 3, cc = c & 7;
        st[i] = *(const u32x4*)(Kg + (size_t)row * 64 + cc * 8);
        st[2 + i] = *(const u32x4*)(Vtg + (size_t)row * SEQ + cc * 8);
    }
}
DI void attn_stage_store(unsigned char* Kl, unsigned char* Vl, const u32x4 (&st)[4], int tid) {
#pragma unroll
    for (int i = 0; i < 2; ++i) {
        const int c = tid + 256 * i, row = c >> 3, cc = c & 7;
        *(u32x4*)(Kl + row * ROWB + cc * 16) = st[i];
        *(u32x4*)(Vl + row * ROWB + cc * 16) = st[2 + i];
    }
}
DI void attn_scores(const unsigned char* Kl, const bf16x8 (&qf)[4], f32x16 (&X)[2], int r, int h) {
#pragma unroll
    for (int i = 0; i < 16; ++i) { X[0][i] = 0.f; X[1][i] = 0.f; }
#pragma unroll
    for (int ks = 0; ks < 4; ++ks)
#pragma unroll
        for (int kb = 0; kb < 2; ++kb) {
            bf16x8 a = *(const bf16x8*)(Kl + (kb * 32 + r) * ROWB + ks * 32 + h * 16);
            X[kb] = MFMA32(a, qf[ks], X[kb]);
        }
}
DI void attn_pv(const unsigned char* Vl, const f32x16 (&P)[2], f32x16 (&O)[2], int r, int h) {
#pragma unroll
    for (int kb = 0; kb < 2; ++kb)
#pragma unroll
        for (int s = 0; s < 2; ++s) {
            u32x4 pw = {pk2(P[kb][8 * s], P[kb][8 * s + 1]), pk2(P[kb][8 * s + 2], P[kb][8 * s + 3]),
                        pk2(P[kb][8 * s + 4], P[kb][8 * s + 5]), pk2(P[kb][8 * s + 6], P[kb][8 * s + 7])};
            bf16x8 pb = __builtin_bit_cast(bf16x8, pw);
#pragma unroll
            for (int db = 0; db < 2; ++db) {
                const unsigned char* q = Vl + (db * 32 + r) * ROWB + (kb * 32 + 16 * s + 4 * h) * 2;
                s16x4 lo = *(const s16x4*)q, hi = *(const s16x4*)(q + 16);
                bf16x8 a = __builtin_shufflevector(lo, hi, 0, 1, 2, 3, 4, 5, 6, 7);
                O[db] = MFMA32(a, pb, O[db]);
            }
        }
}
DI void softmax_update(f32x16 (&X)[2], float& m, float& l, f32x16 (&O)[2]) {
    float mloc = -1e30f;
#pragma unroll
    for (int kb = 0; kb < 2; ++kb)
#pragma unroll
        for (int i = 0; i < 16; ++i) mloc = fmaxf(mloc, X[kb][i]);
    mloc = fmaxf(mloc, __shfl_xor(mloc, 32));
    const float mnew = fmaxf(m, mloc);
    const float alpha = __builtin_amdgcn_exp2f(m - mnew);
    m = mnew;
    float ls = 0.f;
#pragma unroll
    for (int kb = 0; kb < 2; ++kb)
#pragma unroll
        for (int i = 0; i < 16; ++i) {
            const float x = X[kb][i];
            const float pv = x > -1e29f ? __builtin_amdgcn_exp2f(x - mnew) : 0.f;
            X[kb][i] = pv; ls += pv;
        }
    l = l * alpha + ls;
#pragma unroll
    for (int db = 0; db < 2; ++db)
#pragma unroll
        for (int i = 0; i < 16; ++i) O[db][i] *= alpha;
}
DI void softmax_far(f32x16 (&X)[2], float cb, float& m, float& l, f32x16 (&O)[2]) {
    float mloc = -3e38f;
#pragma unroll
    for (int kb = 0; kb < 2; ++kb)
#pragma unroll
        for (int i = 0; i < 16; ++i) mloc = fmaxf(mloc, X[kb][i]);
    mloc += cb;
    mloc = fmaxf(mloc, __shfl_xor(mloc, 32));
    const float mnew = fmaxf(m, mloc);
    if (__any(mnew > m)) {
        const float alpha = __builtin_amdgcn_exp2f(m - mnew);
        m = mnew; l *= alpha;
#pragma unroll
        for (int db = 0; db < 2; ++db)
#pragma unroll
            for (int i = 0; i < 16; ++i) O[db][i] *= alpha;
    }
    const float mc = m - cb;
    f32x2 ls = {0.f, 0.f};
#pragma unroll
    for (int kb = 0; kb < 2; ++kb)
#pragma unroll
        for (int i = 0; i < 16; i += 2) {
            f32x2 pv = {__builtin_amdgcn_exp2f(X[kb][i] - mc), __builtin_amdgcn_exp2f(X[kb][i + 1] - mc)};
            X[kb][i] = pv.x; X[kb][i + 1] = pv.y; ls += pv;
        }
    l += ls.x + ls.y;
}
DI void build_bias_table(const Params& p, unsigned char* lds, int g) {
    const int* buck = (const int*)(p.ws + WS_BUCK);
    float* tb = (float*)(lds + AT_TB);
    for (int i = threadIdx.x; i < 1024; i += NTHREADS) {
        const int hl = i >> 8, d = i & 255;
        tb[i] = p.in[2][buck[d] * 8 + g * 4 + hl] * LOG2E;
    }
}

DI void win_unit(const Params& p, unsigned char* lds, int u) {
    unsigned char* ws = p.ws;
    const int tid = threadIdx.x, lane = tid & 63, wid = tid >> 6, r = lane & 31, h = lane >> 5;
    const int bg = u & 7, t32 = u >> 3, b = bg >> 1, g = bg & 1, t0 = t32 * 32;
    const int hl = r >> 3, t = t0 + wid * 8 + (r & 7);
    const bf16_t* Kg = (const bf16_t*)(ws + WS_KWIN) + (size_t)bg * SEQ * 64;
    const bf16_t* Vtg = (const bf16_t*)(ws + WS_VWINT) + (size_t)bg * 64 * SEQ;
    const bf16_t* Qg = (const bf16_t*)(ws + WS_Q) + ((size_t)(b * 8 + g * 4 + hl) * SEQ + t) * 64;
    __syncthreads();
    build_bias_table(p, lds, g);
    bf16x8 qf[4];
#pragma unroll
    for (int ks = 0; ks < 4; ++ks) qf[ks] = *(const bf16x8*)(Qg + ks * 16 + h * 8);
    const int jlo = t0 < 511 ? 0 : ((t0 - 511) >> 6), jhi = t0 >> 6;
    u32x4 st[4];
    attn_stage_load(Kg + (size_t)jlo * 64 * 64, Vtg + jlo * 64, st, tid);
    attn_stage_store(lds + AT_K0, lds + AT_V0, st, tid);
    __syncthreads();
    const float* tb = (const float*)(lds + AT_TB) + hl * 256;
    const int tmin = t0 + wid * 8;
    float m = -1e30f, l = 0.f;
    f32x16 O[2];
#pragma unroll
    for (int i = 0; i < 16; ++i) { O[0][i] = 0.f; O[1][i] = 0.f; }
    for (int j = jlo; j <= jhi; ++j) {
        const int cur = (j - jlo) & 1;
        if (j < jhi) attn_stage_load(Kg + (size_t)(j + 1) * 64 * 64, Vtg + (j + 1) * 64, st, tid);
        const unsigned char* Kl = lds + AT_K0 + cur * 9216;
        const unsigned char* Vl = lds + AT_V0 + cur * 9216;
        f32x16 X[2];
        attn_scores(Kl, qf, X, r, h);
        const bool far = (tmin - (j * 64 + 63) >= 128) && (tmin + 7 - j * 64 < 512);
        if (far) {
            softmax_far(X, tb[255], m, l, O);
        } else {
#pragma unroll
            for (int kb = 0; kb < 2; ++kb)
#pragma unroll
                for (int i = 0; i < 16; ++i) {
                    const int pos = j * 64 + kb * 32 + (i & 3) + 8 * (i >> 2) + 4 * h;
                    const int dist = t - pos;
                    const bool valid = dist >= 0 && dist < 512;
                    const int di = dist < 0 ? 0 : (dist > 255 ? 255 : dist);
                    X[kb][i] = valid ? X[kb][i] + tb[di] : -1e30f;
                }
            softmax_update(X, m, l, O);
        }
        attn_pv(Vl, X, O, r, h);
        if (j < jhi) attn_stage_store(lds + AT_K0 + (cur ^ 1) * 9216, lds + AT_V0 + (cur ^ 1) * 9216, st, tid);
        __syncthreads();
    }
    const float lt = l + __shfl_xor(l, 32);
    const size_t tok = (size_t)b * SEQ + t;
    const float gate = ((const float*)(ws + WS_GATES))[tok * 24 + 16 + g * 4 + hl];
    const float sc = gate / lt;
    bf16_t* ow = (bf16_t*)(ws + WS_OWIN) + tok * 512 + (g * 4 + hl) * 64;
#pragma unroll
    for (int db = 0; db < 2; ++db)
#pragma unroll
        for (int grp = 0; grp < 4; ++grp) {
            u32x2 o = {pk2(O[db][4 * grp] * sc, O[db][4 * grp + 1] * sc), pk2(O[db][4 * grp + 2] * sc, O[db][4 * grp + 3] * sc)};
            *(u32x2*)(ow + db * 32 + 8 * grp + 4 * h) = o;
        }
}

DI void cmp_stage(const float* __restrict__ kc, const float* __restrict__ vc, int ct, unsigned char* Kl, unsigned char* Vl, bool withv, int tid) {
    {
        const int c = tid >> 2, part = tid & 3;
        const f32x4* src = (const f32x4*)(kc + (size_t)(ct * 64 + c) * 64 + part * 16);
        f32x4 a = src[0], b2 = src[1], c2 = src[2], d2 = src[3];
        u32x4 o0 = {pk2(a.x, a.y), pk2(a.z, a.w), pk2(b2.x, b2.y), pk2(b2.z, b2.w)};
        u32x4 o1 = {pk2(c2.x, c2.y), pk2(c2.z, c2.w), pk2(d2.x, d2.y), pk2(d2.z, d2.w)};
        *(u32x4*)(Kl + c * ROWB + part * 32) = o0;
        *(u32x4*)(Kl + c * ROWB + part * 32 + 16) = o1;
    }
    if (withv) {
        const int c = tid & 63, dg = tid >> 6;
        const f32x4* src = (const f32x4*)(vc + (size_t)(ct * 64 + c) * 64 + dg * 16);
#pragma unroll
        for (int q4 = 0; q4 < 4; ++q4) {
            f32x4 a = src[q4];
            const int d = dg * 16 + q4 * 4;
            *(bf16_t*)(Vl + (d + 0) * ROWB + c * 2) = (bf16_t)f2bf(a.x);
            *(bf16_t*)(Vl + (d + 1) * ROWB + c * 2) = (bf16_t)f2bf(a.y);
            *(bf16_t*)(Vl + (d + 2) * ROWB + c * 2) = (bf16_t)f2bf(a.z);
            *(bf16_t*)(Vl + (d + 3) * ROWB + c * 2) = (bf16_t)f2bf(a.w);
        }
    }
}

DI void slc_unit(const Params& p, unsigned char* lds, int u) {
    unsigned char* ws = p.ws;
    const int tid = threadIdx.x, lane = tid & 63, wid = tid >> 6, r = lane & 31, h = lane >> 5;
    const int bg = u & 7, t32 = u >> 3, b = bg >> 1, g = bg & 1, t0 = t32 * 32;
    const int hl = r >> 3, tokl = r & 7, t = t0 + wid * 8 + tokl;
    const bf16_t* Kg = (const bf16_t*)(ws + WS_KSLC) + (size_t)bg * SEQ * 64;
    const bf16_t* Vtg = (const bf16_t*)(ws + WS_VSLCT) + (size_t)bg * 64 * SEQ;
    const bf16_t* Qg = (const bf16_t*)(ws + WS_Q) + ((size_t)(b * 8 + g * 4 + hl) * SEQ + t) * 64;
    const float* kcmp = (const float*)(ws + WS_KCMP) + (size_t)bg * 256 * 64;
    const float* vcmp = (const float*)(ws + WS_VCMP) + (size_t)bg * 256 * 64;
    __syncthreads();
    build_bias_table(p, lds, g);
    unsigned* imp = (unsigned*)(lds + AT_IMP) + wid * 512;
#pragma unroll
    for (int i = 0; i < 8; ++i) imp[i * 64 + lane] = 0u;
    bf16x8 qf[4];
#pragma unroll
    for (int ks = 0; ks < 4; ++ks) qf[ks] = *(const bf16x8*)(Qg + ks * 16 + h * 8);
    const float* tb = (const float*)(lds + AT_TB) + hl * 256;
    const int cmax = t0 >> 4;
    const int nct = (t0 + 31 >= 31) ? (cmax >> 6) + 1 : 0;
    float m = -1e30f, l = 0.f;
    f32x16 Oc[2];
#pragma unroll
    for (int i = 0; i < 16; ++i) { Oc[0][i] = 0.f; Oc[1][i] = 0.f; }
    for (int ct = 0; ct < nct; ++ct) {
        __syncthreads();
        cmp_stage(kcmp, vcmp, ct, lds + AT_K0, lds + AT_V0, false, tid);
        __syncthreads();
        f32x16 X[2];
        attn_scores(lds + AT_K0, qf, X, r, h);
#pragma unroll
        for (int kb = 0; kb < 2; ++kb)
#pragma unroll
            for (int i = 0; i < 16; ++i) {
                const int c = ct * 64 + kb * 32 + (i & 3) + 8 * (i >> 2) + 4 * h;
                const int dist = t - (16 * c + 31);
                const bool valid = dist >= 0 && c < 255;
                const int di = dist < 0 ? 0 : (dist > 255 ? 255 : dist);
                X[kb][i] = valid ? X[kb][i] + tb[di] : -1e30f;
            }
        f32x16 dummy[2];
#pragma unroll
        for (int i = 0; i < 16; ++i) { dummy[0][i] = 0.f; dummy[1][i] = 0.f; }
        softmax_update(X, m, l, dummy);
    }
    const float lt = l + __shfl_xor(l, 32);
    const float invl = lt > 0.f ? 1.0f / lt : 0.f;
    for (int ct = 0; ct < nct; ++ct) {
        __syncthreads();
        cmp_stage(kcmp, vcmp, ct, lds + AT_K0, lds + AT_V0, true, tid);
        __syncthreads();
        f32x16 X[2];
        attn_scores(lds + AT_K0, qf, X, r, h);
#pragma unroll
        for (int kb = 0; kb < 2; ++kb)
#pragma unroll
            for (int i = 0; i < 16; ++i) {
                const int c = ct * 64 + kb * 32 + (i & 3) + 8 * (i >> 2) + 4 * h;
                const int dist = t - (16 * c + 31);
                const bool valid = dist >= 0 && c < 255;
                const int di = dist < 0 ? 0 : (dist > 255 ? 255 : dist);
                X[kb][i] = valid ? __builtin_amdgcn_exp2f(X[kb][i] + tb[di] - m) * invl : 0.f;
            }
#pragma unroll
        for (int kb = 0; kb < 2; ++kb)
#pragma unroll
            for (int grp = 0; grp < 4; ++grp) {
                const float s4 = (X[kb][4 * grp] + X[kb][4 * grp + 1]) + (X[kb][4 * grp + 2] + X[kb][4 * grp + 3]);
                const int jj = ct * 16 + kb * 8 + 2 * grp + h;
                atomicAdd(&imp[tokl * 64 + jj], (unsigned)(s4 * 67108864.0f + 0.5f));
                if (jj + 1 < 64) atomicAdd(&imp[tokl * 64 + jj + 1], (unsigned)(X[kb][4 * grp + 3] * 67108864.0f + 0.5f));
            }
        attn_pv(lds + AT_V0, X, Oc, r, h);
    }
    unsigned long long* selm = (unsigned long long*)(lds + AT_SEL) + wid * 8;
    for (int tk = 0; tk < 8; ++tk) {
        const int tt = t0 + wid * 8 + tk, curb = tt >> 6;
        int v = (int)imp[tk * 64 + lane];
        if (lane == 0 || lane == curb || lane == curb - 1) v = 0x7fffffff;
        if (lane > curb) v = -1;
        int cnt = 0;
#pragma unroll
        for (int k = 0; k < 64; ++k) {
            const int vk = __builtin_amdgcn_readlane(v, k);
            cnt += (vk > v || (vk == v && k < lane)) ? 1 : 0;
        }
        const unsigned long long mk = __ballot(cnt < 16);
        if (lane == 0) selm[tk] = mk;
    }
    const unsigned long long mysel = selm[tokl];
    __syncthreads();
    const int jhi = t0 >> 6;
    u32x4 st[4];
    attn_stage_load(Kg, Vtg, st, tid);
    attn_stage_store(lds + AT_K0, lds + AT_V0, st, tid);
    __syncthreads();
    float m2 = -1e30f, l2 = 0.f;
    const int tmin = t0 + wid * 8;
    f32x16 O[2];
#pragma unroll
    for (int i = 0; i < 16; ++i) { O[0][i] = 0.f; O[1][i] = 0.f; }
    for (int j = 0; j <= jhi; ++j) {
        const int cur = j & 1;
        if (j < jhi) attn_stage_load(Kg + (size_t)(j + 1) * 64 * 64, Vtg + (j + 1) * 64, st, tid);
        const unsigned char* Kl = lds + AT_K0 + cur * 9216;
        const unsigned char* Vl = lds + AT_V0 + cur * 9216;
        f32x16 X[2];
        attn_scores(Kl, qf, X, r, h);
        const bool selj = (mysel >> j) & 1ull;
        if (tmin - (j * 64 + 63) >= 128) {
            softmax_far(X, selj ? tb[255] : -1e30f, m2, l2, O);
        } else {
#pragma unroll
            for (int kb = 0; kb < 2; ++kb)
#pragma unroll
                for (int i = 0; i < 16; ++i) {
                    const int pos = j * 64 + kb * 32 + (i & 3) + 8 * (i >> 2) + 4 * h;
                    const int dist = t - pos;
                    const bool valid = dist >= 0 && selj;
                    const int di = dist < 0 ? 0 : (dist > 255 ? 255 : dist);
                    X[kb][i] = valid ? X[kb][i] + tb[di] : -1e30f;
                }
            softmax_update(X, m2, l2, O);
        }
        attn_pv(Vl, X, O, r, h);
        if (j < jhi) attn_stage_store(lds + AT_K0 + (cur ^ 1) * 9216, lds + AT_V0 + (cur ^ 1) * 9216, st, tid);
        __syncthreads();
    }
    const float lt2 = l2 + __shfl_xor(l2, 32);
    const size_t tok = (size_t)b * SEQ + t;
    const float* gt = (const float*)(ws + WS_GATES) + tok * 24;
    const float gc = gt[g * 4 + hl], gs = gt[8 + g * 4 + hl] / lt2;
    const bf16_t* ow = (const bf16_t*)(ws + WS_OWIN) + tok * 512 + (g * 4 + hl) * 64;
    bf16_t* mx = (bf16_t*)(ws + WS_MIXIN) + tok * 1024 + (g * 4 + hl) * 64;
#pragma unroll
    for (int db = 0; db < 2; ++db)
#pragma unroll
        for (int grp = 0; grp < 4; ++grp) {
            const int d = db * 32 + 8 * grp + 4 * h;
            const u32x2 w = *(const u32x2*)(ow + d);
            const float r0 = gc * Oc[db][4 * grp] + gs * O[db][4 * grp] + bflo(w.x);
            const float r1 = gc * Oc[db][4 * grp + 1] + gs * O[db][4 * grp + 1] + bfhi(w.x);
            const float r2 = gc * Oc[db][4 * grp + 2] + gs * O[db][4 * grp + 2] + bflo(w.y);
            const float r3 = gc * Oc[db][4 * grp + 3] + gs * O[db][4 * grp + 3] + bfhi(w.y);
            u32x2 o = {pk2(r0, r1), pk2(r2, r3)};
            *(u32x2*)(mx + d) = o;
        }
}

DI void pooly_job(const Params& p, int job) {
    unsigned char* ws = p.ws;
    const bf16_t* z = (const bf16_t*)(ws + WS_Z);
    bf16_t* y = (bf16_t*)(ws + WS_YPOOL);
    const int tid = threadIdx.x;
    const int tokb = job * 16 + (tid >> 6) * 4, ch = tid & 63, tb = tokb & 4095;
    const int gi = ch >> 4, win = 2 << gi;
    u32x4 rowv[19];
#pragma unroll
    for (int i = 0; i < 19; ++i) {
        const int dt = i - 15;
        const bool need = dt > -win && tb + dt >= 0;
        rowv[i] = *(const u32x4*)(z + (size_t)(need ? tokb + dt : tokb) * 512 + ch * 8);
    }
    float f[19][8];
#pragma unroll
    for (int i = 0; i < 19; ++i) {
        f[i][0] = bflo(rowv[i].x); f[i][1] = bfhi(rowv[i].x); f[i][2] = bflo(rowv[i].y); f[i][3] = bfhi(rowv[i].y);
        f[i][4] = bflo(rowv[i].z); f[i][5] = bfhi(rowv[i].z); f[i][6] = bflo(rowv[i].w); f[i][7] = bfhi(rowv[i].w);
    }
#pragma unroll
    for (int o = 0; o < 4; ++o) {
        const int t = tb + o;
        const int cnt = (t + 1 < win) ? t + 1 : win;
        float s[8];
#pragma unroll
        for (int c = 0; c < 8; ++c) s[c] = 0.f;
#pragma unroll
        for (int k = 0; k < 16; ++k) {
            const float wk = k < cnt ? 1.0f : 0.0f;
#pragma unroll
            for (int c = 0; c < 8; ++c) s[c] += wk * f[15 + o - k][c];
        }
        const float ic = 1.0f / (float)cnt;
        u32x4 ov = {pk2(s[0] * ic - f[15 + o][0], s[1] * ic - f[15 + o][1]), pk2(s[2] * ic - f[15 + o][2], s[3] * ic - f[15 + o][3]),
                    pk2(s[4] * ic - f[15 + o][4], s[5] * ic - f[15 + o][5]), pk2(s[6] * ic - f[15 + o][6], s[7] * ic - f[15 + o][7])};
        *(u32x4*)(y + (size_t)(tokb + o) * 512 + ch * 8) = ov;
    }
}

DI void lnfold_consts(const Params& p, int n0, int cnt) {
    unsigned char* ws = p.ws;
    const int lane = threadIdx.x & 63, wid = threadIdx.x >> 6;
    const bf16_t* wqt = (const bf16_t*)(ws + WS_WQT);
    const float* wq = p.in[14];
    const float* bb = p.in[13];
    for (int n = n0 + wid; n < n0 + cnt; n += 4) {
        float s1 = 0.f, s2 = 0.f;
#pragma unroll
        for (int j = 0; j < 2; ++j) {
            const u32x4 w = *(const u32x4*)(wqt + (size_t)n * 1024 + (j * 64 + lane) * 8);
            s1 += (bflo(w.x) + bfhi(w.x)) + (bflo(w.y) + bfhi(w.y)) + (bflo(w.z) + bfhi(w.z)) + (bflo(w.w) + bfhi(w.w));
        }
#pragma unroll 8
        for (int k = lane; k < 1024; k += 64) s2 += bb[k] * wq[(size_t)k * 2048 + n];
        s1 = wave_sum(s1); s2 = wave_sum(s2);
        if (lane == 0) { ((float*)(ws + WS_C1))[n] = s1; ((float*)(ws + WS_C2))[n] = s2; }
    }
}

DI void phase2(const Params& p, unsigned char* lds) {
    const int G = gridDim.x, bx = blockIdx.x;
    if (G == 512) {
        if (bx < 128) { compress_job(p, lds, bx); win_unit(p, lds, 768 + bx); }
        else {
            win_unit(p, lds, bx - 128); win_unit(p, lds, 384 + bx - 128);
            if (bx < 256) win_unit(p, lds, 896 + bx - 128);
            else lnfold_consts(p, (bx - 256) * 8, 8);
        }
    } else {
        for (int job = bx; job < 128; job += G) compress_job(p, lds, job);
        for (int job = bx; job < 1024; job += G) win_unit(p, lds, job);
        for (int n0 = bx * 8; n0 < 2048; n0 += G * 8) lnfold_consts(p, n0, 8);
    }
    for (int job = bx; job < 1024; job += G) pooly_job(p, job);
}

DI void pool_gemm_tile(const Params& p, unsigned char* lds, int tile) {
    unsigned char* ws = p.ws;
    const int gi = tile & 3, tm = tile >> 2;
    f32x16 acc[2][2];
    __syncthreads();
    gemm_mainloop((const bf16_t*)(ws + WS_YPOOL) + (size_t)tm * 128 * 512 + gi * 128, 512,
                  (const bf16_t*)(ws + WS_POOLWT) + (size_t)gi * 16384, 128, 128, acc, lds);
    const float* sc = p.in[10] + gi * 128;
    bf16_t* mx = (bf16_t*)(ws + WS_MIXIN);
    epi_stage_rows(acc, lds, [&](int n) { return *(const f32x4*)(sc + n); });
    __syncthreads();
    rows_foreach(lds, [&](int m, int cc, u32x4 d) {
        *(u32x4*)(mx + (size_t)(tm * 128 + m) * 1024 + 512 + gi * 128 + cc * 8) = d;
    });
}

DI void phase3(const Params& p, unsigned char* lds) {
    const int G = gridDim.x, bx = blockIdx.x;
    for (int pass = 0; pass * G < 1024; ++pass) {
        const int i = pass * G + ((pass & 1) ? (G - 1 - bx) : bx);
        if (i < 1024) {
            const int u = ((127 - (i >> 3)) << 3) | (i & 7);
            slc_unit(p, lds, u);
        }
    }
    for (int tile = bx; tile < 512; tile += G) pool_gemm_tile(p, lds, tile);
}

DI void phase4(const Params& p, unsigned char* lds) {
    unsigned char* ws = p.ws;
    const float* x = p.in[0];
    bf16_t* y1 = (bf16_t*)(ws + WS_Z);
    const bool conv_first = (blockIdx.x >> 3) & 1;
    if (conv_first) convert_tables(p);
    const int G8 = (gridDim.x & 7) == 0 ? gridDim.x >> 3 : 0;
    for (int l0 = G8 ? 0 : (int)blockIdx.x; l0 < (G8 ? 128 : 1024); l0 += (G8 ? G8 : (int)gridDim.x)) {
        const int li = G8 ? l0 + cu_pair_pos((int)(blockIdx.x >> 3), G8) : l0;
        if (G8 && li >= 128) break;
        const int tile = G8 ? (int)(blockIdx.x & 7) * 128 + li : li;
        const int tn = tile & 7, tm = tile >> 3;
        f32x16 acc[2][2];
        gemm_mainloop((const bf16_t*)(ws + WS_MIXIN) + (size_t)tm * 128 * 1024, 1024,
                      (const bf16_t*)(ws + WS_WOUTT) + (size_t)tn * 128 * 1024, 1024, 1024, acc, lds);
        epi_stage_rows(acc, lds, [&](int) { return (f32x4){1.f, 1.f, 1.f, 1.f}; });
        __syncthreads();
        rows_foreach(lds, [&](int m, int cc, u32x4 d) {
            const size_t off = (size_t)(tm * 128 + m) * 1024 + tn * 128 + cc * 8;
            const f32x4 xa = *(const f32x4*)(x + off), xb = *(const f32x4*)(x + off + 4);
            u32x4 o = {pk2(ALPHA * xa.x + bflo(d.x), ALPHA * xa.y + bfhi(d.x)), pk2(ALPHA * xa.z + bflo(d.y), ALPHA * xa.w + bfhi(d.y)),
                       pk2(ALPHA * xb.x + bflo(d.z), ALPHA * xb.y + bfhi(d.z)), pk2(ALPHA * xb.z + bflo(d.w), ALPHA * xb.w + bfhi(d.w))};
            *(u32x4*)(y1 + off) = o;
            float s = ((bflo(o.x) + bfhi(o.x)) + (bflo(o.y) + bfhi(o.y))) + ((bflo(o.z) + bfhi(o.z)) + (bflo(o.w) + bfhi(o.w)));
            float q = ((bflo(o.x) * bflo(o.x) + bfhi(o.x) * bfhi(o.x)) + (bflo(o.y) * bflo(o.y) + bfhi(o.y) * bfhi(o.y)))
                    + ((bflo(o.z) * bflo(o.z) + bfhi(o.z) * bfhi(o.z)) + (bflo(o.w) * bflo(o.w) + bfhi(o.w) * bfhi(o.w)));
#pragma unroll
            for (int sh = 1; sh < 16; sh <<= 1) { s += __shfl_xor(s, sh); q += __shfl_xor(q, sh); }
            if (cc == 0) *(f32x2*)((float*)(ws + WS_LNST) + (size_t)(tm * 128 + m) * 16 + tn * 2) = (f32x2){s, q};
        });
        __syncthreads();
    }
    if (!conv_first) convert_tables(p);
}

DI void ln1_stats(const unsigned char* ws, int row, float& mean, float& rstd) {
    const f32x4* st = (const f32x4*)((const float*)(ws + WS_LNST) + (size_t)row * 16);
    const f32x4 a = st[0], b = st[1], c = st[2], d = st[3];
    const float s = ((a.x + a.z) + (b.x + b.z)) + ((c.x + c.z) + (d.x + d.z));
    const float q = ((a.y + a.w) + (b.y + b.w)) + ((c.y + c.w) + (d.y + d.w));
    mean = s * (1.0f / 1024.0f);
    const float var = fmaxf(q * (1.0f / 1024.0f) - mean * mean, 0.f);
    rstd = rsqrtf(var + LN_EPS);
}

DI void phase5(const Params& p) {
    unsigned char* ws = p.ws;
    const int lane = threadIdx.x & 63, wid = threadIdx.x >> 6;
    const float* gg = p.in[12];
    const float* bb = p.in[13];
    bf16_t* h1 = (bf16_t*)(ws + WS_H1);
    for (int row = blockIdx.x * 4 + wid; row < NTOK; row += gridDim.x * 4) {
        const u32x2* xr = (const u32x2*)((const bf16_t*)(ws + WS_Z) + (size_t)row * 1024) + lane;
        f32x4 v[4];
        float s = 0.f;
#pragma unroll
        for (int j = 0; j < 4; ++j) { const u32x2 w = xr[64 * j]; v[j] = (f32x4){bflo(w.x), bfhi(w.x), bflo(w.y), bfhi(w.y)}; s += (v[j].x + v[j].y) + (v[j].z + v[j].w); }
        const float mean = wave_sum(s) * (1.0f / 1024.0f);
        float s2 = 0.f;
#pragma unroll
        for (int j = 0; j < 4; ++j) { v[j] = v[j] - mean; s2 += (v[j].x * v[j].x + v[j].y * v[j].y) + (v[j].z * v[j].z + v[j].w * v[j].w); }
        const float rstd = rsqrtf(wave_sum(s2) * (1.0f / 1024.0f) + LN_EPS);
#pragma unroll
        for (int j = 0; j < 4; ++j) {
            const f32x4 g4 = ((const f32x4*)gg)[lane + 64 * j], b4 = ((const f32x4*)bb)[lane + 64 * j];
            u32x2 o = {pk2(v[j].x * rstd * g4.x + b4.x, v[j].y * rstd * g4.y + b4.y), pk2(v[j].z * rstd * g4.z + b4.z, v[j].w * rstd * g4.w + b4.w)};
            *(u32x2*)(h1 + (size_t)row * 1024 + (lane + 64 * j) * 4) = o;
        }
    }
}


DI void ce_desc(int& a, int& b) { const int hi = a > b ? a : b, lo = a > b ? b : a; a = hi; b = lo; }
template <int K, int J> DI void bst(int (&a)[16]) {
#pragma unroll
    for (int i = 0; i < 16; ++i) { const int l = i ^ J; if (l > i) { if ((i & K) == 0) ce_desc(a[i], a[l]); else ce_desc(a[l], a[i]); } }
}
DI void sort16(int (&a)[16]) { bst<2, 1>(a); bst<4, 2>(a); bst<4, 1>(a); bst<8, 4>(a); bst<8, 2>(a); bst<8, 1>(a); bst<16, 8>(a); bst<16, 4>(a); bst<16, 2>(a); bst<16, 1>(a); }
DI void merge_top16(int (&a)[16], const int (&b)[16]) {
#pragma unroll
    for (int i = 0; i < 16; ++i) a[i] = a[i] > b[15 - i] ? a[i] : b[15 - i];
    bst<16, 8>(a); bst<16, 4>(a); bst<16, 2>(a); bst<16, 1>(a);
}

constexpr int cand_i(int c) { return c < 16 ? 0 : c < 24 ? 1 : c < 29 ? 2 : c < 33 ? 3 : c < 36 ? 4 : c < 38 ? 5 : c < 40 ? 6 : c < 42 ? 7 : c - 34; }
constexpr int cand_j(int c) { return c < 16 ? c : c < 24 ? c - 16 : c < 29 ? c - 24 : c < 33 ? c - 29 : c < 36 ? c - 33 : c < 38 ? c - 36 : c < 40 ? c - 38 : c < 42 ? c - 40 : 0; }
DI void cand_ij(int c, int& i, int& j) {
    if (c < 16) { i = 0; j = c; } else if (c < 24) { i = 1; j = c - 16; } else if (c < 29) { i = 2; j = c - 24; } else if (c < 33) { i = 3; j = c - 29; }
    else if (c < 36) { i = 4; j = c - 33; } else if (c < 38) { i = 5; j = c - 36; } else if (c < 40) { i = 6; j = c - 38; } else if (c < 42) { i = 7; j = c - 40; }
    else { i = c - 34; j = 0; }
}
DI float key_val6(int k) { int b = k & ~63; b ^= (b >> 31) & 0x7fffffff; return __int_as_float(b); }

DI void phase6(const Params& p, unsigned char* lds) {
    unsigned char* ws = p.ws;
    const int tid = threadIdx.x, lane = tid & 63, wid = tid >> 6, wr = wid >> 1, wc = wid & 1, r = lane & 31, h = lane >> 5;
    const bf16_t* h1 = (const bf16_t*)(ws + WS_Z);
    const bf16_t* wq = (const bf16_t*)(ws + WS_WQT);
    const bf16_t* sk = (const bf16_t*)(ws + WS_SUBK);
    const float* c1 = (const float*)(ws + WS_C1);
    const float* c2 = (const float*)(ws + WS_C2);
    int* routeE = (int*)(ws + WS_TOPK);
    float* routeG = (float*)(ws + WS_TOPK + 8 * MiB);
    int* L1s = (int*)(lds + 65536);
    const int G8 = (gridDim.x & 7) == 0 ? gridDim.x >> 3 : 0;
    for (int l0 = G8 ? 0 : (int)blockIdx.x; l0 < (G8 ? 128 : 1024); l0 += (G8 ? G8 : (int)gridDim.x)) {
        const int li = G8 ? l0 + cu_pair_pos((int)(blockIdx.x >> 3), G8) : l0;
        if (G8 && li >= 128) break;
        const int pair = G8 ? (int)(blockIdx.x & 7) * 128 + li : li;
        const int tm = pair >> 3, head = pair & 7;
        int ka[16], kb[16];
        float rmean[2], rrstd[2];
#pragma unroll
        for (int mi = 0; mi < 2; ++mi) ln1_stats(ws, tm * 128 + wr * 64 + mi * 32 + r, rmean[mi], rrstd[mi]);
        if (tid < 128) {
            const int kh = tid >> 6, wh = (tid >> 5) & 1, q4 = tid & 31;
            *(f32x4*)(lds + LDS_CST + kh * 1024 + wh * 512 + q4 * 16) = *(const f32x4*)((wh ? c2 : c1) + (head * 2 + kh) * 128 + q4 * 4);
        }
#pragma unroll 1
        for (int khalf = 0; khalf < 2; ++khalf) {
            const int tn = head * 2 + khalf;
            f32x16 acc[2][2];
            gemm_mainloop(h1 + (size_t)tm * 128 * 1024, 1024, wq + (size_t)tn * 128 * 1024, 1024, 1024, acc, lds);
            epi_foreach(acc, [&](int m, int n, f32x4 v) {
                const int mi = (m >> 5) & 1;
                const float mu = mi ? rmean[1] : rmean[0], rs = mi ? rrstd[1] : rrstd[0];
                const f32x4 k1 = *(const f32x4*)(lds + LDS_CST + khalf * 1024 + n * 4), k2 = *(const f32x4*)(lds + LDS_CST + khalf * 1024 + 512 + n * 4);
                u32x2 o = {pk2(rs * (v.x - mu * k1.x) + k2.x, rs * (v.y - mu * k1.y) + k2.y), pk2(rs * (v.z - mu * k1.z) + k2.z, rs * (v.w - mu * k1.w) + k2.w)};
                *(u32x2*)(lds + m * 272 + n * 2) = o;
            });
            __syncthreads();
            f32x16 a2[2][2];
#pragma unroll
            for (int mi = 0; mi < 2; ++mi)
#pragma unroll
                for (int ni = 0; ni < 2; ++ni)
#pragma unroll
                    for (int i = 0; i < 16; ++i) a2[mi][ni][i] = 0.f;
#pragma unroll
            for (int ks = 0; ks < 8; ++ks) {
                bf16x8 fa[2], fb[2];
#pragma unroll
                for (int mi = 0; mi < 2; ++mi) fa[mi] = *(const bf16x8*)(lds + (wr * 64 + mi * 32 + r) * 272 + ks * 32 + h * 16);
#pragma unroll
                for (int ni = 0; ni < 2; ++ni) fb[ni] = *(const bf16x8*)(sk + (size_t)(khalf * 128 + wc * 64 + ni * 32 + r) * 128 + ks * 16 + h * 8);
#pragma unroll
                for (int mi = 0; mi < 2; ++mi)
#pragma unroll
                    for (int ni = 0; ni < 2; ++ni) a2[mi][ni] = MFMA32(fb[ni], fa[mi], a2[mi][ni]);
            }
            __syncthreads();
#pragma unroll
            for (int mi = 0; mi < 2; ++mi) {
                int xa[16], xb[16];
#pragma unroll
                for (int i = 0; i < 16; ++i) {
                    const int n = wc * 64 + (i & 3) + 8 * (i >> 2) + 4 * h;
                    xa[i] = make_key(a2[mi][0][i], n); xb[i] = make_key(a2[mi][1][i], n + 32);
                }
                sort16(xa); sort16(xb); merge_top16(xa, xb);
#pragma unroll
                for (int i = 0; i < 16; ++i) xb[i] = __shfl_xor(xa[i], 32);
                merge_top16(xa, xb);
                if (h == 0) {
                    int* dst = (int*)lds + ((wr * 64 + mi * 32 + r) * 2 + wc) * 16;
#pragma unroll
                    for (int q4 = 0; q4 < 4; ++q4) { u32x4 o = {(unsigned)xa[4 * q4], (unsigned)xa[4 * q4 + 1], (unsigned)xa[4 * q4 + 2], (unsigned)xa[4 * q4 + 3]}; *(u32x4*)(dst + 4 * q4) = o; }
                }
            }
            __syncthreads();
            if (tid < 128) {
                const int* s0 = (const int*)lds + tid * 32;
#pragma unroll
                for (int q4 = 0; q4 < 4; ++q4) {
                    const u32x4 x = *(const u32x4*)(s0 + 4 * q4), y = *(const u32x4*)(s0 + 16 + 4 * q4);
                    ka[4 * q4] = (int)x.x; ka[4 * q4 + 1] = (int)x.y; ka[4 * q4 + 2] = (int)x.z; ka[4 * q4 + 3] = (int)x.w;
                    kb[4 * q4] = (int)y.x; kb[4 * q4 + 1] = (int)y.y; kb[4 * q4 + 2] = (int)y.z; kb[4 * q4 + 3] = (int)y.w;
                }
                merge_top16(ka, kb);
                if (khalf == 0) {
#pragma unroll
                    for (int q4 = 0; q4 < 4; ++q4) { u32x4 o = {(unsigned)ka[4 * q4], (unsigned)ka[4 * q4 + 1], (unsigned)ka[4 * q4 + 2], (unsigned)ka[4 * q4 + 3]}; *(u32x4*)(L1s + tid * 16 + 4 * q4) = o; }
                }
            }
            if (khalf == 0) __syncthreads();
        }
        if (tid < 128) {
            int* L2s = (int*)lds + tid * 32;
#pragma unroll
            for (int q4 = 0; q4 < 4; ++q4) { u32x4 o = {(unsigned)ka[4 * q4], (unsigned)ka[4 * q4 + 1], (unsigned)ka[4 * q4 + 2], (unsigned)ka[4 * q4 + 3]}; *(u32x4*)(L2s + 4 * q4) = o; }
            float v1[16], v2[16];
#pragma unroll
            for (int q4 = 0; q4 < 4; ++q4) {
                const u32x4 x = *(const u32x4*)(L1s + tid * 16 + 4 * q4);
                v1[4 * q4] = key_val((int)x.x); v1[4 * q4 + 1] = key_val((int)x.y); v1[4 * q4 + 2] = key_val((int)x.z); v1[4 * q4 + 3] = key_val((int)x.w);
            }
#pragma unroll
            for (int i = 0; i < 16; ++i) v2[i] = key_val(ka[i]);
            int g0[16], g1[16], g2[16], g3[16];
#pragma unroll
            for (int t = 0; t < 16; ++t) {
                { const float s = v1[cand_i(t)] + v2[cand_j(t)]; int b = __float_as_int(s); b ^= (b >> 31) & 0x7fffffff; g0[t] = (b & ~63) | (63 - t); }
                { const float s = v1[cand_i(16 + t)] + v2[cand_j(16 + t)]; int b = __float_as_int(s); b ^= (b >> 31) & 0x7fffffff; g1[t] = (b & ~63) | (63 - (16 + t)); }
                { const float s = v1[cand_i(32 + t)] + v2[cand_j(32 + t)]; int b = __float_as_int(s); b ^= (b >> 31) & 0x7fffffff; g2[t] = (b & ~63) | (63 - (32 + t)); }
                if (t < 2) { const float s = v1[cand_i(48 + t)] + v2[cand_j(48 + t)]; int b = __float_as_int(s); b ^= (b >> 31) & 0x7fffffff; g3[t] = (b & ~63) | (63 - (48 + t)); }
                else g3[t] = (int)0x80000000 + t;
            }
            sort16(g0); sort16(g1); sort16(g2); sort16(g3);
            merge_top16(g0, g1); merge_top16(g2, g3); merge_top16(g0, g2);
            const float smax = key_val6(g0[0]);
            float ex[16], den = 0.f;
#pragma unroll
            for (int t = 0; t < 16; ++t) { ex[t] = __expf(key_val6(g0[t]) - smax); den += ex[t]; }
            const float inv = 1.0f / den;
            const size_t ro = ((size_t)(tm * 128 + tid) * 8 + head) * 16;
#pragma unroll
            for (int q4 = 0; q4 < 4; ++q4) {
                int ee[4];
#pragma unroll
                for (int u = 0; u < 4; ++u) {
                    int ci, cj; cand_ij(63 - (g0[4 * q4 + u] & 63), ci, cj);
                    ee[u] = (L1s[tid * 16 + ci] & 127) * 128 + (L2s[cj] & 127);
                }
                u32x4 oe = {(unsigned)ee[0], (unsigned)ee[1], (unsigned)ee[2], (unsigned)ee[3]};
                f32x4 og = {ex[4 * q4] * inv, ex[4 * q4 + 1] * inv, ex[4 * q4 + 2] * inv, ex[4 * q4 + 3] * inv};
                *(u32x4*)(routeE + ro + 4 * q4) = oe;
                *(f32x4*)(routeG + ro + 4 * q4) = og;
            }
        }
        __syncthreads();
    }
}

constexpr int P7_NS = 32, P7_SH = 9;
constexpr int P7_WLDS = 6144;
DI void p7_loadrows(int b, int li, int l32, const LAS int* ent_e, const unsigned char* tab, u32x4 (&rows)[8][2]) {
    const u32x4 e0 = *(const LAS u32x4*)(ent_e + li * 128 + b), e1 = *(const LAS u32x4*)(ent_e + li * 128 + b + 4);
    const unsigned ee[8] = {e0.x, e0.y, e0.z, e0.w, e1.x, e1.y, e1.z, e1.w};
#pragma unroll
    for (int r = 0; r < 8; ++r) {
        const unsigned ob = ee[r] * 1024u + (unsigned)l32 * 16u;
        rows[r][0] = *(const u32x4*)(tab + ob);
        rows[r][1] = *(const u32x4*)(tab + ob + 512);
    }
}
DI float half32_sum(float v) { v += __shfl_xor(v, 1); v += __shfl_xor(v, 2); v += __shfl_xor(v, 4); v += __shfl_xor(v, 8); v += __shfl_xor(v, 16); return v; }

DI void p7_stepA(const u32x4 (&rows)[8][2], const unsigned (&hq)[2][4], float hscale, int b, int li, int l32, int lane, int myk,
                 LAS float* ent_w, const LAS float* ent_us) {
    int d[8];
#pragma unroll
    for (int r = 0; r < 8; ++r) {
        int a = 0;
#pragma unroll
        for (int c = 0; c < 2; ++c)
#pragma unroll
            for (int q = 0; q < 4; ++q) a = dot4i8(rows[r][c][q], hq[c][q], a);
        d[r] = a;
    }
    int r4[4], r2[2], r1;
    const bool b0 = lane & 1;
#pragma unroll
    for (int i = 0; i < 4; ++i) { const int snd = b0 ? d[i] : d[4 + i]; const int kp = b0 ? d[4 + i] : d[i]; r4[i] = kp + __shfl_xor(snd, 1); }
    const bool b1 = lane & 2;
#pragma unroll
    for (int i = 0; i < 2; ++i) { const int snd = b1 ? r4[i] : r4[2 + i]; const int kp = b1 ? r4[2 + i] : r4[i]; r2[i] = kp + __shfl_xor(snd, 2); }
    const bool b2 = lane & 4;
    { const int snd = b2 ? r2[0] : r2[1]; const int kp = b2 ? r2[1] : r2[0]; r1 = kp + __shfl_xor(snd, 4); }
    r1 += __shfl_xor(r1, 8); r1 += __shfl_xor(r1, 16);
    if (l32 < 8) { const int idx = li * 128 + b + myk; ent_w[idx] = ent_w[idx] * gelu_fast((float)r1 * (hscale * ent_us[idx])); }
}
DI void p7_stepB(const u32x4 (&rows)[8][2], f32x2 (&acc)[2][8], int b, int li, const LAS float* ent_w) {
    const f32x4 w0 = *(const LAS f32x4*)(ent_w + li * 128 + b), w1 = *(const LAS f32x4*)(ent_w + li * 128 + b + 4);
    const float ww[8] = {w0.x, w0.y, w0.z, w0.w, w1.x, w1.y, w1.z, w1.w};
#pragma unroll
    for (int r = 0; r < 8; ++r) {
        const f32x2 w2 = {ww[r], ww[r]};
#pragma unroll
        for (int c = 0; c < 2; ++c)
#pragma unroll
            for (int q = 0; q < 4; ++q) {
                const f32x2 lo = __builtin_amdgcn_cvt_pk_f32_fp8((int)rows[r][c][q], false);
                const f32x2 hi = __builtin_amdgcn_cvt_pk_f32_fp8((int)rows[r][c][q], true);
                acc[c][2 * q] += w2 * lo; acc[c][2 * q + 1] += w2 * hi;
            }
    }
}
DI void p7_loadrows6(int b, int li, int l32, const LAS int* ent_e, const unsigned char* tab, u32x4 (&ra)[8], u32x2 (&rb)[8]) {
    const u32x4 e0 = *(const LAS u32x4*)(ent_e + li * 128 + b), e1 = *(const LAS u32x4*)(ent_e + li * 128 + b + 4);
    const unsigned ee[8] = {e0.x, e0.y, e0.z, e0.w, e1.x, e1.y, e1.z, e1.w};
#pragma unroll
    for (int r = 0; r < 8; ++r) {
        const unsigned ob = ee[r] * 768u;
        ra[r] = *(const u32x4*)(tab + ob + (unsigned)l32 * 16u);
        rb[r] = *(const u32x2*)(tab + ob + 512u + (unsigned)l32 * 8u);
    }
}
DI void p7_stepB6(const u32x4 (&ra)[8], const u32x2 (&rb)[8], f32x2 (&acc)[2][8], int b, int li, const LAS float* ent_w) {
    const f32x4 w0 = *(const LAS f32x4*)(ent_w + li * 128 + b), w1 = *(const LAS f32x4*)(ent_w + li * 128 + b + 4);
    const float ww[8] = {w0.x, w0.y, w0.z, w0.w, w1.x, w1.y, w1.z, w1.w};
#pragma unroll
    for (int r = 0; r < 8; ++r) {
        const u32x6 pk = {ra[r].x, ra[r].y, ra[r].z, ra[r].w, rb[r].x, rb[r].y};
        const f32x32 d = __builtin_amdgcn_cvt_scalef32_pk32_f32_fp6(pk, 1.0f);
        const f32x2 w2 = {ww[r], ww[r]};
#pragma unroll
        for (int c = 0; c < 2; ++c)
#pragma unroll
            for (int i = 0; i < 8; ++i) acc[c][i] += w2 * (f32x2){d[c * 16 + 2 * i], d[c * 16 + 2 * i + 1]};
    }
}
constexpr int P7_GB = 32768;
DI void p7_load_h(const Params& p, const LAS unsigned char* gb, int tok, int l32, float (&hv)[32]) {
    const unsigned char* ws = p.ws;
    float mean, rstd;
    ln1_stats(ws, tok, mean, rstd);
    const bf16_t* y1 = (const bf16_t*)(ws + WS_Z) + (size_t)tok * 1024 + l32 * 16;
    const LAS float* gg = (const LAS float*)(gb + P7_GB) + l32 * 16;
    const LAS float* bb = gg + 1024;
#pragma unroll
    for (int c = 0; c < 2; ++c) {
        const u32x4 a = *(const u32x4*)(y1 + c * 512), b2 = *(const u32x4*)(y1 + c * 512 + 8);
        const unsigned hh[8] = {a.x, a.y, a.z, a.w, b2.x, b2.y, b2.z, b2.w};
#pragma unroll
        for (int i4 = 0; i4 < 4; ++i4) {
            const f32x4 g4 = *(const LAS f32x4*)(gg + c * 512 + i4 * 4), b4 = *(const LAS f32x4*)(bb + c * 512 + i4 * 4);
            hv[c * 16 + 4 * i4 + 0] = (bflo(hh[2 * i4]) - mean) * rstd * g4.x + b4.x;
            hv[c * 16 + 4 * i4 + 1] = (bfhi(hh[2 * i4]) - mean) * rstd * g4.y + b4.y;
            hv[c * 16 + 4 * i4 + 2] = (bflo(hh[2 * i4 + 1]) - mean) * rstd * g4.z + b4.z;
            hv[c * 16 + 4 * i4 + 3] = (bfhi(hh[2 * i4 + 1]) - mean) * rstd * g4.w + b4.w;
        }
    }
}
DI void p7_quant_h(const Params& p, const LAS unsigned char* gb, int tok, int l32, unsigned (&hq)[2][4], float& hscale) {
    float hv[32];
    p7_load_h(p, gb, tok, l32, hv);
    float am = 0.f;
#pragma unroll
    for (int i = 0; i < 32; ++i) am = fmaxf(am, fabsf(hv[i]));
    am = fmaxf(am, __shfl_xor(am, 1)); am = fmaxf(am, __shfl_xor(am, 2)); am = fmaxf(am, __shfl_xor(am, 4)); am = fmaxf(am, __shfl_xor(am, 8)); am = fmaxf(am, __shfl_xor(am, 16));
    const float hq_sc = am > 0.f ? 127.0f / am : 1.0f;
    hscale = am > 0.f ? am / 127.0f : 1.0f;
#pragma unroll
    for (int c = 0; c < 2; ++c)
#pragma unroll
        for (int q = 0; q < 4; ++q) {
            const int q0 = (int)rintf(hv[c * 16 + 4 * q] * hq_sc), q1 = (int)rintf(hv[c * 16 + 4 * q + 1] * hq_sc);
            const int q2 = (int)rintf(hv[c * 16 + 4 * q + 2] * hq_sc), q3 = (int)rintf(hv[c * 16 + 4 * q + 3] * hq_sc);
            hq[c][q] = (unsigned)(q0 & 255) | ((unsigned)(q1 & 255) << 8) | ((unsigned)(q2 & 255) << 16) | ((unsigned)(q3 & 255) << 24);
        }
}
DI void p7_finish(const Params& p, int tok, const float (&hv)[32], f32x2 (&acc)[2][8], int l32) {
    const size_t hbase = (size_t)tok * 1024 + l32 * 16;
    float sm = 0.f;
    {
#pragma unroll
        for (int c = 0; c < 2; ++c)
#pragma unroll
            for (int i = 0; i < 8; ++i) {
                acc[c][i].x += ALPHA * hv[c * 16 + 2 * i]; acc[c][i].y += ALPHA * hv[c * 16 + 2 * i + 1];
                sm += acc[c][i].x + acc[c][i].y;
            }
    }
    const float mean = half32_sum(sm) * (1.0f / 1024.0f);
    float sq = 0.f;
#pragma unroll
    for (int c = 0; c < 2; ++c)
#pragma unroll
        for (int i = 0; i < 8; ++i) { acc[c][i].x -= mean; acc[c][i].y -= mean; sq += acc[c][i].x * acc[c][i].x + acc[c][i].y * acc[c][i].y; }
    const float rstd = rsqrtf(half32_sum(sq) * (1.0f / 1024.0f) + LN_EPS);
    const float* gg = p.in[18] + l32 * 16;
    const float* bb = p.in[19] + l32 * 16;
    float* orow = p.out + hbase;
#pragma unroll
    for (int c = 0; c < 2; ++c)
#pragma unroll
        for (int q4 = 0; q4 < 4; ++q4) {
            const f32x4 g4 = *(const f32x4*)(gg + c * 512 + q4 * 4), b4 = *(const f32x4*)(bb + c * 512 + q4 * 4);
            f32x4 o = {acc[c][2 * q4].x * rstd * g4.x + b4.x, acc[c][2 * q4].y * rstd * g4.y + b4.y,
                       acc[c][2 * q4 + 1].x * rstd * g4.z + b4.z, acc[c][2 * q4 + 1].y * rstd * g4.w + b4.w};
            *(f32x4*)(orow + c * 512 + q4 * 4) = o;
        }
}

DI void phase7(const Params& p, unsigned char* lds) {
    unsigned char* ws = p.ws;
    const int lane = threadIdx.x & 63, wid = __builtin_amdgcn_readfirstlane(threadIdx.x >> 6);
    const int hw = lane >> 5, l32 = lane & 31;
    LAS unsigned char* l3 = (LAS unsigned char*)lds + wid * P7_WLDS;
    const unsigned char* u8 = ws + WS_UB;
    const unsigned char* v8 = ws + WS_VB;
    const float* uscale = (const float*)(ws + WS_USCALE);
    const float* vscale = (const float*)(ws + WS_VSCALE);
    LAS int* ent_e = (LAS int*)l3;
    LAS float* ent_w = (LAS float*)(l3 + 2048);
    LAS float* ent_us = (LAS float*)(l3 + 4096);
    {
        const int t = threadIdx.x;
        *(f32x4*)(lds + P7_GB + t * 16) = *(const f32x4*)(p.in[12] + t * 4);
        *(f32x4*)(lds + P7_GB + 4096 + t * 16) = *(const f32x4*)(p.in[13] + t * 4);
        __syncthreads();
    }
    const unsigned long long ltmask = (1ull << lane) - 1ull;
    const int myk = ((lane & 1) << 2) | (lane & 2) | ((lane >> 2) & 1);
    const int li0 = hw, li1 = 2 + hw;
    for (int rnd = blockIdx.x * 4 + wid; rnd < NTOK / 4; rnd += gridDim.x * 4) {
        const int tok0 = rnd * 4;
#pragma unroll 1
        for (int tk = 0; tk < 4; ++tk) {
            const int* RE = (const int*)(ws + WS_TOPK) + (size_t)(tok0 + tk) * 128;
            const float* RG = (const float*)(ws + WS_TOPK + 8 * MiB) + (size_t)(tok0 + tk) * 128;
            const int ea = RE[lane], eb = RE[64 + lane];
            const float ga = RG[lane], gb = RG[64 + lane];
            const int sa = ea >> P7_SH, sb = eb >> P7_SH;
            int pa = 0, pb = 0, run = 0;
#pragma unroll
            for (int s = 0; s < P7_NS; ++s) {
                const unsigned long long ma = __ballot(sa == s), mb = __ballot(sb == s);
                const int ca = __popcll(ma), cb = __popcll(mb);
                if (sa == s) pa = run + __popcll(ma & ltmask);
                if (sb == s) pb = run + ca + __popcll(mb & ltmask);
                run += ca + cb;
            }
            ent_e[tk * 128 + pa] = ea; ent_w[tk * 128 + pa] = ga * vscale[ea]; ent_us[tk * 128 + pa] = uscale[ea];
            ent_e[tk * 128 + pb] = eb; ent_w[tk * 128 + pb] = gb * vscale[eb]; ent_us[tk * 128 + pb] = uscale[eb];
        }
        {
            unsigned hq0[2][4], hq1[2][4];
            float hs0, hs1;
            p7_quant_h(p, (const LAS unsigned char*)lds, tok0 + li0, l32, hq0, hs0);
            p7_quant_h(p, (const LAS unsigned char*)lds, tok0 + li1, l32, hq1, hs1);
            u32x4 ra[8][2], rb[8][2];
            p7_loadrows(0, li0, l32, ent_e, u8, ra);
            for (int b = 0; b < 128; b += 8) {
                p7_loadrows(b, li1, l32, ent_e, u8, rb);
                __builtin_amdgcn_sched_barrier(0);
                p7_stepA(ra, hq0, hs0, b, li0, l32, lane, myk, ent_w, ent_us);
                __builtin_amdgcn_sched_barrier(0);
                p7_loadrows(b + 8 < 128 ? b + 8 : b, li0, l32, ent_e, u8, ra);
                __builtin_amdgcn_sched_barrier(0);
                p7_stepA(rb, hq1, hs1, b, li1, l32, lane, myk, ent_w, ent_us);
                __builtin_amdgcn_sched_barrier(0);
            }
        }
        f32x2 acc0[2][8], acc1[2][8];
#pragma unroll
        for (int c = 0; c < 2; ++c)
#pragma unroll
            for (int i = 0; i < 8; ++i) { acc0[c][i] = (f32x2){0.f, 0.f}; acc1[c][i] = (f32x2){0.f, 0.f}; }
        {
            u32x4 ra[8], rb[8];
            u32x2 ra2[8], rb2[8];
            p7_loadrows6(0, li0, l32, ent_e, v8, ra, ra2);
            for (int b = 0; b < 128; b += 8) {
                p7_loadrows6(b, li1, l32, ent_e, v8, rb, rb2);
                __builtin_amdgcn_sched_barrier(0);
                p7_stepB6(ra, ra2, acc0, b, li0, ent_w);
                __builtin_amdgcn_sched_barrier(0);
                p7_loadrows6(b + 8 < 128 ? b + 8 : b, li0, l32, ent_e, v8, ra, ra2);
                __builtin_amdgcn_sched_barrier(0);
                p7_stepB6(rb, rb2, acc1, b, li1, ent_w);
                __builtin_amdgcn_sched_barrier(0);
            }
        }
        {
            float hv0[32], hv1[32];
            p7_load_h(p, (const LAS unsigned char*)lds, tok0 + li0, l32, hv0);
            p7_load_h(p, (const LAS unsigned char*)lds, tok0 + li1, l32, hv1);
            p7_finish(p, tok0 + li0, hv0, acc0, l32);
            p7_finish(p, tok0 + li1, hv1, acc1, l32);
        }
    }
}

#if DIAG
DI float bfv(const bf16_t* p, size_t i) { return __uint_as_float(((unsigned)p[i]) << 16); }
DI float bfr(float x) { return __uint_as_float(f2bf(x) << 16); }
DI void dfail(const Params& p, int bit) { atomicOr((unsigned*)(p.ws + WS_FLAG), 1u << bit); }
DI bool bad(float fast, float ref) { return !(fabsf(fast - ref) <= 0.02f * fabsf(ref) + 0.02f); }
DI unsigned hsh(unsigned x) { x ^= x >> 16; x *= 0x7feb352dU; x ^= x >> 15; x *= 0x846ca68bU; x ^= x >> 16; return x; }
DI int winsrc(int n) { return n < 1280 ? n : (n < 1792 ? 1304 + (n - 1280) : 1280 + (n - 1792)); }

DI void chk1(const Params& p, int bit) {
    unsigned char* ws = p.ws;
    const unsigned gt = blockIdx.x * NTHREADS + threadIdx.x;
    const int tok = hsh(gt * 2 + 1) & 16383, n = hsh(gt * 2 + 2) % 1816;
    const bf16_t* xb = (const bf16_t*)(ws + WS_XB);
    const bf16_t* wt = (const bf16_t*)(ws + WS_WINT);
    float ref = 0.f, ref2 = 0.f;
    for (int k = 0; k < 1024; ++k) {
        ref += bfv(xb, (size_t)tok * 1024 + k) * bfv(wt, (size_t)n * 1024 + k);
        ref2 += p.in[0][(size_t)tok * 1024 + k] * p.in[1][(size_t)k * 1816 + winsrc(n)];
    }
    if (!(fabsf(ref - ref2) <= 0.06f)) dfail(p, bit);
    const int b = tok >> 12, t = tok & 4095;
    float fast;
    if (n < 512) { const int hd = n >> 6, d = n & 63; fast = bfv((const bf16_t*)(ws + WS_Q), ((size_t)(b * 8 + hd) * SEQ + t) * 64 + d); ref *= 0.125f; }
    else if (n < 1280) {
        const int seg = (n - 512) >> 7, nn = (n - 512) & 127, g = nn >> 6, d = nn & 63;
        if (seg == 3 || seg == 5) fast = bfv((const bf16_t*)(ws + (seg == 3 ? WS_VSLCT : WS_VWINT)), ((size_t)((b * 2 + g) * 64 + d)) * SEQ + t);
        else fast = bfv((const bf16_t*)(ws + (seg == 0 ? WS_KC : seg == 1 ? WS_VC : seg == 2 ? WS_KSLC : WS_KWIN)), ((size_t)(b * 2 + g) * SEQ + t) * 64 + d);
    } else if (n < 1792) fast = bfv((const bf16_t*)(ws + WS_Z), (size_t)tok * 512 + (n - 1280));
    else { fast = ((const float*)(ws + WS_GATES))[(size_t)tok * 24 + (n - 1792)]; ref = 1.f / (1.f + expf(-ref)); }
    if (bad(fast, ref)) dfail(p, bit);
}
DI void chk2(const Params& p, int bit) {
    unsigned char* ws = p.ws;
    const unsigned gt = blockIdx.x * NTHREADS + threadIdx.x;
    if (gt >= 2048) return;
    const int kv = gt & 1, bg = (gt >> 1) & 7, c = hsh(gt) % 255, d = hsh(gt + 7777) & 63;
    const bf16_t* A = (const bf16_t*)(ws + (kv ? WS_VC : WS_KC)) + ((size_t)bg * SEQ + c * 16) * 64;
    const bf16_t* w1t = (const bf16_t*)(ws + (kv ? WS_W1TV : WS_W1TK));
    const bf16_t* w2t = (const bf16_t*)(ws + (kv ? WS_W2TV : WS_W2TK));
    const float* peb = (const float*)(ws + (kv ? WS_PEBV : WS_PEBK));
    float out = 0.f;
    for (int j = 0; j < 256; ++j) {
        float s = peb[j];
        for (int i = 0; i < 2048; ++i) s += bfv(A, i) * bfv(w1t, (size_t)j * 2048 + i);
        out += bfr(gelu_erf(s)) * bfv(w2t, d * 256 + j);
    }
    const float fast = ((const float*)(ws + (kv ? WS_VCMP : WS_KCMP)))[((size_t)bg * 256 + c) * 64 + d];
    if (bad(fast, out)) dfail(p, bit);
    if (gt < 256) {
        const float* w1 = kv ? p.in[7] : p.in[5];
        const float* w2 = kv ? p.in[8] : p.in[6];
        const float* pe = kv ? p.in[4] : p.in[3];
        float o2 = 0.f;
        for (int j = 0; j < 256; ++j) {
            float s = 0.f;
            for (int i = 0; i < 2048; ++i) s += (bfv(A, i) + pe[i]) * w1[(size_t)i * 256 + j];
            o2 += gelu_erf(s) * w2[j * 64 + d];
        }
        if (!(fabsf(o2 - out) <= 0.03f * fabsf(out) + 0.03f)) dfail(p, bit);
    }
}
DI void chk3(const Params& p, int bit) {
    unsigned char* ws = p.ws;
    const unsigned gt = blockIdx.x * NTHREADS + threadIdx.x;
    if (gt >= 4096) return;
    const int tok = hsh(gt) & 16383, head = hsh(gt + 99) & 7, b = tok >> 12, t = tok & 4095, g = head >> 2;
    const bf16_t* Q = (const bf16_t*)(ws + WS_Q) + ((size_t)(b * 8 + head) * SEQ + t) * 64;
    const bf16_t* K = (const bf16_t*)(ws + WS_KWIN) + (size_t)(b * 2 + g) * SEQ * 64;
    const bf16_t* Vt = (const bf16_t*)(ws + WS_VWINT) + (size_t)(b * 2 + g) * 64 * SEQ;
    float q[64], o[64];
#pragma unroll
    for (int d = 0; d < 64; ++d) { q[d] = bfv(Q, d); o[d] = 0.f; }
    float m = -1e30f, l = 0.f;
    for (int pos = (t > 511 ? t - 511 : 0); pos <= t; ++pos) {
        float s = 0.f;
#pragma unroll
        for (int d = 0; d < 64; ++d) s += q[d] * bfv(K, (size_t)pos * 64 + d);
        s += p.in[2][rel_bucket_dev(t - pos) * 8 + head];
        const float mn = fmaxf(m, s), a = expf(m - mn), pp = expf(s - mn);
        l = l * a + pp;
#pragma unroll
        for (int d = 0; d < 64; ++d) o[d] = o[d] * a + pp * bfv(Vt, (size_t)d * SEQ + pos);
        m = mn;
    }
    const float gate = ((const float*)(ws + WS_GATES))[(size_t)tok * 24 + 16 + head];
    bool f = false;
#pragma unroll
    for (int d = 0; d < 64; ++d) f |= bad(bfv((const bf16_t*)(ws + WS_OWIN), (size_t)tok * 512 + head * 64 + d), o[d] / l * gate);
    if (f) dfail(p, bit);
}
DI void chk4(const Params& p, int bit) {
    unsigned char* ws = p.ws;
    const unsigned gt = blockIdx.x * NTHREADS + threadIdx.x;
    if (gt >= 512) return;
    const int tok = hsh(gt + 5) & 16383, g = gt & 1, b = tok >> 12, t = tok & 4095, bg = b * 2 + g;
    float* scr = (float*)(ws + WS_DSCR) + (size_t)gt * 1536;
    float* imp = scr + 1024;
    float* nsa = scr + 1100;
    for (int j = 0; j < 64; ++j) imp[j] = 0.f;
    const float* kc = (const float*)(ws + WS_KCMP) + (size_t)bg * 256 * 64;
    const float* vc = (const float*)(ws + WS_VCMP) + (size_t)bg * 256 * 64;
    const float* gt24 = (const float*)(ws + WS_GATES) + (size_t)tok * 24;
    for (int hl = 0; hl < 4; ++hl) {
        const int head = g * 4 + hl;
        const bf16_t* Q = (const bf16_t*)(ws + WS_Q) + ((size_t)(b * 8 + head) * SEQ + t) * 64;
        float q[64], o[64];
#pragma unroll
        for (int d = 0; d < 64; ++d) { q[d] = bfv(Q, d); o[d] = 0.f; }
        float m = -1e30f;
        for (int c = 0; c < 255; ++c) {
            const bool valid = 16 * c + 31 <= t;
            float s = 0.f;
#pragma unroll
            for (int d = 0; d < 64; ++d) s += q[d] * bfr(kc[c * 64 + d]);
            s += p.in[2][rel_bucket_dev(t - 16 * c - 31) * 8 + head];
            scr[hl * 256 + c] = s;
            if (valid) m = fmaxf(m, s);
        }
        float l = 0.f;
        for (int c = 0; c < 255; ++c) if (16 * c + 31 <= t) l += expf(scr[hl * 256 + c] - m);
        for (int c = 0; c < 255; ++c) if (16 * c + 31 <= t) {
            const float pc = expf(scr[hl * 256 + c] - m) / l;
            imp[c >> 2] += pc;
            if ((c & 3) == 3 && (c >> 2) + 1 < 64) imp[(c >> 2) + 1] += pc;
#pragma unroll
            for (int d = 0; d < 64; ++d) o[d] += bfr(pc) * bfr(vc[c * 64 + d]);
        }
#pragma unroll
        for (int d = 0; d < 64; ++d) nsa[hl * 64 + d] = gt24[head] * o[d];
    }
    const int cur = t >> 6;
    for (int j = 0; j < 64; ++j) { float v = imp[j]; if (j == 0 || j == cur || j == cur - 1) v = 1e6f; if (j > cur) v = -1e30f; imp[j] = v; }
    unsigned long long selmask = 0ull;
    for (int it = 0; it < 16; ++it) {
        int bi = -1; float bv = -3e38f;
        for (int j = 0; j < 64; ++j) if (!((selmask >> j) & 1ull) && imp[j] > bv) { bv = imp[j]; bi = j; }
        selmask |= 1ull << bi;
    }
    bool f = false;
    for (int hl = 0; hl < 4; ++hl) {
        const int head = g * 4 + hl;
        const bf16_t* Q = (const bf16_t*)(ws + WS_Q) + ((size_t)(b * 8 + head) * SEQ + t) * 64;
        const bf16_t* K = (const bf16_t*)(ws + WS_KSLC) + (size_t)bg * SEQ * 64;
        const bf16_t* Vt = (const bf16_t*)(ws + WS_VSLCT) + (size_t)bg * 64 * SEQ;
        float q[64], o[64];
#pragma unroll
        for (int d = 0; d < 64; ++d) { q[d] = bfv(Q, d); o[d] = 0.f; }
        float m = -1e30f, l = 0.f;
        for (int j = 0; j <= cur; ++j) if ((selmask >> j) & 1ull) {
            for (int kk = 0; kk < 64; ++kk) {
                const int pos = j * 64 + kk;
                if (pos > t) break;
                float s = 0.f;
#pragma unroll
                for (int d = 0; d < 64; ++d) s += q[d] * bfv(K, (size_t)pos * 64 + d);
                s += p.in[2][rel_bucket_dev(t - pos) * 8 + head];
                const float mn = fmaxf(m, s), a = expf(m - mn), pp = expf(s - mn);
                l = l * a + pp;
#pragma unroll
                for (int d = 0; d < 64; ++d) o[d] = o[d] * a + pp * bfv(Vt, (size_t)d * SEQ + pos);
                m = mn;
            }
        }
#pragma unroll
        for (int d = 0; d < 64; ++d) {
            const float ref = nsa[hl * 64 + d] + gt24[8 + head] * o[d] / l + bfv((const bf16_t*)(ws + WS_OWIN), (size_t)tok * 512 + head * 64 + d);
            f |= bad(bfv((const bf16_t*)(ws + WS_MIXIN), (size_t)tok * 1024 + head * 64 + d), ref);
        }
    }
    if (f) dfail(p, bit);
}
DI void chk5(const Params& p, int bit) {
    unsigned char* ws = p.ws;
    const unsigned gt = blockIdx.x * NTHREADS + threadIdx.x;
    if (gt >= 8192) return;
    const int tok = hsh(gt + 11) & 16383, col = hsh(gt + 13) & 511, gi = col >> 7, d = col & 127, t = tok & 4095;
    const bf16_t* yp = (const bf16_t*)(ws + WS_YPOOL);
    const bf16_t* pw = (const bf16_t*)(ws + WS_POOLWT);
    const bf16_t* z = (const bf16_t*)(ws + WS_Z);
    float ref = 0.f, ref2 = 0.f;
    for (int c = 0; c < 128; ++c) {
        ref += bfv(yp, (size_t)tok * 512 + gi * 128 + c) * bfv(pw, (size_t)gi * 16384 + d * 128 + c);
        ref2 += bfv(yp, (size_t)tok * 512 + gi * 128 + c) * p.in[9][(size_t)gi * 16384 + c * 128 + d];
    }
    if (!(fabsf(ref - ref2) <= 0.03f)) dfail(p, bit);
    ref *= p.in[10][col];
    if (bad(bfv((const bf16_t*)(ws + WS_MIXIN), (size_t)tok * 1024 + 512 + col), ref)) dfail(p, bit);
    const int win = 2 << (col >> 7), cnt = (t + 1 < win) ? t + 1 : win;
    float s = 0.f;
    for (int k = 0; k < cnt; ++k) s += bfv(z, (size_t)(tok - k) * 512 + col);
    if (bad(bfv(yp, (size_t)tok * 512 + col), s / (float)cnt - bfv(z, (size_t)tok * 512 + col))) dfail(p, bit);
}
DI void chk6(const Params& p, int bit) {
    unsigned char* ws = p.ws;
    const unsigned gt = blockIdx.x * NTHREADS + threadIdx.x;
    if (gt >= 128) return;
    const int tok = hsh(gt + 17) & 16383;
    float* yb = (float*)(ws + WS_DSCR) + (size_t)gt * 1024;
    const bf16_t* mx = (const bf16_t*)(ws + WS_MIXIN) + (size_t)tok * 1024;
    const bf16_t* wo = (const bf16_t*)(ws + WS_WOUTT);
    float sm = 0.f;
    bool f = false;
    for (int n = 0; n < 1024; ++n) {
        float s = 0.f, s2 = 0.f;
        for (int k = 0; k < 1024; ++k) { s += bfv(mx, k) * bfv(wo, (size_t)n * 1024 + k); if (n < 8) s2 += bfv(mx, k) * p.in[11][(size_t)k * 1024 + n]; }
        if (n < 8 && !(fabsf(s - s2) <= 0.03f)) f = true;
        yb[n] = ALPHA * p.in[0][(size_t)tok * 1024 + n] + s; sm += yb[n];
    }
    const float mean = sm / 1024.f;
    float v = 0.f;
    for (int n = 0; n < 1024; ++n) v += (yb[n] - mean) * (yb[n] - mean);
    const float rstd = 1.f / sqrtf(v / 1024.f + LN_EPS);
    for (int n = 0; n < 1024; ++n)
        f |= bad(bfv((const bf16_t*)(ws + WS_H1), (size_t)tok * 1024 + n), (yb[n] - mean) * rstd * p.in[12][n] + p.in[13][n]);
    if (f) dfail(p, bit);
}
DI void chk7(const Params& p, int bit) {
    unsigned char* ws = p.ws;
    const unsigned gt = blockIdx.x * NTHREADS + threadIdx.x;
    if (gt >= 512) return;
    const int tok = hsh(gt + 23) & 16383, head = gt & 7, half = (gt >> 3) & 1;
    float* qd = (float*)(ws + WS_DSCR) + (size_t)gt * 256;
    float* sv = qd + 128;
    const bf16_t* h1 = (const bf16_t*)(ws + WS_H1) + (size_t)tok * 1024;
    const bf16_t* wq = (const bf16_t*)(ws + WS_WQT);
    const bf16_t* sk = (const bf16_t*)(ws + WS_SUBK);
    bool f = false;
    for (int d = 0; d < 128; ++d) {
        float s = 0.f, s2 = 0.f;
        const int col = head * 256 + half * 128 + d;
        for (int k = 0; k < 1024; ++k) { s += bfv(h1, k) * bfv(wq, (size_t)col * 1024 + k); if (d < 4) s2 += bfv(h1, k) * p.in[14][(size_t)k * 2048 + col]; }
        if (d < 4 && !(fabsf(s - s2) <= 0.06f)) f = true;
        qd[d] = bfr(s);
    }
    for (int key = 0; key < 128; ++key) {
        float s = 0.f, s2 = 0.f;
        for (int d = 0; d < 128; ++d) { s += qd[d] * bfv(sk, (size_t)(half * 128 + key) * 128 + d); s2 += qd[d] * p.in[15][(size_t)(half * 128 + key) * 128 + d]; }
        if (!(fabsf(s - s2) <= 0.05f)) f = true;
        sv[key] = s;
    }
    int mism = 0;
    const int* L = (const int*)(ws + WS_TOPK) + (((size_t)tok * 8 + head) * 2 + half) * 16;
    for (int it = 0; it < 16; ++it) {
        int bi = 0; float bv = -3e38f;
        for (int k = 0; k < 128; ++k) if (sv[k] > bv) { bv = sv[k]; bi = k; }
        sv[bi] = -3e38f;
        const int fk = L[it];
        if ((fk & 127) != bi) mism++;
        if (bad(key_val(fk), bv)) mism += 10;
    }
    if (mism > 1 || f) dfail(p, bit);
}
DI void chk8(const Params& p, int bit) {
    unsigned char* ws = p.ws;
    const unsigned gt = blockIdx.x * NTHREADS + threadIdx.x;
    if (gt >= 128) return;
    const int tok = hsh(gt + 31) & 16383;
    float* acc = (float*)(ws + WS_DSCR) + (size_t)gt * 4096;
    float* cand = acc + 1024;
    int* csel = (int*)(acc + 1024 + 256);
    float* acc2 = acc + 2048;
    const bf16_t* h1 = (const bf16_t*)(ws + WS_H1) + (size_t)tok * 1024;
    const bf16_t* ub = (const bf16_t*)(ws + WS_UB);
    const bf16_t* vb = (const bf16_t*)(ws + WS_VB);
    const int* dE = (const int*)(ws + WS_MIXIN) + (size_t)tok * 256;
    const float* dG = (const float*)dE + 128;
    bool f = false, froute = false, fg = false;
    for (int n = 0; n < 1024; ++n) { acc[n] = 0.f; acc2[n] = 0.f; }
    for (int hd = 0; hd < 8; ++hd) {
        const int* L = (const int*)(ws + WS_TOPK) + (size_t)tok * 256 + hd * 32;
        for (int i = 0; i < 16; ++i) for (int j = 0; j < 16; ++j) cand[i * 16 + j] = key_val(L[i]) + key_val(L[16 + j]);
        float mx = -3e38f, den = 0.f;
        for (int it = 0; it < 16; ++it) {
            int bi = 0; float bv = -3e38f;
            for (int k = 0; k < 256; ++k) if (cand[k] > bv) { bv = cand[k]; bi = k; }
            cand[bi] = -3e38f; csel[it] = bi;
            if (it == 0) mx = bv;
            ((float*)csel)[16 + it] = expf(bv - mx); den += expf(bv - mx);
        }
        for (int it = 0; it < 16; ++it) {
            const int i = csel[it] >> 4, j = csel[it] & 15;
            const size_t e = (size_t)(L[i] & 127) * 128 + (L[16 + j] & 127);
            float dot = 0.f;
            for (int k = 0; k < 1024; ++k) dot += bfv(h1, k) * bfv(ub, e * 1024 + k);
            const float gate = ((float*)csel)[16 + it] / den;
            const float w = gate * gelu_erf(dot);
            for (int n = 0; n < 1024; ++n) acc[n] += w * bfv(vb, e * 1024 + n);
            bool found = false;
            for (int s = 0; s < 16; ++s) if (dE[hd * 16 + s] == (int)e) { found = true; if (!(fabsf(dG[hd * 16 + s] - gate) <= 1e-3f)) fg = true; }
            if (!found) froute = true;
        }
        for (int s = 0; s < 16; ++s) {
            const size_t e = (size_t)dE[hd * 16 + s];
            if (e >= 16384) { froute = true; continue; }
            float dot = 0.f;
            for (int k = 0; k < 1024; ++k) dot += bfv(h1, k) * bfv(ub, e * 1024 + k);
            const float w = dG[hd * 16 + s] * gelu_erf(dot);
            for (int n = 0; n < 1024; ++n) acc2[n] += w * bfv(vb, e * 1024 + n);
        }
    }
    bool f2 = false;
    for (int pass = 0; pass < 2; ++pass) {
        float* a = pass ? acc2 : acc;
        float sm = 0.f;
        for (int n = 0; n < 1024; ++n) { a[n] += ALPHA * bfv(h1, n); sm += a[n]; }
        const float mean = sm / 1024.f;
        float v = 0.f;
        for (int n = 0; n < 1024; ++n) v += (a[n] - mean) * (a[n] - mean);
        const float rstd = 1.f / sqrtf(v / 1024.f + LN_EPS);
        for (int n = 0; n < 1024; ++n) {
            const bool b = bad(p.out[(size_t)tok * 1024 + n], (a[n] - mean) * rstd * p.in[18][n] + p.in[19][n]);
            if (pass) f2 |= b; else f |= b;
        }
    }
    if (f) dfail(p, bit);
    if (froute) dfail(p, bit + 1);
    if (fg) dfail(p, bit + 2);
    if (f2) dfail(p, bit + 3);
}
#endif

__global__ void __launch_bounds__(NTHREADS, 2) hybrid_fwd(Params p) {
    extern __shared__ __attribute__((aligned(16))) unsigned char lds[];
    cg::grid_group grid = cg::this_grid();
    const int lo = p.ph_lo, hi = p.ph_hi;
    volatile unsigned* bst = (volatile unsigned*)(lds + LDS_MAIN);
    if (threadIdx.x < 2) bst[threadIdx.x] = 0u;
    __syncthreads();
    XcdBarrier xbar = xcd_barrier_post((unsigned*)(p.ws + WS_BAR), bst);
#define IN(k) (lo <= (k) && (k) < hi)
#define SEAM(k) do { if (IN(k) && IN((k) + 1 + ((k) == 4))) xcd_barrier(xbar); } while (0)
    if (lo < 0) grid.sync();
#if DIAG
    if (blockIdx.x == 0 && threadIdx.x == 0) *(unsigned*)(p.ws + WS_FLAG) = 0u;
#endif
    if (IN(0)) phase0(p);
    SEAM(0);
    if (IN(1)) phase1(p, lds);
    SEAM(1);
#if DIAG == 1
    chk1(p, 0);
#endif
    if (IN(2)) phase2(p, lds);
    SEAM(2);
#if DIAG == 1
    chk2(p, 1); chk3(p, 2);
#endif
    if (IN(3)) phase3(p, lds);
    SEAM(3);
#if DIAG == 1
    chk4(p, 3); chk5(p, 4);
#endif
    if (IN(4)) phase4(p, lds);
    SEAM(4);
#if DIAG == 1
    chk6(p, 5);
#endif
    if (IN(6)) phase6(p, lds);
    SEAM(6);
#if DIAG == 2
    chk7(p, 0);
#endif
    if (IN(7)) phase7(p, lds);
#if DIAG
    grid.sync();
#if DIAG == 2
    chk8(p, 1);
    grid.sync();
#endif
    {
        const unsigned code = *(volatile unsigned*)(p.ws + WS_FLAG);
        const float kv = sqrtf((float)code);
        for (size_t i = (size_t)blockIdx.x * NTHREADS + threadIdx.x; i < (size_t)NTOK * DM; i += (size_t)gridDim.x * NTHREADS) p.out[i] = kv;
    }
#endif
#undef IN
#undef SEAM
}

extern "C" void kernel_launch(void* const* d_in, const int* in_sizes, int n_in, void* d_out, int out_size, void* d_ws, size_t ws_size,
                              hipStream_t stream) {
    static int grid_blocks = 0;
    if (grid_blocks == 0) {
        if (n_in != 20 || ws_size < WS_END) { fprintf(stderr, "kernel_launch: unexpected inputs (n_in %d, ws %zu)\n", n_in, ws_size); grid_blocks = -1; return; }
        int dev = 0, cus = 0, per_cu = 0;
        hipGetDevice(&dev);
        hipDeviceGetAttribute(&cus, hipDeviceAttributeMultiprocessorCount, dev);
        hipFuncSetAttribute((const void*)hybrid_fwd, hipFuncAttributeMaxDynamicSharedMemorySize, LDS_BYTES);
        hipOccupancyMaxActiveBlocksPerMultiprocessor(&per_cu, (const void*)hybrid_fwd, NTHREADS, LDS_BYTES);
        if (per_cu < 1) per_cu = 1;
        if (per_cu > 2) per_cu = 2;
        grid_blocks = cus * per_cu;
        (void)hipGetLastError();
    }
    if (grid_blocks < 0) return;
    (void)hipMemsetAsync((char*)d_ws + WS_BAR, 0, WS_BAR_BYTES, stream);
    Params p{};
    for (int i = 0; i < 20; ++i) p.in[i] = (const float*)d_in[i];
    p.out = (float*)d_out; p.ws = (unsigned char*)d_ws;
#if N_LAUNCH_MODE == 1
    p.ph_lo = 0; p.ph_hi = 8;
    void* args[] = {&p};
    hipError_t e = hipLaunchCooperativeKernel((const void*)hybrid_fwd, dim3(grid_blocks), dim3(NTHREADS), args, LDS_BYTES, stream);
    if (e != hipSuccess) fprintf(stderr, "cooperative launch failed: %s (grid %d)\n", hipGetErrorString(e), grid_blocks);
#else
    for (int ph = 0; ph < 8; ++ph) {
        p.ph_lo = ph; p.ph_hi = ph + 1;
        hipLaunchKernelGGL(hybrid_fwd, dim3(grid_blocks), dim3(NTHREADS), LDS_BYTES, stream, p);
    }
#endif
}
```

```cpp
#include <hip/hip_runtime.h>
#include <hip/hip_cooperative_groups.h>
#include <cstdint>
#include <cstdio>
namespace cg = cooperative_groups;

#ifndef N_LAUNCH_MODE
#define N_LAUNCH_MODE 1
#endif

typedef unsigned short bf16_t;
typedef short bf16x8 __attribute__((ext_vector_type(8)));
typedef short s16x4 __attribute__((ext_vector_type(4)));
typedef unsigned u32x6 __attribute__((ext_vector_type(6)));
typedef _Float16 f16x32 __attribute__((ext_vector_type(32)));
typedef _Float16 f16x2_t __attribute__((ext_vector_type(2)));
typedef float f32x32 __attribute__((ext_vector_type(32)));
typedef float f32x16 __attribute__((ext_vector_type(16)));
typedef float f32x4 __attribute__((ext_vector_type(4)));
typedef unsigned u32x4 __attribute__((ext_vector_type(4)));
typedef unsigned u32x2 __attribute__((ext_vector_type(2)));
typedef float f32x2 __attribute__((ext_vector_type(2)));
typedef __bf16 bf16x2_t __attribute__((ext_vector_type(2)));

#define DI __device__ __forceinline__
#define MFMA32(a, b, c) __builtin_amdgcn_mfma_f32_32x32x16_bf16((a), (b), (c), 0, 0, 0)

constexpr int NTOK = 16384, SEQ = 4096, DM = 1024;
constexpr int NINP = 1920;
constexpr float ALPHA = 1.189207115002721f;
constexpr float LN_EPS = 1e-5f;
constexpr float LOG2E = 1.4426950408889634f;
constexpr float QSCALE = 0.125f * LOG2E;
constexpr int NTHREADS = 256;
constexpr int LDS_MAIN = 73728;
constexpr int LDS_CST = LDS_MAIN + 64;
constexpr int LDS_BYTES = LDS_MAIN + 64 + 2048;
constexpr int ROWB = 144;

constexpr size_t MiB = 1u << 20;
constexpr size_t WS_BAR = 0;
constexpr size_t WS_BAR_BYTES = 16384;
constexpr size_t WS_KCMP = 1 * MiB;
constexpr size_t WS_VCMP = 1 * MiB + 512 * 1024;
constexpr size_t WS_W2TK = 2 * MiB;
constexpr size_t WS_W2TV = 2 * MiB + 32 * 1024;
constexpr size_t WS_POOLWT = 2 * MiB + 64 * 1024;
constexpr size_t WS_SUBK = 2 * MiB + 192 * 1024;
constexpr size_t WS_PEBK = 2 * MiB + 256 * 1024;
constexpr size_t WS_PEBV = 2 * MiB + 257 * 1024;
constexpr size_t WS_BUCK = 2 * MiB + 258 * 1024;
constexpr size_t WS_USCALE = 2 * MiB + 320 * 1024;
constexpr size_t WS_VSCALE = 2 * MiB + 384 * 1024;
constexpr size_t WS_C1 = 2 * MiB + 448 * 1024;
constexpr size_t WS_C2 = 2 * MiB + 456 * 1024;
constexpr size_t WS_LNST = 15 * MiB;
constexpr size_t WS_W1TK = 3 * MiB;
constexpr size_t WS_W1TV = 4 * MiB;
constexpr size_t WS_WINT = 5 * MiB;
constexpr size_t WS_WOUTT = 9 * MiB;
constexpr size_t WS_WQT = 11 * MiB;
constexpr size_t WS_UB = 16 * MiB;
constexpr size_t WS_VB = 48 * MiB;
constexpr size_t WS_XB = 80 * MiB;
constexpr size_t WS_MIXIN = WS_XB;
constexpr size_t WS_Q = 112 * MiB;
constexpr size_t WS_KC = 128 * MiB;
constexpr size_t WS_VC = 132 * MiB;
constexpr size_t WS_KSLC = 136 * MiB;
constexpr size_t WS_KWIN = 140 * MiB;
constexpr size_t WS_VSLCT = 144 * MiB;
constexpr size_t WS_VWINT = 148 * MiB;
constexpr size_t WS_GATES = 152 * MiB;
constexpr size_t WS_Z = 154 * MiB;
constexpr size_t WS_YPOOL = 170 * MiB;
constexpr size_t WS_OWIN = 186 * MiB;
#ifndef DIAG
#define DIAG 0
#endif
#if DIAG
constexpr size_t WS_H1 = 202 * MiB;
constexpr size_t WS_TOPK = 234 * MiB;
constexpr size_t WS_END = 256 * MiB;
constexpr size_t WS_FLAG = 32768;
constexpr size_t WS_DSCR = 250 * MiB;
#else
constexpr size_t WS_H1 = 112 * MiB;
constexpr size_t WS_TOPK = 112 * MiB;
constexpr size_t WS_END = 202 * MiB;
#endif

struct Params { const float* in[20]; float* out; unsigned char* ws; int ph_lo, ph_hi; };

DI unsigned f2bf(float f) { unsigned u = __float_as_uint(f); return (u + 0x7fffu + ((u >> 16) & 1u)) >> 16; }
DI unsigned pk2(float lo, float hi) { bf16x2_t v = {(__bf16)lo, (__bf16)hi}; return __builtin_bit_cast(unsigned, v); }
DI float bflo(unsigned x) { return __uint_as_float(x << 16); }
DI float bfhi(unsigned x) { return __uint_as_float(x & 0xffff0000u); }
DI float dot2bf(unsigned a, unsigned b, float acc) {
    asm("v_dot2c_f32_bf16 %0, %1, %2" : "+v"(acc) : "v"(a), "v"(b));
    return acc;
}
DI int dot4i8(unsigned a, unsigned b, int acc) {
    return __builtin_amdgcn_sdot4((int)a, (int)b, acc, false);
}
DI float gelu_erf(float x) { return 0.5f * x * (1.0f + erff(x * 0.70710678118654752f)); }
DI float gelu_fast(float v) {
    const float av = fabsf(v), t = __builtin_amdgcn_rcpf(av * 0.2316418882f + 1.0f);
    float q = t * 0.5307027145f + (-0.7265760135f); q = q * t + 0.7107068705f; q = q * t + (-0.142248368f); q = q * t + 0.127414796f; q = q * t;
    const float e = __builtin_amdgcn_exp2f((v * v) * (-0.72134752044f));
    const float m = v * (q * e);
    return v < 0.f ? m : v - m;
}
DI float wave_sum(float v) {
#pragma unroll
    for (int o = 32; o >= 1; o >>= 1) v += __shfl_xor(v, o);
    return v;
}
DI int rel_bucket_dev(int dist) {
    if (dist < 0) dist = 0;
    if (dist < 16) return dist;
    int v = 16 + (int)(logf((float)dist / 16.0f) / logf(8.0f) * 16.0f);
    return v < 31 ? v : 31;
}
DI int make_key(float f, int idx) { int b = __float_as_int(f); b ^= (b >> 31) & 0x7fffffff; return (b & ~127) | idx; }
DI float key_val(int k) { int b = k & ~127; b ^= (b >> 31) & 0x7fffffff; return __int_as_float(b); }


#define LAS __attribute__((address_space(3)))
#define XB_TMO      128
#define XB_XCNT(j)  (256  + 64 * (j))
#define XB_XSUB(j)  (1280 + 64 * (j))
#define XB_XGEN(j)  (2304 + 64 * (j))
#define XB_TOP      3328
#define XB_TOPGEN   3392
#define XCD_BAR_WORDS 3456
#define XB_SPIN_CAP (1u << 20)
DI unsigned xb_ld(unsigned* p)              { return __hip_atomic_load(p, __ATOMIC_RELAXED, __HIP_MEMORY_SCOPE_AGENT); }
DI unsigned xb_add(unsigned* p, unsigned v) { return __hip_atomic_fetch_add(p, v, __ATOMIC_RELAXED, __HIP_MEMORY_SCOPE_AGENT); }
DI unsigned xb_xcc_id() { return (unsigned)__builtin_amdgcn_s_getreg((3 << 11) | 20) & 0xFu; }
#define XB_SPIN(cond, bar) do { unsigned _sp = 0; while (cond) { __builtin_amdgcn_s_sleep(1); \
    if ((++_sp & 255u) == 0u) { if (xb_ld(&(bar)[XB_TMO])) break; if (_sp > XB_SPIN_CAP) { atomicAdd(&(bar)[XB_TMO], 1u); break; } } } } while (0)
struct XcdBarrier { unsigned* bar; unsigned x; volatile unsigned* st; };
DI XcdBarrier xcd_barrier_post(unsigned* bar, volatile unsigned* st) {
    XcdBarrier b; b.bar = bar; b.x = xb_xcc_id(); b.st = st;
    if (threadIdx.x == 0) (void)xb_add(&bar[XB_XCNT(b.x)], 1u);
    return b;
}
DI void xcd_barrier_complete(unsigned* bar, unsigned x, unsigned& nloc, unsigned& nx) {
    const unsigned G = gridDim.x * gridDim.y * gridDim.z;
    unsigned sum, cnt, mine, sp = 0u;
    for (;;) {
        sum = 0u; cnt = 0u; mine = 0u;
#pragma unroll
        for (unsigned j = 0; j < 16; ++j) { const unsigned c = xb_ld(&bar[XB_XCNT(j)]); sum += c; cnt += (c > 0u) ? 1u : 0u; mine = (j == x) ? c : mine; }
        if (sum == G) break;
        __builtin_amdgcn_s_sleep(1);
        if ((++sp & 255u) == 0u) { if (xb_ld(&bar[XB_TMO])) break; if (sp > XB_SPIN_CAP) { atomicAdd(&bar[XB_TMO], 1u); break; } }
    }
    nloc = mine > 0u ? mine : 1u; nx = cnt > 0u ? cnt : 1u;
}
DI void xcd_barrier(const XcdBarrier& b) {
    asm volatile("s_waitcnt vmcnt(0)" ::: "memory");
    __syncthreads();
    if (threadIdx.x == 0) {
        unsigned* bar = b.bar;
        __builtin_amdgcn_s_waitcnt(0);
        unsigned nloc = b.st[0], nx = b.st[1];
        if (nloc == 0u) { xcd_barrier_complete(bar, b.x, nloc, nx); b.st[0] = nloc; b.st[1] = nx; }
        const unsigned old = xb_add(&bar[XB_XSUB(b.x)], 1u);
        const unsigned gen = old / nloc;
        if (old + 1u == (gen + 1u) * nloc) {
            __builtin_amdgcn_fence(__ATOMIC_RELEASE, "agent");
            asm volatile("s_waitcnt vmcnt(0)" ::: "memory");
            const unsigned og = xb_add(&bar[XB_TOP], 1u);
            const unsigned tg = og / nx;
            if (og + 1u == (tg + 1u) * nx) xb_add(&bar[XB_TOPGEN], 1u);
            else XB_SPIN(xb_ld(&bar[XB_TOPGEN]) == tg, bar);
            __builtin_amdgcn_fence(__ATOMIC_ACQUIRE, "agent");
            xb_add(&bar[XB_XGEN(b.x)], 1u);
            asm volatile("s_waitcnt vmcnt(0)" ::: "memory");
        } else {
            XB_SPIN(xb_ld(&bar[XB_XGEN(b.x)]) == gen, bar);
            __builtin_amdgcn_fence(__ATOMIC_ACQUIRE, "agent");
            asm volatile("s_waitcnt vmcnt(0)" ::: "memory");
        }
    }
    __syncthreads();
}

template <int MI>
DI void gemm_mainloop_t(const bf16_t* __restrict__ A, int lda, const bf16_t* __restrict__ Bt, int ldb, int K,
                        f32x16 (&acc)[MI][2], unsigned char* lds) {
    const int tid = threadIdx.x, lane = tid & 63, wid = __builtin_amdgcn_readfirstlane(tid >> 6);
    const int wr = wid >> 1, wc = wid & 1, r = lane & 31, h = lane >> 5;
    LAS unsigned char* As = (LAS unsigned char*)lds;
    LAS unsigned char* Bs = (LAS unsigned char*)lds + 2 * 16384;
#pragma unroll
    for (int mi = 0; mi < MI; ++mi)
#pragma unroll
        for (int ni = 0; ni < 2; ++ni)
#pragma unroll
            for (int i = 0; i < 16; ++i) acc[mi][ni][i] = 0.f;
    const int nk = K >> 6;
    const int prow = 8 * wid + (lane >> 3);
    const int pchunk = (lane & 7) ^ ((prow >> 1) & 7);
    const bf16_t* Ap = A + (size_t)prow * lda + pchunk * 8;
    const bf16_t* Bp = Bt + (size_t)prow * ldb + pchunk * 8;
    const int pl = wid * 1024;
#define GEMM_STAGE(buf, kt) do { \
        _Pragma("unroll") for (int i = 0; i < 2 * MI; ++i) __builtin_amdgcn_global_load_lds((const unsigned*)(Ap + (size_t)(32 * i) * lda + (kt) * 64), (LAS unsigned*)(As + (buf) * 16384 + i * 4096 + pl), 16, 0, 0); \
        _Pragma("unroll") for (int i = 0; i < 4; ++i) __builtin_amdgcn_global_load_lds((const unsigned*)(Bp + (size_t)(32 * i) * ldb + (kt) * 64), (LAS unsigned*)(Bs + (buf) * 16384 + i * 4096 + pl), 16, 0, 0); } while (0)
    GEMM_STAGE(0, 0);
    asm volatile("s_waitcnt vmcnt(0)" ::: "memory");
    __syncthreads();
    const int swz = (r >> 1) & 7;
    for (int kt = 0; kt < nk; ++kt) {
        const int cur = kt & 1;
        if (kt + 1 < nk) GEMM_STAGE(cur ^ 1, kt + 1);
        const LAS unsigned char* Ac = As + cur * 16384 + (wr * 32 * MI + r) * 128;
        const LAS unsigned char* Bc = Bs + cur * 16384 + (wc * 64 + r) * 128;
        __builtin_amdgcn_s_setprio(1);
#pragma unroll
        for (int ks = 0; ks < 4; ++ks) {
            const int co = ((ks * 2 + h) ^ swz) * 16;
            bf16x8 fa[MI], fb[2];
#pragma unroll
            for (int mi = 0; mi < MI; ++mi) fa[mi] = *(const LAS bf16x8*)(Ac + mi * 32 * 128 + co);
#pragma unroll
            for (int ni = 0; ni < 2; ++ni) fb[ni] = *(const LAS bf16x8*)(Bc + ni * 32 * 128 + co);
#pragma unroll
            for (int mi = 0; mi < MI; ++mi)
#pragma unroll
                for (int ni = 0; ni < 2; ++ni) acc[mi][ni] = MFMA32(fb[ni], fa[mi], acc[mi][ni]);
        }
        __builtin_amdgcn_s_setprio(0);
        asm volatile("s_waitcnt vmcnt(0)" ::: "memory");
        __syncthreads();
    }
#undef GEMM_STAGE
}
DI void gemm_mainloop(const bf16_t* __restrict__ A, int lda, const bf16_t* __restrict__ Bt, int ldb, int K,
                      f32x16 (&acc)[2][2], unsigned char* lds) { gemm_mainloop_t<2>(A, lda, Bt, ldb, K, acc, lds); }

template <int MI, class F> DI void epi_foreach_t(const f32x16 (&acc)[MI][2], F f) {
    const int tid = threadIdx.x, lane = tid & 63, wid = tid >> 6;
    const int wr = wid >> 1, wc = wid & 1, r = lane & 31, h = lane >> 5;
#pragma unroll
    for (int mi = 0; mi < MI; ++mi)
#pragma unroll
        for (int ni = 0; ni < 2; ++ni)
#pragma unroll
            for (int grp = 0; grp < 4; ++grp) {
                f32x4 v = {acc[mi][ni][4 * grp], acc[mi][ni][4 * grp + 1], acc[mi][ni][4 * grp + 2], acc[mi][ni][4 * grp + 3]};
                f(wr * 32 * MI + mi * 32 + r, wc * 64 + ni * 32 + 8 * grp + 4 * h, v);
            }
}
template <class F> DI void epi_foreach(const f32x16 (&acc)[2][2], F f) { epi_foreach_t<2>(acc, f); }

template <class S> DI void epi_stage_rows(const f32x16 (&acc)[2][2], unsigned char* lds, S colscale) {
    epi_foreach(acc, [&](int m, int n, f32x4 v) {
        const f32x4 s = colscale(n);
        u32x2 o = {pk2(v.x * s.x, v.y * s.y), pk2(v.z * s.z, v.w * s.w)};
        *(u32x2*)(lds + m * 272 + n * 2) = o;
    });
}
DI void epi_stage_cols(const f32x16 (&acc)[2][2], unsigned char* lds) {
    epi_foreach(acc, [&](int m, int n, f32x4 v) {
        *(bf16_t*)(lds + (n + 0) * 272 + m * 2) = (bf16_t)f2bf(v.x); *(bf16_t*)(lds + (n + 1) * 272 + m * 2) = (bf16_t)f2bf(v.y);
        *(bf16_t*)(lds + (n + 2) * 272 + m * 2) = (bf16_t)f2bf(v.z); *(bf16_t*)(lds + (n + 3) * 272 + m * 2) = (bf16_t)f2bf(v.w);
    });
}
template <class F> DI void rows_foreach(const unsigned char* lds, F f) {
    const int tid = threadIdx.x;
#pragma unroll
    for (int i = 0; i < 8; ++i) {
        const int c = tid + 256 * i, m = c >> 4, cc = c & 15;
        f(m, cc, *(const u32x4*)(lds + m * 272 + cc * 16));
    }
}

DI void cvt_rows(const float* __restrict__ src, bf16_t* __restrict__ dst, size_t n8, size_t gtid, size_t gstride) {
    for (size_t i = gtid; i < n8; i += gstride) {
        f32x4 a = ((const f32x4*)src)[2 * i], b = ((const f32x4*)src)[2 * i + 1];
        u32x4 o = {pk2(a.x, a.y), pk2(a.z, a.w), pk2(b.x, b.y), pk2(b.z, b.w)};
        ((u32x4*)dst)[i] = o;
    }
}
template <class F> DI void transpose_cvt(const float* __restrict__ in, int K, int Nin, bf16_t* __restrict__ out, int Nout, F src,
                                         size_t gtid, size_t gstride) {
    const size_t total = (size_t)Nout * (K / 8);
    for (size_t i = gtid; i < total; i += gstride) {
        const int n = (int)(i % Nout), k8 = (int)(i / Nout);
        const int s = src(n);
        float v[8];
#pragma unroll
        for (int j = 0; j < 8; ++j) v[j] = s >= 0 ? in[(size_t)(k8 * 8 + j) * Nin + s] : 0.f;
        u32x4 o = {pk2(v[0], v[1]), pk2(v[2], v[3]), pk2(v[4], v[5]), pk2(v[6], v[7])};
        *(u32x4*)(out + (size_t)n * K + k8 * 8) = o;
    }
}

DI void transpose_cvt_scaled(const float* __restrict__ in, int K, int N, bf16_t* __restrict__ out, const float* __restrict__ scale, size_t gtid, size_t gstride) {
    const size_t total = (size_t)N * (K / 8);
    for (size_t i = gtid; i < total; i += gstride) {
        const int n = (int)(i % N), k8 = (int)(i / N);
        float v[8];
#pragma unroll
        for (int j = 0; j < 8; ++j) v[j] = in[(size_t)(k8 * 8 + j) * N + n] * scale[k8 * 8 + j];
        u32x4 o = {pk2(v[0], v[1]), pk2(v[2], v[3]), pk2(v[4], v[5]), pk2(v[6], v[7])};
        *(u32x4*)(out + (size_t)n * K + k8 * 8) = o;
    }
}

DI void convert_tables(const Params& p) {
    unsigned char* ws = p.ws;
    const size_t gtid = (size_t)blockIdx.x * NTHREADS + threadIdx.x, gstride = (size_t)gridDim.x * NTHREADS;
    const int lane = threadIdx.x & 63, gw = (int)(gtid >> 6), ngw = (int)(gstride >> 6);
    {
        const int hw = lane >> 5, l32 = lane & 31;
        for (int rr = gw * 2 + hw; rr < 2 * 16384; rr += ngw * 2) {
            const int which = rr >> 14, row = rr & 16383;
            const float* src = (which ? p.in[17] : p.in[16]) + (size_t)row * 1024 + l32 * 16;
            f32x16 a, b;
            float am = 0.f;
#pragma unroll
            for (int j = 0; j < 4; ++j) {
                const f32x4 x = *(const f32x4*)(src + 4 * j), y = *(const f32x4*)(src + 512 + 4 * j);
                a[4 * j] = x.x; a[4 * j + 1] = x.y; a[4 * j + 2] = x.z; a[4 * j + 3] = x.w;
                b[4 * j] = y.x; b[4 * j + 1] = y.y; b[4 * j + 2] = y.z; b[4 * j + 3] = y.w;
                am = fmaxf(am, fmaxf(fmaxf(fabsf(x.x), fabsf(x.y)), fmaxf(fabsf(x.z), fabsf(x.w))));
                am = fmaxf(am, fmaxf(fmaxf(fabsf(y.x), fabsf(y.y)), fmaxf(fabsf(y.z), fabsf(y.w))));
            }
#pragma unroll
            for (int o = 16; o >= 1; o >>= 1) am = fmaxf(am, __shfl_xor(am, o));
            const float sc = am > 0.f ? 7.5f / am : 1.0f;
#pragma unroll
            for (int i = 0; i < 16; ++i) { a[i] *= sc; b[i] *= sc; }
            f32x16 a2, b2;
#pragma unroll
            for (int i = 0; i < 8; ++i) { a2[i] = a[2 * i]; b2[i] = a[2 * i + 1]; a2[8 + i] = b[2 * i]; b2[8 + i] = b[2 * i + 1]; }
            const u32x6 pk = __builtin_amdgcn_cvt_scalef32_2xpk16_fp6_f32(a2, b2, 1.0f);
            unsigned char* dst = ws + (which ? WS_VB : WS_UB) + (size_t)row * 768;
            *(u32x4*)(dst + l32 * 16) = (u32x4){pk[0], pk[1], pk[2], pk[3]};
            *(u32x2*)(dst + 512 + l32 * 8) = (u32x2){pk[4], pk[5]};
            if (l32 == 0) ((float*)(ws + (which ? WS_VSCALE : WS_USCALE)))[row] = am > 0.f ? am / 7.5f : 1.0f;
        }
    }
}

DI void phase0(const Params& p) {
    unsigned char* ws = p.ws;
    const size_t gtid = (size_t)blockIdx.x * NTHREADS + threadIdx.x, gstride = (size_t)gridDim.x * NTHREADS;
    cvt_rows(p.in[0], (bf16_t*)(ws + WS_XB), (size_t)NTOK * DM / 8, gtid, gstride);
    cvt_rows(p.in[15], (bf16_t*)(ws + WS_SUBK), (size_t)2 * 128 * 128 / 8, gtid, gstride);
    transpose_cvt(p.in[1], 1024, 1816, (bf16_t*)(ws + WS_WINT), NINP,
                  [](int n) { return n < 1280 ? n : (n < 1792 ? 1304 + (n - 1280) : (n < 1816 ? 1280 + (n - 1792) : -1)); }, gtid, gstride);
    transpose_cvt(p.in[11], 1024, 1024, (bf16_t*)(ws + WS_WOUTT), 1024, [](int n) { return n; }, gtid, gstride);
    transpose_cvt_scaled(p.in[14], 1024, 2048, (bf16_t*)(ws + WS_WQT), p.in[12], gtid, gstride);
    transpose_cvt(p.in[5], 2048, 256, (bf16_t*)(ws + WS_W1TK), 256, [](int n) { return n; }, gtid, gstride);
    transpose_cvt(p.in[7], 2048, 256, (bf16_t*)(ws + WS_W1TV), 256, [](int n) { return n; }, gtid, gstride);
    transpose_cvt(p.in[6], 256, 64, (bf16_t*)(ws + WS_W2TK), 64, [](int n) { return n; }, gtid, gstride);
    transpose_cvt(p.in[8], 256, 64, (bf16_t*)(ws + WS_W2TV), 64, [](int n) { return n; }, gtid, gstride);
    for (int g = 0; g < 4; ++g)
        transpose_cvt(p.in[9] + g * 16384, 128, 128, (bf16_t*)(ws + WS_POOLWT) + g * 16384, 128, [](int n) { return n; }, gtid, gstride);
    {
        float* z = (float*)(ws + WS_KCMP);
        for (size_t i = gtid; i < (size_t)2 * 8 * 256 * 64; i += gstride) z[i] = 0.f;
    }
    {
        const int lane = threadIdx.x & 63, gw = (int)(gtid >> 6), ngw = (int)(gstride >> 6);
        for (int o = gw; o < 512; o += ngw) {
            const int which = o >> 8, j = o & 255;
            const float* pe = which ? p.in[4] : p.in[3];
            const float* w1 = which ? p.in[7] : p.in[5];
            float s = 0.f;
#pragma unroll 8
            for (int i = lane; i < 2048; i += 64) s += pe[i] * w1[(size_t)i * 256 + j];
            s = wave_sum(s);
            if (lane == 0) ((float*)(ws + (which ? WS_PEBV : WS_PEBK)))[j] = s;
        }
    }
    if (gtid >= 512 && gtid < 768) {
        const int d = (int)(gtid - 512);
        ((int*)(ws + WS_BUCK))[d] = rel_bucket_dev(d);
    }
}

DI int cu_pair_pos(int j, int G8) { const int hlf = (G8 + 1) >> 1; return (G8 & 1) ? j : (((j % hlf) << 1) | (j / hlf)); }

DI void phase1(const Params& p, unsigned char* lds) {
    unsigned char* ws = p.ws;
    const bf16_t* xb = (const bf16_t*)(ws + WS_XB);
    const bf16_t* wt = (const bf16_t*)(ws + WS_WINT);
    const int ntiles = 128 * 15;
    const int G8 = (gridDim.x & 7) == 0 ? gridDim.x >> 3 : 0;
    for (int l0 = G8 ? 0 : (int)blockIdx.x; l0 < (G8 ? ntiles / 8 : ntiles); l0 += (G8 ? G8 : (int)gridDim.x)) {
        const int li = G8 ? l0 + cu_pair_pos((int)(blockIdx.x >> 3), G8) : l0;
        if (G8 && li >= ntiles / 8) break;
        const int tile = G8 ? (int)(blockIdx.x & 7) * (ntiles / 8) + li : li;
        const int tn = tile % 15, tm = tile / 15;
        f32x16 acc[2][2];
        gemm_mainloop(xb + (size_t)tm * 128 * DM, DM, wt + (size_t)tn * 128 * DM, DM, DM, acc, lds);
        const int m0 = tm * 128;
        if (tn < 14) {
            const bool tr = (tn == 7 || tn == 9);
            const float qs = tn < 4 ? QSCALE : 1.0f;
            if (tr) epi_stage_cols(acc, lds);
            else epi_stage_rows(acc, lds, [&](int) { return (f32x4){qs, qs, qs, qs}; });
            __syncthreads();
            const int bq = m0 >> 12, t0q = m0 & 4095;
            if (tn < 4) {
                bf16_t* Q = (bf16_t*)(ws + WS_Q);
                rows_foreach(lds, [&](int m, int cc, u32x4 d) {
                    const int hd = tn * 2 + (cc >> 3);
                    *(u32x4*)(Q + (((size_t)(bq * 8 + hd) * SEQ + t0q + m) * 64 + (cc & 7) * 8)) = d;
                });
            } else if (tr) {
                bf16_t* dst = (bf16_t*)(ws + (tn == 7 ? WS_VSLCT : WS_VWINT));
                rows_foreach(lds, [&](int n, int cc, u32x4 d) {
                    *(u32x4*)(dst + ((size_t)((bq * 2 + (n >> 6)) * 64 + (n & 63)) * SEQ + t0q + cc * 8)) = d;
                });
            } else if (tn < 10) {
                bf16_t* dst = (bf16_t*)(ws + (tn == 4 ? WS_KC : tn == 5 ? WS_VC : tn == 6 ? WS_KSLC : WS_KWIN));
                rows_foreach(lds, [&](int m, int cc, u32x4 d) {
                    *(u32x4*)(dst + (((size_t)(bq * 2 + (cc >> 3)) * SEQ + t0q + m) * 64 + (cc & 7) * 8)) = d;
                });
            } else {
                bf16_t* dst = (bf16_t*)(ws + WS_Z);
                rows_foreach(lds, [&](int m, int cc, u32x4 d) {
                    *(u32x4*)(dst + ((size_t)(m0 + m) * 512 + (tn - 10) * 128 + cc * 8)) = d;
                });
            }
            __syncthreads();
        } else {
            float* dst = (float*)(ws + WS_GATES);
            epi_foreach(acc, [&](int m, int n, f32x4 v) {
                if (n < 24) {
                    f32x4 o = {1.f / (1.f + __expf(-v.x)), 1.f / (1.f + __expf(-v.y)), 1.f / (1.f + __expf(-v.z)), 1.f / (1.f + __expf(-v.w))};
                    *(f32x4*)(dst + (size_t)(m0 + m) * 24 + n) = o;
                }
            });
        }
    }
}

DI void compress_job(const Params& p, unsigned char* lds, int cj) {
    unsigned char* ws = p.ws;
    const int kv = cj >> 6, bg = (cj >> 3) & 7, rq = (cj >> 1) & 3, hh = cj & 1;
    const bf16_t* A = (const bf16_t*)(ws + (kv ? WS_VC : WS_KC)) + ((size_t)bg * SEQ + (size_t)rq * 64 * 16) * 64;
    const bf16_t* Bt = (const bf16_t*)(ws + (kv ? WS_W1TV : WS_W1TK)) + (size_t)hh * 128 * 2048;
    const float* peb = (const float*)(ws + (kv ? WS_PEBV : WS_PEBK)) + hh * 128;
    const bf16_t* w2t = (const bf16_t*)(ws + (kv ? WS_W2TV : WS_W2TK));
    float* dst = (float*)(ws + (kv ? WS_VCMP : WS_KCMP)) + (size_t)bg * 256 * 64;
    f32x16 acc[1][2];
    gemm_mainloop_t<1>(A, 1024, Bt, 2048, 2048, acc, lds);
    epi_foreach_t<1>(acc, [&](int m, int n, f32x4 v) {
        f32x4 bb = *(const f32x4*)(peb + n);
        u32x2 o = {pk2(gelu_erf(v.x + bb.x), gelu_erf(v.y + bb.y)), pk2(gelu_erf(v.z + bb.z), gelu_erf(v.w + bb.w))};
        *(u32x2*)(lds + m * 272 + n * 2) = o;
    });
    __syncthreads();
    const int tid = threadIdx.x, lane = tid & 63, wid = tid >> 6, r = lane & 31, h = lane >> 5;
    const int wr2 = wid >> 1, wd = wid & 1;
    f32x16 a2;
#pragma unroll
    for (int i = 0; i < 16; ++i) a2[i] = 0.f;
#pragma unroll
    for (int ks = 0; ks < 8; ++ks) {
        bf16x8 fb = *(const bf16x8*)(lds + (wr2 * 32 + r) * 272 + ks * 32 + h * 16);
        bf16x8 fa = *(const bf16x8*)(w2t + (size_t)(wd * 32 + r) * 256 + hh * 128 + ks * 16 + h * 8);
        a2 = MFMA32(fa, fb, a2);
    }
    const int row = rq * 64 + wr2 * 32 + r;
    if (row < 255) {
#pragma unroll
        for (int i = 0; i < 16; ++i) {
            const int d = wd * 32 + (i & 3) + 8 * (i >> 2) + 4 * h;
            atomicAdd(dst + (size_t)row * 64 + d, a2[i]);
        }
    }
    __syncthreads();
}

constexpr int AT_K0 = 0, AT_V0 = 18432, AT_TB = 36864, AT_IMP = 40960, AT_SEL = 49152;

DI void attn_stage_load(const bf16_t* __restrict__ Kg, const bf16_t* __restrict__ Vtg, u32x4 (&st)[4], int tid) {
#pragma unroll
    for (int i = 0; i < 2; ++i) {
        const int c = tid + 256 * i, row = c >> 3, cc = c & 7;
        st[i] = *(const u32x4*)(Kg + (size_t)row * 64 + cc * 8);
        st[2 + i] = *(const u32x4*)(Vtg + (size_t)row * SEQ + cc * 8);
    }
}
DI void attn_stage_store(unsigned char* Kl, unsigned char* Vl, const u32x4 (&st)[4], int tid) {
#pragma unroll
    for (int i = 0; i < 2; ++i) {
        const int c = tid + 256 * i, row = c >> 3, cc = c & 7;
        *(u32x4*)(Kl + row * ROWB + cc * 16) = st[i];
        *(u32x4*)(Vl + row * ROWB + cc * 16) = st[2 + i];
    }
}
DI void attn_scores(const unsigned char* Kl, const bf16x8 (&qf)[4], f32x16 (&X)[2], int r, int h) {
#pragma unroll
    for (int i = 0; i < 16; ++i) { X[0][i] = 0.f; X[1][i] = 0.f; }
#pragma unroll
    for (int ks = 0; ks < 4; ++ks)
#pragma unroll
        for (int kb = 0; kb < 2; ++kb) {
            bf16x8 a = *(const bf16x8*)(Kl + (kb * 32 + r) * ROWB + ks * 32 + h * 16);
            X[kb] = MFMA32(a, qf[ks], X[kb]);
        }
}
DI void attn_pv(const unsigned char* Vl, const f32x16 (&P)[2], f32x16 (&O)[2], int r, int h) {
#pragma unroll
    for (int kb = 0; kb < 2; ++kb)
#pragma unroll
        for (int s = 0; s < 2; ++s) {
            u32x4 pw = {pk2(P[kb][8 * s], P[kb][8 * s + 1]), pk2(P[kb][8 * s + 2], P[kb][8 * s + 3]),
                        pk2(P[kb][8 * s + 4], P[kb][8 * s + 5]), pk2(P[kb][8 * s + 6], P[kb][8 * s + 7])};
            bf16x8 pb = __builtin_bit_cast(bf16x8, pw);
#pragma unroll
            for (int db = 0; db < 2; ++db) {
                const unsigned char* q = Vl + (db * 32 + r) * ROWB + (kb * 32 + 16 * s + 4 * h) * 2;
                s16x4 lo = *(const s16x4*)q, hi = *(const s16x4*)(q + 16);
                bf16x8 a = __builtin_shufflevector(lo, hi, 0, 1, 2, 3, 4, 5, 6, 7);
                O[db] = MFMA32(a, pb, O[db]);
            }
        }
}
DI void softmax_update(f32x16 (&X)[2], float& m, float& l, f32x16 (&O)[2]) {
    float mloc = -1e30f;
#pragma unroll
    for (int kb = 0; kb < 2; ++kb)
#pragma unroll
        for (int i = 0; i < 16; ++i) mloc = fmaxf(mloc, X[kb][i]);
    mloc = fmaxf(mloc, __shfl_xor(mloc, 32));
    const float mnew = fmaxf(m, mloc);
    const float alpha = __builtin_amdgcn_exp2f(m - mnew);
    m = mnew;
    float ls = 0.f;
#pragma unroll
    for (int kb = 0; kb < 2; ++kb)
#pragma unroll
        for (int i = 0; i < 16; ++i) {
            const float x = X[kb][i];
            const float pv = x > -1e29f ? __builtin_amdgcn_exp2f(x - mnew) : 0.f;
            X[kb][i] = pv; ls += pv;
        }
    l = l * alpha + ls;
#pragma unroll
    for (int db = 0; db < 2; ++db)
#pragma unroll
        for (int i = 0; i < 16; ++i) O[db][i] *= alpha;
}
DI void softmax_far(f32x16 (&X)[2], float cb, float& m, float& l, f32x16 (&O)[2]) {
    float mloc = -3e38f;
#pragma unroll
    for (int kb = 0; kb < 2; ++kb)
#pragma unroll
        for (int i = 0; i < 16; ++i) mloc = fmaxf(mloc, X[kb][i]);
    mloc += cb;
    mloc = fmaxf(mloc, __shfl_xor(mloc, 32));
    const float mnew = fmaxf(m, mloc);
    if (__any(mnew > m)) {
        const float alpha = __builtin_amdgcn_exp2f(m - mnew);
        m = mnew; l *= alpha;
#pragma unroll
        for (int db = 0; db < 2; ++db)
#pragma unroll
            for (int i = 0; i < 16; ++i) O[db][i] *= alpha;
    }
    const float mc = m - cb;
    f32x2 ls = {0.f, 0.f};
#pragma unroll
    for (int kb = 0; kb < 2; ++kb)
#pragma unroll
        for (int i = 0; i < 16; i += 2) {
            f32x2 pv = {__builtin_amdgcn_exp2f(X[kb][i] - mc), __builtin_amdgcn_exp2f(X[kb][i + 1] - mc)};
            X[kb][i] = pv.x; X[kb][i + 1] = pv.y; ls += pv;
        }
    l += ls.x + ls.y;
}
DI void build_bias_table(const Params& p, unsigned char* lds, int g) {
    const int* buck = (const int*)(p.ws + WS_BUCK);
    float* tb = (float*)(lds + AT_TB);
    for (int i = threadIdx.x; i < 1024; i += NTHREADS) {
        const int hl = i >> 8, d = i & 255;
        tb[i] = p.in[2][buck[d] * 8 + g * 4 + hl] * LOG2E;
    }
}

DI void win_unit(const Params& p, unsigned char* lds, int u) {
    unsigned char* ws = p.ws;
    const int tid = threadIdx.x, lane = tid & 63, wid = tid >> 6, r = lane & 31, h = lane >> 5;
    const int bg = u & 7, t32 = u >> 3, b = bg >> 1, g = bg & 1, t0 = t32 * 32;
    const int hl = r >> 3, t = t0 + wid * 8 + (r & 7);
    const bf16_t* Kg = (const bf16_t*)(ws + WS_KWIN) + (size_t)bg * SEQ * 64;
    const bf16_t* Vtg = (const bf16_t*)(ws + WS_VWINT) + (size_t)bg * 64 * SEQ;
    const bf16_t* Qg = (const bf16_t*)(ws + WS_Q) + ((size_t)(b * 8 + g * 4 + hl) * SEQ + t) * 64;
    __syncthreads();
    build_bias_table(p, lds, g);
    bf16x8 qf[4];
#pragma unroll
    for (int ks = 0; ks < 4; ++ks) qf[ks] = *(const bf16x8*)(Qg + ks * 16 + h * 8);
    const int jlo = t0 < 511 ? 0 : ((t0 - 511) >> 6), jhi = t0 >> 6;
    u32x4 st[4];
    attn_stage_load(Kg + (size_t)jlo * 64 * 64, Vtg + jlo * 64, st, tid);
    attn_stage_store(lds + AT_K0, lds + AT_V0, st, tid);
    __syncthreads();
    const float* tb = (const float*)(lds + AT_TB) + hl * 256;
    const int tmin = t0 + wid * 8;
    float m = -1e30f, l = 0.f;
    f32x16 O[2];
#pragma unroll
    for (int i = 0; i < 16; ++i) { O[0][i] = 0.f; O[1][i] = 0.f; }
    for (int j = jlo; j <= jhi; ++j) {
        const int cur = (j - jlo) & 1;
        if (j < jhi) attn_stage_load(Kg + (size_t)(j + 1) * 64 * 64, Vtg + (j + 1) * 64, st, tid);
        const unsigned char* Kl = lds + AT_K0 + cur * 9216;
        const unsigned char* Vl = lds + AT_V0 + cur * 9216;
        f32x16 X[2];
        attn_scores(Kl, qf, X, r, h);
        const bool far = (tmin - (j * 64 + 63) >= 128) && (tmin + 7 - j * 64 < 512);
        if (far) {
            softmax_far(X, tb[255], m, l, O);
        } else {
#pragma unroll
            for (int kb = 0; kb < 2; ++kb)
#pragma unroll
                for (int i = 0; i < 16; ++i) {
                    const int pos = j * 64 + kb * 32 + (i & 3) + 8 * (i >> 2) + 4 * h;
                    const int dist = t - pos;
                    const bool valid = dist >= 0 && dist < 512;
                    const int di = dist < 0 ? 0 : (dist > 255 ? 255 : dist);
                    X[kb][i] = valid ? X[kb][i] + tb[di] : -1e30f;
                }
            softmax_update(X, m, l, O);
        }
        attn_pv(Vl, X, O, r, h);
        if (j < jhi) attn_stage_store(lds + AT_K0 + (cur ^ 1) * 9216, lds + AT_V0 + (cur ^ 1) * 9216, st, tid);
        __syncthreads();
    }
    const float lt = l + __shfl_xor(l, 32);
    const size_t tok = (size_t)b * SEQ + t;
    const float gate = ((const float*)(ws + WS_GATES))[tok * 24 + 16 + g * 4 + hl];
    const float sc = gate / lt;
    bf16_t* ow = (bf16_t*)(ws + WS_OWIN) + tok * 512 + (g * 4 + hl) * 64;
#pragma unroll
    for (int db = 0; db < 2; ++db)
#pragma unroll
        for (int grp = 0; grp < 4; ++grp) {
            u32x2 o = {pk2(O[db][4 * grp] * sc, O[db][4 * grp + 1] * sc), pk2(O[db][4 * grp + 2] * sc, O[db][4 * grp + 3] * sc)};
            *(u32x2*)(ow + db * 32 + 8 * grp + 4 * h) = o;
        }
}

DI void cmp_stage(const float* __restrict__ kc, const float* __restrict__ vc, int ct, unsigned char* Kl, unsigned char* Vl, bool withv, int tid) {
    {
        const int c = tid >> 2, part = tid & 3;
        const f32x4* src = (const f32x4*)(kc + (size_t)(ct * 64 + c) * 64 + part * 16);
        f32x4 a = src[0], b2 = src[1], c2 = src[2], d2 = src[3];
        u32x4 o0 = {pk2(a.x, a.y), pk2(a.z, a.w), pk2(b2.x, b2.y), pk2(b2.z, b2.w)};
        u32x4 o1 = {pk2(c2.x, c2.y), pk2(c2.z, c2.w), pk2(d2.x, d2.y), pk2(d2.z, d2.w)};
        *(u32x4*)(Kl + c * ROWB + part * 32) = o0;
        *(u32x4*)(Kl + c * ROWB + part * 32 + 16) = o1;
    }
    if (withv) {
        const int c = tid & 63, dg = tid >> 6;
        const f32x4* src = (const f32x4*)(vc + (size_t)(ct * 64 + c) * 64 + dg * 16);
#pragma unroll
        for (int q4 = 0; q4 < 4; ++q4) {
            f32x4 a = src[q4];
            const int d = dg * 16 + q4 * 4;
            *(bf16_t*)(Vl + (d + 0) * ROWB + c * 2) = (bf16_t)f2bf(a.x);
            *(bf16_t*)(Vl + (d + 1) * ROWB + c * 2) = (bf16_t)f2bf(a.y);
            *(bf16_t*)(Vl + (d + 2) * ROWB + c * 2) = (bf16_t)f2bf(a.z);
            *(bf16_t*)(Vl + (d + 3) * ROWB + c * 2) = (bf16_t)f2bf(a.w);
        }
    }
}

DI void slc_unit(const Params& p, unsigned char* lds, int u) {
    unsigned char* ws = p.ws;
    const int tid = threadIdx.x, lane = tid & 63, wid = tid >> 6, r = lane & 31, h = lane >> 5;
    const int bg = u & 7, t32 = u >> 3, b = bg >> 1, g = bg & 1, t0 = t32 * 32;
    const int hl = r >> 3, tokl = r & 7, t = t0 + wid * 8 + tokl;
    const bf16_t* Kg = (const bf16_t*)(ws + WS_KSLC) + (size_t)bg * SEQ * 64;
    const bf16_t* Vtg = (const bf16_t*)(ws + WS_VSLCT) + (size_t)bg * 64 * SEQ;
    const bf16_t* Qg = (const bf16_t*)(ws + WS_Q) + ((size_t)(b * 8 + g * 4 + hl) * SEQ + t) * 64;
    const float* kcmp = (const float*)(ws + WS_KCMP) + (size_t)bg * 256 * 64;
    const float* vcmp = (const float*)(ws + WS_VCMP) + (size_t)bg * 256 * 64;
    __syncthreads();
    build_bias_table(p, lds, g);
    unsigned* imp = (unsigned*)(lds + AT_IMP) + wid * 512;
#pragma unroll
    for (int i = 0; i < 8; ++i) imp[i * 64 + lane] = 0u;
    bf16x8 qf[4];
#pragma unroll
    for (int ks = 0; ks < 4; ++ks) qf[ks] = *(const bf16x8*)(Qg + ks * 16 + h * 8);
    const float* tb = (const float*)(lds + AT_TB) + hl * 256;
    const int cmax = t0 >> 4;
    const int nct = (t0 + 31 >= 31) ? (cmax >> 6) + 1 : 0;
    float m = -1e30f, l = 0.f;
    f32x16 Oc[2];
#pragma unroll
    for (int i = 0; i < 16; ++i) { Oc[0][i] = 0.f; Oc[1][i] = 0.f; }
    for (int ct = 0; ct < nct; ++ct) {
        __syncthreads();
        cmp_stage(kcmp, vcmp, ct, lds + AT_K0, lds + AT_V0, false, tid);
        __syncthreads();
        f32x16 X[2];
        attn_scores(lds + AT_K0, qf, X, r, h);
#pragma unroll
        for (int kb = 0; kb < 2; ++kb)
#pragma unroll
            for (int i = 0; i < 16; ++i) {
                const int c = ct * 64 + kb * 32 + (i & 3) + 8 * (i >> 2) + 4 * h;
                const int dist = t - (16 * c + 31);
                const bool valid = dist >= 0 && c < 255;
                const int di = dist < 0 ? 0 : (dist > 255 ? 255 : dist);
                X[kb][i] = valid ? X[kb][i] + tb[di] : -1e30f;
            }
        f32x16 dummy[2];
#pragma unroll
        for (int i = 0; i < 16; ++i) { dummy[0][i] = 0.f; dummy[1][i] = 0.f; }
        softmax_update(X, m, l, dummy);
    }
    const float lt = l + __shfl_xor(l, 32);
    const float invl = lt > 0.f ? 1.0f / lt : 0.f;
    for (int ct = 0; ct < nct; ++ct) {
        __syncthreads();
        cmp_stage(kcmp, vcmp, ct, lds + AT_K0, lds + AT_V0, true, tid);
        __syncthreads();
        f32x16 X[2];
        attn_scores(lds + AT_K0, qf, X, r, h);
#pragma unroll
        for (int kb = 0; kb < 2; ++kb)
#pragma unroll
            for (int i = 0; i < 16; ++i) {
                const int c = ct * 64 + kb * 32 + (i & 3) + 8 * (i >> 2) + 4 * h;
                const int dist = t - (16 * c + 31);
                const bool valid = dist >= 0 && c < 255;
                const int di = dist < 0 ? 0 : (dist > 255 ? 255 : dist);
                X[kb][i] = valid ? __builtin_amdgcn_exp2f(X[kb][i] + tb[di] - m) * invl : 0.f;
            }
#pragma unroll
        for (int kb = 0; kb < 2; ++kb)
#pragma unroll
            for (int grp = 0; grp < 4; ++grp) {
                const float s4 = (X[kb][4 * grp] + X[kb][4 * grp + 1]) + (X[kb][4 * grp + 2] + X[kb][4 * grp + 3]);
                const int jj = ct * 16 + kb * 8 + 2 * grp + h;
                atomicAdd(&imp[tokl * 64 + jj], (unsigned)(s4 * 67108864.0f + 0.5f));
                if (jj + 1 < 64) atomicAdd(&imp[tokl * 64 + jj + 1], (unsigned)(X[kb][4 * grp + 3] * 67108864.0f + 0.5f));
            }
        attn_pv(lds + AT_V0, X, Oc, r, h);
    }
    unsigned long long* selm = (unsigned long long*)(lds + AT_SEL) + wid * 8;
    for (int tk = 0; tk < 8; ++tk) {
        const int tt = t0 + wid * 8 + tk, curb = tt >> 6;
        int v = (int)imp[tk * 64 + lane];
        if (lane == 0 || lane == curb || lane == curb - 1) v = 0x7fffffff;
        if (lane > curb) v = -1;
        int cnt = 0;
#pragma unroll
        for (int k = 0; k < 64; ++k) {
            const int vk = __builtin_amdgcn_readlane(v, k);
            cnt += (vk > v || (vk == v && k < lane)) ? 1 : 0;
        }
        const unsigned long long mk = __ballot(cnt < 16);
        if (lane == 0) selm[tk] = mk;
    }
    const unsigned long long mysel = selm[tokl];
    __syncthreads();
    const int jhi = t0 >> 6;
    u32x4 st[4];
    attn_stage_load(Kg, Vtg, st, tid);
    attn_stage_store(lds + AT_K0, lds + AT_V0, st, tid);
    __syncthreads();
    float m2 = -1e30f, l2 = 0.f;
    const int tmin = t0 + wid * 8;
    f32x16 O[2];
#pragma unroll
    for (int i = 0; i < 16; ++i) { O[0][i] = 0.f; O[1][i] = 0.f; }
    for (int j = 0; j <= jhi; ++j) {
        const int cur = j & 1;
        if (j < jhi) attn_stage_load(Kg + (size_t)(j + 1) * 64 * 64, Vtg + (j + 1) * 64, st, tid);
        const unsigned char* Kl = lds + AT_K0 + cur * 9216;
        const unsigned char* Vl = lds + AT_V0 + cur * 9216;
        f32x16 X[2];
        attn_scores(Kl, qf, X, r, h);
        const bool selj = (mysel >> j) & 1ull;
        if (tmin - (j * 64 + 63) >= 128) {
            softmax_far(X, selj ? tb[255] : -1e30f, m2, l2, O);
        } else {
#pragma unroll
            for (int kb = 0; kb < 2; ++kb)
#pragma unroll
                for (int i = 0; i < 16; ++i) {
                    const int pos = j * 64 + kb * 32 + (i & 3) + 8 * (i >> 2) + 4 * h;
                    const int dist = t - pos;
                    const bool valid = dist >= 0 && selj;
                    const int di = dist < 0 ? 0 : (dist > 255 ? 255 : dist);
                    X[kb][i] = valid ? X[kb][i] + tb[di] : -1e30f;
                }
            softmax_update(X, m2, l2, O);
        }
        attn_pv(Vl, X, O, r, h);
        if (j < jhi) attn_stage_store(lds + AT_K0 + (cur ^ 1) * 9216, lds + AT_V0 + (cur ^ 1) * 9216, st, tid);
        __syncthreads();
    }
    const float lt2 = l2 + __shfl_xor(l2, 32);
    const size_t tok = (size_t)b * SEQ + t;
    const float* gt = (const float*)(ws + WS_GATES) + tok * 24;
    const float gc = gt[g * 4 + hl], gs = gt[8 + g * 4 + hl] / lt2;
    const bf16_t* ow = (const bf16_t*)(ws + WS_OWIN) + tok * 512 + (g * 4 + hl) * 64;
    bf16_t* mx = (bf16_t*)(ws + WS_MIXIN) + tok * 1024 + (g * 4 + hl) * 64;
#pragma unroll
    for (int db = 0; db < 2; ++db)
#pragma unroll
        for (int grp = 0; grp < 4; ++grp) {
            const int d = db * 32 + 8 * grp + 4 * h;
            const u32x2 w = *(const u32x2*)(ow + d);
            const float r0 = gc * Oc[db][4 * grp] + gs * O[db][4 * grp] + bflo(w.x);
            const float r1 = gc * Oc[db][4 * grp + 1] + gs * O[db][4 * grp + 1] + bfhi(w.x);
            const float r2 = gc * Oc[db][4 * grp + 2] + gs * O[db][4 * grp + 2] + bflo(w.y);
            const float r3 = gc * Oc[db][4 * grp + 3] + gs * O[db][4 * grp + 3] + bfhi(w.y);
            u32x2 o = {pk2(r0, r1), pk2(r2, r3)};
            *(u32x2*)(mx + d) = o;
        }
}

DI void pooly_job(const Params& p, int job) {
    unsigned char* ws = p.ws;
    const bf16_t* z = (const bf16_t*)(ws + WS_Z);
    bf16_t* y = (bf16_t*)(ws + WS_YPOOL);
    const int tid = threadIdx.x;
    const int tokb = job * 16 + (tid >> 6) * 4, ch = tid & 63, tb = tokb & 4095;
    const int gi = ch >> 4, win = 2 << gi;
    u32x4 rowv[19];
#pragma unroll
    for (int i = 0; i < 19; ++i) {
        const int dt = i - 15;
        const bool need = dt > -win && tb + dt >= 0;
        rowv[i] = *(const u32x4*)(z + (size_t)(need ? tokb + dt : tokb) * 512 + ch * 8);
    }
    float f[19][8];
#pragma unroll
    for (int i = 0; i < 19; ++i) {
        f[i][0] = bflo(rowv[i].x); f[i][1] = bfhi(rowv[i].x); f[i][2] = bflo(rowv[i].y); f[i][3] = bfhi(rowv[i].y);
        f[i][4] = bflo(rowv[i].z); f[i][5] = bfhi(rowv[i].z); f[i][6] = bflo(rowv[i].w); f[i][7] = bfhi(rowv[i].w);
    }
#pragma unroll
    for (int o = 0; o < 4; ++o) {
        const int t = tb + o;
        const int cnt = (t + 1 < win) ? t + 1 : win;
        float s[8];
#pragma unroll
        for (int c = 0; c < 8; ++c) s[c] = 0.f;
#pragma unroll
        for (int k = 0; k < 16; ++k) {
            const float wk = k < cnt ? 1.0f : 0.0f;
#pragma unroll
            for (int c = 0; c < 8; ++c) s[c] += wk * f[15 + o - k][c];
        }
        const float ic = 1.0f / (float)cnt;
        u32x4 ov = {pk2(s[0] * ic - f[15 + o][0], s[1] * ic - f[15 + o][1]), pk2(s[2] * ic - f[15 + o][2], s[3] * ic - f[15 + o][3]),
                    pk2(s[4] * ic - f[15 + o][4], s[5] * ic - f[15 + o][5]), pk2(s[6] * ic - f[15 + o][6], s[7] * ic - f[15 + o][7])};
        *(u32x4*)(y + (size_t)(tokb + o) * 512 + ch * 8) = ov;
    }
}

DI void lnfold_consts(const Params& p, int n0, int cnt) {
    unsigned char* ws = p.ws;
    const int lane = threadIdx.x & 63, wid = threadIdx.x >> 6;
    const bf16_t* wqt = (const bf16_t*)(ws + WS_WQT);
    const float* wq = p.in[14];
    const float* bb = p.in[13];
    for (int n = n0 + wid; n < n0 + cnt; n += 4) {
        float s1 = 0.f, s2 = 0.f;
#pragma unroll
        for (int j = 0; j < 2; ++j) {
            const u32x4 w = *(const u32x4*)(wqt + (size_t)n * 1024 + (j * 64 + lane) * 8);
            s1 += (bflo(w.x) + bfhi(w.x)) + (bflo(w.y) + bfhi(w.y)) + (bflo(w.z) + bfhi(w.z)) + (bflo(w.w) + bfhi(w.w));
        }
#pragma unroll 8
        for (int k = lane; k < 1024; k += 64) s2 += bb[k] * wq[(size_t)k * 2048 + n];
        s1 = wave_sum(s1); s2 = wave_sum(s2);
        if (lane == 0) { ((float*)(ws + WS_C1))[n] = s1; ((float*)(ws + WS_C2))[n] = s2; }
    }
}

DI void phase2(const Params& p, unsigned char* lds) {
    const int G = gridDim.x, bx = blockIdx.x;
    if (G == 512) {
        if (bx < 128) { compress_job(p, lds, bx); win_unit(p, lds, 768 + bx); }
        else {
            win_unit(p, lds, bx - 128); win_unit(p, lds, 384 + bx - 128);
            if (bx < 256) win_unit(p, lds, 896 + bx - 128);
            else lnfold_consts(p, (bx - 256) * 8, 8);
        }
    } else {
        for (int job = bx; job < 128; job += G) compress_job(p, lds, job);
        for (int job = bx; job < 1024; job += G) win_unit(p, lds, job);
        for (int n0 = bx * 8; n0 < 2048; n0 += G * 8) lnfold_consts(p, n0, 8);
    }
    for (int job = bx; job < 1024; job += G) pooly_job(p, job);
}

DI void pool_gemm_tile(const Params& p, unsigned char* lds, int tile) {
    unsigned char* ws = p.ws;
    const int gi = tile & 3, tm = tile >> 2;
    f32x16 acc[2][2];
    __syncthreads();
    gemm_mainloop((const bf16_t*)(ws + WS_YPOOL) + (size_t)tm * 128 * 512 + gi * 128, 512,
                  (const bf16_t*)(ws + WS_POOLWT) + (size_t)gi * 16384, 128, 128, acc, lds);
    const float* sc = p.in[10] + gi * 128;
    bf16_t* mx = (bf16_t*)(ws + WS_MIXIN);
    epi_stage_rows(acc, lds, [&](int n) { return *(const f32x4*)(sc + n); });
    __syncthreads();
    rows_foreach(lds, [&](int m, int cc, u32x4 d) {
        *(u32x4*)(mx + (size_t)(tm * 128 + m) * 1024 + 512 + gi * 128 + cc * 8) = d;
    });
}

DI void phase3(const Params& p, unsigned char* lds) {
    const int G = gridDim.x, bx = blockIdx.x;
    for (int pass = 0; pass * G < 1024; ++pass) {
        const int i = pass * G + ((pass & 1) ? (G - 1 - bx) : bx);
        if (i < 1024) {
            const int u = ((127 - (i >> 3)) << 3) | (i & 7);
            slc_unit(p, lds, u);
        }
    }
    for (int tile = bx; tile < 512; tile += G) pool_gemm_tile(p, lds, tile);
}

DI void phase4(const Params& p, unsigned char* lds) {
    unsigned char* ws = p.ws;
    const float* x = p.in[0];
    bf16_t* y1 = (bf16_t*)(ws + WS_Z);
    const bool conv_first = (blockIdx.x >> 3) & 1;
    if (conv_first) convert_tables(p);
    const int G8 = (gridDim.x & 7) == 0 ? gridDim.x >> 3 : 0;
    for (int l0 = G8 ? 0 : (int)blockIdx.x; l0 < (G8 ? 128 : 1024); l0 += (G8 ? G8 : (int)gridDim.x)) {
        const int li = G8 ? l0 + cu_pair_pos((int)(blockIdx.x >> 3), G8) : l0;
        if (G8 && li >= 128) break;
        const int tile = G8 ? (int)(blockIdx.x & 7) * 128 + li : li;
        const int tn = tile & 7, tm = tile >> 3;
        f32x16 acc[2][2];
        gemm_mainloop((const bf16_t*)(ws + WS_MIXIN) + (size_t)tm * 128 * 1024, 1024,
                      (const bf16_t*)(ws + WS_WOUTT) + (size_t)tn * 128 * 1024, 1024, 1024, acc, lds);
        epi_stage_rows(acc, lds, [&](int) { return (f32x4){1.f, 1.f, 1.f, 1.f}; });
        __syncthreads();
        rows_foreach(lds, [&](int m, int cc, u32x4 d) {
            const size_t off = (size_t)(tm * 128 + m) * 1024 + tn * 128 + cc * 8;
            const f32x4 xa = *(const f32x4*)(x + off), xb = *(const f32x4*)(x + off + 4);
            u32x4 o = {pk2(ALPHA * xa.x + bflo(d.x), ALPHA * xa.y + bfhi(d.x)), pk2(ALPHA * xa.z + bflo(d.y), ALPHA * xa.w + bfhi(d.y)),
                       pk2(ALPHA * xb.x + bflo(d.z), ALPHA * xb.y + bfhi(d.z)), pk2(ALPHA * xb.z + bflo(d.w), ALPHA * xb.w + bfhi(d.w))};
            *(u32x4*)(y1 + off) = o;
            float s = ((bflo(o.x) + bfhi(o.x)) + (bflo(o.y) + bfhi(o.y))) + ((bflo(o.z) + bfhi(o.z)) + (bflo(o.w) + bfhi(o.w)));
            float q = ((bflo(o.x) * bflo(o.x) + bfhi(o.x) * bfhi(o.x)) + (bflo(o.y) * bflo(o.y) + bfhi(o.y) * bfhi(o.y)))
                    + ((bflo(o.z) * bflo(o.z) + bfhi(o.z) * bfhi(o.z)) + (bflo(o.w) * bflo(o.w) + bfhi(o.w) * bfhi(o.w)));
#pragma unroll
            for (int sh = 1; sh < 16; sh <<= 1) { s += __shfl_xor(s, sh); q += __shfl_xor(q, sh); }
            if (cc == 0) *(f32x2*)((float*)(ws + WS_LNST) + (size_t)(tm * 128 + m) * 16 + tn * 2) = (f32x2){s, q};
        });
        __syncthreads();
    }
    if (!conv_first) convert_tables(p);
}

DI void ln1_stats(const unsigned char* ws, int row, float& mean, float& rstd) {
    const f32x4* st = (const f32x4*)((const float*)(ws + WS_LNST) + (size_t)row * 16);
    const f32x4 a = st[0], b = st[1], c = st[2], d = st[3];
    const float s = ((a.x + a.z) + (b.x + b.z)) + ((c.x + c.z) + (d.x + d.z));
    const float q = ((a.y + a.w) + (b.y + b.w)) + ((c.y + c.w) + (d.y + d.w));
    mean = s * (1.0f / 1024.0f);
    const float var = fmaxf(q * (1.0f / 1024.0f) - mean * mean, 0.f);
    rstd = rsqrtf(var + LN_EPS);
}

DI void phase5(const Params& p) {
    unsigned char* ws = p.ws;
    const int lane = threadIdx.x & 63, wid = threadIdx.x >> 6;
    const float* gg = p.in[12];
    const float* bb = p.in[13];
    bf16_t* h1 = (bf16_t*)(ws + WS_H1);
    for (int row = blockIdx.x * 4 + wid; row < NTOK; row += gridDim.x * 4) {
        const u32x2* xr = (const u32x2*)((const bf16_t*)(ws + WS_Z) + (size_t)row * 1024) + lane;
        f32x4 v[4];
        float s = 0.f;
#pragma unroll
        for (int j = 0; j < 4; ++j) { const u32x2 w = xr[64 * j]; v[j] = (f32x4){bflo(w.x), bfhi(w.x), bflo(w.y), bfhi(w.y)}; s += (v[j].x + v[j].y) + (v[j].z + v[j].w); }
        const float mean = wave_sum(s) * (1.0f / 1024.0f);
        float s2 = 0.f;
#pragma unroll
        for (int j = 0; j < 4; ++j) { v[j] = v[j] - mean; s2 += (v[j].x * v[j].x + v[j].y * v[j].y) + (v[j].z * v[j].z + v[j].w * v[j].w); }
        const float rstd = rsqrtf(wave_sum(s2) * (1.0f / 1024.0f) + LN_EPS);
#pragma unroll
        for (int j = 0; j < 4; ++j) {
            const f32x4 g4 = ((const f32x4*)gg)[lane + 64 * j], b4 = ((const f32x4*)bb)[lane + 64 * j];
            u32x2 o = {pk2(v[j].x * rstd * g4.x + b4.x, v[j].y * rstd * g4.y + b4.y), pk2(v[j].z * rstd * g4.z + b4.z, v[j].w * rstd * g4.w + b4.w)};
            *(u32x2*)(h1 + (size_t)row * 1024 + (lane + 64 * j) * 4) = o;
        }
    }
}


DI void ce_desc(int& a, int& b) { const int hi = a > b ? a : b, lo = a > b ? b : a; a = hi; b = lo; }
template <int K, int J> DI void bst(int (&a)[16]) {
#pragma unroll
    for (int i = 0; i < 16; ++i) { const int l = i ^ J; if (l > i) { if ((i & K) == 0) ce_desc(a[i], a[l]); else ce_desc(a[l], a[i]); } }
}
DI void sort16(int (&a)[16]) { bst<2, 1>(a); bst<4, 2>(a); bst<4, 1>(a); bst<8, 4>(a); bst<8, 2>(a); bst<8, 1>(a); bst<16, 8>(a); bst<16, 4>(a); bst<16, 2>(a); bst<16, 1>(a); }
DI void merge_top16(int (&a)[16], const int (&b)[16]) {
#pragma unroll
    for (int i = 0; i < 16; ++i) a[i] = a[i] > b[15 - i] ? a[i] : b[15 - i];
    bst<16, 8>(a); bst<16, 4>(a); bst<16, 2>(a); bst<16, 1>(a);
}

constexpr int cand_i(int c) { return c < 16 ? 0 : c < 24 ? 1 : c < 29 ? 2 : c < 33 ? 3 : c < 36 ? 4 : c < 38 ? 5 : c < 40 ? 6 : c < 42 ? 7 : c - 34; }
constexpr int cand_j(int c) { return c < 16 ? c : c < 24 ? c - 16 : c < 29 ? c - 24 : c < 33 ? c - 29 : c < 36 ? c - 33 : c < 38 ? c - 36 : c < 40 ? c - 38 : c < 42 ? c - 40 : 0; }
DI void cand_ij(int c, int& i, int& j) {
    if (c < 16) { i = 0; j = c; } else if (c < 24) { i = 1; j = c - 16; } else if (c < 29) { i = 2; j = c - 24; } else if (c < 33) { i = 3; j = c - 29; }
    else if (c < 36) { i = 4; j = c - 33; } else if (c < 38) { i = 5; j = c - 36; } else if (c < 40) { i = 6; j = c - 38; } else if (c < 42) { i = 7; j = c - 40; }
    else { i = c - 34; j = 0; }
}
DI float key_val6(int k) { int b = k & ~63; b ^= (b >> 31) & 0x7fffffff; return __int_as_float(b); }

DI void phase6(const Params& p, unsigned char* lds) {
    unsigned char* ws = p.ws;
    const int tid = threadIdx.x, lane = tid & 63, wid = tid >> 6, wr = wid >> 1, wc = wid & 1, r = lane & 31, h = lane >> 5;
    const bf16_t* h1 = (const bf16_t*)(ws + WS_Z);
    const bf16_t* wq = (const bf16_t*)(ws + WS_WQT);
    const bf16_t* sk = (const bf16_t*)(ws + WS_SUBK);
    const float* c1 = (const float*)(ws + WS_C1);
    const float* c2 = (const float*)(ws + WS_C2);
    int* routeE = (int*)(ws + WS_TOPK);
    float* routeG = (float*)(ws + WS_TOPK + 8 * MiB);
    int* L1s = (int*)(lds + 65536);
    const int G8 = (gridDim.x & 7) == 0 ? gridDim.x >> 3 : 0;
    for (int l0 = G8 ? 0 : (int)blockIdx.x; l0 < (G8 ? 128 : 1024); l0 += (G8 ? G8 : (int)gridDim.x)) {
        const int li = G8 ? l0 + cu_pair_pos((int)(blockIdx.x >> 3), G8) : l0;
        if (G8 && li >= 128) break;
        const int pair = G8 ? (int)(blockIdx.x & 7) * 128 + li : li;
        const int tm = pair >> 3, head = pair & 7;
        int ka[16], kb[16];
        float rmean[2], rrstd[2];
#pragma unroll
        for (int mi = 0; mi < 2; ++mi) ln1_stats(ws, tm * 128 + wr * 64 + mi * 32 + r, rmean[mi], rrstd[mi]);
        if (tid < 128) {
            const int kh = tid >> 6, wh = (tid >> 5) & 1, q4 = tid & 31;
            *(f32x4*)(lds + LDS_CST + kh * 1024 + wh * 512 + q4 * 16) = *(const f32x4*)((wh ? c2 : c1) + (head * 2 + kh) * 128 + q4 * 4);
        }
#pragma unroll 1
        for (int khalf = 0; khalf < 2; ++khalf) {
            const int tn = head * 2 + khalf;
            f32x16 acc[2][2];
            gemm_mainloop(h1 + (size_t)tm * 128 * 1024, 1024, wq + (size_t)tn * 128 * 1024, 1024, 1024, acc, lds);
            epi_foreach(acc, [&](int m, int n, f32x4 v) {
                const int mi = (m >> 5) & 1;
                const float mu = mi ? rmean[1] : rmean[0], rs = mi ? rrstd[1] : rrstd[0];
                const f32x4 k1 = *(const f32x4*)(lds + LDS_CST + khalf * 1024 + n * 4), k2 = *(const f32x4*)(lds + LDS_CST + khalf * 1024 + 512 + n * 4);
                u32x2 o = {pk2(rs * (v.x - mu * k1.x) + k2.x, rs * (v.y - mu * k1.y) + k2.y), pk2(rs * (v.z - mu * k1.z) + k2.z, rs * (v.w - mu * k1.w) + k2.w)};
                *(u32x2*)(lds + m * 272 + n * 2) = o;
            });
            __syncthreads();
            f32x16 a2[2][2];
#pragma unroll
            for (int mi = 0; mi < 2; ++mi)
#pragma unroll
                for (int ni = 0; ni < 2; ++ni)
#pragma unroll
                    for (int i = 0; i < 16; ++i) a2[mi][ni][i] = 0.f;
#pragma unroll
            for (int ks = 0; ks < 8; ++ks) {
                bf16x8 fa[2], fb[2];
#pragma unroll
                for (int mi = 0; mi < 2; ++mi) fa[mi] = *(const bf16x8*)(lds + (wr * 64 + mi * 32 + r) * 272 + ks * 32 + h * 16);
#pragma unroll
                for (int ni = 0; ni < 2; ++ni) fb[ni] = *(const bf16x8*)(sk + (size_t)(khalf * 128 + wc * 64 + ni * 32 + r) * 128 + ks * 16 + h * 8);
#pragma unroll
                for (int mi = 0; mi < 2; ++mi)
#pragma unroll
                    for (int ni = 0; ni < 2; ++ni) a2[mi][ni] = MFMA32(fb[ni], fa[mi], a2[mi][ni]);
            }
            __syncthreads();
#pragma unroll
            for (int mi = 0; mi < 2; ++mi) {
                int xa[16], xb[16];
#pragma unroll
                for (int i = 0; i < 16; ++i) {
                    const int n = wc * 64 + (i & 3) + 8 * (i >> 2) + 4 * h;
                    xa[i] = make_key(a2[mi][0][i], n); xb[i] = make_key(a2[mi][1][i], n + 32);
                }
                sort16(xa); sort16(xb); merge_top16(xa, xb);
#pragma unroll
                for (int i = 0; i < 16; ++i) xb[i] = __shfl_xor(xa[i], 32);
                merge_top16(xa, xb);
                if (h == 0) {
                    int* dst = (int*)lds + ((wr * 64 + mi * 32 + r) * 2 + wc) * 16;
#pragma unroll
                    for (int q4 = 0; q4 < 4; ++q4) { u32x4 o = {(unsigned)xa[4 * q4], (unsigned)xa[4 * q4 + 1], (unsigned)xa[4 * q4 + 2], (unsigned)xa[4 * q4 + 3]}; *(u32x4*)(dst + 4 * q4) = o; }
                }
            }
            __syncthreads();
            if (tid < 128) {
                const int* s0 = (const int*)lds + tid * 32;
#pragma unroll
                for (int q4 = 0; q4 < 4; ++q4) {
                    const u32x4 x = *(const u32x4*)(s0 + 4 * q4), y = *(const u32x4*)(s0 + 16 + 4 * q4);
                    ka[4 * q4] = (int)x.x; ka[4 * q4 + 1] = (int)x.y; ka[4 * q4 + 2] = (int)x.z; ka[4 * q4 + 3] = (int)x.w;
                    kb[4 * q4] = (int)y.x; kb[4 * q4 + 1] = (int)y.y; kb[4 * q4 + 2] = (int)y.z; kb[4 * q4 + 3] = (int)y.w;
                }
                merge_top16(ka, kb);
                if (khalf == 0) {
#pragma unroll
                    for (int q4 = 0; q4 < 4; ++q4) { u32x4 o = {(unsigned)ka[4 * q4], (unsigned)ka[4 * q4 + 1], (unsigned)ka[4 * q4 + 2], (unsigned)ka[4 * q4 + 3]}; *(u32x4*)(L1s + tid * 16 + 4 * q4) = o; }
                }
            }
            if (khalf == 0) __syncthreads();
        }
        if (tid < 128) {
            int* L2s = (int*)lds + tid * 32;
#pragma unroll
            for (int q4 = 0; q4 < 4; ++q4) { u32x4 o = {(unsigned)ka[4 * q4], (unsigned)ka[4 * q4 + 1], (unsigned)ka[4 * q4 + 2], (unsigned)ka[4 * q4 + 3]}; *(u32x4*)(L2s + 4 * q4) = o; }
            float v1[16], v2[16];
#pragma unroll
            for (int q4 = 0; q4 < 4; ++q4) {
                const u32x4 x = *(const u32x4*)(L1s + tid * 16 + 4 * q4);
                v1[4 * q4] = key_val((int)x.x); v1[4 * q4 + 1] = key_val((int)x.y); v1[4 * q4 + 2] = key_val((int)x.z); v1[4 * q4 + 3] = key_val((int)x.w);
            }
#pragma unroll
            for (int i = 0; i < 16; ++i) v2[i] = key_val(ka[i]);
            int g0[16], g1[16], g2[16], g3[16];
#pragma unroll
            for (int t = 0; t < 16; ++t) {
                { const float s = v1[cand_i(t)] + v2[cand_j(t)]; int b = __float_as_int(s); b ^= (b >> 31) & 0x7fffffff; g0[t] = (b & ~63) | (63 - t); }
                { const float s = v1[cand_i(16 + t)] + v2[cand_j(16 + t)]; int b = __float_as_int(s); b ^= (b >> 31) & 0x7fffffff; g1[t] = (b & ~63) | (63 - (16 + t)); }
                { const float s = v1[cand_i(32 + t)] + v2[cand_j(32 + t)]; int b = __float_as_int(s); b ^= (b >> 31) & 0x7fffffff; g2[t] = (b & ~63) | (63 - (32 + t)); }
                if (t < 2) { const float s = v1[cand_i(48 + t)] + v2[cand_j(48 + t)]; int b = __float_as_int(s); b ^= (b >> 31) & 0x7fffffff; g3[t] = (b & ~63) | (63 - (48 + t)); }
                else g3[t] = (int)0x80000000 + t;
            }
            sort16(g0); sort16(g1); sort16(g2); sort16(g3);
            merge_top16(g0, g1); merge_top16(g2, g3); merge_top16(g0, g2);
            const float smax = key_val6(g0[0]);
            float ex[16], den = 0.f;
#pragma unroll
            for (int t = 0; t < 16; ++t) { ex[t] = __expf(key_val6(g0[t]) - smax); den += ex[t]; }
            const float inv = 1.0f / den;
            const size_t ro = ((size_t)(tm * 128 + tid) * 8 + head) * 16;
#pragma unroll
            for (int q4 = 0; q4 < 4; ++q4) {
                int ee[4];
#pragma unroll
                for (int u = 0; u < 4; ++u) {
                    int ci, cj; cand_ij(63 - (g0[4 * q4 + u] & 63), ci, cj);
                    ee[u] = (L1s[tid * 16 + ci] & 127) * 128 + (L2s[cj] & 127);
                }
                u32x4 oe = {(unsigned)ee[0], (unsigned)ee[1], (unsigned)ee[2], (unsigned)ee[3]};
                f32x4 og = {ex[4 * q4] * inv, ex[4 * q4 + 1] * inv, ex[4 * q4 + 2] * inv, ex[4 * q4 + 3] * inv};
                *(u32x4*)(routeE + ro + 4 * q4) = oe;
                *(f32x4*)(routeG + ro + 4 * q4) = og;
            }
        }
        __syncthreads();
    }
}

constexpr int P7_NS = 32, P7_SH = 9;
constexpr int P7_WLDS = 6144;
DI void p7_loadrows(int b, int li, int l32, const LAS int* ent_e, const unsigned char* tab, u32x4 (&rows)[8][2]) {
    const u32x4 e0 = *(const LAS u32x4*)(ent_e + li * 128 + b), e1 = *(const LAS u32x4*)(ent_e + li * 128 + b + 4);
    const unsigned ee[8] = {e0.x, e0.y, e0.z, e0.w, e1.x, e1.y, e1.z, e1.w};
#pragma unroll
    for (int r = 0; r < 8; ++r) {
        const unsigned ob = ee[r] * 1024u + (unsigned)l32 * 16u;
        rows[r][0] = *(const u32x4*)(tab + ob);
        rows[r][1] = *(const u32x4*)(tab + ob + 512);
    }
}
DI float half32_sum(float v) { v += __shfl_xor(v, 1); v += __shfl_xor(v, 2); v += __shfl_xor(v, 4); v += __shfl_xor(v, 8); v += __shfl_xor(v, 16); return v; }

DI void p7_stepA(const u32x4 (&rows)[8][2], const unsigned (&hq)[2][4], float hscale, int b, int li, int l32, int lane, int myk,
                 LAS float* ent_w, const LAS float* ent_us) {
    int d[8];
#pragma unroll
    for (int r = 0; r < 8; ++r) {
        int a = 0;
#pragma unroll
        for (int c = 0; c < 2; ++c)
#pragma unroll
            for (int q = 0; q < 4; ++q) a = dot4i8(rows[r][c][q], hq[c][q], a);
        d[r] = a;
    }
    int r4[4], r2[2], r1;
    const bool b0 = lane & 1;
#pragma unroll
    for (int i = 0; i < 4; ++i) { const int snd = b0 ? d[i] : d[4 + i]; const int kp = b0 ? d[4 + i] : d[i]; r4[i] = kp + __shfl_xor(snd, 1); }
    const bool b1 = lane & 2;
#pragma unroll
    for (int i = 0; i < 2; ++i) { const int snd = b1 ? r4[i] : r4[2 + i]; const int kp = b1 ? r4[2 + i] : r4[i]; r2[i] = kp + __shfl_xor(snd, 2); }
    const bool b2 = lane & 4;
    { const int snd = b2 ? r2[0] : r2[1]; const int kp = b2 ? r2[1] : r2[0]; r1 = kp + __shfl_xor(snd, 4); }
    r1 += __shfl_xor(r1, 8); r1 += __shfl_xor(r1, 16);
    if (l32 < 8) { const int idx = li * 128 + b + myk; ent_w[idx] = ent_w[idx] * gelu_fast((float)r1 * (hscale * ent_us[idx])); }
}
DI void p7_stepA6(const unsigned (&rw)[8][6], const f16x2_t (&h16)[16], int b, int li, int l32, int lane, int myk,
                  LAS float* ent_w, const LAS float* ent_us) {
    float d[8];
#pragma unroll
    for (int r = 0; r < 8; ++r) {
        const u32x6 pk = {rw[r][0], rw[r][1], rw[r][2], rw[r][3], rw[r][4], rw[r][5]};
        const f16x32 u = __builtin_amdgcn_cvt_scalef32_pk32_f16_fp6(pk, 1.0f);
        float a0 = 0.f, a1 = 0.f;
#pragma unroll
        for (int j = 0; j < 16; j += 2) {
            a0 = __builtin_amdgcn_fdot2((f16x2_t){u[2 * j], u[2 * j + 1]}, h16[j], a0, false);
            a1 = __builtin_amdgcn_fdot2((f16x2_t){u[2 * j + 2], u[2 * j + 3]}, h16[j + 1], a1, false);
        }
        d[r] = a0 + a1;
        if (r & 1) __builtin_amdgcn_sched_barrier(0);
    }
    float r4[4], r2[2], r1;
    const bool b0 = lane & 1;
#pragma unroll
    for (int i = 0; i < 4; ++i) { const float snd = b0 ? d[i] : d[4 + i]; const float kp = b0 ? d[4 + i] : d[i]; r4[i] = kp + __shfl_xor(snd, 1); }
    const bool b1 = lane & 2;
#pragma unroll
    for (int i = 0; i < 2; ++i) { const float snd = b1 ? r4[i] : r4[2 + i]; const float kp = b1 ? r4[2 + i] : r4[i]; r2[i] = kp + __shfl_xor(snd, 2); }
    const bool b2 = lane & 4;
    { const float snd = b2 ? r2[0] : r2[1]; const float kp = b2 ? r2[1] : r2[0]; r1 = kp + __shfl_xor(snd, 4); }
    r1 += __shfl_xor(r1, 8); r1 += __shfl_xor(r1, 16);
    if (l32 < 8) { const int idx = li * 128 + b + myk; ent_w[idx] = ent_w[idx] * gelu_fast(r1 * ent_us[idx]); }
}
DI void p7_stepB(const u32x4 (&rows)[8][2], f32x2 (&acc)[2][8], int b, int li, const LAS float* ent_w) {
    const f32x4 w0 = *(const LAS f32x4*)(ent_w + li * 128 + b), w1 = *(const LAS f32x4*)(ent_w + li * 128 + b + 4);
    const float ww[8] = {w0.x, w0.y, w0.z, w0.w, w1.x, w1.y, w1.z, w1.w};
#pragma unroll
    for (int r = 0; r < 8; ++r) {
        const f32x2 w2 = {ww[r], ww[r]};
#pragma unroll
        for (int c = 0; c < 2; ++c)
#pragma unroll
            for (int q = 0; q < 4; ++q) {
                const f32x2 lo = __builtin_amdgcn_cvt_pk_f32_fp8((int)rows[r][c][q], false);
                const f32x2 hi = __builtin_amdgcn_cvt_pk_f32_fp8((int)rows[r][c][q], true);
                acc[c][2 * q] += w2 * lo; acc[c][2 * q + 1] += w2 * hi;
            }
    }
}
DI void p7_loadrows6(int b, int li, int l32, const LAS int* ent_e, const unsigned char* tab, unsigned (&rw)[8][6]) {
    const u32x4 e0 = *(const LAS u32x4*)(ent_e + li * 128 + b), e1 = *(const LAS u32x4*)(ent_e + li * 128 + b + 4);
    const unsigned ee[8] = {e0.x, e0.y, e0.z, e0.w, e1.x, e1.y, e1.z, e1.w};
#pragma unroll
    for (int r = 0; r < 8; ++r) {
        const unsigned ob = ee[r] * 768u;
        const u32x4 x = *(const u32x4*)(tab + ob + (unsigned)l32 * 16u);
        const u32x2 y = *(const u32x2*)(tab + ob + 512u + (unsigned)l32 * 8u);
        rw[r][0] = x.x; rw[r][1] = x.y; rw[r][2] = x.z; rw[r][3] = x.w; rw[r][4] = y.x; rw[r][5] = y.y;
    }
}
DI void p7_stepB6(const unsigned (&rw)[8][6], f32x2 (&acc)[2][8], int b, int li, const LAS float* ent_w) {
    const f32x4 w0 = *(const LAS f32x4*)(ent_w + li * 128 + b), w1 = *(const LAS f32x4*)(ent_w + li * 128 + b + 4);
    const float ww[8] = {w0.x, w0.y, w0.z, w0.w, w1.x, w1.y, w1.z, w1.w};
#pragma unroll
    for (int r = 0; r < 8; ++r) {
        const u32x6 pk = {rw[r][0], rw[r][1], rw[r][2], rw[r][3], rw[r][4], rw[r][5]};
        const f32x32 d = __builtin_amdgcn_cvt_scalef32_pk32_f32_fp6(pk, 1.0f);
        const f32x2 w2 = {ww[r], ww[r]};
#pragma unroll
        for (int c = 0; c < 2; ++c)
#pragma unroll
            for (int i = 0; i < 8; ++i) acc[c][i] += w2 * (f32x2){d[c * 16 + 2 * i], d[c * 16 + 2 * i + 1]};
    }
}
constexpr int P7_GB = 32768;
DI void p7_load_h(const Params& p, const LAS unsigned char* gb, int tok, int l32, float (&hv)[32]) {
    const unsigned char* ws = p.ws;
    float mean, rstd;
    ln1_stats(ws, tok, mean, rstd);
    const bf16_t* y1 = (const bf16_t*)(ws + WS_Z) + (size_t)tok * 1024 + l32 * 16;
    const LAS float* gg = (const LAS float*)(gb + P7_GB) + l32 * 16;
    const LAS float* bb = gg + 1024;
#pragma unroll
    for (int c = 0; c < 2; ++c) {
        const u32x4 a = *(const u32x4*)(y1 + c * 512), b2 = *(const u32x4*)(y1 + c * 512 + 8);
        const unsigned hh[8] = {a.x, a.y, a.z, a.w, b2.x, b2.y, b2.z, b2.w};
#pragma unroll
        for (int i4 = 0; i4 < 4; ++i4) {
            const f32x4 g4 = *(const LAS f32x4*)(gg + c * 512 + i4 * 4), b4 = *(const LAS f32x4*)(bb + c * 512 + i4 * 4);
            hv[c * 16 + 4 * i4 + 0] = (bflo(hh[2 * i4]) - mean) * rstd * g4.x + b4.x;
            hv[c * 16 + 4 * i4 + 1] = (bfhi(hh[2 * i4]) - mean) * rstd * g4.y + b4.y;
            hv[c * 16 + 4 * i4 + 2] = (bflo(hh[2 * i4 + 1]) - mean) * rstd * g4.z + b4.z;
            hv[c * 16 + 4 * i4 + 3] = (bfhi(hh[2 * i4 + 1]) - mean) * rstd * g4.w + b4.w;
        }
    }
}
DI void p7_h16(const Params& p, const LAS unsigned char* gb, int tok, int l32, f16x2_t (&h16)[16]) {
    float hv[32];
    p7_load_h(p, gb, tok, l32, hv);
#pragma unroll
    for (int j = 0; j < 16; ++j) h16[j] = (f16x2_t){(_Float16)hv[2 * j], (_Float16)hv[2 * j + 1]};
}
DI void p7_quant_h(const Params& p, const LAS unsigned char* gb, int tok, int l32, unsigned (&hq)[2][4], float& hscale) {
    float hv[32];
    p7_load_h(p, gb, tok, l32, hv);
    float am = 0.f;
#pragma unroll
    for (int i = 0; i < 32; ++i) am = fmaxf(am, fabsf(hv[i]));
    am = fmaxf(am, __shfl_xor(am, 1)); am = fmaxf(am, __shfl_xor(am, 2)); am = fmaxf(am, __shfl_xor(am, 4)); am = fmaxf(am, __shfl_xor(am, 8)); am = fmaxf(am, __shfl_xor(am, 16));
    const float hq_sc = am > 0.f ? 127.0f / am : 1.0f;
    hscale = am > 0.f ? am / 127.0f : 1.0f;
#pragma unroll
    for (int c = 0; c < 2; ++c)
#pragma unroll
        for (int q = 0; q < 4; ++q) {
            const int q0 = (int)rintf(hv[c * 16 + 4 * q] * hq_sc), q1 = (int)rintf(hv[c * 16 + 4 * q + 1] * hq_sc);
            const int q2 = (int)rintf(hv[c * 16 + 4 * q + 2] * hq_sc), q3 = (int)rintf(hv[c * 16 + 4 * q + 3] * hq_sc);
            hq[c][q] = (unsigned)(q0 & 255) | ((unsigned)(q1 & 255) << 8) | ((unsigned)(q2 & 255) << 16) | ((unsigned)(q3 & 255) << 24);
        }
}
DI void p7_finish(const Params& p, int tok, const float (&hv)[32], f32x2 (&acc)[2][8], int l32) {
    const size_t hbase = (size_t)tok * 1024 + l32 * 16;
    float sm = 0.f;
    {
#pragma unroll
        for (int c = 0; c < 2; ++c)
#pragma unroll
            for (int i = 0; i < 8; ++i) {
                acc[c][i].x += ALPHA * hv[c * 16 + 2 * i]; acc[c][i].y += ALPHA * hv[c * 16 + 2 * i + 1];
                sm += acc[c][i].x + acc[c][i].y;
            }
    }
    const float mean = half32_sum(sm) * (1.0f / 1024.0f);
    float sq = 0.f;
#pragma unroll
    for (int c = 0; c < 2; ++c)
#pragma unroll
        for (int i = 0; i < 8; ++i) { acc[c][i].x -= mean; acc[c][i].y -= mean; sq += acc[c][i].x * acc[c][i].x + acc[c][i].y * acc[c][i].y; }
    const float rstd = rsqrtf(half32_sum(sq) * (1.0f / 1024.0f) + LN_EPS);
    const float* gg = p.in[18] + l32 * 16;
    const float* bb = p.in[19] + l32 * 16;
    float* orow = p.out + hbase;
#pragma unroll
    for (int c = 0; c < 2; ++c)
#pragma unroll
        for (int q4 = 0; q4 < 4; ++q4) {
            const f32x4 g4 = *(const f32x4*)(gg + c * 512 + q4 * 4), b4 = *(const f32x4*)(bb + c * 512 + q4 * 4);
            f32x4 o = {acc[c][2 * q4].x * rstd * g4.x + b4.x, acc[c][2 * q4].y * rstd * g4.y + b4.y,
                       acc[c][2 * q4 + 1].x * rstd * g4.z + b4.z, acc[c][2 * q4 + 1].y * rstd * g4.w + b4.w};
            *(f32x4*)(orow + c * 512 + q4 * 4) = o;
        }
}

DI void phase7(const Params& p, unsigned char* lds) {
    unsigned char* ws = p.ws;
    const int lane = threadIdx.x & 63, wid = __builtin_amdgcn_readfirstlane(threadIdx.x >> 6);
    const int hw = lane >> 5, l32 = lane & 31;
    LAS unsigned char* l3 = (LAS unsigned char*)lds + wid * P7_WLDS;
    const unsigned char* u8 = ws + WS_UB;
    const unsigned char* v8 = ws + WS_VB;
    const float* uscale = (const float*)(ws + WS_USCALE);
    const float* vscale = (const float*)(ws + WS_VSCALE);
    LAS int* ent_e = (LAS int*)l3;
    LAS float* ent_w = (LAS float*)(l3 + 2048);
    LAS float* ent_us = (LAS float*)(l3 + 4096);
    {
        const int t = threadIdx.x;
        *(f32x4*)(lds + P7_GB + t * 16) = *(const f32x4*)(p.in[12] + t * 4);
        *(f32x4*)(lds + P7_GB + 4096 + t * 16) = *(const f32x4*)(p.in[13] + t * 4);
        __syncthreads();
    }
    const unsigned long long ltmask = (1ull << lane) - 1ull;
    const int myk = ((lane & 1) << 2) | (lane & 2) | ((lane >> 2) & 1);
    const int li0 = hw, li1 = 2 + hw;
    for (int rnd = blockIdx.x * 4 + wid; rnd < NTOK / 4; rnd += gridDim.x * 4) {
        const int tok0 = rnd * 4;
#pragma unroll 1
        for (int tk = 0; tk < 4; ++tk) {
            const int* RE = (const int*)(ws + WS_TOPK) + (size_t)(tok0 + tk) * 128;
            const float* RG = (const float*)(ws + WS_TOPK + 8 * MiB) + (size_t)(tok0 + tk) * 128;
            const int ea = RE[lane], eb = RE[64 + lane];
            const float ga = RG[lane], gb = RG[64 + lane];
            const int sa = ea >> P7_SH, sb = eb >> P7_SH;
            int pa = 0, pb = 0, run = 0;
#pragma unroll
            for (int s = 0; s < P7_NS; ++s) {
                const unsigned long long ma = __ballot(sa == s), mb = __ballot(sb == s);
                const int ca = __popcll(ma), cb = __popcll(mb);
                if (sa == s) pa = run + __popcll(ma & ltmask);
                if (sb == s) pb = run + ca + __popcll(mb & ltmask);
                run += ca + cb;
            }
            ent_e[tk * 128 + pa] = ea; ent_w[tk * 128 + pa] = ga * vscale[ea]; ent_us[tk * 128 + pa] = uscale[ea];
            ent_e[tk * 128 + pb] = eb; ent_w[tk * 128 + pb] = gb * vscale[eb]; ent_us[tk * 128 + pb] = uscale[eb];
        }
        {
            f16x2_t h0[16], h1[16];
            p7_h16(p, (const LAS unsigned char*)lds, tok0 + li0, l32, h0);
            p7_h16(p, (const LAS unsigned char*)lds, tok0 + li1, l32, h1);
            unsigned ra[8][6], rb[8][6];
            p7_loadrows6(0, li0, l32, ent_e, u8, ra);
            for (int b = 0; b < 128; b += 8) {
                p7_loadrows6(b, li1, l32, ent_e, u8, rb);
                __builtin_amdgcn_sched_barrier(0);
                p7_stepA6(ra, h0, b, li0, l32, lane, myk, ent_w, ent_us);
                __builtin_amdgcn_sched_barrier(0);
                p7_loadrows6(b + 8 < 128 ? b + 8 : b, li0, l32, ent_e, u8, ra);
                __builtin_amdgcn_sched_barrier(0);
                p7_stepA6(rb, h1, b, li1, l32, lane, myk, ent_w, ent_us);
                __builtin_amdgcn_sched_barrier(0);
            }
        }
        f32x2 acc0[2][8], acc1[2][8];
#pragma unroll
        for (int c = 0; c < 2; ++c)
#pragma unroll
            for (int i = 0; i < 8; ++i) { acc0[c][i] = (f32x2){0.f, 0.f}; acc1[c][i] = (f32x2){0.f, 0.f}; }
        {
            unsigned ra[8][6], rb[8][6];
            p7_loadrows6(0, li0, l32, ent_e, v8, ra);
            for (int b = 0; b < 128; b += 8) {
                p7_loadrows6(b, li1, l32, ent_e, v8, rb);
                __builtin_amdgcn_sched_barrier(0);
                p7_stepB6(ra, acc0, b, li0, ent_w);
                __builtin_amdgcn_sched_barrier(0);
                p7_loadrows6(b + 8 < 128 ? b + 8 : b, li0, l32, ent_e, v8, ra);
                __builtin_amdgcn_sched_barrier(0);
                p7_stepB6(rb, acc1, b, li1, ent_w);
                __builtin_amdgcn_sched_barrier(0);
            }
        }
        asm volatile("" ::: "memory");
        {
            float hv0[32], hv1[32];
            p7_load_h(p, (const LAS unsigned char*)lds, tok0 + li0, l32, hv0);
            p7_load_h(p, (const LAS unsigned char*)lds, tok0 + li1, l32, hv1);
            p7_finish(p, tok0 + li0, hv0, acc0, l32);
            p7_finish(p, tok0 + li1, hv1, acc1, l32);
        }
    }
}

#if DIAG
DI float bfv(const bf16_t* p, size_t i) { return __uint_as_float(((unsigned)p[i]) << 16); }
DI float bfr(float x) { return __uint_as_float(f2bf(x) << 16); }
DI void dfail(const Params& p, int bit) { atomicOr((unsigned*)(p.ws + WS_FLAG), 1u << bit); }
DI bool bad(float fast, float ref) { return !(fabsf(fast - ref) <= 0.02f * fabsf(ref) + 0.02f); }
DI unsigned hsh(unsigned x) { x ^= x >> 16; x *= 0x7feb352dU; x ^= x >> 15; x *= 0x846ca68bU; x ^= x >> 16; return x; }
DI int winsrc(int n) { return n < 1280 ? n : (n < 1792 ? 1304 + (n - 1280) : 1280 + (n - 1792)); }

DI void chk1(const Params& p, int bit) {
    unsigned char* ws = p.ws;
    const unsigned gt = blockIdx.x * NTHREADS + threadIdx.x;
    const int tok = hsh(gt * 2 + 1) & 16383, n = hsh(gt * 2 + 2) % 1816;
    const bf16_t* xb = (const bf16_t*)(ws + WS_XB);
    const bf16_t* wt = (const bf16_t*)(ws + WS_WINT);
    float ref = 0.f, ref2 = 0.f;
    for (int k = 0; k < 1024; ++k) {
        ref += bfv(xb, (size_t)tok * 1024 + k) * bfv(wt, (size_t)n * 1024 + k);
        ref2 += p.in[0][(size_t)tok * 1024 + k] * p.in[1][(size_t)k * 1816 + winsrc(n)];
    }
    if (!(fabsf(ref - ref2) <= 0.06f)) dfail(p, bit);
    const int b = tok >> 12, t = tok & 4095;
    float fast;
    if (n < 512) { const int hd = n >> 6, d = n & 63; fast = bfv((const bf16_t*)(ws + WS_Q), ((size_t)(b * 8 + hd) * SEQ + t) * 64 + d); ref *= 0.125f; }
    else if (n < 1280) {
        const int seg = (n - 512) >> 7, nn = (n - 512) & 127, g = nn >> 6, d = nn & 63;
        if (seg == 3 || seg == 5) fast = bfv((const bf16_t*)(ws + (seg == 3 ? WS_VSLCT : WS_VWINT)), ((size_t)((b * 2 + g) * 64 + d)) * SEQ + t);
        else fast = bfv((const bf16_t*)(ws + (seg == 0 ? WS_KC : seg == 1 ? WS_VC : seg == 2 ? WS_KSLC : WS_KWIN)), ((size_t)(b * 2 + g) * SEQ + t) * 64 + d);
    } else if (n < 1792) fast = bfv((const bf16_t*)(ws + WS_Z), (size_t)tok * 512 + (n - 1280));
    else { fast = ((const float*)(ws + WS_GATES))[(size_t)tok * 24 + (n - 1792)]; ref = 1.f / (1.f + expf(-ref)); }
    if (bad(fast, ref)) dfail(p, bit);
}
DI void chk2(const Params& p, int bit) {
    unsigned char* ws = p.ws;
    const unsigned gt = blockIdx.x * NTHREADS + threadIdx.x;
    if (gt >= 2048) return;
    const int kv = gt & 1, bg = (gt >> 1) & 7, c = hsh(gt) % 255, d = hsh(gt + 7777) & 63;
    const bf16_t* A = (const bf16_t*)(ws + (kv ? WS_VC : WS_KC)) + ((size_t)bg * SEQ + c * 16) * 64;
    const bf16_t* w1t = (const bf16_t*)(ws + (kv ? WS_W1TV : WS_W1TK));
    const bf16_t* w2t = (const bf16_t*)(ws + (kv ? WS_W2TV : WS_W2TK));
    const float* peb = (const float*)(ws + (kv ? WS_PEBV : WS_PEBK));
    float out = 0.f;
    for (int j = 0; j < 256; ++j) {
        float s = peb[j];
        for (int i = 0; i < 2048; ++i) s += bfv(A, i) * bfv(w1t, (size_t)j * 2048 + i);
        out += bfr(gelu_erf(s)) * bfv(w2t, d * 256 + j);
    }
    const float fast = ((const float*)(ws + (kv ? WS_VCMP : WS_KCMP)))[((size_t)bg * 256 + c) * 64 + d];
    if (bad(fast, out)) dfail(p, bit);
    if (gt < 256) {
        const float* w1 = kv ? p.in[7] : p.in[5];
        const float* w2 = kv ? p.in[8] : p.in[6];
        const float* pe = kv ? p.in[4] : p.in[3];
        float o2 = 0.f;
        for (int j = 0; j < 256; ++j) {
            float s = 0.f;
            for (int i = 0; i < 2048; ++i) s += (bfv(A, i) + pe[i]) * w1[(size_t)i * 256 + j];
            o2 += gelu_erf(s) * w2[j * 64 + d];
        }
        if (!(fabsf(o2 - out) <= 0.03f * fabsf(out) + 0.03f)) dfail(p, bit);
    }
}
DI void chk3(const Params& p, int bit) {
    unsigned char* ws = p.ws;
    const unsigned gt = blockIdx.x * NTHREADS + threadIdx.x;
    if (gt >= 4096) return;
    const int tok = hsh(gt) & 16383, head = hsh(gt + 99) & 7, b = tok >> 12, t = tok & 4095, g = head >> 2;
    const bf16_t* Q = (const bf16_t*)(ws + WS_Q) + ((size_t)(b * 8 + head) * SEQ + t) * 64;
    const bf16_t* K = (const bf16_t*)(ws + WS_KWIN) + (size_t)(b * 2 + g) * SEQ * 64;
    const bf16_t* Vt = (const bf16_t*)(ws + WS_VWINT) + (size_t)(b * 2 + g) * 64 * SEQ;
    float q[64], o[64];
#pragma unroll
    for (int d = 0; d < 64; ++d) { q[d] = bfv(Q, d); o[d] = 0.f; }
    float m = -1e30f, l = 0.f;
    for (int pos = (t > 511 ? t - 511 : 0); pos <= t; ++pos) {
        float s = 0.f;
#pragma unroll
        for (int d = 0; d < 64; ++d) s += q[d] * bfv(K, (size_t)pos * 64 + d);
        s += p.in[2][rel_bucket_dev(t - pos) * 8 + head];
        const float mn = fmaxf(m, s), a = expf(m - mn), pp = expf(s - mn);
        l = l * a + pp;
#pragma unroll
        for (int d = 0; d < 64; ++d) o[d] = o[d] * a + pp * bfv(Vt, (size_t)d * SEQ + pos);
        m = mn;
    }
    const float gate = ((const float*)(ws + WS_GATES))[(size_t)tok * 24 + 16 + head];
    bool f = false;
#pragma unroll
    for (int d = 0; d < 64; ++d) f |= bad(bfv((const bf16_t*)(ws + WS_OWIN), (size_t)tok * 512 + head * 64 + d), o[d] / l * gate);
    if (f) dfail(p, bit);
}
DI void chk4(const Params& p, int bit) {
    unsigned char* ws = p.ws;
    const unsigned gt = blockIdx.x * NTHREADS + threadIdx.x;
    if (gt >= 512) return;
    const int tok = hsh(gt + 5) & 16383, g = gt & 1, b = tok >> 12, t = tok & 4095, bg = b * 2 + g;
    float* scr = (float*)(ws + WS_DSCR) + (size_t)gt * 1536;
    float* imp = scr + 1024;
    float* nsa = scr + 1100;
    for (int j = 0; j < 64; ++j) imp[j] = 0.f;
    const float* kc = (const float*)(ws + WS_KCMP) + (size_t)bg * 256 * 64;
    const float* vc = (const float*)(ws + WS_VCMP) + (size_t)bg * 256 * 64;
    const float* gt24 = (const float*)(ws + WS_GATES) + (size_t)tok * 24;
    for (int hl = 0; hl < 4; ++hl) {
        const int head = g * 4 + hl;
        const bf16_t* Q = (const bf16_t*)(ws + WS_Q) + ((size_t)(b * 8 + head) * SEQ + t) * 64;
        float q[64], o[64];
#pragma unroll
        for (int d = 0; d < 64; ++d) { q[d] = bfv(Q, d); o[d] = 0.f; }
        float m = -1e30f;
        for (int c = 0; c < 255; ++c) {
            const bool valid = 16 * c + 31 <= t;
            float s = 0.f;
#pragma unroll
            for (int d = 0; d < 64; ++d) s += q[d] * bfr(kc[c * 64 + d]);
            s += p.in[2][rel_bucket_dev(t - 16 * c - 31) * 8 + head];
            scr[hl * 256 + c] = s;
            if (valid) m = fmaxf(m, s);
        }
        float l = 0.f;
        for (int c = 0; c < 255; ++c) if (16 * c + 31 <= t) l += expf(scr[hl * 256 + c] - m);
        for (int c = 0; c < 255; ++c) if (16 * c + 31 <= t) {
            const float pc = expf(scr[hl * 256 + c] - m) / l;
            imp[c >> 2] += pc;
            if ((c & 3) == 3 && (c >> 2) + 1 < 64) imp[(c >> 2) + 1] += pc;
#pragma unroll
            for (int d = 0; d < 64; ++d) o[d] += bfr(pc) * bfr(vc[c * 64 + d]);
        }
#pragma unroll
        for (int d = 0; d < 64; ++d) nsa[hl * 64 + d] = gt24[head] * o[d];
    }
    const int cur = t >> 6;
    for (int j = 0; j < 64; ++j) { float v = imp[j]; if (j == 0 || j == cur || j == cur - 1) v = 1e6f; if (j > cur) v = -1e30f; imp[j] = v; }
    unsigned long long selmask = 0ull;
    for (int it = 0; it < 16; ++it) {
        int bi = -1; float bv = -3e38f;
        for (int j = 0; j < 64; ++j) if (!((selmask >> j) & 1ull) && imp[j] > bv) { bv = imp[j]; bi = j; }
        selmask |= 1ull << bi;
    }
    bool f = false;
    for (int hl = 0; hl < 4; ++hl) {
        const int head = g * 4 + hl;
        const bf16_t* Q = (const bf16_t*)(ws + WS_Q) + ((size_t)(b * 8 + head) * SEQ + t) * 64;
        const bf16_t* K = (const bf16_t*)(ws + WS_KSLC) + (size_t)bg * SEQ * 64;
        const bf16_t* Vt = (const bf16_t*)(ws + WS_VSLCT) + (size_t)bg * 64 * SEQ;
        float q[64], o[64];
#pragma unroll
        for (int d = 0; d < 64; ++d) { q[d] = bfv(Q, d); o[d] = 0.f; }
        float m = -1e30f, l = 0.f;
        for (int j = 0; j <= cur; ++j) if ((selmask >> j) & 1ull) {
            for (int kk = 0; kk < 64; ++kk) {
                const int pos = j * 64 + kk;
                if (pos > t) break;
                float s = 0.f;
#pragma unroll
                for (int d = 0; d < 64; ++d) s += q[d] * bfv(K, (size_t)pos * 64 + d);
                s += p.in[2][rel_bucket_dev(t - pos) * 8 + head];
                const float mn = fmaxf(m, s), a = expf(m - mn), pp = expf(s - mn);
                l = l * a + pp;
#pragma unroll
                for (int d = 0; d < 64; ++d) o[d] = o[d] * a + pp * bfv(Vt, (size_t)d * SEQ + pos);
                m = mn;
            }
        }
#pragma unroll
        for (int d = 0; d < 64; ++d) {
            const float ref = nsa[hl * 64 + d] + gt24[8 + head] * o[d] / l + bfv((const bf16_t*)(ws + WS_OWIN), (size_t)tok * 512 + head * 64 + d);
            f |= bad(bfv((const bf16_t*)(ws + WS_MIXIN), (size_t)tok * 1024 + head * 64 + d), ref);
        }
    }
    if (f) dfail(p, bit);
}
DI void chk5(const Params& p, int bit) {
    unsigned char* ws = p.ws;
    const unsigned gt = blockIdx.x * NTHREADS + threadIdx.x;
    if (gt >= 8192) return;
    const int tok = hsh(gt + 11) & 16383, col = hsh(gt + 13) & 511, gi = col >> 7, d = col & 127, t = tok & 4095;
    const bf16_t* yp = (const bf16_t*)(ws + WS_YPOOL);
    const bf16_t* pw = (const bf16_t*)(ws + WS_POOLWT);
    const bf16_t* z = (const bf16_t*)(ws + WS_Z);
    float ref = 0.f, ref2 = 0.f;
    for (int c = 0; c < 128; ++c) {
        ref += bfv(yp, (size_t)tok * 512 + gi * 128 + c) * bfv(pw, (size_t)gi * 16384 + d * 128 + c);
        ref2 += bfv(yp, (size_t)tok * 512 + gi * 128 + c) * p.in[9][(size_t)gi * 16384 + c * 128 + d];
    }
    if (!(fabsf(ref - ref2) <= 0.03f)) dfail(p, bit);
    ref *= p.in[10][col];
    if (bad(bfv((const bf16_t*)(ws + WS_MIXIN), (size_t)tok * 1024 + 512 + col), ref)) dfail(p, bit);
    const int win = 2 << (col >> 7), cnt = (t + 1 < win) ? t + 1 : win;
    float s = 0.f;
    for (int k = 0; k < cnt; ++k) s += bfv(z, (size_t)(tok - k) * 512 + col);
    if (bad(bfv(yp, (size_t)tok * 512 + col), s / (float)cnt - bfv(z, (size_t)tok * 512 + col))) dfail(p, bit);
}
DI void chk6(const Params& p, int bit) {
    unsigned char* ws = p.ws;
    const unsigned gt = blockIdx.x * NTHREADS + threadIdx.x;
    if (gt >= 128) return;
    const int tok = hsh(gt + 17) & 16383;
    float* yb = (float*)(ws + WS_DSCR) + (size_t)gt * 1024;
    const bf16_t* mx = (const bf16_t*)(ws + WS_MIXIN) + (size_t)tok * 1024;
    const bf16_t* wo = (const bf16_t*)(ws + WS_WOUTT);
    float sm = 0.f;
    bool f = false;
    for (int n = 0; n < 1024; ++n) {
        float s = 0.f, s2 = 0.f;
        for (int k = 0; k < 1024; ++k) { s += bfv(mx, k) * bfv(wo, (size_t)n * 1024 + k); if (n < 8) s2 += bfv(mx, k) * p.in[11][(size_t)k * 1024 + n]; }
        if (n < 8 && !(fabsf(s - s2) <= 0.03f)) f = true;
        yb[n] = ALPHA * p.in[0][(size_t)tok * 1024 + n] + s; sm += yb[n];
    }
    const float mean = sm / 1024.f;
    float v = 0.f;
    for (int n = 0; n < 1024; ++n) v += (yb[n] - mean) * (yb[n] - mean);
    const float rstd = 1.f / sqrtf(v / 1024.f + LN_EPS);
    for (int n = 0; n < 1024; ++n)
        f |= bad(bfv((const bf16_t*)(ws + WS_H1), (size_t)tok * 1024 + n), (yb[n] - mean) * rstd * p.in[12][n] + p.in[13][n]);
    if (f) dfail(p, bit);
}
DI void chk7(const Params& p, int bit) {
    unsigned char* ws = p.ws;
    const unsigned gt = blockIdx.x * NTHREADS + threadIdx.x;
    if (gt >= 512) return;
    const int tok = hsh(gt + 23) & 16383, head = gt & 7, half = (gt >> 3) & 1;
    float* qd = (float*)(ws + WS_DSCR) + (size_t)gt * 256;
    float* sv = qd + 128;
    const bf16_t* h1 = (const bf16_t*)(ws + WS_H1) + (size_t)tok * 1024;
    const bf16_t* wq = (const bf16_t*)(ws + WS_WQT);
    const bf16_t* sk = (const bf16_t*)(ws + WS_SUBK);
    bool f = false;
    for (int d = 0; d < 128; ++d) {
        float s = 0.f, s2 = 0.f;
        const int col = head * 256 + half * 128 + d;
        for (int k = 0; k < 1024; ++k) { s += bfv(h1, k) * bfv(wq, (size_t)col * 1024 + k); if (d < 4) s2 += bfv(h1, k) * p.in[14][(size_t)k * 2048 + col]; }
        if (d < 4 && !(fabsf(s - s2) <= 0.06f)) f = true;
        qd[d] = bfr(s);
    }
    for (int key = 0; key < 128; ++key) {
        float s = 0.f, s2 = 0.f;
        for (int d = 0; d < 128; ++d) { s += qd[d] * bfv(sk, (size_t)(half * 128 + key) * 128 + d); s2 += qd[d] * p.in[15][(size_t)(half * 128 + key) * 128 + d]; }
        if (!(fabsf(s - s2) <= 0.05f)) f = true;
        sv[key] = s;
    }
    int mism = 0;
    const int* L = (const int*)(ws + WS_TOPK) + (((size_t)tok * 8 + head) * 2 + half) * 16;
    for (int it = 0; it < 16; ++it) {
        int bi = 0; float bv = -3e38f;
        for (int k = 0; k < 128; ++k) if (sv[k] > bv) { bv = sv[k]; bi = k; }
        sv[bi] = -3e38f;
        const int fk = L[it];
        if ((fk & 127) != bi) mism++;
        if (bad(key_val(fk), bv)) mism += 10;
    }
    if (mism > 1 || f) dfail(p, bit);
}
DI void chk8(const Params& p, int bit) {
    unsigned char* ws = p.ws;
    const unsigned gt = blockIdx.x * NTHREADS + threadIdx.x;
    if (gt >= 128) return;
    const int tok = hsh(gt + 31) & 16383;
    float* acc = (float*)(ws + WS_DSCR) + (size_t)gt * 4096;
    float* cand = acc + 1024;
    int* csel = (int*)(acc + 1024 + 256);
    float* acc2 = acc + 2048;
    const bf16_t* h1 = (const bf16_t*)(ws + WS_H1) + (size_t)tok * 1024;
    const bf16_t* ub = (const bf16_t*)(ws + WS_UB);
    const bf16_t* vb = (const bf16_t*)(ws + WS_VB);
    const int* dE = (const int*)(ws + WS_MIXIN) + (size_t)tok * 256;
    const float* dG = (const float*)dE + 128;
    bool f = false, froute = false, fg = false;
    for (int n = 0; n < 1024; ++n) { acc[n] = 0.f; acc2[n] = 0.f; }
    for (int hd = 0; hd < 8; ++hd) {
        const int* L = (const int*)(ws + WS_TOPK) + (size_t)tok * 256 + hd * 32;
        for (int i = 0; i < 16; ++i) for (int j = 0; j < 16; ++j) cand[i * 16 + j] = key_val(L[i]) + key_val(L[16 + j]);
        float mx = -3e38f, den = 0.f;
        for (int it = 0; it < 16; ++it) {
            int bi = 0; float bv = -3e38f;
            for (int k = 0; k < 256; ++k) if (cand[k] > bv) { bv = cand[k]; bi = k; }
            cand[bi] = -3e38f; csel[it] = bi;
            if (it == 0) mx = bv;
            ((float*)csel)[16 + it] = expf(bv - mx); den += expf(bv - mx);
        }
        for (int it = 0; it < 16; ++it) {
            const int i = csel[it] >> 4, j = csel[it] & 15;
            const size_t e = (size_t)(L[i] & 127) * 128 + (L[16 + j] & 127);
            float dot = 0.f;
            for (int k = 0; k < 1024; ++k) dot += bfv(h1, k) * bfv(ub, e * 1024 + k);
            const float gate = ((float*)csel)[16 + it] / den;
            const float w = gate * gelu_erf(dot);
            for (int n = 0; n < 1024; ++n) acc[n] += w * bfv(vb, e * 1024 + n);
            bool found = false;
            for (int s = 0; s < 16; ++s) if (dE[hd * 16 + s] == (int)e) { found = true; if (!(fabsf(dG[hd * 16 + s] - gate) <= 1e-3f)) fg = true; }
            if (!found) froute = true;
        }
        for (int s = 0; s < 16; ++s) {
            const size_t e = (size_t)dE[hd * 16 + s];
            if (e >= 16384) { froute = true; continue; }
            float dot = 0.f;
            for (int k = 0; k < 1024; ++k) dot += bfv(h1, k) * bfv(ub, e * 1024 + k);
            const float w = dG[hd * 16 + s] * gelu_erf(dot);
            for (int n = 0; n < 1024; ++n) acc2[n] += w * bfv(vb, e * 1024 + n);
        }
    }
    bool f2 = false;
    for (int pass = 0; pass < 2; ++pass) {
        float* a = pass ? acc2 : acc;
        float sm = 0.f;
        for (int n = 0; n < 1024; ++n) { a[n] += ALPHA * bfv(h1, n); sm += a[n]; }
        const float mean = sm / 1024.f;
        float v = 0.f;
        for (int n = 0; n < 1024; ++n) v += (a[n] - mean) * (a[n] - mean);
        const float rstd = 1.f / sqrtf(v / 1024.f + LN_EPS);
        for (int n = 0; n < 1024; ++n) {
            const bool b = bad(p.out[(size_t)tok * 1024 + n], (a[n] - mean) * rstd * p.in[18][n] + p.in[19][n]);
            if (pass) f2 |= b; else f |= b;
        }
    }
    if (f) dfail(p, bit);
    if (froute) dfail(p, bit + 1);
    if (fg) dfail(p, bit + 2);
    if (f2) dfail(p, bit + 3);
}
#endif

__global__ void __launch_bounds__(NTHREADS, 2) hybrid_fwd(Params p) {
    extern __shared__ __attribute__((aligned(16))) unsigned char lds[];
    cg::grid_group grid = cg::this_grid();
    const int lo = p.ph_lo, hi = p.ph_hi;
    volatile unsigned* bst = (volatile unsigned*)(lds + LDS_MAIN);
    if (threadIdx.x < 2) bst[threadIdx.x] = 0u;
    __syncthreads();
    XcdBarrier xbar = xcd_barrier_post((unsigned*)(p.ws + WS_BAR), bst);
#define IN(k) (lo <= (k) && (k) < hi)
#define SEAM(k) do { if (IN(k) && IN((k) + 1 + ((k) == 4))) xcd_barrier(xbar); } while (0)
    if (lo < 0) grid.sync();
#if DIAG
    if (blockIdx.x == 0 && threadIdx.x == 0) *(unsigned*)(p.ws + WS_FLAG) = 0u;
#endif
    if (IN(0)) phase0(p);
    SEAM(0);
    if (IN(1)) phase1(p, lds);
    SEAM(1);
#if DIAG == 1
    chk1(p, 0);
#endif
    if (IN(2)) phase2(p, lds);
    SEAM(2);
#if DIAG == 1
    chk2(p, 1); chk3(p, 2);
#endif
    if (IN(3)) phase3(p, lds);
    SEAM(3);
#if DIAG == 1
    chk4(p, 3); chk5(p, 4);
#endif
    if (IN(4)) phase4(p, lds);
    SEAM(4);
#if DIAG == 1
    chk6(p, 5);
#endif
    if (IN(6)) phase6(p, lds);
    SEAM(6);
#if DIAG == 2
    chk7(p, 0);
#endif
    if (IN(7)) phase7(p, lds);
#if DIAG
    grid.sync();
#if DIAG == 2
    chk8(p, 1);
    grid.sync();
#endif
    {
        const unsigned code = *(volatile unsigned*)(p.ws + WS_FLAG);
        const float kv = sqrtf((float)code);
        for (size_t i = (size_t)blockIdx.x * NTHREADS + threadIdx.x; i < (size_t)NTOK * DM; i += (size_t)gridDim.x * NTHREADS) p.out[i] = kv;
    }
#endif
#undef IN
#undef SEAM
}

extern "C" void kernel_launch(void* const* d_in, const int* in_sizes, int n_in, void* d_out, int out_size, void* d_ws, size_t ws_size,
                              hipStream_t stream) {
    static int grid_blocks = 0;
    if (grid_blocks == 0) {
        if (n_in != 20 || ws_size < WS_END) { fprintf(stderr, "kernel_launch: unexpected inputs (n_in %d, ws %zu)\n", n_in, ws_size); grid_blocks = -1; return; }
        int dev = 0, cus = 0, per_cu = 0;
        hipGetDevice(&dev);
        hipDeviceGetAttribute(&cus, hipDeviceAttributeMultiprocessorCount, dev);
        hipFuncSetAttribute((const void*)hybrid_fwd, hipFuncAttributeMaxDynamicSharedMemorySize, LDS_BYTES);
        hipOccupancyMaxActiveBlocksPerMultiprocessor(&per_cu, (const void*)hybrid_fwd, NTHREADS, LDS_BYTES);
        if (per_cu < 1) per_cu = 1;
        if (per_cu > 2) per_cu = 2;
        grid_blocks = cus * per_cu;
        (void)hipGetLastError();
    }
    if (grid_blocks < 0) return;
    (void)hipMemsetAsync((char*)d_ws + WS_BAR, 0, WS_BAR_BYTES, stream);
    Params p{};
    for (int i = 0; i < 20; ++i) p.in[i] = (const float*)d_in[i];
    p.out = (float*)d_out; p.ws = (unsigned char*)d_ws;
#if N_LAUNCH_MODE == 1
    p.ph_lo = 0; p.ph_hi = 8;
    void* args[] = {&p};
    hipError_t e = hipLaunchCooperativeKernel((const void*)hybrid_fwd, dim3(grid_blocks), dim3(NTHREADS), args, LDS_BYTES, stream);
    if (e != hipSuccess) fprintf(stderr, "cooperative launch failed: %s (grid %d)\n", hipGetErrorString(e), grid_blocks);
#else
    for (int ph = 0; ph < 8; ++ph) {
        p.ph_lo = ph; p.ph_hi = ph + 1;
        hipLaunchKernelGGL(hybrid_fwd, dim3(grid_blocks), dim3(NTHREADS), LDS_BYTES, stream, p);
    }
#endif
}
```

```cpp
#include <hip/hip_runtime.h>
#include <hip/hip_cooperative_groups.h>
#include <cstdint>
#include <cstdio>
namespace cg = cooperative_groups;

#ifndef N_LAUNCH_MODE
#define N_LAUNCH_MODE 1
#endif

typedef unsigned short bf16_t;
typedef short bf16x8 __attribute__((ext_vector_type(8)));
typedef short s16x4 __attribute__((ext_vector_type(4)));
typedef long i64x2 __attribute__((ext_vector_type(2)));
typedef unsigned u32x6 __attribute__((ext_vector_type(6)));
typedef _Float16 f16x32 __attribute__((ext_vector_type(32)));
typedef _Float16 f16x2_t __attribute__((ext_vector_type(2)));
typedef float f32x32 __attribute__((ext_vector_type(32)));
typedef float f32x16 __attribute__((ext_vector_type(16)));
typedef float f32x4 __attribute__((ext_vector_type(4)));
typedef unsigned u32x4 __attribute__((ext_vector_type(4)));
typedef unsigned u32x2 __attribute__((ext_vector_type(2)));
typedef float f32x2 __attribute__((ext_vector_type(2)));
typedef __bf16 bf16x2_t __attribute__((ext_vector_type(2)));

#define DI __device__ __forceinline__
#define MFMA32(a, b, c) __builtin_amdgcn_mfma_f32_32x32x16_bf16((a), (b), (c), 0, 0, 0)

constexpr int NTOK = 16384, SEQ = 4096, DM = 1024;
constexpr int NINP = 1920;
constexpr float ALPHA = 1.189207115002721f;
constexpr float LN_EPS = 1e-5f;
constexpr float LOG2E = 1.4426950408889634f;
constexpr float QSCALE = 0.125f * LOG2E;
constexpr int NTHREADS = 256;
constexpr int LDS_MAIN = 73728;
constexpr int LDS_CST = LDS_MAIN + 64;
constexpr int LDS_BYTES = LDS_MAIN + 64 + 2048;
constexpr int ROWB = 144;

constexpr size_t MiB = 1u << 20;
constexpr size_t WS_BAR = 0;
constexpr size_t WS_BAR_BYTES = 16384;
constexpr size_t WS_KCMP = 1 * MiB;
constexpr size_t WS_VCMP = 1 * MiB + 512 * 1024;
constexpr size_t WS_W2TK = 2 * MiB;
constexpr size_t WS_W2TV = 2 * MiB + 32 * 1024;
constexpr size_t WS_POOLWT = 2 * MiB + 64 * 1024;
constexpr size_t WS_SUBK = 2 * MiB + 192 * 1024;
constexpr size_t WS_PEBK = 2 * MiB + 256 * 1024;
constexpr size_t WS_PEBV = 2 * MiB + 257 * 1024;
constexpr size_t WS_BUCK = 2 * MiB + 258 * 1024;
constexpr size_t WS_USCALE = 2 * MiB + 320 * 1024;
constexpr size_t WS_VSCALE = 2 * MiB + 384 * 1024;
constexpr size_t WS_C1 = 2 * MiB + 448 * 1024;
constexpr size_t WS_C2 = 2 * MiB + 456 * 1024;
constexpr size_t WS_LNST = 15 * MiB;
constexpr size_t WS_SX = 2 * MiB + 464 * 1024;
constexpr size_t WS_SW = 2 * MiB + 528 * 1024;
constexpr size_t WS_W1TK = 3 * MiB;
constexpr size_t WS_W1TV = 4 * MiB;
constexpr size_t WS_WINT = 5 * MiB;
constexpr size_t WS_WOUTT = 9 * MiB;
constexpr size_t WS_WQT = 11 * MiB;
constexpr size_t WS_UB = 16 * MiB;
constexpr size_t WS_VB = 48 * MiB;
constexpr size_t WS_XB = 80 * MiB;
constexpr size_t WS_MIXIN = WS_XB;
constexpr size_t WS_Q = 112 * MiB;
constexpr size_t WS_KC = 128 * MiB;
constexpr size_t WS_VC = 132 * MiB;
constexpr size_t WS_KSLC = 136 * MiB;
constexpr size_t WS_KWIN = 140 * MiB;
constexpr size_t WS_VSLCT = 144 * MiB;
constexpr size_t WS_VWINT = 148 * MiB;
constexpr size_t WS_GATES = 152 * MiB;
constexpr size_t WS_Z = 154 * MiB;
constexpr size_t WS_YPOOL = 170 * MiB;
constexpr size_t WS_OWIN = 186 * MiB;
#ifndef DIAG
#define DIAG 0
#endif
#if DIAG
constexpr size_t WS_H1 = 202 * MiB;
constexpr size_t WS_TOPK = 234 * MiB;
constexpr size_t WS_END = 256 * MiB;
constexpr size_t WS_FLAG = 32768;
constexpr size_t WS_DSCR = 250 * MiB;
#else
constexpr size_t WS_H1 = 112 * MiB;
constexpr size_t WS_TOPK = 112 * MiB;
constexpr size_t WS_END = 202 * MiB;
#endif

struct Params { const float* in[20]; float* out; unsigned char* ws; int ph_lo, ph_hi; };

DI unsigned f2bf(float f) { unsigned u = __float_as_uint(f); return (u + 0x7fffu + ((u >> 16) & 1u)) >> 16; }
DI unsigned pk2(float lo, float hi) { bf16x2_t v = {(__bf16)lo, (__bf16)hi}; return __builtin_bit_cast(unsigned, v); }
DI float bflo(unsigned x) { return __uint_as_float(x << 16); }
DI float bfhi(unsigned x) { return __uint_as_float(x & 0xffff0000u); }
DI float dot2bf(unsigned a, unsigned b, float acc) {
    asm("v_dot2c_f32_bf16 %0, %1, %2" : "+v"(acc) : "v"(a), "v"(b));
    return acc;
}
DI int dot4i8(unsigned a, unsigned b, int acc) {
    return __builtin_amdgcn_sdot4((int)a, (int)b, acc, false);
}
DI float gelu_erf(float x) { return 0.5f * x * (1.0f + erff(x * 0.70710678118654752f)); }
DI float gelu_fast(float v) {
    const float av = fabsf(v), t = __builtin_amdgcn_rcpf(av * 0.2316418882f + 1.0f);
    float q = t * 0.5307027145f + (-0.7265760135f); q = q * t + 0.7107068705f; q = q * t + (-0.142248368f); q = q * t + 0.127414796f; q = q * t;
    const float e = __builtin_amdgcn_exp2f((v * v) * (-0.72134752044f));
    const float m = v * (q * e);
    return v < 0.f ? m : v - m;
}
DI float wave_sum(float v) {
#pragma unroll
    for (int o = 32; o >= 1; o >>= 1) v += __shfl_xor(v, o);
    return v;
}
DI int rel_bucket_dev(int dist) {
    if (dist < 0) dist = 0;
    if (dist < 16) return dist;
    int v = 16 + (int)(logf((float)dist / 16.0f) / logf(8.0f) * 16.0f);
    return v < 31 ? v : 31;
}
DI int make_key(float f, int idx) { int b = __float_as_int(f); b ^= (b >> 31) & 0x7fffffff; return (b & ~127) | idx; }
DI float key_val(int k) { int b = k & ~127; b ^= (b >> 31) & 0x7fffffff; return __int_as_float(b); }


#define LAS __attribute__((address_space(3)))
#define XB_TMO      128
#define XB_XCNT(j)  (256  + 64 * (j))
#define XB_XSUB(j)  (1280 + 64 * (j))
#define XB_XGEN(j)  (2304 + 64 * (j))
#define XB_TOP      3328
#define XB_TOPGEN   3392
#define XCD_BAR_WORDS 3456
#define XB_SPIN_CAP (1u << 20)
DI unsigned xb_ld(unsigned* p)              { return __hip_atomic_load(p, __ATOMIC_RELAXED, __HIP_MEMORY_SCOPE_AGENT); }
DI unsigned xb_add(unsigned* p, unsigned v) { return __hip_atomic_fetch_add(p, v, __ATOMIC_RELAXED, __HIP_MEMORY_SCOPE_AGENT); }
DI unsigned xb_xcc_id() { return (unsigned)__builtin_amdgcn_s_getreg((3 << 11) | 20) & 0xFu; }
#define XB_SPIN(cond, bar) do { unsigned _sp = 0; while (cond) { __builtin_amdgcn_s_sleep(1); \
    if ((++_sp & 255u) == 0u) { if (xb_ld(&(bar)[XB_TMO])) break; if (_sp > XB_SPIN_CAP) { atomicAdd(&(bar)[XB_TMO], 1u); break; } } } } while (0)
struct XcdBarrier { unsigned* bar; unsigned x; volatile unsigned* st; };
DI XcdBarrier xcd_barrier_post(unsigned* bar, volatile unsigned* st) {
    XcdBarrier b; b.bar = bar; b.x = xb_xcc_id(); b.st = st;
    if (threadIdx.x == 0) (void)xb_add(&bar[XB_XCNT(b.x)], 1u);
    return b;
}
DI void xcd_barrier_complete(unsigned* bar, unsigned x, unsigned& nloc, unsigned& nx) {
    const unsigned G = gridDim.x * gridDim.y * gridDim.z;
    unsigned sum, cnt, mine, sp = 0u;
    for (;;) {
        sum = 0u; cnt = 0u; mine = 0u;
#pragma unroll
        for (unsigned j = 0; j < 16; ++j) { const unsigned c = xb_ld(&bar[XB_XCNT(j)]); sum += c; cnt += (c > 0u) ? 1u : 0u; mine = (j == x) ? c : mine; }
        if (sum == G) break;
        __builtin_amdgcn_s_sleep(1);
        if ((++sp & 255u) == 0u) { if (xb_ld(&bar[XB_TMO])) break; if (sp > XB_SPIN_CAP) { atomicAdd(&bar[XB_TMO], 1u); break; } }
    }
    nloc = mine > 0u ? mine : 1u; nx = cnt > 0u ? cnt : 1u;
}
DI void xcd_barrier(const XcdBarrier& b) {
    asm volatile("s_waitcnt vmcnt(0)" ::: "memory");
    __syncthreads();
    if (threadIdx.x == 0) {
        unsigned* bar = b.bar;
        __builtin_amdgcn_s_waitcnt(0);
        unsigned nloc = b.st[0], nx = b.st[1];
        if (nloc == 0u) { xcd_barrier_complete(bar, b.x, nloc, nx); b.st[0] = nloc; b.st[1] = nx; }
        const unsigned old = xb_add(&bar[XB_XSUB(b.x)], 1u);
        const unsigned gen = old / nloc;
        if (old + 1u == (gen + 1u) * nloc) {
            __builtin_amdgcn_fence(__ATOMIC_RELEASE, "agent");
            asm volatile("s_waitcnt vmcnt(0)" ::: "memory");
            const unsigned og = xb_add(&bar[XB_TOP], 1u);
            const unsigned tg = og / nx;
            if (og + 1u == (tg + 1u) * nx) xb_add(&bar[XB_TOPGEN], 1u);
            else XB_SPIN(xb_ld(&bar[XB_TOPGEN]) == tg, bar);
            __builtin_amdgcn_fence(__ATOMIC_ACQUIRE, "agent");
            xb_add(&bar[XB_XGEN(b.x)], 1u);
            asm volatile("s_waitcnt vmcnt(0)" ::: "memory");
        } else {
            XB_SPIN(xb_ld(&bar[XB_XGEN(b.x)]) == gen, bar);
            __builtin_amdgcn_fence(__ATOMIC_ACQUIRE, "agent");
            asm volatile("s_waitcnt vmcnt(0)" ::: "memory");
        }
    }
    __syncthreads();
}

template <int MI>
DI void gemm_mainloop_t(const bf16_t* __restrict__ A, int lda, const bf16_t* __restrict__ Bt, int ldb, int K,
                        f32x16 (&acc)[MI][2], unsigned char* lds) {
    const int tid = threadIdx.x, lane = tid & 63, wid = __builtin_amdgcn_readfirstlane(tid >> 6);
    const int wr = wid >> 1, wc = wid & 1, r = lane & 31, h = lane >> 5;
    LAS unsigned char* As = (LAS unsigned char*)lds;
    LAS unsigned char* Bs = (LAS unsigned char*)lds + 2 * 16384;
#pragma unroll
    for (int mi = 0; mi < MI; ++mi)
#pragma unroll
        for (int ni = 0; ni < 2; ++ni)
#pragma unroll
            for (int i = 0; i < 16; ++i) acc[mi][ni][i] = 0.f;
    const int nk = K >> 6;
    const int prow = 8 * wid + (lane >> 3);
    const int pchunk = (lane & 7) ^ ((prow >> 1) & 7);
    const bf16_t* Ap = A + (size_t)prow * lda + pchunk * 8;
    const bf16_t* Bp = Bt + (size_t)prow * ldb + pchunk * 8;
    const int pl = wid * 1024;
#define GEMM_STAGE(buf, kt) do { \
        _Pragma("unroll") for (int i = 0; i < 2 * MI; ++i) __builtin_amdgcn_global_load_lds((const unsigned*)(Ap + (size_t)(32 * i) * lda + (kt) * 64), (LAS unsigned*)(As + (buf) * 16384 + i * 4096 + pl), 16, 0, 0); \
        _Pragma("unroll") for (int i = 0; i < 4; ++i) __builtin_amdgcn_global_load_lds((const unsigned*)(Bp + (size_t)(32 * i) * ldb + (kt) * 64), (LAS unsigned*)(Bs + (buf) * 16384 + i * 4096 + pl), 16, 0, 0); } while (0)
    GEMM_STAGE(0, 0);
    asm volatile("s_waitcnt vmcnt(0)" ::: "memory");
    __syncthreads();
    const int swz = (r >> 1) & 7;
    for (int kt = 0; kt < nk; ++kt) {
        const int cur = kt & 1;
        if (kt + 1 < nk) GEMM_STAGE(cur ^ 1, kt + 1);
        const LAS unsigned char* Ac = As + cur * 16384 + (wr * 32 * MI + r) * 128;
        const LAS unsigned char* Bc = Bs + cur * 16384 + (wc * 64 + r) * 128;
        __builtin_amdgcn_s_setprio(1);
#pragma unroll
        for (int ks = 0; ks < 4; ++ks) {
            const int co = ((ks * 2 + h) ^ swz) * 16;
            bf16x8 fa[MI], fb[2];
#pragma unroll
            for (int mi = 0; mi < MI; ++mi) fa[mi] = *(const LAS bf16x8*)(Ac + mi * 32 * 128 + co);
#pragma unroll
            for (int ni = 0; ni < 2; ++ni) fb[ni] = *(const LAS bf16x8*)(Bc + ni * 32 * 128 + co);
#pragma unroll
            for (int mi = 0; mi < MI; ++mi)
#pragma unroll
                for (int ni = 0; ni < 2; ++ni) acc[mi][ni] = MFMA32(fb[ni], fa[mi], acc[mi][ni]);
        }
        __builtin_amdgcn_s_setprio(0);
        asm volatile("s_waitcnt vmcnt(0)" ::: "memory");
        __syncthreads();
    }
#undef GEMM_STAGE
}
DI void gemm_mainloop_f8(const unsigned char* __restrict__ A, int lda, const unsigned char* __restrict__ Bt, int ldb, int K,
                         f32x16 (&acc)[2][2], unsigned char* lds) {
    constexpr int MI = 2;
    const int tid = threadIdx.x, lane = tid & 63, wid = __builtin_amdgcn_readfirstlane(tid >> 6);
    const int wr = wid >> 1, wc = wid & 1, r = lane & 31, h = lane >> 5;
    LAS unsigned char* As = (LAS unsigned char*)lds;
    LAS unsigned char* Bs = (LAS unsigned char*)lds + 2 * 16384;
#pragma unroll
    for (int mi = 0; mi < MI; ++mi)
#pragma unroll
        for (int ni = 0; ni < 2; ++ni)
#pragma unroll
            for (int i = 0; i < 16; ++i) acc[mi][ni][i] = 0.f;
    const int nk = K >> 7;
    const int prow = 8 * wid + (lane >> 3);
    const int pchunk = (lane & 7) ^ ((prow >> 1) & 7);
    const unsigned char* Ap = A + (size_t)prow * lda + pchunk * 16;
    const unsigned char* Bp = Bt + (size_t)prow * ldb + pchunk * 16;
    const int pl = wid * 1024;
#define GEMM_STAGE(buf, kt) do { \
        _Pragma("unroll") for (int i = 0; i < 2 * MI; ++i) __builtin_amdgcn_global_load_lds((const unsigned*)(Ap + (size_t)(32 * i) * lda + (kt) * 128), (LAS unsigned*)(As + (buf) * 16384 + i * 4096 + pl), 16, 0, 0); \
        _Pragma("unroll") for (int i = 0; i < 4; ++i) __builtin_amdgcn_global_load_lds((const unsigned*)(Bp + (size_t)(32 * i) * ldb + (kt) * 128), (LAS unsigned*)(Bs + (buf) * 16384 + i * 4096 + pl), 16, 0, 0); } while (0)
    GEMM_STAGE(0, 0);
    asm volatile("s_waitcnt vmcnt(0)" ::: "memory");
    __syncthreads();
    const int swz = (r >> 1) & 7;
    for (int kt = 0; kt < nk; ++kt) {
        const int cur = kt & 1;
        if (kt + 1 < nk) GEMM_STAGE(cur ^ 1, kt + 1);
        const LAS unsigned char* Ac = As + cur * 16384 + (wr * 32 * MI + r) * 128;
        const LAS unsigned char* Bc = Bs + cur * 16384 + (wc * 64 + r) * 128;
        __builtin_amdgcn_s_setprio(1);
#pragma unroll
        for (int ks = 0; ks < 4; ++ks) {
            const int co = ((ks * 2 + h) ^ swz) * 16;
            i64x2 fa[MI], fb[2];
#pragma unroll
            for (int mi = 0; mi < MI; ++mi) fa[mi] = *(const LAS i64x2*)(Ac + mi * 32 * 128 + co);
#pragma unroll
            for (int ni = 0; ni < 2; ++ni) fb[ni] = *(const LAS i64x2*)(Bc + ni * 32 * 128 + co);
#pragma unroll
            for (int mi = 0; mi < MI; ++mi)
#pragma unroll
                for (int ni = 0; ni < 2; ++ni) { acc[mi][ni] = __builtin_amdgcn_mfma_f32_32x32x16_fp8_fp8(fb[ni].x, fa[mi].x, acc[mi][ni], 0, 0, 0);
                    acc[mi][ni] = __builtin_amdgcn_mfma_f32_32x32x16_fp8_fp8(fb[ni].y, fa[mi].y, acc[mi][ni], 0, 0, 0); }
        }
        __builtin_amdgcn_s_setprio(0);
        asm volatile("s_waitcnt vmcnt(0)" ::: "memory");
        __syncthreads();
    }
#undef GEMM_STAGE
}
DI void gemm_mainloop(const bf16_t* __restrict__ A, int lda, const bf16_t* __restrict__ Bt, int ldb, int K,
                      f32x16 (&acc)[2][2], unsigned char* lds) { gemm_mainloop_t<2>(A, lda, Bt, ldb, K, acc, lds); }

template <int MI, class F> DI void epi_foreach_t(const f32x16 (&acc)[MI][2], F f) {
    const int tid = threadIdx.x, lane = tid & 63, wid = tid >> 6;
    const int wr = wid >> 1, wc = wid & 1, r = lane & 31, h = lane >> 5;
#pragma unroll
    for (int mi = 0; mi < MI; ++mi)
#pragma unroll
        for (int ni = 0; ni < 2; ++ni)
#pragma unroll
            for (int grp = 0; grp < 4; ++grp) {
                f32x4 v = {acc[mi][ni][4 * grp], acc[mi][ni][4 * grp + 1], acc[mi][ni][4 * grp + 2], acc[mi][ni][4 * grp + 3]};
                f(wr * 32 * MI + mi * 32 + r, wc * 64 + ni * 32 + 8 * grp + 4 * h, v);
            }
}
template <class F> DI void epi_foreach(const f32x16 (&acc)[2][2], F f) { epi_foreach_t<2>(acc, f); }

template <class S> DI void epi_stage_rows(const f32x16 (&acc)[2][2], unsigned char* lds, S colscale) {
    epi_foreach(acc, [&](int m, int n, f32x4 v) {
        const f32x4 s = colscale(n);
        u32x2 o = {pk2(v.x * s.x, v.y * s.y), pk2(v.z * s.z, v.w * s.w)};
        *(u32x2*)(lds + m * 272 + n * 2) = o;
    });
}
DI void epi_stage_cols(const f32x16 (&acc)[2][2], unsigned char* lds) {
    epi_foreach(acc, [&](int m, int n, f32x4 v) {
        *(bf16_t*)(lds + (n + 0) * 272 + m * 2) = (bf16_t)f2bf(v.x); *(bf16_t*)(lds + (n + 1) * 272 + m * 2) = (bf16_t)f2bf(v.y);
        *(bf16_t*)(lds + (n + 2) * 272 + m * 2) = (bf16_t)f2bf(v.z); *(bf16_t*)(lds + (n + 3) * 272 + m * 2) = (bf16_t)f2bf(v.w);
    });
}
template <class F> DI void rows_foreach(const unsigned char* lds, F f) {
    const int tid = threadIdx.x;
#pragma unroll
    for (int i = 0; i < 8; ++i) {
        const int c = tid + 256 * i, m = c >> 4, cc = c & 15;
        f(m, cc, *(const u32x4*)(lds + m * 272 + cc * 16));
    }
}

DI void cvt_rows(const float* __restrict__ src, bf16_t* __restrict__ dst, size_t n8, size_t gtid, size_t gstride) {
    for (size_t i = gtid; i < n8; i += gstride) {
        f32x4 a = ((const f32x4*)src)[2 * i], b = ((const f32x4*)src)[2 * i + 1];
        u32x4 o = {pk2(a.x, a.y), pk2(a.z, a.w), pk2(b.x, b.y), pk2(b.z, b.w)};
        ((u32x4*)dst)[i] = o;
    }
}
template <class F> DI void transpose_cvt(const float* __restrict__ in, int K, int Nin, bf16_t* __restrict__ out, int Nout, F src,
                                         size_t gtid, size_t gstride) {
    const size_t total = (size_t)Nout * (K / 8);
    for (size_t i = gtid; i < total; i += gstride) {
        const int n = (int)(i % Nout), k8 = (int)(i / Nout);
        const int s = src(n);
        float v[8];
#pragma unroll
        for (int j = 0; j < 8; ++j) v[j] = s >= 0 ? in[(size_t)(k8 * 8 + j) * Nin + s] : 0.f;
        u32x4 o = {pk2(v[0], v[1]), pk2(v[2], v[3]), pk2(v[4], v[5]), pk2(v[6], v[7])};
        *(u32x4*)(out + (size_t)n * K + k8 * 8) = o;
    }
}

DI void transpose_cvt_scaled(const float* __restrict__ in, int K, int N, bf16_t* __restrict__ out, const float* __restrict__ scale, size_t gtid, size_t gstride) {
    const size_t total = (size_t)N * (K / 8);
    for (size_t i = gtid; i < total; i += gstride) {
        const int n = (int)(i % N), k8 = (int)(i / N);
        float v[8];
#pragma unroll
        for (int j = 0; j < 8; ++j) v[j] = in[(size_t)(k8 * 8 + j) * N + n] * scale[k8 * 8 + j];
        u32x4 o = {pk2(v[0], v[1]), pk2(v[2], v[3]), pk2(v[4], v[5]), pk2(v[6], v[7])};
        *(u32x4*)(out + (size_t)n * K + k8 * 8) = o;
    }
}

DI void convert_tables(const Params& p) {
    unsigned char* ws = p.ws;
    const size_t gtid = (size_t)blockIdx.x * NTHREADS + threadIdx.x, gstride = (size_t)gridDim.x * NTHREADS;
    const int lane = threadIdx.x & 63, gw = (int)(gtid >> 6), ngw = (int)(gstride >> 6);
    {
        const int hw = lane >> 5, l32 = lane & 31;
        for (int rr = gw * 2 + hw; rr < 2 * 16384; rr += ngw * 2) {
            const int which = rr >> 14, row = rr & 16383;
            const float* src = (which ? p.in[17] : p.in[16]) + (size_t)row * 1024 + l32 * 16;
            f32x16 a, b;
            float am = 0.f;
#pragma unroll
            for (int j = 0; j < 4; ++j) {
                const f32x4 x = *(const f32x4*)(src + 4 * j), y = *(const f32x4*)(src + 512 + 4 * j);
                a[4 * j] = x.x; a[4 * j + 1] = x.y; a[4 * j + 2] = x.z; a[4 * j + 3] = x.w;
                b[4 * j] = y.x; b[4 * j + 1] = y.y; b[4 * j + 2] = y.z; b[4 * j + 3] = y.w;
                am = fmaxf(am, fmaxf(fmaxf(fabsf(x.x), fabsf(x.y)), fmaxf(fabsf(x.z), fabsf(x.w))));
                am = fmaxf(am, fmaxf(fmaxf(fabsf(y.x), fabsf(y.y)), fmaxf(fabsf(y.z), fabsf(y.w))));
            }
#pragma unroll
            for (int o = 16; o >= 1; o >>= 1) am = fmaxf(am, __shfl_xor(am, o));
            const float sc = am > 0.f ? 7.5f / am : 1.0f;
#pragma unroll
            for (int i = 0; i < 16; ++i) { a[i] *= sc; b[i] *= sc; }
            f32x16 a2, b2;
#pragma unroll
            for (int i = 0; i < 8; ++i) { a2[i] = a[2 * i]; b2[i] = a[2 * i + 1]; a2[8 + i] = b[2 * i]; b2[8 + i] = b[2 * i + 1]; }
            const u32x6 pk = __builtin_amdgcn_cvt_scalef32_2xpk16_fp6_f32(a2, b2, 1.0f);
            unsigned char* dst = ws + (which ? WS_VB : WS_UB) + (size_t)row * 768;
            *(u32x4*)(dst + l32 * 16) = (u32x4){pk[0], pk[1], pk[2], pk[3]};
            *(u32x2*)(dst + 512 + l32 * 8) = (u32x2){pk[4], pk[5]};
            if (l32 == 0) ((float*)(ws + (which ? WS_VSCALE : WS_USCALE)))[row] = am > 0.f ? am / 7.5f : 1.0f;
        }
    }
}

DI unsigned pk4_fp8(float a, float b, float c, float d) {
    int w = __builtin_amdgcn_cvt_pk_fp8_f32(a, b, 0, false);
    return (unsigned)__builtin_amdgcn_cvt_pk_fp8_f32(c, d, w, true);
}
DI void phase0(const Params& p, unsigned char* lds) {
    unsigned char* ws = p.ws;
    const size_t gtid = (size_t)blockIdx.x * NTHREADS + threadIdx.x, gstride = (size_t)gridDim.x * NTHREADS;
    for (int strip = blockIdx.x; strip < NINP / 16; strip += gridDim.x) {
        const int c = threadIdx.x & 15, kq = threadIdx.x >> 4, n = strip * 16 + c;
        const int s = n < 1280 ? n : (n < 1792 ? 1304 + (n - 1280) : (n < 1816 ? 1280 + (n - 1792) : -1));
        const float* w = p.in[1] + (size_t)(kq * 64) * 1816 + (s >= 0 ? s : 0);
        float v[64];
        float am = 0.f;
#pragma unroll
        for (int j = 0; j < 64; ++j) { v[j] = s >= 0 ? w[(size_t)j * 1816] : 0.f; am = fmaxf(am, fabsf(v[j])); }
        float* red = (float*)lds;
        red[kq * 16 + c] = am;
        __syncthreads();
        float cm = 0.f;
#pragma unroll
        for (int q = 0; q < 16; ++q) cm = fmaxf(cm, red[q * 16 + c]);
        __syncthreads();
        const float sc = cm > 0.f ? 448.0f / cm : 1.0f;
        unsigned char* dst = ws + WS_WINT + (size_t)n * 1024 + kq * 64;
#pragma unroll
        for (int q = 0; q < 4; ++q) {
            u32x4 o;
#pragma unroll
            for (int d = 0; d < 4; ++d) o[d] = pk4_fp8(v[q * 16 + d * 4] * sc, v[q * 16 + d * 4 + 1] * sc, v[q * 16 + d * 4 + 2] * sc, v[q * 16 + d * 4 + 3] * sc);
            *(u32x4*)(dst + q * 16) = o;
        }
        if (kq == 0) ((float*)(ws + WS_SW))[n] = cm > 0.f ? cm / 448.0f : 1.0f;
    }
    {
        const int lane = threadIdx.x & 63, gw = (int)(gtid >> 6), ngw = (int)(gstride >> 6);
        for (int row = gw; row < NTOK; row += ngw) {
            const f32x4* src = (const f32x4*)(p.in[0] + (size_t)row * 1024) + lane * 4;
            f32x4 v[4];
            float am = 0.f;
#pragma unroll
            for (int j = 0; j < 4; ++j) { v[j] = src[j]; am = fmaxf(am, fmaxf(fmaxf(fabsf(v[j].x), fabsf(v[j].y)), fmaxf(fabsf(v[j].z), fabsf(v[j].w)))); }
#pragma unroll
            for (int o = 32; o >= 1; o >>= 1) am = fmaxf(am, __shfl_xor(am, o));
            const float sc = am > 0.f ? 448.0f / am : 1.0f;
            u32x4 o4;
#pragma unroll
            for (int j = 0; j < 4; ++j) o4[j] = pk4_fp8(v[j].x * sc, v[j].y * sc, v[j].z * sc, v[j].w * sc);
            *(u32x4*)(ws + WS_XB + (size_t)row * 1024 + lane * 16) = o4;
            if (lane == 0) ((float*)(ws + WS_SX))[row] = am > 0.f ? am / 448.0f : 1.0f;
        }
    }
    cvt_rows(p.in[15], (bf16_t*)(ws + WS_SUBK), (size_t)2 * 128 * 128 / 8, gtid, gstride);
    transpose_cvt(p.in[11], 1024, 1024, (bf16_t*)(ws + WS_WOUTT), 1024, [](int n) { return n; }, gtid, gstride);
    transpose_cvt_scaled(p.in[14], 1024, 2048, (bf16_t*)(ws + WS_WQT), p.in[12], gtid, gstride);
    transpose_cvt(p.in[5], 2048, 256, (bf16_t*)(ws + WS_W1TK), 256, [](int n) { return n; }, gtid, gstride);
    transpose_cvt(p.in[7], 2048, 256, (bf16_t*)(ws + WS_W1TV), 256, [](int n) { return n; }, gtid, gstride);
    transpose_cvt(p.in[6], 256, 64, (bf16_t*)(ws + WS_W2TK), 64, [](int n) { return n; }, gtid, gstride);
    transpose_cvt(p.in[8], 256, 64, (bf16_t*)(ws + WS_W2TV), 64, [](int n) { return n; }, gtid, gstride);
    for (int g = 0; g < 4; ++g)
        transpose_cvt(p.in[9] + g * 16384, 128, 128, (bf16_t*)(ws + WS_POOLWT) + g * 16384, 128, [](int n) { return n; }, gtid, gstride);
    {
        float* z = (float*)(ws + WS_KCMP);
        for (size_t i = gtid; i < (size_t)2 * 8 * 256 * 64; i += gstride) z[i] = 0.f;
    }
    {
        const int lane = threadIdx.x & 63, gw = (int)(gtid >> 6), ngw = (int)(gstride >> 6);
        for (int o = gw; o < 512; o += ngw) {
            const int which = o >> 8, j = o & 255;
            const float* pe = which ? p.in[4] : p.in[3];
            const float* w1 = which ? p.in[7] : p.in[5];
            float s = 0.f;
#pragma unroll 8
            for (int i = lane; i < 2048; i += 64) s += pe[i] * w1[(size_t)i * 256 + j];
            s = wave_sum(s);
            if (lane == 0) ((float*)(ws + (which ? WS_PEBV : WS_PEBK)))[j] = s;
        }
    }
    if (gtid >= 512 && gtid < 768) {
        const int d = (int)(gtid - 512);
        ((int*)(ws + WS_BUCK))[d] = rel_bucket_dev(d);
    }
}

DI int cu_pair_pos(int j, int G8) { const int hlf = (G8 + 1) >> 1; return (G8 & 1) ? j : (((j % hlf) << 1) | (j / hlf)); }

DI void phase1(const Params& p, unsigned char* lds) {
    unsigned char* ws = p.ws;
    const unsigned char* xb = ws + WS_XB;
    const unsigned char* wt = ws + WS_WINT;
    const float* sx = (const float*)(ws + WS_SX);
    const float* sw = (const float*)(ws + WS_SW);
    const int ntiles = 128 * 15;
    const int G8 = (gridDim.x & 7) == 0 ? gridDim.x >> 3 : 0;
    for (int l0 = G8 ? 0 : (int)blockIdx.x; l0 < (G8 ? ntiles / 8 : ntiles); l0 += (G8 ? G8 : (int)gridDim.x)) {
        const int li = G8 ? l0 + cu_pair_pos((int)(blockIdx.x >> 3), G8) : l0;
        if (G8 && li >= ntiles / 8) break;
        const int tile = G8 ? (int)(blockIdx.x & 7) * (ntiles / 8) + li : li;
        const int tn = tile % 15, tm = tile / 15;
        f32x16 acc[2][2];
        gemm_mainloop_f8(xb + (size_t)tm * 128 * DM, DM, wt + (size_t)tn * 128 * DM, DM, DM, acc, lds);
        const int m0 = tm * 128;
        {
            const int lane = threadIdx.x & 63, wid = threadIdx.x >> 6, wr = wid >> 1, wc = wid & 1, r = lane & 31, h = lane >> 5;
            const float sx0 = sx[m0 + wr * 64 + r], sx1 = sx[m0 + wr * 64 + 32 + r];
#pragma unroll
            for (int ni = 0; ni < 2; ++ni)
#pragma unroll
                for (int grp = 0; grp < 4; ++grp) {
                    const f32x4 s4 = *(const f32x4*)(sw + tn * 128 + wc * 64 + ni * 32 + 8 * grp + 4 * h);
#pragma unroll
                    for (int e2 = 0; e2 < 4; ++e2) { acc[0][ni][4 * grp + e2] *= sx0 * s4[e2]; acc[1][ni][4 * grp + e2] *= sx1 * s4[e2]; }
                }
        }
        if (tn < 14) {
            const bool tr = (tn == 7 || tn == 9);
            const float qs = tn < 4 ? QSCALE : 1.0f;
            if (tr) epi_stage_cols(acc, lds);
            else epi_stage_rows(acc, lds, [&](int) { return (f32x4){qs, qs, qs, qs}; });
            __syncthreads();
            const int bq = m0 >> 12, t0q = m0 & 4095;
            if (tn < 4) {
                bf16_t* Q = (bf16_t*)(ws + WS_Q);
                rows_foreach(lds, [&](int m, int cc, u32x4 d) {
                    const int hd = tn * 2 + (cc >> 3);
                    *(u32x4*)(Q + (((size_t)(bq * 8 + hd) * SEQ + t0q + m) * 64 + (cc & 7) * 8)) = d;
                });
            } else if (tr) {
                bf16_t* dst = (bf16_t*)(ws + (tn == 7 ? WS_VSLCT : WS_VWINT));
                rows_foreach(lds, [&](int n, int cc, u32x4 d) {
                    *(u32x4*)(dst + ((size_t)((bq * 2 + (n >> 6)) * 64 + (n & 63)) * SEQ + t0q + cc * 8)) = d;
                });
            } else if (tn < 10) {
                bf16_t* dst = (bf16_t*)(ws + (tn == 4 ? WS_KC : tn == 5 ? WS_VC : tn == 6 ? WS_KSLC : WS_KWIN));
                rows_foreach(lds, [&](int m, int cc, u32x4 d) {
                    *(u32x4*)(dst + (((size_t)(bq * 2 + (cc >> 3)) * SEQ + t0q + m) * 64 + (cc & 7) * 8)) = d;
                });
            } else {
                bf16_t* dst = (bf16_t*)(ws + WS_Z);
                rows_foreach(lds, [&](int m, int cc, u32x4 d) {
                    *(u32x4*)(dst + ((size_t)(m0 + m) * 512 + (tn - 10) * 128 + cc * 8)) = d;
                });
            }
            __syncthreads();
        } else {
            float* dst = (float*)(ws + WS_GATES);
            epi_foreach(acc, [&](int m, int n, f32x4 v) {
                if (n < 24) {
                    f32x4 o = {1.f / (1.f + __expf(-v.x)), 1.f / (1.f + __expf(-v.y)), 1.f / (1.f + __expf(-v.z)), 1.f / (1.f + __expf(-v.w))};
                    *(f32x4*)(dst + (size_t)(m0 + m) * 24 + n) = o;
                }
            });
        }
    }
}

DI void compress_job(const Params& p, unsigned char* lds, int cj) {
    unsigned char* ws = p.ws;
    const int kv = cj >> 6, bg = (cj >> 3) & 7, rq = (cj >> 1) & 3, hh = cj & 1;
    const bf16_t* A = (const bf16_t*)(ws + (kv ? WS_VC : WS_KC)) + ((size_t)bg * SEQ + (size_t)rq * 64 * 16) * 64;
    const bf16_t* Bt = (const bf16_t*)(ws + (kv ? WS_W1TV : WS_W1TK)) + (size_t)hh * 128 * 2048;
    const float* peb = (const float*)(ws + (kv ? WS_PEBV : WS_PEBK)) + hh * 128;
    const bf16_t* w2t = (const bf16_t*)(ws + (kv ? WS_W2TV : WS_W2TK));
    float* dst = (float*)(ws + (kv ? WS_VCMP : WS_KCMP)) + (size_t)bg * 256 * 64;
    f32x16 acc[1][2];
    gemm_mainloop_t<1>(A, 1024, Bt, 2048, 2048, acc, lds);
    epi_foreach_t<1>(acc, [&](int m, int n, f32x4 v) {
        f32x4 bb = *(const f32x4*)(peb + n);
        u32x2 o = {pk2(gelu_erf(v.x + bb.x), gelu_erf(v.y + bb.y)), pk2(gelu_erf(v.z + bb.z), gelu_erf(v.w + bb.w))};
        *(u32x2*)(lds + m * 272 + n * 2) = o;
    });
    __syncthreads();
    const int tid = threadIdx.x, lane = tid & 63, wid = tid >> 6, r = lane & 31, h = lane >> 5;
    const int wr2 = wid >> 1, wd = wid & 1;
    f32x16 a2;
#pragma unroll
    for (int i = 0; i < 16; ++i) a2[i] = 0.f;
#pragma unroll
    for (int ks = 0; ks < 8; ++ks) {
        bf16x8 fb = *(const bf16x8*)(lds + (wr2 * 32 + r) * 272 + ks * 32 + h * 16);
        bf16x8 fa = *(const bf16x8*)(w2t + (size_t)(wd * 32 + r) * 256 + hh * 128 + ks * 16 + h * 8);
        a2 = MFMA32(fa, fb, a2);
    }
    const int row = rq * 64 + wr2 * 32 + r;
    if (row < 255) {
#pragma unroll
        for (int i = 0; i < 16; ++i) {
            const int d = wd * 32 + (i & 3) + 8 * (i >> 2) + 4 * h;
            atomicAdd(dst + (size_t)row * 64 + d, a2[i]);
        }
    }
    __syncthreads();
}

constexpr int AT_K0 = 0, AT_V0 = 18432, AT_TB = 36864, AT_IMP = 40960, AT_SEL = 49152;

DI void attn_stage_load(const bf16_t* __restrict__ Kg, const bf16_t* __restrict__ Vtg, u32x4 (&st)[4], int tid) {
#pragma unroll
    for (int i = 0; i < 2; ++i) {
        const int c = tid + 256 * i, row = c >> 3, cc = c & 7;
        st[i] = *(const u32x4*)(Kg + (size_t)row * 64 + cc * 8);
        st[2 + i] = *(const u32x4*)(Vtg + (size_t)row * SEQ + cc * 8);
    }
}
DI void attn_stage_store(unsigned char* Kl, unsigned char* Vl, const u32x4 (&st)[4], int tid) {
#pragma unroll
    for (int i = 0; i < 2; ++i) {
        const int c = tid + 256 * i, row = c >> 3, cc = c & 7;
        *(u32x4*)(Kl + row * ROWB + cc * 16) = st[i];
        *(u32x4*)(Vl + row * ROWB + cc * 16) = st[2 + i];
    }
}
DI void attn_scores(const unsigned char* Kl, const bf16x8 (&qf)[4], f32x16 (&X)[2], int r, int h) {
#pragma unroll
    for (int i = 0; i < 16; ++i) { X[0][i] = 0.f; X[1][i] = 0.f; }
#pragma unroll
    for (int ks = 0; ks < 4; ++ks)
#pragma unroll
        for (int kb = 0; kb < 2; ++kb) {
            bf16x8 a = *(const bf16x8*)(Kl + (kb * 32 + r) * ROWB + ks * 32 + h * 16);
            X[kb] = MFMA32(a, qf[ks], X[kb]);
        }
}
DI void attn_pv(const unsigned char* Vl, const f32x16 (&P)[2], f32x16 (&O)[2], int r, int h) {
#pragma unroll
    for (int kb = 0; kb < 2; ++kb)
#pragma unroll
        for (int s = 0; s < 2; ++s) {
            u32x4 pw = {pk2(P[kb][8 * s], P[kb][8 * s + 1]), pk2(P[kb][8 * s + 2], P[kb][8 * s + 3]),
                        pk2(P[kb][8 * s + 4], P[kb][8 * s + 5]), pk2(P[kb][8 * s + 6], P[kb][8 * s + 7])};
            bf16x8 pb = __builtin_bit_cast(bf16x8, pw);
#pragma unroll
            for (int db = 0; db < 2; ++db) {
                const unsigned char* q = Vl + (db * 32 + r) * ROWB + (kb * 32 + 16 * s + 4 * h) * 2;
                s16x4 lo = *(const s16x4*)q, hi = *(const s16x4*)(q + 16);
                bf16x8 a = __builtin_shufflevector(lo, hi, 0, 1, 2, 3, 4, 5, 6, 7);
                O[db] = MFMA32(a, pb, O[db]);
            }
        }
}
DI void softmax_update(f32x16 (&X)[2], float& m, float& l, f32x16 (&O)[2]) {
    float mloc = -1e30f;
#pragma unroll
    for (int kb = 0; kb < 2; ++kb)
#pragma unroll
        for (int i = 0; i < 16; ++i) mloc = fmaxf(mloc, X[kb][i]);
    mloc = fmaxf(mloc, __shfl_xor(mloc, 32));
    const float mnew = fmaxf(m, mloc);
    const float alpha = __builtin_amdgcn_exp2f(m - mnew);
    m = mnew;
    float ls = 0.f;
#pragma unroll
    for (int kb = 0; kb < 2; ++kb)
#pragma unroll
        for (int i = 0; i < 16; ++i) {
            const float x = X[kb][i];
            const float pv = x > -1e29f ? __builtin_amdgcn_exp2f(x - mnew) : 0.f;
            X[kb][i] = pv; ls += pv;
        }
    l = l * alpha + ls;
#pragma unroll
    for (int db = 0; db < 2; ++db)
#pragma unroll
        for (int i = 0; i < 16; ++i) O[db][i] *= alpha;
}
DI void softmax_far(f32x16 (&X)[2], float cb, float& m, float& l, f32x16 (&O)[2]) {
    float mloc = -3e38f;
#pragma unroll
    for (int kb = 0; kb < 2; ++kb)
#pragma unroll
        for (int i = 0; i < 16; ++i) mloc = fmaxf(mloc, X[kb][i]);
    mloc += cb;
    mloc = fmaxf(mloc, __shfl_xor(mloc, 32));
    const float mnew = fmaxf(m, mloc);
    if (__any(mnew > m)) {
        const float alpha = __builtin_amdgcn_exp2f(m - mnew);
        m = mnew; l *= alpha;
#pragma unroll
        for (int db = 0; db < 2; ++db)
#pragma unroll
            for (int i = 0; i < 16; ++i) O[db][i] *= alpha;
    }
    const float mc = m - cb;
    f32x2 ls = {0.f, 0.f};
#pragma unroll
    for (int kb = 0; kb < 2; ++kb)
#pragma unroll
        for (int i = 0; i < 16; i += 2) {
            f32x2 pv = {__builtin_amdgcn_exp2f(X[kb][i] - mc), __builtin_amdgcn_exp2f(X[kb][i + 1] - mc)};
            X[kb][i] = pv.x; X[kb][i + 1] = pv.y; ls += pv;
        }
    l += ls.x + ls.y;
}
DI void build_bias_table(const Params& p, unsigned char* lds, int g) {
    const int* buck = (const int*)(p.ws + WS_BUCK);
    float* tb = (float*)(lds + AT_TB);
    for (int i = threadIdx.x; i < 1024; i += NTHREADS) {
        const int hl = i >> 8, d = i & 255;
        tb[i] = p.in[2][buck[d] * 8 + g * 4 + hl] * LOG2E;
    }
}

DI void win_unit(const Params& p, unsigned char* lds, int u) {
    unsigned char* ws = p.ws;
    const int tid = threadIdx.x, lane = tid & 63, wid = tid >> 6, r = lane & 31, h = lane >> 5;
    const int bg = u & 7, t32 = u >> 3, b = bg >> 1, g = bg & 1, t0 = t32 * 32;
    const int hl = r >> 3, t = t0 + wid * 8 + (r & 7);
    const bf16_t* Kg = (const bf16_t*)(ws + WS_KWIN) + (size_t)bg * SEQ * 64;
    const bf16_t* Vtg = (const bf16_t*)(ws + WS_VWINT) + (size_t)bg * 64 * SEQ;
    const bf16_t* Qg = (const bf16_t*)(ws + WS_Q) + ((size_t)(b * 8 + g * 4 + hl) * SEQ + t) * 64;
    __syncthreads();
    build_bias_table(p, lds, g);
    bf16x8 qf[4];
#pragma unroll
    for (int ks = 0; ks < 4; ++ks) qf[ks] = *(const bf16x8*)(Qg + ks * 16 + h * 8);
    const int jlo = t0 < 511 ? 0 : ((t0 - 511) >> 6), jhi = t0 >> 6;
    u32x4 st[4];
    attn_stage_load(Kg + (size_t)jlo * 64 * 64, Vtg + jlo * 64, st, tid);
    attn_stage_store(lds + AT_K0, lds + AT_V0, st, tid);
    __syncthreads();
    const float* tb = (const float*)(lds + AT_TB) + hl * 256;
    const int tmin = t0 + wid * 8;
    float m = -1e30f, l = 0.f;
    f32x16 O[2];
#pragma unroll
    for (int i = 0; i < 16; ++i) { O[0][i] = 0.f; O[1][i] = 0.f; }
    for (int j = jlo; j <= jhi; ++j) {
        const int cur = (j - jlo) & 1;
        if (j < jhi) attn_stage_load(Kg + (size_t)(j + 1) * 64 * 64, Vtg + (j + 1) * 64, st, tid);
        const unsigned char* Kl = lds + AT_K0 + cur * 9216;
        const unsigned char* Vl = lds + AT_V0 + cur * 9216;
        f32x16 X[2];
        attn_scores(Kl, qf, X, r, h);
        const bool far = (tmin - (j * 64 + 63) >= 128) && (tmin + 7 - j * 64 < 512);
        if (far) {
            softmax_far(X, tb[255], m, l, O);
        } else {
#pragma unroll
            for (int kb = 0; kb < 2; ++kb)
#pragma unroll
                for (int i = 0; i < 16; ++i) {
                    const int pos = j * 64 + kb * 32 + (i & 3) + 8 * (i >> 2) + 4 * h;
                    const int dist = t - pos;
                    const bool valid = dist >= 0 && dist < 512;
                    const int di = dist < 0 ? 0 : (dist > 255 ? 255 : dist);
                    X[kb][i] = valid ? X[kb][i] + tb[di] : -1e30f;
                }
            softmax_update(X, m, l, O);
        }
        attn_pv(Vl, X, O, r, h);
        if (j < jhi) attn_stage_store(lds + AT_K0 + (cur ^ 1) * 9216, lds + AT_V0 + (cur ^ 1) * 9216, st, tid);
        __syncthreads();
    }
    const float lt = l + __shfl_xor(l, 32);
    const size_t tok = (size_t)b * SEQ + t;
    const float gate = ((const float*)(ws + WS_GATES))[tok * 24 + 16 + g * 4 + hl];
    const float sc = gate / lt;
    bf16_t* ow = (bf16_t*)(ws + WS_OWIN) + tok * 512 + (g * 4 + hl) * 64;
#pragma unroll
    for (int db = 0; db < 2; ++db)
#pragma unroll
        for (int grp = 0; grp < 4; ++grp) {
            u32x2 o = {pk2(O[db][4 * grp] * sc, O[db][4 * grp + 1] * sc), pk2(O[db][4 * grp + 2] * sc, O[db][4 * grp + 3] * sc)};
            *(u32x2*)(ow + db * 32 + 8 * grp + 4 * h) = o;
        }
}

DI void cmp_stage(const float* __restrict__ kc, const float* __restrict__ vc, int ct, unsigned char* Kl, unsigned char* Vl, bool withv, int tid) {
    {
        const int c = tid >> 2, part = tid & 3;
        const f32x4* src = (const f32x4*)(kc + (size_t)(ct * 64 + c) * 64 + part * 16);
        f32x4 a = src[0], b2 = src[1], c2 = src[2], d2 = src[3];
        u32x4 o0 = {pk2(a.x, a.y), pk2(a.z, a.w), pk2(b2.x, b2.y), pk2(b2.z, b2.w)};
        u32x4 o1 = {pk2(c2.x, c2.y), pk2(c2.z, c2.w), pk2(d2.x, d2.y), pk2(d2.z, d2.w)};
        *(u32x4*)(Kl + c * ROWB + part * 32) = o0;
        *(u32x4*)(Kl + c * ROWB + part * 32 + 16) = o1;
    }
    if (withv) {
        const int c = tid & 63, dg = tid >> 6;
        const f32x4* src = (const f32x4*)(vc + (size_t)(ct * 64 + c) * 64 + dg * 16);
#pragma unroll
        for (int q4 = 0; q4 < 4; ++q4) {
            f32x4 a = src[q4];
            const int d = dg * 16 + q4 * 4;
            *(bf16_t*)(Vl + (d + 0) * ROWB + c * 2) = (bf16_t)f2bf(a.x);
            *(bf16_t*)(Vl + (d + 1) * ROWB + c * 2) = (bf16_t)f2bf(a.y);
            *(bf16_t*)(Vl + (d + 2) * ROWB + c * 2) = (bf16_t)f2bf(a.z);
            *(bf16_t*)(Vl + (d + 3) * ROWB + c * 2) = (bf16_t)f2bf(a.w);
        }
    }
}

DI void slc_unit(const Params& p, unsigned char* lds, int u) {
    unsigned char* ws = p.ws;
    const int tid = threadIdx.x, lane = tid & 63, wid = tid >> 6, r = lane & 31, h = lane >> 5;
    const int bg = u & 7, t32 = u >> 3, b = bg >> 1, g = bg & 1, t0 = t32 * 32;
    const int hl = r >> 3, tokl = r & 7, t = t0 + wid * 8 + tokl;
    const bf16_t* Kg = (const bf16_t*)(ws + WS_KSLC) + (size_t)bg * SEQ * 64;
    const bf16_t* Vtg = (const bf16_t*)(ws + WS_VSLCT) + (size_t)bg * 64 * SEQ;
    const bf16_t* Qg = (const bf16_t*)(ws + WS_Q) + ((size_t)(b * 8 + g * 4 + hl) * SEQ + t) * 64;
    const float* kcmp = (const float*)(ws + WS_KCMP) + (size_t)bg * 256 * 64;
    const float* vcmp = (const float*)(ws + WS_VCMP) + (size_t)bg * 256 * 64;
    __syncthreads();
    build_bias_table(p, lds, g);
    unsigned* imp = (unsigned*)(lds + AT_IMP) + wid * 512;
#pragma unroll
    for (int i = 0; i < 8; ++i) imp[i * 64 + lane] = 0u;
    bf16x8 qf[4];
#pragma unroll
    for (int ks = 0; ks < 4; ++ks) qf[ks] = *(const bf16x8*)(Qg + ks * 16 + h * 8);
    const float* tb = (const float*)(lds + AT_TB) + hl * 256;
    const int cmax = t0 >> 4;
    const int nct = (t0 + 31 >= 31) ? (cmax >> 6) + 1 : 0;
    float m = -1e30f, l = 0.f;
    f32x16 Oc[2];
#pragma unroll
    for (int i = 0; i < 16; ++i) { Oc[0][i] = 0.f; Oc[1][i] = 0.f; }
    for (int ct = 0; ct < nct; ++ct) {
        __syncthreads();
        cmp_stage(kcmp, vcmp, ct, lds + AT_K0, lds + AT_V0, false, tid);
        __syncthreads();
        f32x16 X[2];
        attn_scores(lds + AT_K0, qf, X, r, h);
#pragma unroll
        for (int kb = 0; kb < 2; ++kb)
#pragma unroll
            for (int i = 0; i < 16; ++i) {
                const int c = ct * 64 + kb * 32 + (i & 3) + 8 * (i >> 2) + 4 * h;
                const int dist = t - (16 * c + 31);
                const bool valid = dist >= 0 && c < 255;
                const int di = dist < 0 ? 0 : (dist > 255 ? 255 : dist);
                X[kb][i] = valid ? X[kb][i] + tb[di] : -1e30f;
            }
        f32x16 dummy[2];
#pragma unroll
        for (int i = 0; i < 16; ++i) { dummy[0][i] = 0.f; dummy[1][i] = 0.f; }
        softmax_update(X, m, l, dummy);
    }
    const float lt = l + __shfl_xor(l, 32);
    const float invl = lt > 0.f ? 1.0f / lt : 0.f;
    for (int ct = 0; ct < nct; ++ct) {
        __syncthreads();
        cmp_stage(kcmp, vcmp, ct, lds + AT_K0, lds + AT_V0, true, tid);
        __syncthreads();
        f32x16 X[2];
        attn_scores(lds + AT_K0, qf, X, r, h);
#pragma unroll
        for (int kb = 0; kb < 2; ++kb)
#pragma unroll
            for (int i = 0; i < 16; ++i) {
                const int c = ct * 64 + kb * 32 + (i & 3) + 8 * (i >> 2) + 4 * h;
                const int dist = t - (16 * c + 31);
                const bool valid = dist >= 0 && c < 255;
                const int di = dist < 0 ? 0 : (dist > 255 ? 255 : dist);
                X[kb][i] = valid ? __builtin_amdgcn_exp2f(X[kb][i] + tb[di] - m) * invl : 0.f;
            }
#pragma unroll
        for (int kb = 0; kb < 2; ++kb)
#pragma unroll
            for (int grp = 0; grp < 4; ++grp) {
                const float s4 = (X[kb][4 * grp] + X[kb][4 * grp + 1]) + (X[kb][4 * grp + 2] + X[kb][4 * grp + 3]);
                const int jj = ct * 16 + kb * 8 + 2 * grp + h;
                atomicAdd(&imp[tokl * 64 + jj], (unsigned)(s4 * 67108864.0f + 0.5f));
                if (jj + 1 < 64) atomicAdd(&imp[tokl * 64 + jj + 1], (unsigned)(X[kb][4 * grp + 3] * 67108864.0f + 0.5f));
            }
        attn_pv(lds + AT_V0, X, Oc, r, h);
    }
    unsigned long long* selm = (unsigned long long*)(lds + AT_SEL) + wid * 8;
    for (int tk = 0; tk < 8; ++tk) {
        const int tt = t0 + wid * 8 + tk, curb = tt >> 6;
        int v = (int)imp[tk * 64 + lane];
        if (lane == 0 || lane == curb || lane == curb - 1) v = 0x7fffffff;
        if (lane > curb) v = -1;
        int cnt = 0;
#pragma unroll
        for (int k = 0; k < 64; ++k) {
            const int vk = __builtin_amdgcn_readlane(v, k);
            cnt += (vk > v || (vk == v && k < lane)) ? 1 : 0;
        }
        const unsigned long long mk = __ballot(cnt < 16);
        if (lane == 0) selm[tk] = mk;
    }
    const unsigned long long mysel = selm[tokl];
    __syncthreads();
    const int jhi = t0 >> 6;
    u32x4 st[4];
    attn_stage_load(Kg, Vtg, st, tid);
    attn_stage_store(lds + AT_K0, lds + AT_V0, st, tid);
    __syncthreads();
    float m2 = -1e30f, l2 = 0.f;
    const int tmin = t0 + wid * 8;
    f32x16 O[2];
#pragma unroll
    for (int i = 0; i < 16; ++i) { O[0][i] = 0.f; O[1][i] = 0.f; }
    for (int j = 0; j <= jhi; ++j) {
        const int cur = j & 1;
        if (j < jhi) attn_stage_load(Kg + (size_t)(j + 1) * 64 * 64, Vtg + (j + 1) * 64, st, tid);
        const unsigned char* Kl = lds + AT_K0 + cur * 9216;
        const unsigned char* Vl = lds + AT_V0 + cur * 9216;
        f32x16 X[2];
        attn_scores(Kl, qf, X, r, h);
        const bool selj = (mysel >> j) & 1ull;
        if (tmin - (j * 64 + 63) >= 128) {
            softmax_far(X, selj ? tb[255] : -1e30f, m2, l2, O);
        } else {
#pragma unroll
            for (int kb = 0; kb < 2; ++kb)
#pragma unroll
                for (int i = 0; i < 16; ++i) {
                    const int pos = j * 64 + kb * 32 + (i & 3) + 8 * (i >> 2) + 4 * h;
                    const int dist = t - pos;
                    const bool valid = dist >= 0 && selj;
                    const int di = dist < 0 ? 0 : (dist > 255 ? 255 : dist);
                    X[kb][i] = valid ? X[kb][i] + tb[di] : -1e30f;
                }
            softmax_update(X, m2, l2, O);
        }
        attn_pv(Vl, X, O, r, h);
        if (j < jhi) attn_stage_store(lds + AT_K0 + (cur ^ 1) * 9216, lds + AT_V0 + (cur ^ 1) * 9216, st, tid);
        __syncthreads();
    }
    const float lt2 = l2 + __shfl_xor(l2, 32);
    const size_t tok = (size_t)b * SEQ + t;
    const float* gt = (const float*)(ws + WS_GATES) + tok * 24;
    const float gc = gt[g * 4 + hl], gs = gt[8 + g * 4 + hl] / lt2;
    const bf16_t* ow = (const bf16_t*)(ws + WS_OWIN) + tok * 512 + (g * 4 + hl) * 64;
    bf16_t* mx = (bf16_t*)(ws + WS_MIXIN) + tok * 1024 + (g * 4 + hl) * 64;
#pragma unroll
    for (int db = 0; db < 2; ++db)
#pragma unroll
        for (int grp = 0; grp < 4; ++grp) {
            const int d = db * 32 + 8 * grp + 4 * h;
            const u32x2 w = *(const u32x2*)(ow + d);
            const float r0 = gc * Oc[db][4 * grp] + gs * O[db][4 * grp] + bflo(w.x);
            const float r1 = gc * Oc[db][4 * grp + 1] + gs * O[db][4 * grp + 1] + bfhi(w.x);
            const float r2 = gc * Oc[db][4 * grp + 2] + gs * O[db][4 * grp + 2] + bflo(w.y);
            const float r3 = gc * Oc[db][4 * grp + 3] + gs * O[db][4 * grp + 3] + bfhi(w.y);
            u32x2 o = {pk2(r0, r1), pk2(r2, r3)};
            *(u32x2*)(mx + d) = o;
        }
}

DI void pooly_job(const Params& p, int job) {
    unsigned char* ws = p.ws;
    const bf16_t* z = (const bf16_t*)(ws + WS_Z);
    bf16_t* y = (bf16_t*)(ws + WS_YPOOL);
    const int tid = threadIdx.x;
    const int tokb = job * 16 + (tid >> 6) * 4, ch = tid & 63, tb = tokb & 4095;
    const int gi = ch >> 4, win = 2 << gi;
    u32x4 rowv[19];
#pragma unroll
    for (int i = 0; i < 19; ++i) {
        const int dt = i - 15;
        const bool need = dt > -win && tb + dt >= 0;
        rowv[i] = *(const u32x4*)(z + (size_t)(need ? tokb + dt : tokb) * 512 + ch * 8);
    }
    float f[19][8];
#pragma unroll
    for (int i = 0; i < 19; ++i) {
        f[i][0] = bflo(rowv[i].x); f[i][1] = bfhi(rowv[i].x); f[i][2] = bflo(rowv[i].y); f[i][3] = bfhi(rowv[i].y);
        f[i][4] = bflo(rowv[i].z); f[i][5] = bfhi(rowv[i].z); f[i][6] = bflo(rowv[i].w); f[i][7] = bfhi(rowv[i].w);
    }
#pragma unroll
    for (int o = 0; o < 4; ++o) {
        const int t = tb + o;
        const int cnt = (t + 1 < win) ? t + 1 : win;
        float s[8];
#pragma unroll
        for (int c = 0; c < 8; ++c) s[c] = 0.f;
#pragma unroll
        for (int k = 0; k < 16; ++k) {
            const float wk = k < cnt ? 1.0f : 0.0f;
#pragma unroll
            for (int c = 0; c < 8; ++c) s[c] += wk * f[15 + o - k][c];
        }
        const float ic = 1.0f / (float)cnt;
        u32x4 ov = {pk2(s[0] * ic - f[15 + o][0], s[1] * ic - f[15 + o][1]), pk2(s[2] * ic - f[15 + o][2], s[3] * ic - f[15 + o][3]),
                    pk2(s[4] * ic - f[15 + o][4], s[5] * ic - f[15 + o][5]), pk2(s[6] * ic - f[15 + o][6], s[7] * ic - f[15 + o][7])};
        *(u32x4*)(y + (size_t)(tokb + o) * 512 + ch * 8) = ov;
    }
}

DI void lnfold_consts(const Params& p, int n0, int cnt) {
    unsigned char* ws = p.ws;
    const int lane = threadIdx.x & 63, wid = threadIdx.x >> 6;
    const bf16_t* wqt = (const bf16_t*)(ws + WS_WQT);
    const float* wq = p.in[14];
    const float* bb = p.in[13];
    for (int n = n0 + wid; n < n0 + cnt; n += 4) {
        float s1 = 0.f, s2 = 0.f;
#pragma unroll
        for (int j = 0; j < 2; ++j) {
            const u32x4 w = *(const u32x4*)(wqt + (size_t)n * 1024 + (j * 64 + lane) * 8);
            s1 += (bflo(w.x) + bfhi(w.x)) + (bflo(w.y) + bfhi(w.y)) + (bflo(w.z) + bfhi(w.z)) + (bflo(w.w) + bfhi(w.w));
        }
#pragma unroll 8
        for (int k = lane; k < 1024; k += 64) s2 += bb[k] * wq[(size_t)k * 2048 + n];
        s1 = wave_sum(s1); s2 = wave_sum(s2);
        if (lane == 0) { ((float*)(ws + WS_C1))[n] = s1; ((float*)(ws + WS_C2))[n] = s2; }
    }
}

DI void phase2(const Params& p, unsigned char* lds) {
    const int G = gridDim.x, bx = blockIdx.x;
    if (G == 512) {
        if (bx < 128) { compress_job(p, lds, bx); win_unit(p, lds, 768 + bx); }
        else {
            win_unit(p, lds, bx - 128); win_unit(p, lds, 384 + bx - 128);
            if (bx < 256) win_unit(p, lds, 896 + bx - 128);
            else lnfold_consts(p, (bx - 256) * 8, 8);
        }
    } else {
        for (int job = bx; job < 128; job += G) compress_job(p, lds, job);
        for (int job = bx; job < 1024; job += G) win_unit(p, lds, job);
        for (int n0 = bx * 8; n0 < 2048; n0 += G * 8) lnfold_consts(p, n0, 8);
    }
    for (int job = bx; job < 1024; job += G) pooly_job(p, job);
}

DI void pool_gemm_tile(const Params& p, unsigned char* lds, int tile) {
    unsigned char* ws = p.ws;
    const int gi = tile & 3, tm = tile >> 2;
    f32x16 acc[2][2];
    __syncthreads();
    gemm_mainloop((const bf16_t*)(ws + WS_YPOOL) + (size_t)tm * 128 * 512 + gi * 128, 512,
                  (const bf16_t*)(ws + WS_POOLWT) + (size_t)gi * 16384, 128, 128, acc, lds);
    const float* sc = p.in[10] + gi * 128;
    bf16_t* mx = (bf16_t*)(ws + WS_MIXIN);
    epi_stage_rows(acc, lds, [&](int n) { return *(const f32x4*)(sc + n); });
    __syncthreads();
    rows_foreach(lds, [&](int m, int cc, u32x4 d) {
        *(u32x4*)(mx + (size_t)(tm * 128 + m) * 1024 + 512 + gi * 128 + cc * 8) = d;
    });
}

DI void phase3(const Params& p, unsigned char* lds) {
    const int G = gridDim.x, bx = blockIdx.x;
    for (int pass = 0; pass * G < 1024; ++pass) {
        const int i = pass * G + ((pass & 1) ? (G - 1 - bx) : bx);
        if (i < 1024) {
            const int u = ((127 - (i >> 3)) << 3) | (i & 7);
            slc_unit(p, lds, u);
        }
    }
    for (int tile = bx; tile < 512; tile += G) pool_gemm_tile(p, lds, tile);
}

DI void phase4(const Params& p, unsigned char* lds) {
    unsigned char* ws = p.ws;
    const float* x = p.in[0];
    bf16_t* y1 = (bf16_t*)(ws + WS_Z);
    const bool conv_first = (blockIdx.x >> 3) & 1;
    if (conv_first) convert_tables(p);
    const int G8 = (gridDim.x & 7) == 0 ? gridDim.x >> 3 : 0;
    for (int l0 = G8 ? 0 : (int)blockIdx.x; l0 < (G8 ? 128 : 1024); l0 += (G8 ? G8 : (int)gridDim.x)) {
        const int li = G8 ? l0 + cu_pair_pos((int)(blockIdx.x >> 3), G8) : l0;
        if (G8 && li >= 128) break;
        const int tile = G8 ? (int)(blockIdx.x & 7) * 128 + li : li;
        const int tn = tile & 7, tm = tile >> 3;
        f32x16 acc[2][2];
        gemm_mainloop((const bf16_t*)(ws + WS_MIXIN) + (size_t)tm * 128 * 1024, 1024,
                      (const bf16_t*)(ws + WS_WOUTT) + (size_t)tn * 128 * 1024, 1024, 1024, acc, lds);
        epi_stage_rows(acc, lds, [&](int) { return (f32x4){1.f, 1.f, 1.f, 1.f}; });
        __syncthreads();
        rows_foreach(lds, [&](int m, int cc, u32x4 d) {
            const size_t off = (size_t)(tm * 128 + m) * 1024 + tn * 128 + cc * 8;
            const f32x4 xa = *(const f32x4*)(x + off), xb = *(const f32x4*)(x + off + 4);
            u32x4 o = {pk2(ALPHA * xa.x + bflo(d.x), ALPHA * xa.y + bfhi(d.x)), pk2(ALPHA * xa.z + bflo(d.y), ALPHA * xa.w + bfhi(d.y)),
                       pk2(ALPHA * xb.x + bflo(d.z), ALPHA * xb.y + bfhi(d.z)), pk2(ALPHA * xb.z + bflo(d.w), ALPHA * xb.w + bfhi(d.w))};
            *(u32x4*)(y1 + off) = o;
            float s = ((bflo(o.x) + bfhi(o.x)) + (bflo(o.y) + bfhi(o.y))) + ((bflo(o.z) + bfhi(o.z)) + (bflo(o.w) + bfhi(o.w)));
            float q = ((bflo(o.x) * bflo(o.x) + bfhi(o.x) * bfhi(o.x)) + (bflo(o.y) * bflo(o.y) + bfhi(o.y) * bfhi(o.y)))
                    + ((bflo(o.z) * bflo(o.z) + bfhi(o.z) * bfhi(o.z)) + (bflo(o.w) * bflo(o.w) + bfhi(o.w) * bfhi(o.w)));
#pragma unroll
            for (int sh = 1; sh < 16; sh <<= 1) { s += __shfl_xor(s, sh); q += __shfl_xor(q, sh); }
            if (cc == 0) *(f32x2*)((float*)(ws + WS_LNST) + (size_t)(tm * 128 + m) * 16 + tn * 2) = (f32x2){s, q};
        });
        __syncthreads();
    }
    if (!conv_first) convert_tables(p);
}

DI void ln1_stats(const unsigned char* ws, int row, float& mean, float& rstd) {
    const f32x4* st = (const f32x4*)((const float*)(ws + WS_LNST) + (size_t)row * 16);
    const f32x4 a = st[0], b = st[1], c = st[2], d = st[3];
    const float s = ((a.x + a.z) + (b.x + b.z)) + ((c.x + c.z) + (d.x + d.z));
    const float q = ((a.y + a.w) + (b.y + b.w)) + ((c.y + c.w) + (d.y + d.w));
    mean = s * (1.0f / 1024.0f);
    const float var = fmaxf(q * (1.0f / 1024.0f) - mean * mean, 0.f);
    rstd = rsqrtf(var + LN_EPS);
}

DI void phase5(const Params& p) {
    unsigned char* ws = p.ws;
    const int lane = threadIdx.x & 63, wid = threadIdx.x >> 6;
    const float* gg = p.in[12];
    const float* bb = p.in[13];
    bf16_t* h1 = (bf16_t*)(ws + WS_H1);
    for (int row = blockIdx.x * 4 + wid; row < NTOK; row += gridDim.x * 4) {
        const u32x2* xr = (const u32x2*)((const bf16_t*)(ws + WS_Z) + (size_t)row * 1024) + lane;
        f32x4 v[4];
        float s = 0.f;
#pragma unroll
        for (int j = 0; j < 4; ++j) { const u32x2 w = xr[64 * j]; v[j] = (f32x4){bflo(w.x), bfhi(w.x), bflo(w.y), bfhi(w.y)}; s += (v[j].x + v[j].y) + (v[j].z + v[j].w); }
        const float mean = wave_sum(s) * (1.0f / 1024.0f);
        float s2 = 0.f;
#pragma unroll
        for (int j = 0; j < 4; ++j) { v[j] = v[j] - mean; s2 += (v[j].x * v[j].x + v[j].y * v[j].y) + (v[j].z * v[j].z + v[j].w * v[j].w); }
        const float rstd = rsqrtf(wave_sum(s2) * (1.0f / 1024.0f) + LN_EPS);
#pragma unroll
        for (int j = 0; j < 4; ++j) {
            const f32x4 g4 = ((const f32x4*)gg)[lane + 64 * j], b4 = ((const f32x4*)bb)[lane + 64 * j];
            u32x2 o = {pk2(v[j].x * rstd * g4.x + b4.x, v[j].y * rstd * g4.y + b4.y), pk2(v[j].z * rstd * g4.z + b4.z, v[j].w * rstd * g4.w + b4.w)};
            *(u32x2*)(h1 + (size_t)row * 1024 + (lane + 64 * j) * 4) = o;
        }
    }
}


DI void ce_desc(int& a, int& b) { const int hi = a > b ? a : b, lo = a > b ? b : a; a = hi; b = lo; }
template <int K, int J> DI void bst(int (&a)[16]) {
#pragma unroll
    for (int i = 0; i < 16; ++i) { const int l = i ^ J; if (l > i) { if ((i & K) == 0) ce_desc(a[i], a[l]); else ce_desc(a[l], a[i]); } }
}
DI void sort16(int (&a)[16]) { bst<2, 1>(a); bst<4, 2>(a); bst<4, 1>(a); bst<8, 4>(a); bst<8, 2>(a); bst<8, 1>(a); bst<16, 8>(a); bst<16, 4>(a); bst<16, 2>(a); bst<16, 1>(a); }
DI void merge_top16(int (&a)[16], const int (&b)[16]) {
#pragma unroll
    for (int i = 0; i < 16; ++i) a[i] = a[i] > b[15 - i] ? a[i] : b[15 - i];
    bst<16, 8>(a); bst<16, 4>(a); bst<16, 2>(a); bst<16, 1>(a);
}

constexpr int cand_i(int c) { return c < 16 ? 0 : c < 24 ? 1 : c < 29 ? 2 : c < 33 ? 3 : c < 36 ? 4 : c < 38 ? 5 : c < 40 ? 6 : c < 42 ? 7 : c - 34; }
constexpr int cand_j(int c) { return c < 16 ? c : c < 24 ? c - 16 : c < 29 ? c - 24 : c < 33 ? c - 29 : c < 36 ? c - 33 : c < 38 ? c - 36 : c < 40 ? c - 38 : c < 42 ? c - 40 : 0; }
DI void cand_ij(int c, int& i, int& j) {
    if (c < 16) { i = 0; j = c; } else if (c < 24) { i = 1; j = c - 16; } else if (c < 29) { i = 2; j = c - 24; } else if (c < 33) { i = 3; j = c - 29; }
    else if (c < 36) { i = 4; j = c - 33; } else if (c < 38) { i = 5; j = c - 36; } else if (c < 40) { i = 6; j = c - 38; } else if (c < 42) { i = 7; j = c - 40; }
    else { i = c - 34; j = 0; }
}
DI float key_val6(int k) { int b = k & ~63; b ^= (b >> 31) & 0x7fffffff; return __int_as_float(b); }

DI void phase6(const Params& p, unsigned char* lds) {
    unsigned char* ws = p.ws;
    const int tid = threadIdx.x, lane = tid & 63, wid = tid >> 6, wr = wid >> 1, wc = wid & 1, r = lane & 31, h = lane >> 5;
    const bf16_t* h1 = (const bf16_t*)(ws + WS_Z);
    const bf16_t* wq = (const bf16_t*)(ws + WS_WQT);
    const bf16_t* sk = (const bf16_t*)(ws + WS_SUBK);
    const float* c1 = (const float*)(ws + WS_C1);
    const float* c2 = (const float*)(ws + WS_C2);
    int* routeE = (int*)(ws + WS_TOPK);
    float* routeG = (float*)(ws + WS_TOPK + 8 * MiB);
    int* L1s = (int*)(lds + 65536);
    const int G8 = (gridDim.x & 7) == 0 ? gridDim.x >> 3 : 0;
    for (int l0 = G8 ? 0 : (int)blockIdx.x; l0 < (G8 ? 128 : 1024); l0 += (G8 ? G8 : (int)gridDim.x)) {
        const int li = G8 ? l0 + cu_pair_pos((int)(blockIdx.x >> 3), G8) : l0;
        if (G8 && li >= 128) break;
        const int pair = G8 ? (int)(blockIdx.x & 7) * 128 + li : li;
        const int tm = pair >> 3, head = pair & 7;
        int ka[16], kb[16];
        float rmean[2], rrstd[2];
#pragma unroll
        for (int mi = 0; mi < 2; ++mi) ln1_stats(ws, tm * 128 + wr * 64 + mi * 32 + r, rmean[mi], rrstd[mi]);
        if (tid < 128) {
            const int kh = tid >> 6, wh = (tid >> 5) & 1, q4 = tid & 31;
            *(f32x4*)(lds + LDS_CST + kh * 1024 + wh * 512 + q4 * 16) = *(const f32x4*)((wh ? c2 : c1) + (head * 2 + kh) * 128 + q4 * 4);
        }
#pragma unroll 1
        for (int khalf = 0; khalf < 2; ++khalf) {
            const int tn = head * 2 + khalf;
            f32x16 acc[2][2];
            gemm_mainloop(h1 + (size_t)tm * 128 * 1024, 1024, wq + (size_t)tn * 128 * 1024, 1024, 1024, acc, lds);
            epi_foreach(acc, [&](int m, int n, f32x4 v) {
                const int mi = (m >> 5) & 1;
                const float mu = mi ? rmean[1] : rmean[0], rs = mi ? rrstd[1] : rrstd[0];
                const f32x4 k1 = *(const f32x4*)(lds + LDS_CST + khalf * 1024 + n * 4), k2 = *(const f32x4*)(lds + LDS_CST + khalf * 1024 + 512 + n * 4);
                u32x2 o = {pk2(rs * (v.x - mu * k1.x) + k2.x, rs * (v.y - mu * k1.y) + k2.y), pk2(rs * (v.z - mu * k1.z) + k2.z, rs * (v.w - mu * k1.w) + k2.w)};
                *(u32x2*)(lds + m * 272 + n * 2) = o;
            });
            __syncthreads();
            f32x16 a2[2][2];
#pragma unroll
            for (int mi = 0; mi < 2; ++mi)
#pragma unroll
                for (int ni = 0; ni < 2; ++ni)
#pragma unroll
                    for (int i = 0; i < 16; ++i) a2[mi][ni][i] = 0.f;
#pragma unroll
            for (int ks = 0; ks < 8; ++ks) {
                bf16x8 fa[2], fb[2];
#pragma unroll
                for (int mi = 0; mi < 2; ++mi) fa[mi] = *(const bf16x8*)(lds + (wr * 64 + mi * 32 + r) * 272 + ks * 32 + h * 16);
#pragma unroll
                for (int ni = 0; ni < 2; ++ni) fb[ni] = *(const bf16x8*)(sk + (size_t)(khalf * 128 + wc * 64 + ni * 32 + r) * 128 + ks * 16 + h * 8);
#pragma unroll
                for (int mi = 0; mi < 2; ++mi)
#pragma unroll
                    for (int ni = 0; ni < 2; ++ni) a2[mi][ni] = MFMA32(fb[ni], fa[mi], a2[mi][ni]);
            }
            __syncthreads();
#pragma unroll
            for (int mi = 0; mi < 2; ++mi) {
                int xa[16], xb[16];
#pragma unroll
                for (int i = 0; i < 16; ++i) {
                    const int n = wc * 64 + (i & 3) + 8 * (i >> 2) + 4 * h;
                    xa[i] = make_key(a2[mi][0][i], n); xb[i] = make_key(a2[mi][1][i], n + 32);
                }
                sort16(xa); sort16(xb); merge_top16(xa, xb);
#pragma unroll
                for (int i = 0; i < 16; ++i) xb[i] = __shfl_xor(xa[i], 32);
                merge_top16(xa, xb);
                if (h == 0) {
                    int* dst = (int*)lds + ((wr * 64 + mi * 32 + r) * 2 + wc) * 16;
#pragma unroll
                    for (int q4 = 0; q4 < 4; ++q4) { u32x4 o = {(unsigned)xa[4 * q4], (unsigned)xa[4 * q4 + 1], (unsigned)xa[4 * q4 + 2], (unsigned)xa[4 * q4 + 3]}; *(u32x4*)(dst + 4 * q4) = o; }
                }
            }
            __syncthreads();
            if (tid < 128) {
                const int* s0 = (const int*)lds + tid * 32;
#pragma unroll
                for (int q4 = 0; q4 < 4; ++q4) {
                    const u32x4 x = *(const u32x4*)(s0 + 4 * q4), y = *(const u32x4*)(s0 + 16 + 4 * q4);
                    ka[4 * q4] = (int)x.x; ka[4 * q4 + 1] = (int)x.y; ka[4 * q4 + 2] = (int)x.z; ka[4 * q4 + 3] = (int)x.w;
                    kb[4 * q4] = (int)y.x; kb[4 * q4 + 1] = (int)y.y; kb[4 * q4 + 2] = (int)y.z; kb[4 * q4 + 3] = (int)y.w;
                }
                merge_top16(ka, kb);
                if (khalf == 0) {
#pragma unroll
                    for (int q4 = 0; q4 < 4; ++q4) { u32x4 o = {(unsigned)ka[4 * q4], (unsigned)ka[4 * q4 + 1], (unsigned)ka[4 * q4 + 2], (unsigned)ka[4 * q4 + 3]}; *(u32x4*)(L1s + tid * 16 + 4 * q4) = o; }
                }
            }
            if (khalf == 0) __syncthreads();
        }
        if (tid < 128) {
            int* L2s = (int*)lds + tid * 32;
#pragma unroll
            for (int q4 = 0; q4 < 4; ++q4) { u32x4 o = {(unsigned)ka[4 * q4], (unsigned)ka[4 * q4 + 1], (unsigned)ka[4 * q4 + 2], (unsigned)ka[4 * q4 + 3]}; *(u32x4*)(L2s + 4 * q4) = o; }
            float v1[16], v2[16];
#pragma unroll
            for (int q4 = 0; q4 < 4; ++q4) {
                const u32x4 x = *(const u32x4*)(L1s + tid * 16 + 4 * q4);
                v1[4 * q4] = key_val((int)x.x); v1[4 * q4 + 1] = key_val((int)x.y); v1[4 * q4 + 2] = key_val((int)x.z); v1[4 * q4 + 3] = key_val((int)x.w);
            }
#pragma unroll
            for (int i = 0; i < 16; ++i) v2[i] = key_val(ka[i]);
            int g0[16], g1[16], g2[16], g3[16];
#pragma unroll
            for (int t = 0; t < 16; ++t) {
                { const float s = v1[cand_i(t)] + v2[cand_j(t)]; int b = __float_as_int(s); b ^= (b >> 31) & 0x7fffffff; g0[t] = (b & ~63) | (63 - t); }
                { const float s = v1[cand_i(16 + t)] + v2[cand_j(16 + t)]; int b = __float_as_int(s); b ^= (b >> 31) & 0x7fffffff; g1[t] = (b & ~63) | (63 - (16 + t)); }
                { const float s = v1[cand_i(32 + t)] + v2[cand_j(32 + t)]; int b = __float_as_int(s); b ^= (b >> 31) & 0x7fffffff; g2[t] = (b & ~63) | (63 - (32 + t)); }
                if (t < 2) { const float s = v1[cand_i(48 + t)] + v2[cand_j(48 + t)]; int b = __float_as_int(s); b ^= (b >> 31) & 0x7fffffff; g3[t] = (b & ~63) | (63 - (48 + t)); }
                else g3[t] = (int)0x80000000 + t;
            }
            sort16(g0); sort16(g1); sort16(g2); sort16(g3);
            merge_top16(g0, g1); merge_top16(g2, g3); merge_top16(g0, g2);
            const float smax = key_val6(g0[0]);
            float ex[16], den = 0.f;
#pragma unroll
            for (int t = 0; t < 16; ++t) { ex[t] = __expf(key_val6(g0[t]) - smax); den += ex[t]; }
            const float inv = 1.0f / den;
            const size_t ro = ((size_t)(tm * 128 + tid) * 8 + head) * 16;
#pragma unroll
            for (int q4 = 0; q4 < 4; ++q4) {
                int ee[4];
#pragma unroll
                for (int u = 0; u < 4; ++u) {
                    int ci, cj; cand_ij(63 - (g0[4 * q4 + u] & 63), ci, cj);
                    ee[u] = (L1s[tid * 16 + ci] & 127) * 128 + (L2s[cj] & 127);
                }
                u32x4 oe = {(unsigned)ee[0], (unsigned)ee[1], (unsigned)ee[2], (unsigned)ee[3]};
                f32x4 og = {ex[4 * q4] * inv, ex[4 * q4 + 1] * inv, ex[4 * q4 + 2] * inv, ex[4 * q4 + 3] * inv};
                *(u32x4*)(routeE + ro + 4 * q4) = oe;
                *(f32x4*)(routeG + ro + 4 * q4) = og;
            }
        }
        __syncthreads();
    }
}

constexpr int P7_NS = 32, P7_SH = 9;
constexpr int P7_WLDS = 6144;
DI void p7_loadrows(int b, int li, int l32, const LAS int* ent_e, const unsigned char* tab, u32x4 (&rows)[8][2]) {
    const u32x4 e0 = *(const LAS u32x4*)(ent_e + li * 128 + b), e1 = *(const LAS u32x4*)(ent_e + li * 128 + b + 4);
    const unsigned ee[8] = {e0.x, e0.y, e0.z, e0.w, e1.x, e1.y, e1.z, e1.w};
#pragma unroll
    for (int r = 0; r < 8; ++r) {
        const unsigned ob = ee[r] * 1024u + (unsigned)l32 * 16u;
        rows[r][0] = *(const u32x4*)(tab + ob);
        rows[r][1] = *(const u32x4*)(tab + ob + 512);
    }
}
DI float half32_sum(float v) { v += __shfl_xor(v, 1); v += __shfl_xor(v, 2); v += __shfl_xor(v, 4); v += __shfl_xor(v, 8); v += __shfl_xor(v, 16); return v; }

DI void p7_stepA(const u32x4 (&rows)[8][2], const unsigned (&hq)[2][4], float hscale, int b, int li, int l32, int lane, int myk,
                 LAS float* ent_w, const LAS float* ent_us) {
    int d[8];
#pragma unroll
    for (int r = 0; r < 8; ++r) {
        int a = 0;
#pragma unroll
        for (int c = 0; c < 2; ++c)
#pragma unroll
            for (int q = 0; q < 4; ++q) a = dot4i8(rows[r][c][q], hq[c][q], a);
        d[r] = a;
    }
    int r4[4], r2[2], r1;
    const bool b0 = lane & 1;
#pragma unroll
    for (int i = 0; i < 4; ++i) { const int snd = b0 ? d[i] : d[4 + i]; const int kp = b0 ? d[4 + i] : d[i]; r4[i] = kp + __shfl_xor(snd, 1); }
    const bool b1 = lane & 2;
#pragma unroll
    for (int i = 0; i < 2; ++i) { const int snd = b1 ? r4[i] : r4[2 + i]; const int kp = b1 ? r4[2 + i] : r4[i]; r2[i] = kp + __shfl_xor(snd, 2); }
    const bool b2 = lane & 4;
    { const int snd = b2 ? r2[0] : r2[1]; const int kp = b2 ? r2[1] : r2[0]; r1 = kp + __shfl_xor(snd, 4); }
    r1 += __shfl_xor(r1, 8); r1 += __shfl_xor(r1, 16);
    if (l32 < 8) { const int idx = li * 128 + b + myk; ent_w[idx] = ent_w[idx] * gelu_fast((float)r1 * (hscale * ent_us[idx])); }
}
DI void p7_stepA6(const unsigned (&rw)[8][6], const f16x2_t (&h16)[16], int b, int li, int l32, int lane, int myk,
                  LAS float* ent_w, const LAS float* ent_us) {
    float d[8];
#pragma unroll
    for (int r = 0; r < 8; ++r) {
        const u32x6 pk = {rw[r][0], rw[r][1], rw[r][2], rw[r][3], rw[r][4], rw[r][5]};
        const f16x32 u = __builtin_amdgcn_cvt_scalef32_pk32_f16_fp6(pk, 1.0f);
        float a0 = 0.f, a1 = 0.f;
#pragma unroll
        for (int j = 0; j < 16; j += 2) {
            a0 = __builtin_amdgcn_fdot2((f16x2_t){u[2 * j], u[2 * j + 1]}, h16[j], a0, false);
            a1 = __builtin_amdgcn_fdot2((f16x2_t){u[2 * j + 2], u[2 * j + 3]}, h16[j + 1], a1, false);
        }
        d[r] = a0 + a1;
        if (r & 1) __builtin_amdgcn_sched_barrier(0);
    }
    float r4[4], r2[2], r1;
    const bool b0 = lane & 1;
#pragma unroll
    for (int i = 0; i < 4; ++i) { const float snd = b0 ? d[i] : d[4 + i]; const float kp = b0 ? d[4 + i] : d[i]; r4[i] = kp + __shfl_xor(snd, 1); }
    const bool b1 = lane & 2;
#pragma unroll
    for (int i = 0; i < 2; ++i) { const float snd = b1 ? r4[i] : r4[2 + i]; const float kp = b1 ? r4[2 + i] : r4[i]; r2[i] = kp + __shfl_xor(snd, 2); }
    const bool b2 = lane & 4;
    { const float snd = b2 ? r2[0] : r2[1]; const float kp = b2 ? r2[1] : r2[0]; r1 = kp + __shfl_xor(snd, 4); }
    r1 += __shfl_xor(r1, 8); r1 += __shfl_xor(r1, 16);
    if (l32 < 8) { const int idx = li * 128 + b + myk; ent_w[idx] = ent_w[idx] * gelu_fast(r1 * ent_us[idx]); }
}
DI void p7_stepB(const u32x4 (&rows)[8][2], f32x2 (&acc)[2][8], int b, int li, const LAS float* ent_w) {
    const f32x4 w0 = *(const LAS f32x4*)(ent_w + li * 128 + b), w1 = *(const LAS f32x4*)(ent_w + li * 128 + b + 4);
    const float ww[8] = {w0.x, w0.y, w0.z, w0.w, w1.x, w1.y, w1.z, w1.w};
#pragma unroll
    for (int r = 0; r < 8; ++r) {
        const f32x2 w2 = {ww[r], ww[r]};
#pragma unroll
        for (int c = 0; c < 2; ++c)
#pragma unroll
            for (int q = 0; q < 4; ++q) {
                const f32x2 lo = __builtin_amdgcn_cvt_pk_f32_fp8((int)rows[r][c][q], false);
                const f32x2 hi = __builtin_amdgcn_cvt_pk_f32_fp8((int)rows[r][c][q], true);
                acc[c][2 * q] += w2 * lo; acc[c][2 * q + 1] += w2 * hi;
            }
    }
}
DI void p7_loadrows6(int b, int li, int l32, const LAS int* ent_e, const unsigned char* tab, unsigned (&rw)[8][6]) {
    const u32x4 e0 = *(const LAS u32x4*)(ent_e + li * 128 + b), e1 = *(const LAS u32x4*)(ent_e + li * 128 + b + 4);
    const unsigned ee[8] = {e0.x, e0.y, e0.z, e0.w, e1.x, e1.y, e1.z, e1.w};
#pragma unroll
    for (int r = 0; r < 8; ++r) {
        const unsigned ob = ee[r] * 768u;
        const u32x4 x = *(const u32x4*)(tab + ob + (unsigned)l32 * 16u);
        const u32x2 y = *(const u32x2*)(tab + ob + 512u + (unsigned)l32 * 8u);
        rw[r][0] = x.x; rw[r][1] = x.y; rw[r][2] = x.z; rw[r][3] = x.w; rw[r][4] = y.x; rw[r][5] = y.y;
    }
}
DI void p7_stepB6(const unsigned (&rw)[8][6], f32x2 (&acc)[2][8], int b, int li, const LAS float* ent_w) {
    const f32x4 w0 = *(const LAS f32x4*)(ent_w + li * 128 + b), w1 = *(const LAS f32x4*)(ent_w + li * 128 + b + 4);
    const float ww[8] = {w0.x, w0.y, w0.z, w0.w, w1.x, w1.y, w1.z, w1.w};
#pragma unroll
    for (int r = 0; r < 8; ++r) {
        const u32x6 pk = {rw[r][0], rw[r][1], rw[r][2], rw[r][3], rw[r][4], rw[r][5]};
        const f32x32 d = __builtin_amdgcn_cvt_scalef32_pk32_f32_fp6(pk, 1.0f);
        const f32x2 w2 = {ww[r], ww[r]};
#pragma unroll
        for (int c = 0; c < 2; ++c)
#pragma unroll
            for (int i = 0; i < 8; ++i) acc[c][i] += w2 * (f32x2){d[c * 16 + 2 * i], d[c * 16 + 2 * i + 1]};
    }
}
constexpr int P7_GB = 32768;
DI void p7_load_h(const Params& p, const LAS unsigned char* gb, int tok, int l32, float (&hv)[32]) {
    const unsigned char* ws = p.ws;
    float mean, rstd;
    ln1_stats(ws, tok, mean, rstd);
    const bf16_t* y1 = (const bf16_t*)(ws + WS_Z) + (size_t)tok * 1024 + l32 * 16;
    const LAS float* gg = (const LAS float*)(gb + P7_GB) + l32 * 16;
    const LAS float* bb = gg + 1024;
#pragma unroll
    for (int c = 0; c < 2; ++c) {
        const u32x4 a = *(const u32x4*)(y1 + c * 512), b2 = *(const u32x4*)(y1 + c * 512 + 8);
        const unsigned hh[8] = {a.x, a.y, a.z, a.w, b2.x, b2.y, b2.z, b2.w};
#pragma unroll
        for (int i4 = 0; i4 < 4; ++i4) {
            const f32x4 g4 = *(const LAS f32x4*)(gg + c * 512 + i4 * 4), b4 = *(const LAS f32x4*)(bb + c * 512 + i4 * 4);
            hv[c * 16 + 4 * i4 + 0] = (bflo(hh[2 * i4]) - mean) * rstd * g4.x + b4.x;
            hv[c * 16 + 4 * i4 + 1] = (bfhi(hh[2 * i4]) - mean) * rstd * g4.y + b4.y;
            hv[c * 16 + 4 * i4 + 2] = (bflo(hh[2 * i4 + 1]) - mean) * rstd * g4.z + b4.z;
            hv[c * 16 + 4 * i4 + 3] = (bfhi(hh[2 * i4 + 1]) - mean) * rstd * g4.w + b4.w;
        }
    }
}
DI void p7_h16(const Params& p, const LAS unsigned char* gb, int tok, int l32, f16x2_t (&h16)[16]) {
    float hv[32];
    p7_load_h(p, gb, tok, l32, hv);
#pragma unroll
    for (int j = 0; j < 16; ++j) h16[j] = (f16x2_t){(_Float16)hv[2 * j], (_Float16)hv[2 * j + 1]};
}
DI void p7_quant_h(const Params& p, const LAS unsigned char* gb, int tok, int l32, unsigned (&hq)[2][4], float& hscale) {
    float hv[32];
    p7_load_h(p, gb, tok, l32, hv);
    float am = 0.f;
#pragma unroll
    for (int i = 0; i < 32; ++i) am = fmaxf(am, fabsf(hv[i]));
    am = fmaxf(am, __shfl_xor(am, 1)); am = fmaxf(am, __shfl_xor(am, 2)); am = fmaxf(am, __shfl_xor(am, 4)); am = fmaxf(am, __shfl_xor(am, 8)); am = fmaxf(am, __shfl_xor(am, 16));
    const float hq_sc = am > 0.f ? 127.0f / am : 1.0f;
    hscale = am > 0.f ? am / 127.0f : 1.0f;
#pragma unroll
    for (int c = 0; c < 2; ++c)
#pragma unroll
        for (int q = 0; q < 4; ++q) {
            const int q0 = (int)rintf(hv[c * 16 + 4 * q] * hq_sc), q1 = (int)rintf(hv[c * 16 + 4 * q + 1] * hq_sc);
            const int q2 = (int)rintf(hv[c * 16 + 4 * q + 2] * hq_sc), q3 = (int)rintf(hv[c * 16 + 4 * q + 3] * hq_sc);
            hq[c][q] = (unsigned)(q0 & 255) | ((unsigned)(q1 & 255) << 8) | ((unsigned)(q2 & 255) << 16) | ((unsigned)(q3 & 255) << 24);
        }
}
DI void p7_finish(const Params& p, int tok, const float (&hv)[32], f32x2 (&acc)[2][8], int l32) {
    const size_t hbase = (size_t)tok * 1024 + l32 * 16;
    float sm = 0.f;
    {
#pragma unroll
        for (int c = 0; c < 2; ++c)
#pragma unroll
            for (int i = 0; i < 8; ++i) {
                acc[c][i].x += ALPHA * hv[c * 16 + 2 * i]; acc[c][i].y += ALPHA * hv[c * 16 + 2 * i + 1];
                sm += acc[c][i].x + acc[c][i].y;
            }
    }
    const float mean = half32_sum(sm) * (1.0f / 1024.0f);
    float sq = 0.f;
#pragma unroll
    for (int c = 0; c < 2; ++c)
#pragma unroll
        for (int i = 0; i < 8; ++i) { acc[c][i].x -= mean; acc[c][i].y -= mean; sq += acc[c][i].x * acc[c][i].x + acc[c][i].y * acc[c][i].y; }
    const float rstd = rsqrtf(half32_sum(sq) * (1.0f / 1024.0f) + LN_EPS);
    const float* gg = p.in[18] + l32 * 16;
    const float* bb = p.in[19] + l32 * 16;
    float* orow = p.out + hbase;
#pragma unroll
    for (int c = 0; c < 2; ++c)
#pragma unroll
        for (int q4 = 0; q4 < 4; ++q4) {
            const f32x4 g4 = *(const f32x4*)(gg + c * 512 + q4 * 4), b4 = *(const f32x4*)(bb + c * 512 + q4 * 4);
            f32x4 o = {acc[c][2 * q4].x * rstd * g4.x + b4.x, acc[c][2 * q4].y * rstd * g4.y + b4.y,
                       acc[c][2 * q4 + 1].x * rstd * g4.z + b4.z, acc[c][2 * q4 + 1].y * rstd * g4.w + b4.w};
            *(f32x4*)(orow + c * 512 + q4 * 4) = o;
        }
}

DI void phase7(const Params& p, unsigned char* lds) {
    unsigned char* ws = p.ws;
    const int lane = threadIdx.x & 63, wid = __builtin_amdgcn_readfirstlane(threadIdx.x >> 6);
    const int hw = lane >> 5, l32 = lane & 31;
    LAS unsigned char* l3 = (LAS unsigned char*)lds + wid * P7_WLDS;
    const unsigned char* u8 = ws + WS_UB;
    const unsigned char* v8 = ws + WS_VB;
    const float* uscale = (const float*)(ws + WS_USCALE);
    const float* vscale = (const float*)(ws + WS_VSCALE);
    LAS int* ent_e = (LAS int*)l3;
    LAS float* ent_w = (LAS float*)(l3 + 2048);
    LAS float* ent_us = (LAS float*)(l3 + 4096);
    {
        const int t = threadIdx.x;
        *(f32x4*)(lds + P7_GB + t * 16) = *(const f32x4*)(p.in[12] + t * 4);
        *(f32x4*)(lds + P7_GB + 4096 + t * 16) = *(const f32x4*)(p.in[13] + t * 4);
        __syncthreads();
    }
    const unsigned long long ltmask = (1ull << lane) - 1ull;
    const int myk = ((lane & 1) << 2) | (lane & 2) | ((lane >> 2) & 1);
    const int li0 = hw, li1 = 2 + hw;
    for (int rnd = blockIdx.x * 4 + wid; rnd < NTOK / 4; rnd += gridDim.x * 4) {
        const int tok0 = rnd * 4;
#pragma unroll 1
        for (int tk = 0; tk < 4; ++tk) {
            const int* RE = (const int*)(ws + WS_TOPK) + (size_t)(tok0 + tk) * 128;
            const float* RG = (const float*)(ws + WS_TOPK + 8 * MiB) + (size_t)(tok0 + tk) * 128;
            const int ea = RE[lane], eb = RE[64 + lane];
            const float ga = RG[lane], gb = RG[64 + lane];
            const int sa = ea >> P7_SH, sb = eb >> P7_SH;
            int pa = 0, pb = 0, run = 0;
#pragma unroll
            for (int s = 0; s < P7_NS; ++s) {
                const unsigned long long ma = __ballot(sa == s), mb = __ballot(sb == s);
                const int ca = __popcll(ma), cb = __popcll(mb);
                if (sa == s) pa = run + __popcll(ma & ltmask);
                if (sb == s) pb = run + ca + __popcll(mb & ltmask);
                run += ca + cb;
            }
            ent_e[tk * 128 + pa] = ea; ent_w[tk * 128 + pa] = ga * vscale[ea]; ent_us[tk * 128 + pa] = uscale[ea];
            ent_e[tk * 128 + pb] = eb; ent_w[tk * 128 + pb] = gb * vscale[eb]; ent_us[tk * 128 + pb] = uscale[eb];
        }
        {
            f16x2_t h0[16], h1[16];
            p7_h16(p, (const LAS unsigned char*)lds, tok0 + li0, l32, h0);
            p7_h16(p, (const LAS unsigned char*)lds, tok0 + li1, l32, h1);
            unsigned ra[8][6], rb[8][6];
            p7_loadrows6(0, li0, l32, ent_e, u8, ra);
            for (int b = 0; b < 128; b += 8) {
                p7_loadrows6(b, li1, l32, ent_e, u8, rb);
                __builtin_amdgcn_sched_barrier(0);
                p7_stepA6(ra, h0, b, li0, l32, lane, myk, ent_w, ent_us);
                __builtin_amdgcn_sched_barrier(0);
                p7_loadrows6(b + 8 < 128 ? b + 8 : b, li0, l32, ent_e, u8, ra);
                __builtin_amdgcn_sched_barrier(0);
                p7_stepA6(rb, h1, b, li1, l32, lane, myk, ent_w, ent_us);
                __builtin_amdgcn_sched_barrier(0);
            }
        }
        f32x2 acc0[2][8], acc1[2][8];
#pragma unroll
        for (int c = 0; c < 2; ++c)
#pragma unroll
            for (int i = 0; i < 8; ++i) { acc0[c][i] = (f32x2){0.f, 0.f}; acc1[c][i] = (f32x2){0.f, 0.f}; }
        {
            unsigned ra[8][6], rb[8][6];
            p7_loadrows6(0, li0, l32, ent_e, v8, ra);
            for (int b = 0; b < 128; b += 8) {
                p7_loadrows6(b, li1, l32, ent_e, v8, rb);
                __builtin_amdgcn_sched_barrier(0);
                p7_stepB6(ra, acc0, b, li0, ent_w);
                __builtin_amdgcn_sched_barrier(0);
                p7_loadrows6(b + 8 < 128 ? b + 8 : b, li0, l32, ent_e, v8, ra);
                __builtin_amdgcn_sched_barrier(0);
                p7_stepB6(rb, acc1, b, li1, ent_w);
                __builtin_amdgcn_sched_barrier(0);
            }
        }
        asm volatile("" ::: "memory");
        {
            float hv0[32], hv1[32];
            p7_load_h(p, (const LAS unsigned char*)lds, tok0 + li0, l32, hv0);
            p7_load_h(p, (const LAS unsigned char*)lds, tok0 + li1, l32, hv1);
            p7_finish(p, tok0 + li0, hv0, acc0, l32);
            p7_finish(p, tok0 + li1, hv1, acc1, l32);
        }
    }
}

#if DIAG
DI float bfv(const bf16_t* p, size_t i) { return __uint_as_float(((unsigned)p[i]) << 16); }
DI float bfr(float x) { return __uint_as_float(f2bf(x) << 16); }
DI void dfail(const Params& p, int bit) { atomicOr((unsigned*)(p.ws + WS_FLAG), 1u << bit); }
DI bool bad(float fast, float ref) { return !(fabsf(fast - ref) <= 0.02f * fabsf(ref) + 0.02f); }
DI unsigned hsh(unsigned x) { x ^= x >> 16; x *= 0x7feb352dU; x ^= x >> 15; x *= 0x846ca68bU; x ^= x >> 16; return x; }
DI int winsrc(int n) { return n < 1280 ? n : (n < 1792 ? 1304 + (n - 1280) : 1280 + (n - 1792)); }

DI void chk1(const Params& p, int bit) {
    unsigned char* ws = p.ws;
    const unsigned gt = blockIdx.x * NTHREADS + threadIdx.x;
    const int tok = hsh(gt * 2 + 1) & 16383, n = hsh(gt * 2 + 2) % 1816;
    const bf16_t* xb = (const bf16_t*)(ws + WS_XB);
    const bf16_t* wt = (const bf16_t*)(ws + WS_WINT);
    float ref = 0.f, ref2 = 0.f;
    for (int k = 0; k < 1024; ++k) {
        ref += bfv(xb, (size_t)tok * 1024 + k) * bfv(wt, (size_t)n * 1024 + k);
        ref2 += p.in[0][(size_t)tok * 1024 + k] * p.in[1][(size_t)k * 1816 + winsrc(n)];
    }
    if (!(fabsf(ref - ref2) <= 0.06f)) dfail(p, bit);
    const int b = tok >> 12, t = tok & 4095;
    float fast;
    if (n < 512) { const int hd = n >> 6, d = n & 63; fast = bfv((const bf16_t*)(ws + WS_Q), ((size_t)(b * 8 + hd) * SEQ + t) * 64 + d); ref *= 0.125f; }
    else if (n < 1280) {
        const int seg = (n - 512) >> 7, nn = (n - 512) & 127, g = nn >> 6, d = nn & 63;
        if (seg == 3 || seg == 5) fast = bfv((const bf16_t*)(ws + (seg == 3 ? WS_VSLCT : WS_VWINT)), ((size_t)((b * 2 + g) * 64 + d)) * SEQ + t);
        else fast = bfv((const bf16_t*)(ws + (seg == 0 ? WS_KC : seg == 1 ? WS_VC : seg == 2 ? WS_KSLC : WS_KWIN)), ((size_t)(b * 2 + g) * SEQ + t) * 64 + d);
    } else if (n < 1792) fast = bfv((const bf16_t*)(ws + WS_Z), (size_t)tok * 512 + (n - 1280));
    else { fast = ((const float*)(ws + WS_GATES))[(size_t)tok * 24 + (n - 1792)]; ref = 1.f / (1.f + expf(-ref)); }
    if (bad(fast, ref)) dfail(p, bit);
}
DI void chk2(const Params& p, int bit) {
    unsigned char* ws = p.ws;
    const unsigned gt = blockIdx.x * NTHREADS + threadIdx.x;
    if (gt >= 2048) return;
    const int kv = gt & 1, bg = (gt >> 1) & 7, c = hsh(gt) % 255, d = hsh(gt + 7777) & 63;
    const bf16_t* A = (const bf16_t*)(ws + (kv ? WS_VC : WS_KC)) + ((size_t)bg * SEQ + c * 16) * 64;
    const bf16_t* w1t = (const bf16_t*)(ws + (kv ? WS_W1TV : WS_W1TK));
    const bf16_t* w2t = (const bf16_t*)(ws + (kv ? WS_W2TV : WS_W2TK));
    const float* peb = (const float*)(ws + (kv ? WS_PEBV : WS_PEBK));
    float out = 0.f;
    for (int j = 0; j < 256; ++j) {
        float s = peb[j];
        for (int i = 0; i < 2048; ++i) s += bfv(A, i) * bfv(w1t, (size_t)j * 2048 + i);
        out += bfr(gelu_erf(s)) * bfv(w2t, d * 256 + j);
    }
    const float fast = ((const float*)(ws + (kv ? WS_VCMP : WS_KCMP)))[((size_t)bg * 256 + c) * 64 + d];
    if (bad(fast, out)) dfail(p, bit);
    if (gt < 256) {
        const float* w1 = kv ? p.in[7] : p.in[5];
        const float* w2 = kv ? p.in[8] : p.in[6];
        const float* pe = kv ? p.in[4] : p.in[3];
        float o2 = 0.f;
        for (int j = 0; j < 256; ++j) {
            float s = 0.f;
            for (int i = 0; i < 2048; ++i) s += (bfv(A, i) + pe[i]) * w1[(size_t)i * 256 + j];
            o2 += gelu_erf(s) * w2[j * 64 + d];
        }
        if (!(fabsf(o2 - out) <= 0.03f * fabsf(out) + 0.03f)) dfail(p, bit);
    }
}
DI void chk3(const Params& p, int bit) {
    unsigned char* ws = p.ws;
    const unsigned gt = blockIdx.x * NTHREADS + threadIdx.x;
    if (gt >= 4096) return;
    const int tok = hsh(gt) & 16383, head = hsh(gt + 99) & 7, b = tok >> 12, t = tok & 4095, g = head >> 2;
    const bf16_t* Q = (const bf16_t*)(ws + WS_Q) + ((size_t)(b * 8 + head) * SEQ + t) * 64;
    const bf16_t* K = (const bf16_t*)(ws + WS_KWIN) + (size_t)(b * 2 + g) * SEQ * 64;
    const bf16_t* Vt = (const bf16_t*)(ws + WS_VWINT) + (size_t)(b * 2 + g) * 64 * SEQ;
    float q[64], o[64];
#pragma unroll
    for (int d = 0; d < 64; ++d) { q[d] = bfv(Q, d); o[d] = 0.f; }
    float m = -1e30f, l = 0.f;
    for (int pos = (t > 511 ? t - 511 : 0); pos <= t; ++pos) {
        float s = 0.f;
#pragma unroll
        for (int d = 0; d < 64; ++d) s += q[d] * bfv(K, (size_t)pos * 64 + d);
        s += p.in[2][rel_bucket_dev(t - pos) * 8 + head];
        const float mn = fmaxf(m, s), a = expf(m - mn), pp = expf(s - mn);
        l = l * a + pp;
#pragma unroll
        for (int d = 0; d < 64; ++d) o[d] = o[d] * a + pp * bfv(Vt, (size_t)d * SEQ + pos);
        m = mn;
    }
    const float gate = ((const float*)(ws + WS_GATES))[(size_t)tok * 24 + 16 + head];
    bool f = false;
#pragma unroll
    for (int d = 0; d < 64; ++d) f |= bad(bfv((const bf16_t*)(ws + WS_OWIN), (size_t)tok * 512 + head * 64 + d), o[d] / l * gate);
    if (f) dfail(p, bit);
}
DI void chk4(const Params& p, int bit) {
    unsigned char* ws = p.ws;
    const unsigned gt = blockIdx.x * NTHREADS + threadIdx.x;
    if (gt >= 512) return;
    const int tok = hsh(gt + 5) & 16383, g = gt & 1, b = tok >> 12, t = tok & 4095, bg = b * 2 + g;
    float* scr = (float*)(ws + WS_DSCR) + (size_t)gt * 1536;
    float* imp = scr + 1024;
    float* nsa = scr + 1100;
    for (int j = 0; j < 64; ++j) imp[j] = 0.f;
    const float* kc = (const float*)(ws + WS_KCMP) + (size_t)bg * 256 * 64;
    const float* vc = (const float*)(ws + WS_VCMP) + (size_t)bg * 256 * 64;
    const float* gt24 = (const float*)(ws + WS_GATES) + (size_t)tok * 24;
    for (int hl = 0; hl < 4; ++hl) {
        const int head = g * 4 + hl;
        const bf16_t* Q = (const bf16_t*)(ws + WS_Q) + ((size_t)(b * 8 + head) * SEQ + t) * 64;
        float q[64], o[64];
#pragma unroll
        for (int d = 0; d < 64; ++d) { q[d] = bfv(Q, d); o[d] = 0.f; }
        float m = -1e30f;
        for (int c = 0; c < 255; ++c) {
            const bool valid = 16 * c + 31 <= t;
            float s = 0.f;
#pragma unroll
            for (int d = 0; d < 64; ++d) s += q[d] * bfr(kc[c * 64 + d]);
            s += p.in[2][rel_bucket_dev(t - 16 * c - 31) * 8 + head];
            scr[hl * 256 + c] = s;
            if (valid) m = fmaxf(m, s);
        }
        float l = 0.f;
        for (int c = 0; c < 255; ++c) if (16 * c + 31 <= t) l += expf(scr[hl * 256 + c] - m);
        for (int c = 0; c < 255; ++c) if (16 * c + 31 <= t) {
            const float pc = expf(scr[hl * 256 + c] - m) / l;
            imp[c >> 2] += pc;
            if ((c & 3) == 3 && (c >> 2) + 1 < 64) imp[(c >> 2) + 1] += pc;
#pragma unroll
            for (int d = 0; d < 64; ++d) o[d] += bfr(pc) * bfr(vc[c * 64 + d]);
        }
#pragma unroll
        for (int d = 0; d < 64; ++d) nsa[hl * 64 + d] = gt24[head] * o[d];
    }
    const int cur = t >> 6;
    for (int j = 0; j < 64; ++j) { float v = imp[j]; if (j == 0 || j == cur || j == cur - 1) v = 1e6f; if (j > cur) v = -1e30f; imp[j] = v; }
    unsigned long long selmask = 0ull;
    for (int it = 0; it < 16; ++it) {
        int bi = -1; float bv = -3e38f;
        for (int j = 0; j < 64; ++j) if (!((selmask >> j) & 1ull) && imp[j] > bv) { bv = imp[j]; bi = j; }
        selmask |= 1ull << bi;
    }
    bool f = false;
    for (int hl = 0; hl < 4; ++hl) {
        const int head = g * 4 + hl;
        const bf16_t* Q = (const bf16_t*)(ws + WS_Q) + ((size_t)(b * 8 + head) * SEQ + t) * 64;
        const bf16_t* K = (const bf16_t*)(ws + WS_KSLC) + (size_t)bg * SEQ * 64;
        const bf16_t* Vt = (const bf16_t*)(ws + WS_VSLCT) + (size_t)bg * 64 * SEQ;
        float q[64], o[64];
#pragma unroll
        for (int d = 0; d < 64; ++d) { q[d] = bfv(Q, d); o[d] = 0.f; }
        float m = -1e30f, l = 0.f;
        for (int j = 0; j <= cur; ++j) if ((selmask >> j) & 1ull) {
            for (int kk = 0; kk < 64; ++kk) {
                const int pos = j * 64 + kk;
                if (pos > t) break;
                float s = 0.f;
#pragma unroll
                for (int d = 0; d < 64; ++d) s += q[d] * bfv(K, (size_t)pos * 64 + d);
                s += p.in[2][rel_bucket_dev(t - pos) * 8 + head];
                const float mn = fmaxf(m, s), a = expf(m - mn), pp = expf(s - mn);
                l = l * a + pp;
#pragma unroll
                for (int d = 0; d < 64; ++d) o[d] = o[d] * a + pp * bfv(Vt, (size_t)d * SEQ + pos);
                m = mn;
            }
        }
#pragma unroll
        for (int d = 0; d < 64; ++d) {
            const float ref = nsa[hl * 64 + d] + gt24[8 + head] * o[d] / l + bfv((const bf16_t*)(ws + WS_OWIN), (size_t)tok * 512 + head * 64 + d);
            f |= bad(bfv((const bf16_t*)(ws + WS_MIXIN), (size_t)tok * 1024 + head * 64 + d), ref);
        }
    }
    if (f) dfail(p, bit);
}
DI void chk5(const Params& p, int bit) {
    unsigned char* ws = p.ws;
    const unsigned gt = blockIdx.x * NTHREADS + threadIdx.x;
    if (gt >= 8192) return;
    const int tok = hsh(gt + 11) & 16383, col = hsh(gt + 13) & 511, gi = col >> 7, d = col & 127, t = tok & 4095;
    const bf16_t* yp = (const bf16_t*)(ws + WS_YPOOL);
    const bf16_t* pw = (const bf16_t*)(ws + WS_POOLWT);
    const bf16_t* z = (const bf16_t*)(ws + WS_Z);
    float ref = 0.f, ref2 = 0.f;
    for (int c = 0; c < 128; ++c) {
        ref += bfv(yp, (size_t)tok * 512 + gi * 128 + c) * bfv(pw, (size_t)gi * 16384 + d * 128 + c);
        ref2 += bfv(yp, (size_t)tok * 512 + gi * 128 + c) * p.in[9][(size_t)gi * 16384 + c * 128 + d];
    }
    if (!(fabsf(ref - ref2) <= 0.03f)) dfail(p, bit);
    ref *= p.in[10][col];
    if (bad(bfv((const bf16_t*)(ws + WS_MIXIN), (size_t)tok * 1024 + 512 + col), ref)) dfail(p, bit);
    const int win = 2 << (col >> 7), cnt = (t + 1 < win) ? t + 1 : win;
    float s = 0.f;
    for (int k = 0; k < cnt; ++k) s += bfv(z, (size_t)(tok - k) * 512 + col);
    if (bad(bfv(yp, (size_t)tok * 512 + col), s / (float)cnt - bfv(z, (size_t)tok * 512 + col))) dfail(p, bit);
}
DI void chk6(const Params& p, int bit) {
    unsigned char* ws = p.ws;
    const unsigned gt = blockIdx.x * NTHREADS + threadIdx.x;
    if (gt >= 128) return;
    const int tok = hsh(gt + 17) & 16383;
    float* yb = (float*)(ws + WS_DSCR) + (size_t)gt * 1024;
    const bf16_t* mx = (const bf16_t*)(ws + WS_MIXIN) + (size_t)tok * 1024;
    const bf16_t* wo = (const bf16_t*)(ws + WS_WOUTT);
    float sm = 0.f;
    bool f = false;
    for (int n = 0; n < 1024; ++n) {
        float s = 0.f, s2 = 0.f;
        for (int k = 0; k < 1024; ++k) { s += bfv(mx, k) * bfv(wo, (size_t)n * 1024 + k); if (n < 8) s2 += bfv(mx, k) * p.in[11][(size_t)k * 1024 + n]; }
        if (n < 8 && !(fabsf(s - s2) <= 0.03f)) f = true;
        yb[n] = ALPHA * p.in[0][(size_t)tok * 1024 + n] + s; sm += yb[n];
    }
    const float mean = sm / 1024.f;
    float v = 0.f;
    for (int n = 0; n < 1024; ++n) v += (yb[n] - mean) * (yb[n] - mean);
    const float rstd = 1.f / sqrtf(v / 1024.f + LN_EPS);
    for (int n = 0; n < 1024; ++n)
        f |= bad(bfv((const bf16_t*)(ws + WS_H1), (size_t)tok * 1024 + n), (yb[n] - mean) * rstd * p.in[12][n] + p.in[13][n]);
    if (f) dfail(p, bit);
}
DI void chk7(const Params& p, int bit) {
    unsigned char* ws = p.ws;
    const unsigned gt = blockIdx.x * NTHREADS + threadIdx.x;
    if (gt >= 512) return;
    const int tok = hsh(gt + 23) & 16383, head = gt & 7, half = (gt >> 3) & 1;
    float* qd = (float*)(ws + WS_DSCR) + (size_t)gt * 256;
    float* sv = qd + 128;
    const bf16_t* h1 = (const bf16_t*)(ws + WS_H1) + (size_t)tok * 1024;
    const bf16_t* wq = (const bf16_t*)(ws + WS_WQT);
    const bf16_t* sk = (const bf16_t*)(ws + WS_SUBK);
    bool f = false;
    for (int d = 0; d < 128; ++d) {
        float s = 0.f, s2 = 0.f;
        const int col = head * 256 + half * 128 + d;
        for (int k = 0; k < 1024; ++k) { s += bfv(h1, k) * bfv(wq, (size_t)col * 1024 + k); if (d < 4) s2 += bfv(h1, k) * p.in[14][(size_t)k * 2048 + col]; }
        if (d < 4 && !(fabsf(s - s2) <= 0.06f)) f = true;
        qd[d] = bfr(s);
    }
    for (int key = 0; key < 128; ++key) {
        float s = 0.f, s2 = 0.f;
        for (int d = 0; d < 128; ++d) { s += qd[d] * bfv(sk, (size_t)(half * 128 + key) * 128 + d); s2 += qd[d] * p.in[15][(size_t)(half * 128 + key) * 128 + d]; }
        if (!(fabsf(s - s2) <= 0.05f)) f = true;
        sv[key] = s;
    }
    int mism = 0;
    const int* L = (const int*)(ws + WS_TOPK) + (((size_t)tok * 8 + head) * 2 + half) * 16;
    for (int it = 0; it < 16; ++it) {
        int bi = 0; float bv = -3e38f;
        for (int k = 0; k < 128; ++k) if (sv[k] > bv) { bv = sv[k]; bi = k; }
        sv[bi] = -3e38f;
        const int fk = L[it];
        if ((fk & 127) != bi) mism++;
        if (bad(key_val(fk), bv)) mism += 10;
    }
    if (mism > 1 || f) dfail(p, bit);
}
DI void chk8(const Params& p, int bit) {
    unsigned char* ws = p.ws;
    const unsigned gt = blockIdx.x * NTHREADS + threadIdx.x;
    if (gt >= 128) return;
    const int tok = hsh(gt + 31) & 16383;
    float* acc = (float*)(ws + WS_DSCR) + (size_t)gt * 4096;
    float* cand = acc + 1024;
    int* csel = (int*)(acc + 1024 + 256);
    float* acc2 = acc + 2048;
    const bf16_t* h1 = (const bf16_t*)(ws + WS_H1) + (size_t)tok * 1024;
    const bf16_t* ub = (const bf16_t*)(ws + WS_UB);
    const bf16_t* vb = (const bf16_t*)(ws + WS_VB);
    const int* dE = (const int*)(ws + WS_MIXIN) + (size_t)tok * 256;
    const float* dG = (const float*)dE + 128;
    bool f = false, froute = false, fg = false;
    for (int n = 0; n < 1024; ++n) { acc[n] = 0.f; acc2[n] = 0.f; }
    for (int hd = 0; hd < 8; ++hd) {
        const int* L = (const int*)(ws + WS_TOPK) + (size_t)tok * 256 + hd * 32;
        for (int i = 0; i < 16; ++i) for (int j = 0; j < 16; ++j) cand[i * 16 + j] = key_val(L[i]) + key_val(L[16 + j]);
        float mx = -3e38f, den = 0.f;
        for (int it = 0; it < 16; ++it) {
            int bi = 0; float bv = -3e38f;
            for (int k = 0; k < 256; ++k) if (cand[k] > bv) { bv = cand[k]; bi = k; }
            cand[bi] = -3e38f; csel[it] = bi;
            if (it == 0) mx = bv;
            ((float*)csel)[16 + it] = expf(bv - mx); den += expf(bv - mx);
        }
        for (int it = 0; it < 16; ++it) {
            const int i = csel[it] >> 4, j = csel[it] & 15;
            const size_t e = (size_t)(L[i] & 127) * 128 + (L[16 + j] & 127);
            float dot = 0.f;
            for (int k = 0; k < 1024; ++k) dot += bfv(h1, k) * bfv(ub, e * 1024 + k);
            const float gate = ((float*)csel)[16 + it] / den;
            const float w = gate * gelu_erf(dot);
            for (int n = 0; n < 1024; ++n) acc[n] += w * bfv(vb, e * 1024 + n);
            bool found = false;
            for (int s = 0; s < 16; ++s) if (dE[hd * 16 + s] == (int)e) { found = true; if (!(fabsf(dG[hd * 16 + s] - gate) <= 1e-3f)) fg = true; }
            if (!found) froute = true;
        }
        for (int s = 0; s < 16; ++s) {
            const size_t e = (size_t)dE[hd * 16 + s];
            if (e >= 16384) { froute = true; continue; }
            float dot = 0.f;
            for (int k = 0; k < 1024; ++k) dot += bfv(h1, k) * bfv(ub, e * 1024 + k);
            const float w = dG[hd * 16 + s] * gelu_erf(dot);
            for (int n = 0; n < 1024; ++n) acc2[n] += w * bfv(vb, e * 1024 + n);
        }
    }
    bool f2 = false;
    for (int pass = 0; pass < 2; ++pass) {
        float* a = pass ? acc2 : acc;
        float sm = 0.f;
        for (int n = 0; n < 1024; ++n) { a[n] += ALPHA * bfv(h1, n); sm += a[n]; }
        const float mean = sm / 1024.f;
        float v = 0.f;
        for (int n = 0; n < 1024; ++n) v += (a[n] - mean) * (a[n] - mean);
        const float rstd = 1.f / sqrtf(v / 1024.f + LN_EPS);
        for (int n = 0; n < 1024; ++n) {
            const bool b = bad(p.out[(size_t)tok * 1024 + n], (a[n] - mean) * rstd * p.in[18][n] + p.in[19][n]);
            if (pass) f2 |= b; else f |= b;
        }
    }
    if (f) dfail(p, bit);
    if (froute) dfail(p, bit + 1);
    if (fg) dfail(p, bit + 2);
    if (f2) dfail(p, bit + 3);
}
#endif

__global__ void __launch_bounds__(NTHREADS, 2) hybrid_fwd(Params p) {
    extern __shared__ __attribute__((aligned(16))) unsigned char lds[];
    cg::grid_group grid = cg::this_grid();
    const int lo = p.ph_lo, hi = p.ph_hi;
    volatile unsigned* bst = (volatile unsigned*)(lds + LDS_MAIN);
    if (threadIdx.x < 2) bst[threadIdx.x] = 0u;
    __syncthreads();
    XcdBarrier xbar = xcd_barrier_post((unsigned*)(p.ws + WS_BAR), bst);
#define IN(k) (lo <= (k) && (k) < hi)
#define SEAM(k) do { if (IN(k) && IN((k) + 1 + ((k) == 4))) xcd_barrier(xbar); } while (0)
    if (lo < 0) grid.sync();
#if DIAG
    if (blockIdx.x == 0 && threadIdx.x == 0) *(unsigned*)(p.ws + WS_FLAG) = 0u;
#endif
    if (IN(0)) phase0(p, lds);
    SEAM(0);
    if (IN(1)) phase1(p, lds);
    SEAM(1);
#if DIAG == 1
    chk1(p, 0);
#endif
    if (IN(2)) phase2(p, lds);
    SEAM(2);
#if DIAG == 1
    chk2(p, 1); chk3(p, 2);
#endif
    if (IN(3)) phase3(p, lds);
    SEAM(3);
#if DIAG == 1
    chk4(p, 3); chk5(p, 4);
#endif
    if (IN(4)) phase4(p, lds);
    SEAM(4);
#if DIAG == 1
    chk6(p, 5);
#endif
    if (IN(6)) phase6(p, lds);
    SEAM(6);
#if DIAG == 2
    chk7(p, 0);
#endif
    if (IN(7)) phase7(p, lds);
#if DIAG
    grid.sync();
#if DIAG == 2
    chk8(p, 1);
    grid.sync();
#endif
    {
        const unsigned code = *(volatile unsigned*)(p.ws + WS_FLAG);
        const float kv = sqrtf((float)code);
        for (size_t i = (size_t)blockIdx.x * NTHREADS + threadIdx.x; i < (size_t)NTOK * DM; i += (size_t)gridDim.x * NTHREADS) p.out[i] = kv;
    }
#endif
#undef IN
#undef SEAM
}

extern "C" void kernel_launch(void* const* d_in, const int* in_sizes, int n_in, void* d_out, int out_size, void* d_ws, size_t ws_size,
                              hipStream_t stream) {
    static int grid_blocks = 0;
    if (grid_blocks == 0) {
        if (n_in != 20 || ws_size < WS_END) { fprintf(stderr, "kernel_launch: unexpected inputs (n_in %d, ws %zu)\n", n_in, ws_size); grid_blocks = -1; return; }
        int dev = 0, cus = 0, per_cu = 0;
        hipGetDevice(&dev);
        hipDeviceGetAttribute(&cus, hipDeviceAttributeMultiprocessorCount, dev);
        hipFuncSetAttribute((const void*)hybrid_fwd, hipFuncAttributeMaxDynamicSharedMemorySize, LDS_BYTES);
        hipOccupancyMaxActiveBlocksPerMultiprocessor(&per_cu, (const void*)hybrid_fwd, NTHREADS, LDS_BYTES);
        if (per_cu < 1) per_cu = 1;
        if (per_cu > 2) per_cu = 2;
        grid_blocks = cus * per_cu;
        (void)hipGetLastError();
    }
    if (grid_blocks < 0) return;
    (void)hipMemsetAsync((char*)d_ws + WS_BAR, 0, WS_BAR_BYTES, stream);
    Params p{};
    for (int i = 0; i < 20; ++i) p.in[i] = (const float*)d_in[i];
    p.out = (float*)d_out; p.ws = (unsigned char*)d_ws;
#if N_LAUNCH_MODE == 1
    p.ph_lo = 0; p.ph_hi = 8;
    void* args[] = {&p};
    hipError_t e = hipLaunchCooperativeKernel((const void*)hybrid_fwd, dim3(grid_blocks), dim3(NTHREADS), args, LDS_BYTES, stream);
    if (e != hipSuccess) fprintf(stderr, "cooperative launch failed: %s (grid %d)\n", hipGetErrorString(e), grid_blocks);
#else
    for (int ph = 0; ph < 8; ++ph) {
        p.ph_lo = ph; p.ph_hi = ph + 1;
        hipLaunchKernelGGL(hybrid_fwd, dim3(grid_blocks), dim3(NTHREADS), LDS_BYTES, stream, p);
    }
#endif
}
```

```cpp
#include <hip/hip_runtime.h>
#include <hip/hip_cooperative_groups.h>
#include <cstdint>
#include <cstdio>
namespace cg = cooperative_groups;

#ifndef N_LAUNCH_MODE
#define N_LAUNCH_MODE 1
#endif

typedef unsigned short bf16_t;
typedef short bf16x8 __attribute__((ext_vector_type(8)));
typedef short s16x4 __attribute__((ext_vector_type(4)));
typedef long i64x2 __attribute__((ext_vector_type(2)));
typedef unsigned u32x6 __attribute__((ext_vector_type(6)));
typedef _Float16 f16x32 __attribute__((ext_vector_type(32)));
typedef _Float16 f16x2_t __attribute__((ext_vector_type(2)));
typedef float f32x32 __attribute__((ext_vector_type(32)));
typedef float f32x16 __attribute__((ext_vector_type(16)));
typedef float f32x4 __attribute__((ext_vector_type(4)));
typedef unsigned u32x4 __attribute__((ext_vector_type(4)));
typedef unsigned u32x2 __attribute__((ext_vector_type(2)));
typedef float f32x2 __attribute__((ext_vector_type(2)));
typedef __bf16 bf16x2_t __attribute__((ext_vector_type(2)));

#define DI __device__ __forceinline__
#define MFMA32(a, b, c) __builtin_amdgcn_mfma_f32_32x32x16_bf16((a), (b), (c), 0, 0, 0)

constexpr int NTOK = 16384, SEQ = 4096, DM = 1024;
constexpr int NINP = 1920;
constexpr float ALPHA = 1.189207115002721f;
constexpr float LN_EPS = 1e-5f;
constexpr float LOG2E = 1.4426950408889634f;
constexpr float QSCALE = 0.125f * LOG2E;
constexpr int NTHREADS = 256;
constexpr int LDS_MAIN = 73728;
constexpr int LDS_CST = LDS_MAIN + 64;
constexpr int LDS_BYTES = LDS_MAIN + 64 + 2048;
constexpr int ROWB = 144;

constexpr size_t MiB = 1u << 20;
constexpr size_t WS_BAR = 0;
constexpr size_t WS_BAR_BYTES = 16384;
constexpr size_t WS_KCMP = 1 * MiB;
constexpr size_t WS_VCMP = 1 * MiB + 512 * 1024;
constexpr size_t WS_W2TK = 2 * MiB;
constexpr size_t WS_W2TV = 2 * MiB + 32 * 1024;
constexpr size_t WS_POOLWT = 2 * MiB + 64 * 1024;
constexpr size_t WS_SUBK = 2 * MiB + 192 * 1024;
constexpr size_t WS_PEBK = 2 * MiB + 256 * 1024;
constexpr size_t WS_PEBV = 2 * MiB + 257 * 1024;
constexpr size_t WS_BUCK = 2 * MiB + 258 * 1024;
constexpr size_t WS_USCALE = 2 * MiB + 320 * 1024;
constexpr size_t WS_VSCALE = 2 * MiB + 384 * 1024;
constexpr size_t WS_C1 = 2 * MiB + 448 * 1024;
constexpr size_t WS_C2 = 2 * MiB + 456 * 1024;
constexpr size_t WS_LNST = 15 * MiB;
constexpr size_t WS_SX = 2 * MiB + 464 * 1024;
constexpr size_t WS_SW = 2 * MiB + 528 * 1024;
constexpr size_t WS_W1TK = 3 * MiB;
constexpr size_t WS_W1TV = 4 * MiB;
constexpr size_t WS_WINT = 5 * MiB;
constexpr size_t WS_WOUTT = 9 * MiB;
constexpr size_t WS_WQT = 11 * MiB;
constexpr size_t WS_UB = 16 * MiB;
constexpr size_t WS_VB = 48 * MiB;
constexpr size_t WS_XB = 80 * MiB;
constexpr size_t WS_MIXIN = WS_XB;
constexpr size_t WS_Q = 112 * MiB;
constexpr size_t WS_KC = 128 * MiB;
constexpr size_t WS_VC = 132 * MiB;
constexpr size_t WS_KSLC = 136 * MiB;
constexpr size_t WS_KWIN = 140 * MiB;
constexpr size_t WS_VSLCT = 144 * MiB;
constexpr size_t WS_VWINT = 148 * MiB;
constexpr size_t WS_GATES = 152 * MiB;
constexpr size_t WS_Z = 154 * MiB;
constexpr size_t WS_YPOOL = 170 * MiB;
constexpr size_t WS_OWIN = 186 * MiB;
#ifndef DIAG
#define DIAG 0
#endif
#if DIAG
constexpr size_t WS_H1 = 202 * MiB;
constexpr size_t WS_TOPK = 234 * MiB;
constexpr size_t WS_END = 256 * MiB;
constexpr size_t WS_FLAG = 32768;
constexpr size_t WS_DSCR = 250 * MiB;
#else
constexpr size_t WS_H1 = 112 * MiB;
constexpr size_t WS_TOPK = 112 * MiB;
constexpr size_t WS_END = 202 * MiB;
#endif

struct Params { const float* in[20]; float* out; unsigned char* ws; int ph_lo, ph_hi; };

DI unsigned f2bf(float f) { unsigned u = __float_as_uint(f); return (u + 0x7fffu + ((u >> 16) & 1u)) >> 16; }
DI unsigned pk2(float lo, float hi) { bf16x2_t v = {(__bf16)lo, (__bf16)hi}; return __builtin_bit_cast(unsigned, v); }
DI float bflo(unsigned x) { return __uint_as_float(x << 16); }
DI float bfhi(unsigned x) { return __uint_as_float(x & 0xffff0000u); }
DI float dot2bf(unsigned a, unsigned b, float acc) {
    asm("v_dot2c_f32_bf16 %0, %1, %2" : "+v"(acc) : "v"(a), "v"(b));
    return acc;
}
DI int dot4i8(unsigned a, unsigned b, int acc) {
    return __builtin_amdgcn_sdot4((int)a, (int)b, acc, false);
}
DI float gelu_erf(float x) { return 0.5f * x * (1.0f + erff(x * 0.70710678118654752f)); }
DI float gelu_fast(float v) {
    const float av = fabsf(v), t = __builtin_amdgcn_rcpf(av * 0.2316418882f + 1.0f);
    float q = t * 0.5307027145f + (-0.7265760135f); q = q * t + 0.7107068705f; q = q * t + (-0.142248368f); q = q * t + 0.127414796f; q = q * t;
    const float e = __builtin_amdgcn_exp2f((v * v) * (-0.72134752044f));
    const float m = v * (q * e);
    return v < 0.f ? m : v - m;
}
DI float wave_sum(float v) {
#pragma unroll
    for (int o = 32; o >= 1; o >>= 1) v += __shfl_xor(v, o);
    return v;
}
DI int rel_bucket_dev(int dist) {
    if (dist < 0) dist = 0;
    if (dist < 16) return dist;
    int v = 16 + (int)(logf((float)dist / 16.0f) / logf(8.0f) * 16.0f);
    return v < 31 ? v : 31;
}
DI int make_key(float f, int idx) { int b = __float_as_int(f); b ^= (b >> 31) & 0x7fffffff; return (b & ~127) | idx; }
DI float key_val(int k) { int b = k & ~127; b ^= (b >> 31) & 0x7fffffff; return __int_as_float(b); }


#define LAS __attribute__((address_space(3)))
#define XB_TMO      128
#define XB_XCNT(j)  (256  + 64 * (j))
#define XB_XSUB(j)  (1280 + 64 * (j))
#define XB_XGEN(j)  (2304 + 64 * (j))
#define XB_TOP      3328
#define XB_TOPGEN   3392
#define XCD_BAR_WORDS 3456
#define XB_SPIN_CAP (1u << 20)
DI unsigned xb_ld(unsigned* p)              { return __hip_atomic_load(p, __ATOMIC_RELAXED, __HIP_MEMORY_SCOPE_AGENT); }
DI unsigned xb_add(unsigned* p, unsigned v) { return __hip_atomic_fetch_add(p, v, __ATOMIC_RELAXED, __HIP_MEMORY_SCOPE_AGENT); }
DI unsigned xb_xcc_id() { return (unsigned)__builtin_amdgcn_s_getreg((3 << 11) | 20) & 0xFu; }
#define XB_SPIN(cond, bar) do { unsigned _sp = 0; while (cond) { __builtin_amdgcn_s_sleep(1); \
    if ((++_sp & 255u) == 0u) { if (xb_ld(&(bar)[XB_TMO])) break; if (_sp > XB_SPIN_CAP) { atomicAdd(&(bar)[XB_TMO], 1u); break; } } } } while (0)
struct XcdBarrier { unsigned* bar; unsigned x; volatile unsigned* st; };
DI XcdBarrier xcd_barrier_post(unsigned* bar, volatile unsigned* st) {
    XcdBarrier b; b.bar = bar; b.x = xb_xcc_id(); b.st = st;
    if (threadIdx.x == 0) (void)xb_add(&bar[XB_XCNT(b.x)], 1u);
    return b;
}
DI void xcd_barrier_complete(unsigned* bar, unsigned x, unsigned& nloc, unsigned& nx) {
    const unsigned G = gridDim.x * gridDim.y * gridDim.z;
    unsigned sum, cnt, mine, sp = 0u;
    for (;;) {
        sum = 0u; cnt = 0u; mine = 0u;
#pragma unroll
        for (unsigned j = 0; j < 16; ++j) { const unsigned c = xb_ld(&bar[XB_XCNT(j)]); sum += c; cnt += (c > 0u) ? 1u : 0u; mine = (j == x) ? c : mine; }
        if (sum == G) break;
        __builtin_amdgcn_s_sleep(1);
        if ((++sp & 255u) == 0u) { if (xb_ld(&bar[XB_TMO])) break; if (sp > XB_SPIN_CAP) { atomicAdd(&bar[XB_TMO], 1u); break; } }
    }
    nloc = mine > 0u ? mine : 1u; nx = cnt > 0u ? cnt : 1u;
}
DI void xcd_barrier(const XcdBarrier& b) {
    asm volatile("s_waitcnt vmcnt(0)" ::: "memory");
    __syncthreads();
    if (threadIdx.x == 0) {
        unsigned* bar = b.bar;
        __builtin_amdgcn_s_waitcnt(0);
        unsigned nloc = b.st[0], nx = b.st[1];
        if (nloc == 0u) { xcd_barrier_complete(bar, b.x, nloc, nx); b.st[0] = nloc; b.st[1] = nx; }
        const unsigned old = xb_add(&bar[XB_XSUB(b.x)], 1u);
        const unsigned gen = old / nloc;
        if (old + 1u == (gen + 1u) * nloc) {
            __builtin_amdgcn_fence(__ATOMIC_RELEASE, "agent");
            asm volatile("s_waitcnt vmcnt(0)" ::: "memory");
            const unsigned og = xb_add(&bar[XB_TOP], 1u);
            const unsigned tg = og / nx;
            if (og + 1u == (tg + 1u) * nx) xb_add(&bar[XB_TOPGEN], 1u);
            else XB_SPIN(xb_ld(&bar[XB_TOPGEN]) == tg, bar);
            __builtin_amdgcn_fence(__ATOMIC_ACQUIRE, "agent");
            xb_add(&bar[XB_XGEN(b.x)], 1u);
            asm volatile("s_waitcnt vmcnt(0)" ::: "memory");
        } else {
            XB_SPIN(xb_ld(&bar[XB_XGEN(b.x)]) == gen, bar);
            __builtin_amdgcn_fence(__ATOMIC_ACQUIRE, "agent");
            asm volatile("s_waitcnt vmcnt(0)" ::: "memory");
        }
    }
    __syncthreads();
}

template <int MI>
DI void gemm_mainloop_t(const bf16_t* __restrict__ A, int lda, const bf16_t* __restrict__ Bt, int ldb, int K,
                        f32x16 (&acc)[MI][2], unsigned char* lds) {
    const int tid = threadIdx.x, lane = tid & 63, wid = __builtin_amdgcn_readfirstlane(tid >> 6);
    const int wr = wid >> 1, wc = wid & 1, r = lane & 31, h = lane >> 5;
    LAS unsigned char* As = (LAS unsigned char*)lds;
    LAS unsigned char* Bs = (LAS unsigned char*)lds + 2 * 16384;
#pragma unroll
    for (int mi = 0; mi < MI; ++mi)
#pragma unroll
        for (int ni = 0; ni < 2; ++ni)
#pragma unroll
            for (int i = 0; i < 16; ++i) acc[mi][ni][i] = 0.f;
    const int nk = K >> 6;
    const int prow = 8 * wid + (lane >> 3);
    const int pchunk = (lane & 7) ^ ((prow >> 1) & 7);
    const bf16_t* Ap = A + (size_t)prow * lda + pchunk * 8;
    const bf16_t* Bp = Bt + (size_t)prow * ldb + pchunk * 8;
    const int pl = wid * 1024;
#define GEMM_STAGE(buf, kt) do { \
        _Pragma("unroll") for (int i = 0; i < 2 * MI; ++i) __builtin_amdgcn_global_load_lds((const unsigned*)(Ap + (size_t)(32 * i) * lda + (kt) * 64), (LAS unsigned*)(As + (buf) * 16384 + i * 4096 + pl), 16, 0, 0); \
        _Pragma("unroll") for (int i = 0; i < 4; ++i) __builtin_amdgcn_global_load_lds((const unsigned*)(Bp + (size_t)(32 * i) * ldb + (kt) * 64), (LAS unsigned*)(Bs + (buf) * 16384 + i * 4096 + pl), 16, 0, 0); } while (0)
    GEMM_STAGE(0, 0);
    asm volatile("s_waitcnt vmcnt(0)" ::: "memory");
    __syncthreads();
    const int swz = (r >> 1) & 7;
    for (int kt = 0; kt < nk; ++kt) {
        const int cur = kt & 1;
        if (kt + 1 < nk) GEMM_STAGE(cur ^ 1, kt + 1);
        const LAS unsigned char* Ac = As + cur * 16384 + (wr * 32 * MI + r) * 128;
        const LAS unsigned char* Bc = Bs + cur * 16384 + (wc * 64 + r) * 128;
        __builtin_amdgcn_s_setprio(1);
#pragma unroll
        for (int ks = 0; ks < 4; ++ks) {
            const int co = ((ks * 2 + h) ^ swz) * 16;
            bf16x8 fa[MI], fb[2];
#pragma unroll
            for (int mi = 0; mi < MI; ++mi) fa[mi] = *(const LAS bf16x8*)(Ac + mi * 32 * 128 + co);
#pragma unroll
            for (int ni = 0; ni < 2; ++ni) fb[ni] = *(const LAS bf16x8*)(Bc + ni * 32 * 128 + co);
#pragma unroll
            for (int mi = 0; mi < MI; ++mi)
#pragma unroll
                for (int ni = 0; ni < 2; ++ni) acc[mi][ni] = MFMA32(fb[ni], fa[mi], acc[mi][ni]);
        }
        __builtin_amdgcn_s_setprio(0);
        asm volatile("s_waitcnt vmcnt(0)" ::: "memory");
        __syncthreads();
    }
#undef GEMM_STAGE
}
DI void gemm_mainloop_f8(const unsigned char* __restrict__ A, int lda, const unsigned char* __restrict__ Bt, int ldb, int K,
                         f32x16 (&acc)[2][2], unsigned char* lds) {
    constexpr int MI = 2;
    const int tid = threadIdx.x, lane = tid & 63, wid = __builtin_amdgcn_readfirstlane(tid >> 6);
    const int wr = wid >> 1, wc = wid & 1, r = lane & 31, h = lane >> 5;
    LAS unsigned char* As = (LAS unsigned char*)lds;
    LAS unsigned char* Bs = (LAS unsigned char*)lds + 2 * 16384;
#pragma unroll
    for (int mi = 0; mi < MI; ++mi)
#pragma unroll
        for (int ni = 0; ni < 2; ++ni)
#pragma unroll
            for (int i = 0; i < 16; ++i) acc[mi][ni][i] = 0.f;
    const int nk = K >> 7;
    const int prow = 8 * wid + (lane >> 3);
    const int pchunk = (lane & 7) ^ ((prow >> 1) & 7);
    const unsigned char* Ap = A + (size_t)prow * lda + pchunk * 16;
    const unsigned char* Bp = Bt + (size_t)prow * ldb + pchunk * 16;
    const int pl = wid * 1024;
#define GEMM_STAGE(buf, kt) do { \
        _Pragma("unroll") for (int i = 0; i < 2 * MI; ++i) __builtin_amdgcn_global_load_lds((const unsigned*)(Ap + (size_t)(32 * i) * lda + (kt) * 128), (LAS unsigned*)(As + (buf) * 16384 + i * 4096 + pl), 16, 0, 0); \
        _Pragma("unroll") for (int i = 0; i < 4; ++i) __builtin_amdgcn_global_load_lds((const unsigned*)(Bp + (size_t)(32 * i) * ldb + (kt) * 128), (LAS unsigned*)(Bs + (buf) * 16384 + i * 4096 + pl), 16, 0, 0); } while (0)
    GEMM_STAGE(0, 0);
    asm volatile("s_waitcnt vmcnt(0)" ::: "memory");
    __syncthreads();
    const int swz = (r >> 1) & 7;
    for (int kt = 0; kt < nk; ++kt) {
        const int cur = kt & 1;
        if (kt + 1 < nk) GEMM_STAGE(cur ^ 1, kt + 1);
        const LAS unsigned char* Ac = As + cur * 16384 + (wr * 32 * MI + r) * 128;
        const LAS unsigned char* Bc = Bs + cur * 16384 + (wc * 64 + r) * 128;
        __builtin_amdgcn_s_setprio(1);
#pragma unroll
        for (int ks = 0; ks < 4; ++ks) {
            const int co = ((ks * 2 + h) ^ swz) * 16;
            i64x2 fa[MI], fb[2];
#pragma unroll
            for (int mi = 0; mi < MI; ++mi) fa[mi] = *(const LAS i64x2*)(Ac + mi * 32 * 128 + co);
#pragma unroll
            for (int ni = 0; ni < 2; ++ni) fb[ni] = *(const LAS i64x2*)(Bc + ni * 32 * 128 + co);
#pragma unroll
            for (int mi = 0; mi < MI; ++mi)
#pragma unroll
                for (int ni = 0; ni < 2; ++ni) { acc[mi][ni] = __builtin_amdgcn_mfma_f32_32x32x16_fp8_fp8(fb[ni].x, fa[mi].x, acc[mi][ni], 0, 0, 0);
                    acc[mi][ni] = __builtin_amdgcn_mfma_f32_32x32x16_fp8_fp8(fb[ni].y, fa[mi].y, acc[mi][ni], 0, 0, 0); }
        }
        __builtin_amdgcn_s_setprio(0);
        asm volatile("s_waitcnt vmcnt(0)" ::: "memory");
        __syncthreads();
    }
#undef GEMM_STAGE
}
DI void gemm_mainloop(const bf16_t* __restrict__ A, int lda, const bf16_t* __restrict__ Bt, int ldb, int K,
                      f32x16 (&acc)[2][2], unsigned char* lds) { gemm_mainloop_t<2>(A, lda, Bt, ldb, K, acc, lds); }

template <int MI, class F> DI void epi_foreach_t(const f32x16 (&acc)[MI][2], F f) {
    const int tid = threadIdx.x, lane = tid & 63, wid = tid >> 6;
    const int wr = wid >> 1, wc = wid & 1, r = lane & 31, h = lane >> 5;
#pragma unroll
    for (int mi = 0; mi < MI; ++mi)
#pragma unroll
        for (int ni = 0; ni < 2; ++ni)
#pragma unroll
            for (int grp = 0; grp < 4; ++grp) {
                f32x4 v = {acc[mi][ni][4 * grp], acc[mi][ni][4 * grp + 1], acc[mi][ni][4 * grp + 2], acc[mi][ni][4 * grp + 3]};
                f(wr * 32 * MI + mi * 32 + r, wc * 64 + ni * 32 + 8 * grp + 4 * h, v);
            }
}
template <class F> DI void epi_foreach(const f32x16 (&acc)[2][2], F f) { epi_foreach_t<2>(acc, f); }

template <class S> DI void epi_stage_rows(const f32x16 (&acc)[2][2], unsigned char* lds, S colscale) {
    epi_foreach(acc, [&](int m, int n, f32x4 v) {
        const f32x4 s = colscale(n);
        u32x2 o = {pk2(v.x * s.x, v.y * s.y), pk2(v.z * s.z, v.w * s.w)};
        *(u32x2*)(lds + m * 272 + n * 2) = o;
    });
}
DI void epi_stage_cols(const f32x16 (&acc)[2][2], unsigned char* lds) {
    epi_foreach(acc, [&](int m, int n, f32x4 v) {
        *(bf16_t*)(lds + (n + 0) * 272 + m * 2) = (bf16_t)f2bf(v.x); *(bf16_t*)(lds + (n + 1) * 272 + m * 2) = (bf16_t)f2bf(v.y);
        *(bf16_t*)(lds + (n + 2) * 272 + m * 2) = (bf16_t)f2bf(v.z); *(bf16_t*)(lds + (n + 3) * 272 + m * 2) = (bf16_t)f2bf(v.w);
    });
}
template <class F> DI void rows_foreach(const unsigned char* lds, F f) {
    const int tid = threadIdx.x;
#pragma unroll
    for (int i = 0; i < 8; ++i) {
        const int c = tid + 256 * i, m = c >> 4, cc = c & 15;
        f(m, cc, *(const u32x4*)(lds + m * 272 + cc * 16));
    }
}

DI void cvt_rows(const float* __restrict__ src, bf16_t* __restrict__ dst, size_t n8, size_t gtid, size_t gstride) {
    for (size_t i = gtid; i < n8; i += gstride) {
        f32x4 a = ((const f32x4*)src)[2 * i], b = ((const f32x4*)src)[2 * i + 1];
        u32x4 o = {pk2(a.x, a.y), pk2(a.z, a.w), pk2(b.x, b.y), pk2(b.z, b.w)};
        ((u32x4*)dst)[i] = o;
    }
}
template <class F> DI void transpose_cvt(const float* __restrict__ in, int K, int Nin, bf16_t* __restrict__ out, int Nout, F src,
                                         size_t gtid, size_t gstride) {
    const size_t total = (size_t)Nout * (K / 8);
    for (size_t i = gtid; i < total; i += gstride) {
        const int n = (int)(i % Nout), k8 = (int)(i / Nout);
        const int s = src(n);
        float v[8];
#pragma unroll
        for (int j = 0; j < 8; ++j) v[j] = s >= 0 ? in[(size_t)(k8 * 8 + j) * Nin + s] : 0.f;
        u32x4 o = {pk2(v[0], v[1]), pk2(v[2], v[3]), pk2(v[4], v[5]), pk2(v[6], v[7])};
        *(u32x4*)(out + (size_t)n * K + k8 * 8) = o;
    }
}

DI void transpose_cvt_scaled(const float* __restrict__ in, int K, int N, bf16_t* __restrict__ out, const float* __restrict__ scale, size_t gtid, size_t gstride) {
    const size_t total = (size_t)N * (K / 8);
    for (size_t i = gtid; i < total; i += gstride) {
        const int n = (int)(i % N), k8 = (int)(i / N);
        float v[8];
#pragma unroll
        for (int j = 0; j < 8; ++j) v[j] = in[(size_t)(k8 * 8 + j) * N + n] * scale[k8 * 8 + j];
        u32x4 o = {pk2(v[0], v[1]), pk2(v[2], v[3]), pk2(v[4], v[5]), pk2(v[6], v[7])};
        *(u32x4*)(out + (size_t)n * K + k8 * 8) = o;
    }
}

DI void convert_tables(const Params& p) {
    unsigned char* ws = p.ws;
    const size_t gtid = (size_t)blockIdx.x * NTHREADS + threadIdx.x, gstride = (size_t)gridDim.x * NTHREADS;
    const int lane = threadIdx.x & 63, gw = (int)(gtid >> 6), ngw = (int)(gstride >> 6);
    {
        const int hw = lane >> 5, l32 = lane & 31;
        for (int rr = gw * 2 + hw; rr < 2 * 16384; rr += ngw * 2) {
            const int which = rr >> 14, row = rr & 16383;
            const float* src = (which ? p.in[17] : p.in[16]) + (size_t)row * 1024 + l32 * 16;
            f32x16 a, b;
            float am = 0.f;
#pragma unroll
            for (int j = 0; j < 4; ++j) {
                const f32x4 x = *(const f32x4*)(src + 4 * j), y = *(const f32x4*)(src + 512 + 4 * j);
                a[4 * j] = x.x; a[4 * j + 1] = x.y; a[4 * j + 2] = x.z; a[4 * j + 3] = x.w;
                b[4 * j] = y.x; b[4 * j + 1] = y.y; b[4 * j + 2] = y.z; b[4 * j + 3] = y.w;
                am = fmaxf(am, fmaxf(fmaxf(fabsf(x.x), fabsf(x.y)), fmaxf(fabsf(x.z), fabsf(x.w))));
                am = fmaxf(am, fmaxf(fmaxf(fabsf(y.x), fabsf(y.y)), fmaxf(fabsf(y.z), fabsf(y.w))));
            }
#pragma unroll
            for (int o = 16; o >= 1; o >>= 1) am = fmaxf(am, __shfl_xor(am, o));
            if (which) {
                const float s4 = am > 0.f ? 6.0f / am : 1.0f;
                u32x4 o = {0u, 0u, 0u, 0u};
#define PK4(dst, src, d, q) dst = __builtin_amdgcn_cvt_scalef32_pk_fp4_f32(dst, src[(d) * 8 + 2 * (q)] * s4, src[(d) * 8 + 2 * (q) + 1] * s4, 1.0f, q)
                PK4(o[0], a, 0, 0); PK4(o[0], a, 0, 1); PK4(o[0], a, 0, 2); PK4(o[0], a, 0, 3);
                PK4(o[1], a, 1, 0); PK4(o[1], a, 1, 1); PK4(o[1], a, 1, 2); PK4(o[1], a, 1, 3);
                PK4(o[2], b, 0, 0); PK4(o[2], b, 0, 1); PK4(o[2], b, 0, 2); PK4(o[2], b, 0, 3);
                PK4(o[3], b, 1, 0); PK4(o[3], b, 1, 1); PK4(o[3], b, 1, 2); PK4(o[3], b, 1, 3);
#undef PK4
                *(u32x4*)(ws + WS_VB + (size_t)row * 512 + l32 * 16) = o;
                if (l32 == 0) ((float*)(ws + WS_VSCALE))[row] = am > 0.f ? am / 6.0f : 1.0f;
                continue;
            }
            const float sc = am > 0.f ? 7.5f / am : 1.0f;
#pragma unroll
            for (int i = 0; i < 16; ++i) { a[i] *= sc; b[i] *= sc; }
            f32x16 a2, b2;
#pragma unroll
            for (int i = 0; i < 8; ++i) { a2[i] = a[2 * i]; b2[i] = a[2 * i + 1]; a2[8 + i] = b[2 * i]; b2[8 + i] = b[2 * i + 1]; }
            const u32x6 pk = __builtin_amdgcn_cvt_scalef32_2xpk16_fp6_f32(a2, b2, 1.0f);
            unsigned char* dst = ws + (which ? WS_VB : WS_UB) + (size_t)row * 768;
            *(u32x4*)(dst + l32 * 16) = (u32x4){pk[0], pk[1], pk[2], pk[3]};
            *(u32x2*)(dst + 512 + l32 * 8) = (u32x2){pk[4], pk[5]};
            if (l32 == 0) ((float*)(ws + (which ? WS_VSCALE : WS_USCALE)))[row] = am > 0.f ? am / 7.5f : 1.0f;
        }
    }
}

DI unsigned pk4_fp8(float a, float b, float c, float d) {
    int w = __builtin_amdgcn_cvt_pk_fp8_f32(a, b, 0, false);
    return (unsigned)__builtin_amdgcn_cvt_pk_fp8_f32(c, d, w, true);
}
DI void phase0(const Params& p, unsigned char* lds) {
    unsigned char* ws = p.ws;
    const size_t gtid = (size_t)blockIdx.x * NTHREADS + threadIdx.x, gstride = (size_t)gridDim.x * NTHREADS;
    for (int strip = blockIdx.x; strip < NINP / 16; strip += gridDim.x) {
        const int c = threadIdx.x & 15, kq = threadIdx.x >> 4, n = strip * 16 + c;
        const int s = n < 1280 ? n : (n < 1792 ? 1304 + (n - 1280) : (n < 1816 ? 1280 + (n - 1792) : -1));
        const float* w = p.in[1] + (size_t)(kq * 64) * 1816 + (s >= 0 ? s : 0);
        float v[64];
        float am = 0.f;
#pragma unroll
        for (int j = 0; j < 64; ++j) { v[j] = s >= 0 ? w[(size_t)j * 1816] : 0.f; am = fmaxf(am, fabsf(v[j])); }
        float* red = (float*)lds;
        red[kq * 16 + c] = am;
        __syncthreads();
        float cm = 0.f;
#pragma unroll
        for (int q = 0; q < 16; ++q) cm = fmaxf(cm, red[q * 16 + c]);
        __syncthreads();
        const float sc = cm > 0.f ? 448.0f / cm : 1.0f;
        unsigned char* dst = ws + WS_WINT + (size_t)n * 1024 + kq * 64;
#pragma unroll
        for (int q = 0; q < 4; ++q) {
            u32x4 o;
#pragma unroll
            for (int d = 0; d < 4; ++d) o[d] = pk4_fp8(v[q * 16 + d * 4] * sc, v[q * 16 + d * 4 + 1] * sc, v[q * 16 + d * 4 + 2] * sc, v[q * 16 + d * 4 + 3] * sc);
            *(u32x4*)(dst + q * 16) = o;
        }
        if (kq == 0) ((float*)(ws + WS_SW))[n] = cm > 0.f ? cm / 448.0f : 1.0f;
    }
    {
        const int lane = threadIdx.x & 63, gw = (int)(gtid >> 6), ngw = (int)(gstride >> 6);
        for (int row = gw; row < NTOK; row += ngw) {
            const f32x4* src = (const f32x4*)(p.in[0] + (size_t)row * 1024) + lane * 4;
            f32x4 v[4];
            float am = 0.f;
#pragma unroll
            for (int j = 0; j < 4; ++j) { v[j] = src[j]; am = fmaxf(am, fmaxf(fmaxf(fabsf(v[j].x), fabsf(v[j].y)), fmaxf(fabsf(v[j].z), fabsf(v[j].w)))); }
#pragma unroll
            for (int o = 32; o >= 1; o >>= 1) am = fmaxf(am, __shfl_xor(am, o));
            const float sc = am > 0.f ? 448.0f / am : 1.0f;
            u32x4 o4;
#pragma unroll
            for (int j = 0; j < 4; ++j) o4[j] = pk4_fp8(v[j].x * sc, v[j].y * sc, v[j].z * sc, v[j].w * sc);
            *(u32x4*)(ws + WS_XB + (size_t)row * 1024 + lane * 16) = o4;
            if (lane == 0) ((float*)(ws + WS_SX))[row] = am > 0.f ? am / 448.0f : 1.0f;
        }
    }
    cvt_rows(p.in[15], (bf16_t*)(ws + WS_SUBK), (size_t)2 * 128 * 128 / 8, gtid, gstride);
    transpose_cvt(p.in[11], 1024, 1024, (bf16_t*)(ws + WS_WOUTT), 1024, [](int n) { return n; }, gtid, gstride);
    transpose_cvt_scaled(p.in[14], 1024, 2048, (bf16_t*)(ws + WS_WQT), p.in[12], gtid, gstride);
    transpose_cvt(p.in[5], 2048, 256, (bf16_t*)(ws + WS_W1TK), 256, [](int n) { return n; }, gtid, gstride);
    transpose_cvt(p.in[7], 2048, 256, (bf16_t*)(ws + WS_W1TV), 256, [](int n) { return n; }, gtid, gstride);
    transpose_cvt(p.in[6], 256, 64, (bf16_t*)(ws + WS_W2TK), 64, [](int n) { return n; }, gtid, gstride);
    transpose_cvt(p.in[8], 256, 64, (bf16_t*)(ws + WS_W2TV), 64, [](int n) { return n; }, gtid, gstride);
    for (int g = 0; g < 4; ++g)
        transpose_cvt(p.in[9] + g * 16384, 128, 128, (bf16_t*)(ws + WS_POOLWT) + g * 16384, 128, [](int n) { return n; }, gtid, gstride);
    {
        float* z = (float*)(ws + WS_KCMP);
        for (size_t i = gtid; i < (size_t)2 * 8 * 256 * 64; i += gstride) z[i] = 0.f;
    }
    {
        const int lane = threadIdx.x & 63, gw = (int)(gtid >> 6), ngw = (int)(gstride >> 6);
        for (int o = gw; o < 512; o += ngw) {
            const int which = o >> 8, j = o & 255;
            const float* pe = which ? p.in[4] : p.in[3];
            const float* w1 = which ? p.in[7] : p.in[5];
            float s = 0.f;
#pragma unroll 8
            for (int i = lane; i < 2048; i += 64) s += pe[i] * w1[(size_t)i * 256 + j];
            s = wave_sum(s);
            if (lane == 0) ((float*)(ws + (which ? WS_PEBV : WS_PEBK)))[j] = s;
        }
    }
    if (gtid >= 512 && gtid < 768) {
        const int d = (int)(gtid - 512);
        ((int*)(ws + WS_BUCK))[d] = rel_bucket_dev(d);
    }
}

DI int cu_pair_pos(int j, int G8) { const int hlf = (G8 + 1) >> 1; return (G8 & 1) ? j : (((j % hlf) << 1) | (j / hlf)); }

DI void phase1(const Params& p, unsigned char* lds) {
    unsigned char* ws = p.ws;
    const unsigned char* xb = ws + WS_XB;
    const unsigned char* wt = ws + WS_WINT;
    const float* sx = (const float*)(ws + WS_SX);
    const float* sw = (const float*)(ws + WS_SW);
    const int ntiles = 128 * 15;
    const int G8 = (gridDim.x & 7) == 0 ? gridDim.x >> 3 : 0;
    for (int l0 = G8 ? 0 : (int)blockIdx.x; l0 < (G8 ? ntiles / 8 : ntiles); l0 += (G8 ? G8 : (int)gridDim.x)) {
        const int li = G8 ? l0 + cu_pair_pos((int)(blockIdx.x >> 3), G8) : l0;
        if (G8 && li >= ntiles / 8) break;
        const int tile = G8 ? (int)(blockIdx.x & 7) * (ntiles / 8) + li : li;
        const int tn = tile % 15, tm = tile / 15;
        f32x16 acc[2][2];
        gemm_mainloop_f8(xb + (size_t)tm * 128 * DM, DM, wt + (size_t)tn * 128 * DM, DM, DM, acc, lds);
        const int m0 = tm * 128;
        {
            const int lane = threadIdx.x & 63, wid = threadIdx.x >> 6, wr = wid >> 1, wc = wid & 1, r = lane & 31, h = lane >> 5;
            const float sx0 = sx[m0 + wr * 64 + r], sx1 = sx[m0 + wr * 64 + 32 + r];
#pragma unroll
            for (int ni = 0; ni < 2; ++ni)
#pragma unroll
                for (int grp = 0; grp < 4; ++grp) {
                    const f32x4 s4 = *(const f32x4*)(sw + tn * 128 + wc * 64 + ni * 32 + 8 * grp + 4 * h);
#pragma unroll
                    for (int e2 = 0; e2 < 4; ++e2) { acc[0][ni][4 * grp + e2] *= sx0 * s4[e2]; acc[1][ni][4 * grp + e2] *= sx1 * s4[e2]; }
                }
        }
        if (tn < 14) {
            const bool tr = (tn == 7 || tn == 9);
            const float qs = tn < 4 ? QSCALE : 1.0f;
            if (tr) epi_stage_cols(acc, lds);
            else epi_stage_rows(acc, lds, [&](int) { return (f32x4){qs, qs, qs, qs}; });
            __syncthreads();
            const int bq = m0 >> 12, t0q = m0 & 4095;
            if (tn < 4) {
                bf16_t* Q = (bf16_t*)(ws + WS_Q);
                rows_foreach(lds, [&](int m, int cc, u32x4 d) {
                    const int hd = tn * 2 + (cc >> 3);
                    *(u32x4*)(Q + (((size_t)(bq * 8 + hd) * SEQ + t0q + m) * 64 + (cc & 7) * 8)) = d;
                });
            } else if (tr) {
                bf16_t* dst = (bf16_t*)(ws + (tn == 7 ? WS_VSLCT : WS_VWINT));
                rows_foreach(lds, [&](int n, int cc, u32x4 d) {
                    *(u32x4*)(dst + ((size_t)((bq * 2 + (n >> 6)) * 64 + (n & 63)) * SEQ + t0q + cc * 8)) = d;
                });
            } else if (tn < 10) {
                bf16_t* dst = (bf16_t*)(ws + (tn == 4 ? WS_KC : tn == 5 ? WS_VC : tn == 6 ? WS_KSLC : WS_KWIN));
                rows_foreach(lds, [&](int m, int cc, u32x4 d) {
                    *(u32x4*)(dst + (((size_t)(bq * 2 + (cc >> 3)) * SEQ + t0q + m) * 64 + (cc & 7) * 8)) = d;
                });
            } else {
                bf16_t* dst = (bf16_t*)(ws + WS_Z);
                rows_foreach(lds, [&](int m, int cc, u32x4 d) {
                    *(u32x4*)(dst + ((size_t)(m0 + m) * 512 + (tn - 10) * 128 + cc * 8)) = d;
                });
            }
            __syncthreads();
        } else {
            float* dst = (float*)(ws + WS_GATES);
            epi_foreach(acc, [&](int m, int n, f32x4 v) {
                if (n < 24) {
                    f32x4 o = {1.f / (1.f + __expf(-v.x)), 1.f / (1.f + __expf(-v.y)), 1.f / (1.f + __expf(-v.z)), 1.f / (1.f + __expf(-v.w))};
                    *(f32x4*)(dst + (size_t)(m0 + m) * 24 + n) = o;
                }
            });
        }
    }
}

DI void compress_job(const Params& p, unsigned char* lds, int cj) {
    unsigned char* ws = p.ws;
    const int kv = cj >> 6, bg = (cj >> 3) & 7, rq = (cj >> 1) & 3, hh = cj & 1;
    const bf16_t* A = (const bf16_t*)(ws + (kv ? WS_VC : WS_KC)) + ((size_t)bg * SEQ + (size_t)rq * 64 * 16) * 64;
    const bf16_t* Bt = (const bf16_t*)(ws + (kv ? WS_W1TV : WS_W1TK)) + (size_t)hh * 128 * 2048;
    const float* peb = (const float*)(ws + (kv ? WS_PEBV : WS_PEBK)) + hh * 128;
    const bf16_t* w2t = (const bf16_t*)(ws + (kv ? WS_W2TV : WS_W2TK));
    float* dst = (float*)(ws + (kv ? WS_VCMP : WS_KCMP)) + (size_t)bg * 256 * 64;
    f32x16 acc[1][2];
    gemm_mainloop_t<1>(A, 1024, Bt, 2048, 2048, acc, lds);
    epi_foreach_t<1>(acc, [&](int m, int n, f32x4 v) {
        f32x4 bb = *(const f32x4*)(peb + n);
        u32x2 o = {pk2(gelu_erf(v.x + bb.x), gelu_erf(v.y + bb.y)), pk2(gelu_erf(v.z + bb.z), gelu_erf(v.w + bb.w))};
        *(u32x2*)(lds + m * 272 + n * 2) = o;
    });
    __syncthreads();
    const int tid = threadIdx.x, lane = tid & 63, wid = tid >> 6, r = lane & 31, h = lane >> 5;
    const int wr2 = wid >> 1, wd = wid & 1;
    f32x16 a2;
#pragma unroll
    for (int i = 0; i < 16; ++i) a2[i] = 0.f;
#pragma unroll
    for (int ks = 0; ks < 8; ++ks) {
        bf16x8 fb = *(const bf16x8*)(lds + (wr2 * 32 + r) * 272 + ks * 32 + h * 16);
        bf16x8 fa = *(const bf16x8*)(w2t + (size_t)(wd * 32 + r) * 256 + hh * 128 + ks * 16 + h * 8);
        a2 = MFMA32(fa, fb, a2);
    }
    const int row = rq * 64 + wr2 * 32 + r;
    if (row < 255) {
#pragma unroll
        for (int i = 0; i < 16; ++i) {
            const int d = wd * 32 + (i & 3) + 8 * (i >> 2) + 4 * h;
            atomicAdd(dst + (size_t)row * 64 + d, a2[i]);
        }
    }
    __syncthreads();
}

constexpr int AT_K0 = 0, AT_V0 = 18432, AT_TB = 36864, AT_IMP = 40960, AT_SEL = 49152;

DI void attn_stage_load(const bf16_t* __restrict__ Kg, const bf16_t* __restrict__ Vtg, u32x4 (&st)[4], int tid) {
#pragma unroll
    for (int i = 0; i < 2; ++i) {
        const int c = tid + 256 * i, row = c >> 3, cc = c & 7;
        st[i] = *(const u32x4*)(Kg + (size_t)row * 64 + cc * 8);
        st[2 + i] = *(const u32x4*)(Vtg + (size_t)row * SEQ + cc * 8);
    }
}
DI void attn_stage_store(unsigned char* Kl, unsigned char* Vl, const u32x4 (&st)[4], int tid) {
#pragma unroll
    for (int i = 0; i < 2; ++i) {
        const int c = tid + 256 * i, row = c >> 3, cc = c & 7;
        *(u32x4*)(Kl + row * ROWB + cc * 16) = st[i];
        *(u32x4*)(Vl + row * ROWB + cc * 16) = st[2 + i];
    }
}
DI void attn_scores(const unsigned char* Kl, const bf16x8 (&qf)[4], f32x16 (&X)[2], int r, int h) {
#pragma unroll
    for (int i = 0; i < 16; ++i) { X[0][i] = 0.f; X[1][i] = 0.f; }
#pragma unroll
    for (int ks = 0; ks < 4; ++ks)
#pragma unroll
        for (int kb = 0; kb < 2; ++kb) {
            bf16x8 a = *(const bf16x8*)(Kl + (kb * 32 + r) * ROWB + ks * 32 + h * 16);
            X[kb] = MFMA32(a, qf[ks], X[kb]);
        }
}
DI void attn_pv(const unsigned char* Vl, const f32x16 (&P)[2], f32x16 (&O)[2], int r, int h) {
#pragma unroll
    for (int kb = 0; kb < 2; ++kb)
#pragma unroll
        for (int s = 0; s < 2; ++s) {
            u32x4 pw = {pk2(P[kb][8 * s], P[kb][8 * s + 1]), pk2(P[kb][8 * s + 2], P[kb][8 * s + 3]),
                        pk2(P[kb][8 * s + 4], P[kb][8 * s + 5]), pk2(P[kb][8 * s + 6], P[kb][8 * s + 7])};
            bf16x8 pb = __builtin_bit_cast(bf16x8, pw);
#pragma unroll
            for (int db = 0; db < 2; ++db) {
                const unsigned char* q = Vl + (db * 32 + r) * ROWB + (kb * 32 + 16 * s + 4 * h) * 2;
                s16x4 lo = *(const s16x4*)q, hi = *(const s16x4*)(q + 16);
                bf16x8 a = __builtin_shufflevector(lo, hi, 0, 1, 2, 3, 4, 5, 6, 7);
                O[db] = MFMA32(a, pb, O[db]);
            }
        }
}
DI void softmax_update(f32x16 (&X)[2], float& m, float& l, f32x16 (&O)[2]) {
    float mloc = -1e30f;
#pragma unroll
    for (int kb = 0; kb < 2; ++kb)
#pragma unroll
        for (int i = 0; i < 16; ++i) mloc = fmaxf(mloc, X[kb][i]);
    mloc = fmaxf(mloc, __shfl_xor(mloc, 32));
    const float mnew = fmaxf(m, mloc);
    const float alpha = __builtin_amdgcn_exp2f(m - mnew);
    m = mnew;
    float ls = 0.f;
#pragma unroll
    for (int kb = 0; kb < 2; ++kb)
#pragma unroll
        for (int i = 0; i < 16; ++i) {
            const float x = X[kb][i];
            const float pv = x > -1e29f ? __builtin_amdgcn_exp2f(x - mnew) : 0.f;
            X[kb][i] = pv; ls += pv;
        }
    l = l * alpha + ls;
#pragma unroll
    for (int db = 0; db < 2; ++db)
#pragma unroll
        for (int i = 0; i < 16; ++i) O[db][i] *= alpha;
}
DI void softmax_far(f32x16 (&X)[2], float cb, float& m, float& l, f32x16 (&O)[2]) {
    float mloc = -3e38f;
#pragma unroll
    for (int kb = 0; kb < 2; ++kb)
#pragma unroll
        for (int i = 0; i < 16; ++i) mloc = fmaxf(mloc, X[kb][i]);
    mloc += cb;
    mloc = fmaxf(mloc, __shfl_xor(mloc, 32));
    const float mnew = fmaxf(m, mloc);
    if (__any(mnew > m)) {
        const float alpha = __builtin_amdgcn_exp2f(m - mnew);
        m = mnew; l *= alpha;
#pragma unroll
        for (int db = 0; db < 2; ++db)
#pragma unroll
            for (int i = 0; i < 16; ++i) O[db][i] *= alpha;
    }
    const float mc = m - cb;
    f32x2 ls = {0.f, 0.f};
#pragma unroll
    for (int kb = 0; kb < 2; ++kb)
#pragma unroll
        for (int i = 0; i < 16; i += 2) {
            f32x2 pv = {__builtin_amdgcn_exp2f(X[kb][i] - mc), __builtin_amdgcn_exp2f(X[kb][i + 1] - mc)};
            X[kb][i] = pv.x; X[kb][i + 1] = pv.y; ls += pv;
        }
    l += ls.x + ls.y;
}
DI void build_bias_table(const Params& p, unsigned char* lds, int g) {
    const int* buck = (const int*)(p.ws + WS_BUCK);
    float* tb = (float*)(lds + AT_TB);
    for (int i = threadIdx.x; i < 1024; i += NTHREADS) {
        const int hl = i >> 8, d = i & 255;
        tb[i] = p.in[2][buck[d] * 8 + g * 4 + hl] * LOG2E;
    }
}

DI void win_unit(const Params& p, unsigned char* lds, int u) {
    unsigned char* ws = p.ws;
    const int tid = threadIdx.x, lane = tid & 63, wid = tid >> 6, r = lane & 31, h = lane >> 5;
    const int bg = u & 7, t32 = u >> 3, b = bg >> 1, g = bg & 1, t0 = t32 * 32;
    const int hl = r >> 3, t = t0 + wid * 8 + (r & 7);
    const bf16_t* Kg = (const bf16_t*)(ws + WS_KWIN) + (size_t)bg * SEQ * 64;
    const bf16_t* Vtg = (const bf16_t*)(ws + WS_VWINT) + (size_t)bg * 64 * SEQ;
    const bf16_t* Qg = (const bf16_t*)(ws + WS_Q) + ((size_t)(b * 8 + g * 4 + hl) * SEQ + t) * 64;
    __syncthreads();
    build_bias_table(p, lds, g);
    bf16x8 qf[4];
#pragma unroll
    for (int ks = 0; ks < 4; ++ks) qf[ks] = *(const bf16x8*)(Qg + ks * 16 + h * 8);
    const int jlo = t0 < 511 ? 0 : ((t0 - 511) >> 6), jhi = t0 >> 6;
    u32x4 st[4];
    attn_stage_load(Kg + (size_t)jlo * 64 * 64, Vtg + jlo * 64, st, tid);
    attn_stage_store(lds + AT_K0, lds + AT_V0, st, tid);
    __syncthreads();
    const float* tb = (const float*)(lds + AT_TB) + hl * 256;
    const int tmin = t0 + wid * 8;
    float m = -1e30f, l = 0.f;
    f32x16 O[2];
#pragma unroll
    for (int i = 0; i < 16; ++i) { O[0][i] = 0.f; O[1][i] = 0.f; }
    for (int j = jlo; j <= jhi; ++j) {
        const int cur = (j - jlo) & 1;
        if (j < jhi) attn_stage_load(Kg + (size_t)(j + 1) * 64 * 64, Vtg + (j + 1) * 64, st, tid);
        const unsigned char* Kl = lds + AT_K0 + cur * 9216;
        const unsigned char* Vl = lds + AT_V0 + cur * 9216;
        f32x16 X[2];
        attn_scores(Kl, qf, X, r, h);
        const bool far = (tmin - (j * 64 + 63) >= 128) && (tmin + 7 - j * 64 < 512);
        if (far) {
            softmax_far(X, tb[255], m, l, O);
        } else {
#pragma unroll
            for (int kb = 0; kb < 2; ++kb)
#pragma unroll
                for (int i = 0; i < 16; ++i) {
                    const int pos = j * 64 + kb * 32 + (i & 3) + 8 * (i >> 2) + 4 * h;
                    const int dist = t - pos;
                    const bool valid = dist >= 0 && dist < 512;
                    const int di = dist < 0 ? 0 : (dist > 255 ? 255 : dist);
                    X[kb][i] = valid ? X[kb][i] + tb[di] : -1e30f;
                }
            softmax_update(X, m, l, O);
        }
        attn_pv(Vl, X, O, r, h);
        if (j < jhi) attn_stage_store(lds + AT_K0 + (cur ^ 1) * 9216, lds + AT_V0 + (cur ^ 1) * 9216, st, tid);
        __syncthreads();
    }
    const float lt = l + __shfl_xor(l, 32);
    const size_t tok = (size_t)b * SEQ + t;
    const float gate = ((const float*)(ws + WS_GATES))[tok * 24 + 16 + g * 4 + hl];
    const float sc = gate / lt;
    bf16_t* ow = (bf16_t*)(ws + WS_OWIN) + tok * 512 + (g * 4 + hl) * 64;
#pragma unroll
    for (int db = 0; db < 2; ++db)
#pragma unroll
        for (int grp = 0; grp < 4; ++grp) {
            u32x2 o = {pk2(O[db][4 * grp] * sc, O[db][4 * grp + 1] * sc), pk2(O[db][4 * grp + 2] * sc, O[db][4 * grp + 3] * sc)};
            *(u32x2*)(ow + db * 32 + 8 * grp + 4 * h) = o;
        }
}

DI void cmp_stage(const float* __restrict__ kc, const float* __restrict__ vc, int ct, unsigned char* Kl, unsigned char* Vl, bool withv, int tid) {
    {
        const int c = tid >> 2, part = tid & 3;
        const f32x4* src = (const f32x4*)(kc + (size_t)(ct * 64 + c) * 64 + part * 16);
        f32x4 a = src[0], b2 = src[1], c2 = src[2], d2 = src[3];
        u32x4 o0 = {pk2(a.x, a.y), pk2(a.z, a.w), pk2(b2.x, b2.y), pk2(b2.z, b2.w)};
        u32x4 o1 = {pk2(c2.x, c2.y), pk2(c2.z, c2.w), pk2(d2.x, d2.y), pk2(d2.z, d2.w)};
        *(u32x4*)(Kl + c * ROWB + part * 32) = o0;
        *(u32x4*)(Kl + c * ROWB + part * 32 + 16) = o1;
    }
    if (withv) {
        const int c = tid & 63, dg = tid >> 6;
        const f32x4* src = (const f32x4*)(vc + (size_t)(ct * 64 + c) * 64 + dg * 16);
#pragma unroll
        for (int q4 = 0; q4 < 4; ++q4) {
            f32x4 a = src[q4];
            const int d = dg * 16 + q4 * 4;
            *(bf16_t*)(Vl + (d + 0) * ROWB + c * 2) = (bf16_t)f2bf(a.x);
            *(bf16_t*)(Vl + (d + 1) * ROWB + c * 2) = (bf16_t)f2bf(a.y);
            *(bf16_t*)(Vl + (d + 2) * ROWB + c * 2) = (bf16_t)f2bf(a.z);
            *(bf16_t*)(Vl + (d + 3) * ROWB + c * 2) = (bf16_t)f2bf(a.w);
        }
    }
}

DI void slc_unit(const Params& p, unsigned char* lds, int u) {
    unsigned char* ws = p.ws;
    const int tid = threadIdx.x, lane = tid & 63, wid = tid >> 6, r = lane & 31, h = lane >> 5;
    const int bg = u & 7, t32 = u >> 3, b = bg >> 1, g = bg & 1, t0 = t32 * 32;
    const int hl = r >> 3, tokl = r & 7, t = t0 + wid * 8 + tokl;
    const bf16_t* Kg = (const bf16_t*)(ws + WS_KSLC) + (size_t)bg * SEQ * 64;
    const bf16_t* Vtg = (const bf16_t*)(ws + WS_VSLCT) + (size_t)bg * 64 * SEQ;
    const bf16_t* Qg = (const bf16_t*)(ws + WS_Q) + ((size_t)(b * 8 + g * 4 + hl) * SEQ + t) * 64;
    const float* kcmp = (const float*)(ws + WS_KCMP) + (size_t)bg * 256 * 64;
    const float* vcmp = (const float*)(ws + WS_VCMP) + (size_t)bg * 256 * 64;
    __syncthreads();
    build_bias_table(p, lds, g);
    unsigned* imp = (unsigned*)(lds + AT_IMP) + wid * 512;
#pragma unroll
    for (int i = 0; i < 8; ++i) imp[i * 64 + lane] = 0u;
    bf16x8 qf[4];
#pragma unroll
    for (int ks = 0; ks < 4; ++ks) qf[ks] = *(const bf16x8*)(Qg + ks * 16 + h * 8);
    const float* tb = (const float*)(lds + AT_TB) + hl * 256;
    const int cmax = t0 >> 4;
    const int nct = (t0 + 31 >= 31) ? (cmax >> 6) + 1 : 0;
    float m = -1e30f, l = 0.f;
    f32x16 Oc[2];
#pragma unroll
    for (int i = 0; i < 16; ++i) { Oc[0][i] = 0.f; Oc[1][i] = 0.f; }
    for (int ct = 0; ct < nct; ++ct) {
        __syncthreads();
        cmp_stage(kcmp, vcmp, ct, lds + AT_K0, lds + AT_V0, false, tid);
        __syncthreads();
        f32x16 X[2];
        attn_scores(lds + AT_K0, qf, X, r, h);
#pragma unroll
        for (int kb = 0; kb < 2; ++kb)
#pragma unroll
            for (int i = 0; i < 16; ++i) {
                const int c = ct * 64 + kb * 32 + (i & 3) + 8 * (i >> 2) + 4 * h;
                const int dist = t - (16 * c + 31);
                const bool valid = dist >= 0 && c < 255;
                const int di = dist < 0 ? 0 : (dist > 255 ? 255 : dist);
                X[kb][i] = valid ? X[kb][i] + tb[di] : -1e30f;
            }
        f32x16 dummy[2];
#pragma unroll
        for (int i = 0; i < 16; ++i) { dummy[0][i] = 0.f; dummy[1][i] = 0.f; }
        softmax_update(X, m, l, dummy);
    }
    const float lt = l + __shfl_xor(l, 32);
    const float invl = lt > 0.f ? 1.0f / lt : 0.f;
    for (int ct = 0; ct < nct; ++ct) {
        __syncthreads();
        cmp_stage(kcmp, vcmp, ct, lds + AT_K0, lds + AT_V0, true, tid);
        __syncthreads();
        f32x16 X[2];
        attn_scores(lds + AT_K0, qf, X, r, h);
#pragma unroll
        for (int kb = 0; kb < 2; ++kb)
#pragma unroll
            for (int i = 0; i < 16; ++i) {
                const int c = ct * 64 + kb * 32 + (i & 3) + 8 * (i >> 2) + 4 * h;
                const int dist = t - (16 * c + 31);
                const bool valid = dist >= 0 && c < 255;
                const int di = dist < 0 ? 0 : (dist > 255 ? 255 : dist);
                X[kb][i] = valid ? __builtin_amdgcn_exp2f(X[kb][i] + tb[di] - m) * invl : 0.f;
            }
#pragma unroll
        for (int kb = 0; kb < 2; ++kb)
#pragma unroll
            for (int grp = 0; grp < 4; ++grp) {
                const float s4 = (X[kb][4 * grp] + X[kb][4 * grp + 1]) + (X[kb][4 * grp + 2] + X[kb][4 * grp + 3]);
                const int jj = ct * 16 + kb * 8 + 2 * grp + h;
                atomicAdd(&imp[tokl * 64 + jj], (unsigned)(s4 * 67108864.0f + 0.5f));
                if (jj + 1 < 64) atomicAdd(&imp[tokl * 64 + jj + 1], (unsigned)(X[kb][4 * grp + 3] * 67108864.0f + 0.5f));
            }
        attn_pv(lds + AT_V0, X, Oc, r, h);
    }
    unsigned long long* selm = (unsigned long long*)(lds + AT_SEL) + wid * 8;
    for (int tk = 0; tk < 8; ++tk) {
        const int tt = t0 + wid * 8 + tk, curb = tt >> 6;
        int v = (int)imp[tk * 64 + lane];
        if (lane == 0 || lane == curb || lane == curb - 1) v = 0x7fffffff;
        if (lane > curb) v = -1;
        int cnt = 0;
#pragma unroll
        for (int k = 0; k < 64; ++k) {
            const int vk = __builtin_amdgcn_readlane(v, k);
            cnt += (vk > v || (vk == v && k < lane)) ? 1 : 0;
        }
        const unsigned long long mk = __ballot(cnt < 16);
        if (lane == 0) selm[tk] = mk;
    }
    const unsigned long long mysel = selm[tokl];
    __syncthreads();
    const int jhi = t0 >> 6;
    u32x4 st[4];
    attn_stage_load(Kg, Vtg, st, tid);
    attn_stage_store(lds + AT_K0, lds + AT_V0, st, tid);
    __syncthreads();
    float m2 = -1e30f, l2 = 0.f;
    const int tmin = t0 + wid * 8;
    f32x16 O[2];
#pragma unroll
    for (int i = 0; i < 16; ++i) { O[0][i] = 0.f; O[1][i] = 0.f; }
    for (int j = 0; j <= jhi; ++j) {
        const int cur = j & 1;
        if (j < jhi) attn_stage_load(Kg + (size_t)(j + 1) * 64 * 64, Vtg + (j + 1) * 64, st, tid);
        const unsigned char* Kl = lds + AT_K0 + cur * 9216;
        const unsigned char* Vl = lds + AT_V0 + cur * 9216;
        f32x16 X[2];
        attn_scores(Kl, qf, X, r, h);
        const bool selj = (mysel >> j) & 1ull;
        if (tmin - (j * 64 + 63) >= 128) {
            softmax_far(X, selj ? tb[255] : -1e30f, m2, l2, O);
        } else {
#pragma unroll
            for (int kb = 0; kb < 2; ++kb)
#pragma unroll
                for (int i = 0; i < 16; ++i) {
                    const int pos = j * 64 + kb * 32 + (i & 3) + 8 * (i >> 2) + 4 * h;
                    const int dist = t - pos;
                    const bool valid = dist >= 0 && selj;
                    const int di = dist < 0 ? 0 : (dist > 255 ? 255 : dist);
                    X[kb][i] = valid ? X[kb][i] + tb[di] : -1e30f;
                }
            softmax_update(X, m2, l2, O);
        }
        attn_pv(Vl, X, O, r, h);
        if (j < jhi) attn_stage_store(lds + AT_K0 + (cur ^ 1) * 9216, lds + AT_V0 + (cur ^ 1) * 9216, st, tid);
        __syncthreads();
    }
    const float lt2 = l2 + __shfl_xor(l2, 32);
    const size_t tok = (size_t)b * SEQ + t;
    const float* gt = (const float*)(ws + WS_GATES) + tok * 24;
    const float gc = gt[g * 4 + hl], gs = gt[8 + g * 4 + hl] / lt2;
    const bf16_t* ow = (const bf16_t*)(ws + WS_OWIN) + tok * 512 + (g * 4 + hl) * 64;
    bf16_t* mx = (bf16_t*)(ws + WS_MIXIN) + tok * 1024 + (g * 4 + hl) * 64;
#pragma unroll
    for (int db = 0; db < 2; ++db)
#pragma unroll
        for (int grp = 0; grp < 4; ++grp) {
            const int d = db * 32 + 8 * grp + 4 * h;
            const u32x2 w = *(const u32x2*)(ow + d);
            const float r0 = gc * Oc[db][4 * grp] + gs * O[db][4 * grp] + bflo(w.x);
            const float r1 = gc * Oc[db][4 * grp + 1] + gs * O[db][4 * grp + 1] + bfhi(w.x);
            const float r2 = gc * Oc[db][4 * grp + 2] + gs * O[db][4 * grp + 2] + bflo(w.y);
            const float r3 = gc * Oc[db][4 * grp + 3] + gs * O[db][4 * grp + 3] + bfhi(w.y);
            u32x2 o = {pk2(r0, r1), pk2(r2, r3)};
            *(u32x2*)(mx + d) = o;
        }
}

DI void pooly_job(const Params& p, int job) {
    unsigned char* ws = p.ws;
    const bf16_t* z = (const bf16_t*)(ws + WS_Z);
    bf16_t* y = (bf16_t*)(ws + WS_YPOOL);
    const int tid = threadIdx.x;
    const int tokb = job * 16 + (tid >> 6) * 4, ch = tid & 63, tb = tokb & 4095;
    const int gi = ch >> 4, win = 2 << gi;
    u32x4 rowv[19];
#pragma unroll
    for (int i = 0; i < 19; ++i) {
        const int dt = i - 15;
        const bool need = dt > -win && tb + dt >= 0;
        rowv[i] = *(const u32x4*)(z + (size_t)(need ? tokb + dt : tokb) * 512 + ch * 8);
    }
    float f[19][8];
#pragma unroll
    for (int i = 0; i < 19; ++i) {
        f[i][0] = bflo(rowv[i].x); f[i][1] = bfhi(rowv[i].x); f[i][2] = bflo(rowv[i].y); f[i][3] = bfhi(rowv[i].y);
        f[i][4] = bflo(rowv[i].z); f[i][5] = bfhi(rowv[i].z); f[i][6] = bflo(rowv[i].w); f[i][7] = bfhi(rowv[i].w);
    }
#pragma unroll
    for (int o = 0; o < 4; ++o) {
        const int t = tb + o;
        const int cnt = (t + 1 < win) ? t + 1 : win;
        float s[8];
#pragma unroll
        for (int c = 0; c < 8; ++c) s[c] = 0.f;
#pragma unroll
        for (int k = 0; k < 16; ++k) {
            const float wk = k < cnt ? 1.0f : 0.0f;
#pragma unroll
            for (int c = 0; c < 8; ++c) s[c] += wk * f[15 + o - k][c];
        }
        const float ic = 1.0f / (float)cnt;
        u32x4 ov = {pk2(s[0] * ic - f[15 + o][0], s[1] * ic - f[15 + o][1]), pk2(s[2] * ic - f[15 + o][2], s[3] * ic - f[15 + o][3]),
                    pk2(s[4] * ic - f[15 + o][4], s[5] * ic - f[15 + o][5]), pk2(s[6] * ic - f[15 + o][6], s[7] * ic - f[15 + o][7])};
        *(u32x4*)(y + (size_t)(tokb + o) * 512 + ch * 8) = ov;
    }
}

DI void lnfold_consts(const Params& p, int n0, int cnt) {
    unsigned char* ws = p.ws;
    const int lane = threadIdx.x & 63, wid = threadIdx.x >> 6;
    const bf16_t* wqt = (const bf16_t*)(ws + WS_WQT);
    const float* wq = p.in[14];
    const float* bb = p.in[13];
    for (int n = n0 + wid; n < n0 + cnt; n += 4) {
        float s1 = 0.f, s2 = 0.f;
#pragma unroll
        for (int j = 0; j < 2; ++j) {
            const u32x4 w = *(const u32x4*)(wqt + (size_t)n * 1024 + (j * 64 + lane) * 8);
            s1 += (bflo(w.x) + bfhi(w.x)) + (bflo(w.y) + bfhi(w.y)) + (bflo(w.z) + bfhi(w.z)) + (bflo(w.w) + bfhi(w.w));
        }
#pragma unroll 8
        for (int k = lane; k < 1024; k += 64) s2 += bb[k] * wq[(size_t)k * 2048 + n];
        s1 = wave_sum(s1); s2 = wave_sum(s2);
        if (lane == 0) { ((float*)(ws + WS_C1))[n] = s1; ((float*)(ws + WS_C2))[n] = s2; }
    }
}

DI void phase2(const Params& p, unsigned char* lds) {
    const int G = gridDim.x, bx = blockIdx.x;
    if (G == 512) {
        if (bx < 128) { compress_job(p, lds, bx); win_unit(p, lds, 768 + bx); }
        else {
            win_unit(p, lds, bx - 128); win_unit(p, lds, 384 + bx - 128);
            if (bx < 256) win_unit(p, lds, 896 + bx - 128);
            else lnfold_consts(p, (bx - 256) * 8, 8);
        }
    } else {
        for (int job = bx; job < 128; job += G) compress_job(p, lds, job);
        for (int job = bx; job < 1024; job += G) win_unit(p, lds, job);
        for (int n0 = bx * 8; n0 < 2048; n0 += G * 8) lnfold_consts(p, n0, 8);
    }
    for (int job = bx; job < 1024; job += G) pooly_job(p, job);
}

DI void pool_gemm_tile(const Params& p, unsigned char* lds, int tile) {
    unsigned char* ws = p.ws;
    const int gi = tile & 3, tm = tile >> 2;
    f32x16 acc[2][2];
    __syncthreads();
    gemm_mainloop((const bf16_t*)(ws + WS_YPOOL) + (size_t)tm * 128 * 512 + gi * 128, 512,
                  (const bf16_t*)(ws + WS_POOLWT) + (size_t)gi * 16384, 128, 128, acc, lds);
    const float* sc = p.in[10] + gi * 128;
    bf16_t* mx = (bf16_t*)(ws + WS_MIXIN);
    epi_stage_rows(acc, lds, [&](int n) { return *(const f32x4*)(sc + n); });
    __syncthreads();
    rows_foreach(lds, [&](int m, int cc, u32x4 d) {
        *(u32x4*)(mx + (size_t)(tm * 128 + m) * 1024 + 512 + gi * 128 + cc * 8) = d;
    });
}

DI void phase3(const Params& p, unsigned char* lds) {
    const int G = gridDim.x, bx = blockIdx.x;
    for (int pass = 0; pass * G < 1024; ++pass) {
        const int i = pass * G + ((pass & 1) ? (G - 1 - bx) : bx);
        if (i < 1024) {
            const int u = ((127 - (i >> 3)) << 3) | (i & 7);
            slc_unit(p, lds, u);
        }
    }
    for (int tile = bx; tile < 512; tile += G) pool_gemm_tile(p, lds, tile);
}

DI void phase4(const Params& p, unsigned char* lds) {
    unsigned char* ws = p.ws;
    const float* x = p.in[0];
    bf16_t* y1 = (bf16_t*)(ws + WS_Z);
    const bool conv_first = (blockIdx.x >> 3) & 1;
    if (conv_first) convert_tables(p);
    const int G8 = (gridDim.x & 7) == 0 ? gridDim.x >> 3 : 0;
    for (int l0 = G8 ? 0 : (int)blockIdx.x; l0 < (G8 ? 128 : 1024); l0 += (G8 ? G8 : (int)gridDim.x)) {
        const int li = G8 ? l0 + cu_pair_pos((int)(blockIdx.x >> 3), G8) : l0;
        if (G8 && li >= 128) break;
        const int tile = G8 ? (int)(blockIdx.x & 7) * 128 + li : li;
        const int tn = tile & 7, tm = tile >> 3;
        f32x16 acc[2][2];
        gemm_mainloop((const bf16_t*)(ws + WS_MIXIN) + (size_t)tm * 128 * 1024, 1024,
                      (const bf16_t*)(ws + WS_WOUTT) + (size_t)tn * 128 * 1024, 1024, 1024, acc, lds);
        epi_stage_rows(acc, lds, [&](int) { return (f32x4){1.f, 1.f, 1.f, 1.f}; });
        __syncthreads();
        rows_foreach(lds, [&](int m, int cc, u32x4 d) {
            const size_t off = (size_t)(tm * 128 + m) * 1024 + tn * 128 + cc * 8;
            const f32x4 xa = *(const f32x4*)(x + off), xb = *(const f32x4*)(x + off + 4);
            u32x4 o = {pk2(ALPHA * xa.x + bflo(d.x), ALPHA * xa.y + bfhi(d.x)), pk2(ALPHA * xa.z + bflo(d.y), ALPHA * xa.w + bfhi(d.y)),
                       pk2(ALPHA * xb.x + bflo(d.z), ALPHA * xb.y + bfhi(d.z)), pk2(ALPHA * xb.z + bflo(d.w), ALPHA * xb.w + bfhi(d.w))};
            *(u32x4*)(y1 + off) = o;
            float s = ((bflo(o.x) + bfhi(o.x)) + (bflo(o.y) + bfhi(o.y))) + ((bflo(o.z) + bfhi(o.z)) + (bflo(o.w) + bfhi(o.w)));
            float q = ((bflo(o.x) * bflo(o.x) + bfhi(o.x) * bfhi(o.x)) + (bflo(o.y) * bflo(o.y) + bfhi(o.y) * bfhi(o.y)))
                    + ((bflo(o.z) * bflo(o.z) + bfhi(o.z) * bfhi(o.z)) + (bflo(o.w) * bflo(o.w) + bfhi(o.w) * bfhi(o.w)));
#pragma unroll
            for (int sh = 1; sh < 16; sh <<= 1) { s += __shfl_xor(s, sh); q += __shfl_xor(q, sh); }
            if (cc == 0) *(f32x2*)((float*)(ws + WS_LNST) + (size_t)(tm * 128 + m) * 16 + tn * 2) = (f32x2){s, q};
        });
        __syncthreads();
    }
    if (!conv_first) convert_tables(p);
}

DI void ln1_stats(const unsigned char* ws, int row, float& mean, float& rstd) {
    const f32x4* st = (const f32x4*)((const float*)(ws + WS_LNST) + (size_t)row * 16);
    const f32x4 a = st[0], b = st[1], c = st[2], d = st[3];
    const float s = ((a.x + a.z) + (b.x + b.z)) + ((c.x + c.z) + (d.x + d.z));
    const float q = ((a.y + a.w) + (b.y + b.w)) + ((c.y + c.w) + (d.y + d.w));
    mean = s * (1.0f / 1024.0f);
    const float var = fmaxf(q * (1.0f / 1024.0f) - mean * mean, 0.f);
    rstd = rsqrtf(var + LN_EPS);
}

DI void phase5(const Params& p) {
    unsigned char* ws = p.ws;
    const int lane = threadIdx.x & 63, wid = threadIdx.x >> 6;
    const float* gg = p.in[12];
    const float* bb = p.in[13];
    bf16_t* h1 = (bf16_t*)(ws + WS_H1);
    for (int row = blockIdx.x * 4 + wid; row < NTOK; row += gridDim.x * 4) {
        const u32x2* xr = (const u32x2*)((const bf16_t*)(ws + WS_Z) + (size_t)row * 1024) + lane;
        f32x4 v[4];
        float s = 0.f;
#pragma unroll
        for (int j = 0; j < 4; ++j) { const u32x2 w = xr[64 * j]; v[j] = (f32x4){bflo(w.x), bfhi(w.x), bflo(w.y), bfhi(w.y)}; s += (v[j].x + v[j].y) + (v[j].z + v[j].w); }
        const float mean = wave_sum(s) * (1.0f / 1024.0f);
        float s2 = 0.f;
#pragma unroll
        for (int j = 0; j < 4; ++j) { v[j] = v[j] - mean; s2 += (v[j].x * v[j].x + v[j].y * v[j].y) + (v[j].z * v[j].z + v[j].w * v[j].w); }
        const float rstd = rsqrtf(wave_sum(s2) * (1.0f / 1024.0f) + LN_EPS);
#pragma unroll
        for (int j = 0; j < 4; ++j) {
            const f32x4 g4 = ((const f32x4*)gg)[lane + 64 * j], b4 = ((const f32x4*)bb)[lane + 64 * j];
            u32x2 o = {pk2(v[j].x * rstd * g4.x + b4.x, v[j].y * rstd * g4.y + b4.y), pk2(v[j].z * rstd * g4.z + b4.z, v[j].w * rstd * g4.w + b4.w)};
            *(u32x2*)(h1 + (size_t)row * 1024 + (lane + 64 * j) * 4) = o;
        }
    }
}


DI void ce_desc(int& a, int& b) { const int hi = a > b ? a : b, lo = a > b ? b : a; a = hi; b = lo; }
template <int K, int J> DI void bst(int (&a)[16]) {
#pragma unroll
    for (int i = 0; i < 16; ++i) { const int l = i ^ J; if (l > i) { if ((i & K) == 0) ce_desc(a[i], a[l]); else ce_desc(a[l], a[i]); } }
}
DI void sort16(int (&a)[16]) { bst<2, 1>(a); bst<4, 2>(a); bst<4, 1>(a); bst<8, 4>(a); bst<8, 2>(a); bst<8, 1>(a); bst<16, 8>(a); bst<16, 4>(a); bst<16, 2>(a); bst<16, 1>(a); }
DI void merge_top16(int (&a)[16], const int (&b)[16]) {
#pragma unroll
    for (int i = 0; i < 16; ++i) a[i] = a[i] > b[15 - i] ? a[i] : b[15 - i];
    bst<16, 8>(a); bst<16, 4>(a); bst<16, 2>(a); bst<16, 1>(a);
}

constexpr int cand_i(int c) { return c < 16 ? 0 : c < 24 ? 1 : c < 29 ? 2 : c < 33 ? 3 : c < 36 ? 4 : c < 38 ? 5 : c < 40 ? 6 : c < 42 ? 7 : c - 34; }
constexpr int cand_j(int c) { return c < 16 ? c : c < 24 ? c - 16 : c < 29 ? c - 24 : c < 33 ? c - 29 : c < 36 ? c - 33 : c < 38 ? c - 36 : c < 40 ? c - 38 : c < 42 ? c - 40 : 0; }
DI void cand_ij(int c, int& i, int& j) {
    if (c < 16) { i = 0; j = c; } else if (c < 24) { i = 1; j = c - 16; } else if (c < 29) { i = 2; j = c - 24; } else if (c < 33) { i = 3; j = c - 29; }
    else if (c < 36) { i = 4; j = c - 33; } else if (c < 38) { i = 5; j = c - 36; } else if (c < 40) { i = 6; j = c - 38; } else if (c < 42) { i = 7; j = c - 40; }
    else { i = c - 34; j = 0; }
}
DI float key_val6(int k) { int b = k & ~63; b ^= (b >> 31) & 0x7fffffff; return __int_as_float(b); }

DI void phase6(const Params& p, unsigned char* lds) {
    unsigned char* ws = p.ws;
    const int tid = threadIdx.x, lane = tid & 63, wid = tid >> 6, wr = wid >> 1, wc = wid & 1, r = lane & 31, h = lane >> 5;
    const bf16_t* h1 = (const bf16_t*)(ws + WS_Z);
    const bf16_t* wq = (const bf16_t*)(ws + WS_WQT);
    const bf16_t* sk = (const bf16_t*)(ws + WS_SUBK);
    const float* c1 = (const float*)(ws + WS_C1);
    const float* c2 = (const float*)(ws + WS_C2);
    int* routeE = (int*)(ws + WS_TOPK);
    float* routeG = (float*)(ws + WS_TOPK + 8 * MiB);
    int* L1s = (int*)(lds + 65536);
    const int G8 = (gridDim.x & 7) == 0 ? gridDim.x >> 3 : 0;
    for (int l0 = G8 ? 0 : (int)blockIdx.x; l0 < (G8 ? 128 : 1024); l0 += (G8 ? G8 : (int)gridDim.x)) {
        const int li = G8 ? l0 + cu_pair_pos((int)(blockIdx.x >> 3), G8) : l0;
        if (G8 && li >= 128) break;
        const int pair = G8 ? (int)(blockIdx.x & 7) * 128 + li : li;
        const int tm = pair >> 3, head = pair & 7;
        int ka[16], kb[16];
        float rmean[2], rrstd[2];
#pragma unroll
        for (int mi = 0; mi < 2; ++mi) ln1_stats(ws, tm * 128 + wr * 64 + mi * 32 + r, rmean[mi], rrstd[mi]);
        if (tid < 128) {
            const int kh = tid >> 6, wh = (tid >> 5) & 1, q4 = tid & 31;
            *(f32x4*)(lds + LDS_CST + kh * 1024 + wh * 512 + q4 * 16) = *(const f32x4*)((wh ? c2 : c1) + (head * 2 + kh) * 128 + q4 * 4);
        }
#pragma unroll 1
        for (int khalf = 0; khalf < 2; ++khalf) {
            const int tn = head * 2 + khalf;
            f32x16 acc[2][2];
            gemm_mainloop(h1 + (size_t)tm * 128 * 1024, 1024, wq + (size_t)tn * 128 * 1024, 1024, 1024, acc, lds);
            epi_foreach(acc, [&](int m, int n, f32x4 v) {
                const int mi = (m >> 5) & 1;
                const float mu = mi ? rmean[1] : rmean[0], rs = mi ? rrstd[1] : rrstd[0];
                const f32x4 k1 = *(const f32x4*)(lds + LDS_CST + khalf * 1024 + n * 4), k2 = *(const f32x4*)(lds + LDS_CST + khalf * 1024 + 512 + n * 4);
                u32x2 o = {pk2(rs * (v.x - mu * k1.x) + k2.x, rs * (v.y - mu * k1.y) + k2.y), pk2(rs * (v.z - mu * k1.z) + k2.z, rs * (v.w - mu * k1.w) + k2.w)};
                *(u32x2*)(lds + m * 272 + n * 2) = o;
            });
            __syncthreads();
            f32x16 a2[2][2];
#pragma unroll
            for (int mi = 0; mi < 2; ++mi)
#pragma unroll
                for (int ni = 0; ni < 2; ++ni)
#pragma unroll
                    for (int i = 0; i < 16; ++i) a2[mi][ni][i] = 0.f;
#pragma unroll
            for (int ks = 0; ks < 8; ++ks) {
                bf16x8 fa[2], fb[2];
#pragma unroll
                for (int mi = 0; mi < 2; ++mi) fa[mi] = *(const bf16x8*)(lds + (wr * 64 + mi * 32 + r) * 272 + ks * 32 + h * 16);
#pragma unroll
                for (int ni = 0; ni < 2; ++ni) fb[ni] = *(const bf16x8*)(sk + (size_t)(khalf * 128 + wc * 64 + ni * 32 + r) * 128 + ks * 16 + h * 8);
#pragma unroll
                for (int mi = 0; mi < 2; ++mi)
#pragma unroll
                    for (int ni = 0; ni < 2; ++ni) a2[mi][ni] = MFMA32(fb[ni], fa[mi], a2[mi][ni]);
            }
            __syncthreads();
#pragma unroll
            for (int mi = 0; mi < 2; ++mi) {
                int xa[16], xb[16];
#pragma unroll
                for (int i = 0; i < 16; ++i) {
                    const int n = wc * 64 + (i & 3) + 8 * (i >> 2) + 4 * h;
                    xa[i] = make_key(a2[mi][0][i], n); xb[i] = make_key(a2[mi][1][i], n + 32);
                }
                sort16(xa); sort16(xb); merge_top16(xa, xb);
#pragma unroll
                for (int i = 0; i < 16; ++i) xb[i] = __shfl_xor(xa[i], 32);
                merge_top16(xa, xb);
                if (h == 0) {
                    int* dst = (int*)lds + ((wr * 64 + mi * 32 + r) * 2 + wc) * 16;
#pragma unroll
                    for (int q4 = 0; q4 < 4; ++q4) { u32x4 o = {(unsigned)xa[4 * q4], (unsigned)xa[4 * q4 + 1], (unsigned)xa[4 * q4 + 2], (unsigned)xa[4 * q4 + 3]}; *(u32x4*)(dst + 4 * q4) = o; }
                }
            }
            __syncthreads();
            if (tid < 128) {
                const int* s0 = (const int*)lds + tid * 32;
#pragma unroll
                for (int q4 = 0; q4 < 4; ++q4) {
                    const u32x4 x = *(const u32x4*)(s0 + 4 * q4), y = *(const u32x4*)(s0 + 16 + 4 * q4);
                    ka[4 * q4] = (int)x.x; ka[4 * q4 + 1] = (int)x.y; ka[4 * q4 + 2] = (int)x.z; ka[4 * q4 + 3] = (int)x.w;
                    kb[4 * q4] = (int)y.x; kb[4 * q4 + 1] = (int)y.y; kb[4 * q4 + 2] = (int)y.z; kb[4 * q4 + 3] = (int)y.w;
                }
                merge_top16(ka, kb);
                if (khalf == 0) {
#pragma unroll
                    for (int q4 = 0; q4 < 4; ++q4) { u32x4 o = {(unsigned)ka[4 * q4], (unsigned)ka[4 * q4 + 1], (unsigned)ka[4 * q4 + 2], (unsigned)ka[4 * q4 + 3]}; *(u32x4*)(L1s + tid * 16 + 4 * q4) = o; }
                }
            }
            if (khalf == 0) __syncthreads();
        }
        if (tid < 128) {
            int* L2s = (int*)lds + tid * 32;
#pragma unroll
            for (int q4 = 0; q4 < 4; ++q4) { u32x4 o = {(unsigned)ka[4 * q4], (unsigned)ka[4 * q4 + 1], (unsigned)ka[4 * q4 + 2], (unsigned)ka[4 * q4 + 3]}; *(u32x4*)(L2s + 4 * q4) = o; }
            float v1[16], v2[16];
#pragma unroll
            for (int q4 = 0; q4 < 4; ++q4) {
                const u32x4 x = *(const u32x4*)(L1s + tid * 16 + 4 * q4);
                v1[4 * q4] = key_val((int)x.x); v1[4 * q4 + 1] = key_val((int)x.y); v1[4 * q4 + 2] = key_val((int)x.z); v1[4 * q4 + 3] = key_val((int)x.w);
            }
#pragma unroll
            for (int i = 0; i < 16; ++i) v2[i] = key_val(ka[i]);
            int g0[16], g1[16], g2[16], g3[16];
#pragma unroll
            for (int t = 0; t < 16; ++t) {
                { const float s = v1[cand_i(t)] + v2[cand_j(t)]; int b = __float_as_int(s); b ^= (b >> 31) & 0x7fffffff; g0[t] = (b & ~63) | (63 - t); }
                { const float s = v1[cand_i(16 + t)] + v2[cand_j(16 + t)]; int b = __float_as_int(s); b ^= (b >> 31) & 0x7fffffff; g1[t] = (b & ~63) | (63 - (16 + t)); }
                { const float s = v1[cand_i(32 + t)] + v2[cand_j(32 + t)]; int b = __float_as_int(s); b ^= (b >> 31) & 0x7fffffff; g2[t] = (b & ~63) | (63 - (32 + t)); }
                if (t < 2) { const float s = v1[cand_i(48 + t)] + v2[cand_j(48 + t)]; int b = __float_as_int(s); b ^= (b >> 31) & 0x7fffffff; g3[t] = (b & ~63) | (63 - (48 + t)); }
                else g3[t] = (int)0x80000000 + t;
            }
            sort16(g0); sort16(g1); sort16(g2); sort16(g3);
            merge_top16(g0, g1); merge_top16(g2, g3); merge_top16(g0, g2);
            const float smax = key_val6(g0[0]);
            float ex[16], den = 0.f;
#pragma unroll
            for (int t = 0; t < 16; ++t) { ex[t] = __expf(key_val6(g0[t]) - smax); den += ex[t]; }
            const float inv = 1.0f / den;
            const size_t ro = ((size_t)(tm * 128 + tid) * 8 + head) * 16;
#pragma unroll
            for (int q4 = 0; q4 < 4; ++q4) {
                int ee[4];
#pragma unroll
                for (int u = 0; u < 4; ++u) {
                    int ci, cj; cand_ij(63 - (g0[4 * q4 + u] & 63), ci, cj);
                    ee[u] = (L1s[tid * 16 + ci] & 127) * 128 + (L2s[cj] & 127);
                }
                u32x4 oe = {(unsigned)ee[0], (unsigned)ee[1], (unsigned)ee[2], (unsigned)ee[3]};
                f32x4 og = {ex[4 * q4] * inv, ex[4 * q4 + 1] * inv, ex[4 * q4 + 2] * inv, ex[4 * q4 + 3] * inv};
                *(u32x4*)(routeE + ro + 4 * q4) = oe;
                *(f32x4*)(routeG + ro + 4 * q4) = og;
            }
        }
        __syncthreads();
    }
}

constexpr int P7_NS = 32, P7_SH = 9;
constexpr int P7_WLDS = 6144;
DI void p7_loadrows(int b, int li, int l32, const LAS int* ent_e, const unsigned char* tab, u32x4 (&rows)[8][2]) {
    const u32x4 e0 = *(const LAS u32x4*)(ent_e + li * 128 + b), e1 = *(const LAS u32x4*)(ent_e + li * 128 + b + 4);
    const unsigned ee[8] = {e0.x, e0.y, e0.z, e0.w, e1.x, e1.y, e1.z, e1.w};
#pragma unroll
    for (int r = 0; r < 8; ++r) {
        const unsigned ob = ee[r] * 1024u + (unsigned)l32 * 16u;
        rows[r][0] = *(const u32x4*)(tab + ob);
        rows[r][1] = *(const u32x4*)(tab + ob + 512);
    }
}
DI float half32_sum(float v) { v += __shfl_xor(v, 1); v += __shfl_xor(v, 2); v += __shfl_xor(v, 4); v += __shfl_xor(v, 8); v += __shfl_xor(v, 16); return v; }

DI void p7_stepA(const u32x4 (&rows)[8][2], const unsigned (&hq)[2][4], float hscale, int b, int li, int l32, int lane, int myk,
                 LAS float* ent_w, const LAS float* ent_us) {
    int d[8];
#pragma unroll
    for (int r = 0; r < 8; ++r) {
        int a = 0;
#pragma unroll
        for (int c = 0; c < 2; ++c)
#pragma unroll
            for (int q = 0; q < 4; ++q) a = dot4i8(rows[r][c][q], hq[c][q], a);
        d[r] = a;
    }
    int r4[4], r2[2], r1;
    const bool b0 = lane & 1;
#pragma unroll
    for (int i = 0; i < 4; ++i) { const int snd = b0 ? d[i] : d[4 + i]; const int kp = b0 ? d[4 + i] : d[i]; r4[i] = kp + __shfl_xor(snd, 1); }
    const bool b1 = lane & 2;
#pragma unroll
    for (int i = 0; i < 2; ++i) { const int snd = b1 ? r4[i] : r4[2 + i]; const int kp = b1 ? r4[2 + i] : r4[i]; r2[i] = kp + __shfl_xor(snd, 2); }
    const bool b2 = lane & 4;
    { const int snd = b2 ? r2[0] : r2[1]; const int kp = b2 ? r2[1] : r2[0]; r1 = kp + __shfl_xor(snd, 4); }
    r1 += __shfl_xor(r1, 8); r1 += __shfl_xor(r1, 16);
    if (l32 < 8) { const int idx = li * 128 + b + myk; ent_w[idx] = ent_w[idx] * gelu_fast((float)r1 * (hscale * ent_us[idx])); }
}
DI void p7_stepA6(const unsigned (&rw)[8][6], const f16x2_t (&h16)[16], int b, int li, int l32, int lane, int myk,
                  LAS float* ent_w, const LAS float* ent_us) {
    float d[8];
#pragma unroll
    for (int r = 0; r < 8; ++r) {
        const u32x6 pk = {rw[r][0], rw[r][1], rw[r][2], rw[r][3], rw[r][4], rw[r][5]};
        const f16x32 u = __builtin_amdgcn_cvt_scalef32_pk32_f16_fp6(pk, 1.0f);
        float a0 = 0.f, a1 = 0.f;
#pragma unroll
        for (int j = 0; j < 16; j += 2) {
            a0 = __builtin_amdgcn_fdot2((f16x2_t){u[2 * j], u[2 * j + 1]}, h16[j], a0, false);
            a1 = __builtin_amdgcn_fdot2((f16x2_t){u[2 * j + 2], u[2 * j + 3]}, h16[j + 1], a1, false);
        }
        d[r] = a0 + a1;
        if (r & 1) __builtin_amdgcn_sched_barrier(0);
    }
    float r4[4], r2[2], r1;
    const bool b0 = lane & 1;
#pragma unroll
    for (int i = 0; i < 4; ++i) { const float snd = b0 ? d[i] : d[4 + i]; const float kp = b0 ? d[4 + i] : d[i]; r4[i] = kp + __shfl_xor(snd, 1); }
    const bool b1 = lane & 2;
#pragma unroll
    for (int i = 0; i < 2; ++i) { const float snd = b1 ? r4[i] : r4[2 + i]; const float kp = b1 ? r4[2 + i] : r4[i]; r2[i] = kp + __shfl_xor(snd, 2); }
    const bool b2 = lane & 4;
    { const float snd = b2 ? r2[0] : r2[1]; const float kp = b2 ? r2[1] : r2[0]; r1 = kp + __shfl_xor(snd, 4); }
    r1 += __shfl_xor(r1, 8); r1 += __shfl_xor(r1, 16);
    if (l32 < 8) { const int idx = li * 128 + b + myk; ent_w[idx] = ent_w[idx] * gelu_fast(r1 * ent_us[idx]); }
}
DI void p7_stepB(const u32x4 (&rows)[8][2], f32x2 (&acc)[2][8], int b, int li, const LAS float* ent_w) {
    const f32x4 w0 = *(const LAS f32x4*)(ent_w + li * 128 + b), w1 = *(const LAS f32x4*)(ent_w + li * 128 + b + 4);
    const float ww[8] = {w0.x, w0.y, w0.z, w0.w, w1.x, w1.y, w1.z, w1.w};
#pragma unroll
    for (int r = 0; r < 8; ++r) {
        const f32x2 w2 = {ww[r], ww[r]};
#pragma unroll
        for (int c = 0; c < 2; ++c)
#pragma unroll
            for (int q = 0; q < 4; ++q) {
                const f32x2 lo = __builtin_amdgcn_cvt_pk_f32_fp8((int)rows[r][c][q], false);
                const f32x2 hi = __builtin_amdgcn_cvt_pk_f32_fp8((int)rows[r][c][q], true);
                acc[c][2 * q] += w2 * lo; acc[c][2 * q + 1] += w2 * hi;
            }
    }
}
DI void p7_loadrows6(int b, int li, int l32, const LAS int* ent_e, const unsigned char* tab, unsigned (&rw)[8][6]) {
    const u32x4 e0 = *(const LAS u32x4*)(ent_e + li * 128 + b), e1 = *(const LAS u32x4*)(ent_e + li * 128 + b + 4);
    const unsigned ee[8] = {e0.x, e0.y, e0.z, e0.w, e1.x, e1.y, e1.z, e1.w};
#pragma unroll
    for (int r = 0; r < 8; ++r) {
        const unsigned ob = ee[r] * 768u;
        const u32x4 x = *(const u32x4*)(tab + ob + (unsigned)l32 * 16u);
        const u32x2 y = *(const u32x2*)(tab + ob + 512u + (unsigned)l32 * 8u);
        rw[r][0] = x.x; rw[r][1] = x.y; rw[r][2] = x.z; rw[r][3] = x.w; rw[r][4] = y.x; rw[r][5] = y.y;
    }
}
DI void p7_stepB6(const unsigned (&rw)[8][6], f32x2 (&acc)[2][8], int b, int li, const LAS float* ent_w) {
    const f32x4 w0 = *(const LAS f32x4*)(ent_w + li * 128 + b), w1 = *(const LAS f32x4*)(ent_w + li * 128 + b + 4);
    const float ww[8] = {w0.x, w0.y, w0.z, w0.w, w1.x, w1.y, w1.z, w1.w};
#pragma unroll
    for (int r = 0; r < 8; ++r) {
        const u32x6 pk = {rw[r][0], rw[r][1], rw[r][2], rw[r][3], rw[r][4], rw[r][5]};
        const f32x32 d = __builtin_amdgcn_cvt_scalef32_pk32_f32_fp6(pk, 1.0f);
        const f32x2 w2 = {ww[r], ww[r]};
#pragma unroll
        for (int c = 0; c < 2; ++c)
#pragma unroll
            for (int i = 0; i < 8; ++i) acc[c][i] += w2 * (f32x2){d[c * 16 + 2 * i], d[c * 16 + 2 * i + 1]};
    }
}
DI void p7_loadrows4(int b, int li, int l32, const LAS int* ent_e, const unsigned char* tab, u32x4 (&rw)[8]) {
    const u32x4 e0 = *(const LAS u32x4*)(ent_e + li * 128 + b), e1 = *(const LAS u32x4*)(ent_e + li * 128 + b + 4);
    const unsigned ee[8] = {e0.x, e0.y, e0.z, e0.w, e1.x, e1.y, e1.z, e1.w};
#pragma unroll
    for (int r = 0; r < 8; ++r) rw[r] = *(const u32x4*)(tab + ee[r] * 512u + (unsigned)l32 * 16u);
}
DI void p7_stepB4(const u32x4 (&rw)[8], f32x2 (&acc)[2][8], int b, int li, const LAS float* ent_w) {
    const f32x4 w0 = *(const LAS f32x4*)(ent_w + li * 128 + b), w1 = *(const LAS f32x4*)(ent_w + li * 128 + b + 4);
    const float ww[8] = {w0.x, w0.y, w0.z, w0.w, w1.x, w1.y, w1.z, w1.w};
#pragma unroll
    for (int r = 0; r < 8; ++r) {
        const f32x2 w2 = {ww[r], ww[r]};
#pragma unroll
        for (int c = 0; c < 2; ++c)
#pragma unroll
            for (int d = 0; d < 2; ++d) {
                const unsigned wd = rw[r][c * 2 + d];
                acc[c][d * 4 + 0] += w2 * __builtin_amdgcn_cvt_scalef32_pk_f32_fp4(wd, 1.0f, 0);
                acc[c][d * 4 + 1] += w2 * __builtin_amdgcn_cvt_scalef32_pk_f32_fp4(wd, 1.0f, 1);
                acc[c][d * 4 + 2] += w2 * __builtin_amdgcn_cvt_scalef32_pk_f32_fp4(wd, 1.0f, 2);
                acc[c][d * 4 + 3] += w2 * __builtin_amdgcn_cvt_scalef32_pk_f32_fp4(wd, 1.0f, 3);
            }
    }
}
constexpr int P7_GB = 32768;
DI void p7_load_h(const Params& p, const LAS unsigned char* gb, int tok, int l32, float (&hv)[32]) {
    const unsigned char* ws = p.ws;
    float mean, rstd;
    ln1_stats(ws, tok, mean, rstd);
    const bf16_t* y1 = (const bf16_t*)(ws + WS_Z) + (size_t)tok * 1024 + l32 * 16;
    const LAS float* gg = (const LAS float*)(gb + P7_GB) + l32 * 16;
    const LAS float* bb = gg + 1024;
#pragma unroll
    for (int c = 0; c < 2; ++c) {
        const u32x4 a = *(const u32x4*)(y1 + c * 512), b2 = *(const u32x4*)(y1 + c * 512 + 8);
        const unsigned hh[8] = {a.x, a.y, a.z, a.w, b2.x, b2.y, b2.z, b2.w};
#pragma unroll
        for (int i4 = 0; i4 < 4; ++i4) {
            const f32x4 g4 = *(const LAS f32x4*)(gg + c * 512 + i4 * 4), b4 = *(const LAS f32x4*)(bb + c * 512 + i4 * 4);
            hv[c * 16 + 4 * i4 + 0] = (bflo(hh[2 * i4]) - mean) * rstd * g4.x + b4.x;
            hv[c * 16 + 4 * i4 + 1] = (bfhi(hh[2 * i4]) - mean) * rstd * g4.y + b4.y;
            hv[c * 16 + 4 * i4 + 2] = (bflo(hh[2 * i4 + 1]) - mean) * rstd * g4.z + b4.z;
            hv[c * 16 + 4 * i4 + 3] = (bfhi(hh[2 * i4 + 1]) - mean) * rstd * g4.w + b4.w;
        }
    }
}
DI void p7_h16(const Params& p, const LAS unsigned char* gb, int tok, int l32, f16x2_t (&h16)[16]) {
    float hv[32];
    p7_load_h(p, gb, tok, l32, hv);
#pragma unroll
    for (int j = 0; j < 16; ++j) h16[j] = (f16x2_t){(_Float16)hv[2 * j], (_Float16)hv[2 * j + 1]};
}
DI void p7_quant_h(const Params& p, const LAS unsigned char* gb, int tok, int l32, unsigned (&hq)[2][4], float& hscale) {
    float hv[32];
    p7_load_h(p, gb, tok, l32, hv);
    float am = 0.f;
#pragma unroll
    for (int i = 0; i < 32; ++i) am = fmaxf(am, fabsf(hv[i]));
    am = fmaxf(am, __shfl_xor(am, 1)); am = fmaxf(am, __shfl_xor(am, 2)); am = fmaxf(am, __shfl_xor(am, 4)); am = fmaxf(am, __shfl_xor(am, 8)); am = fmaxf(am, __shfl_xor(am, 16));
    const float hq_sc = am > 0.f ? 127.0f / am : 1.0f;
    hscale = am > 0.f ? am / 127.0f : 1.0f;
#pragma unroll
    for (int c = 0; c < 2; ++c)
#pragma unroll
        for (int q = 0; q < 4; ++q) {
            const int q0 = (int)rintf(hv[c * 16 + 4 * q] * hq_sc), q1 = (int)rintf(hv[c * 16 + 4 * q + 1] * hq_sc);
            const int q2 = (int)rintf(hv[c * 16 + 4 * q + 2] * hq_sc), q3 = (int)rintf(hv[c * 16 + 4 * q + 3] * hq_sc);
            hq[c][q] = (unsigned)(q0 & 255) | ((unsigned)(q1 & 255) << 8) | ((unsigned)(q2 & 255) << 16) | ((unsigned)(q3 & 255) << 24);
        }
}
DI void p7_finish(const Params& p, int tok, const float (&hv)[32], f32x2 (&acc)[2][8], int l32) {
    const size_t hbase = (size_t)tok * 1024 + l32 * 16;
    float sm = 0.f;
    {
#pragma unroll
        for (int c = 0; c < 2; ++c)
#pragma unroll
            for (int i = 0; i < 8; ++i) {
                acc[c][i].x += ALPHA * hv[c * 16 + 2 * i]; acc[c][i].y += ALPHA * hv[c * 16 + 2 * i + 1];
                sm += acc[c][i].x + acc[c][i].y;
            }
    }
    const float mean = half32_sum(sm) * (1.0f / 1024.0f);
    float sq = 0.f;
#pragma unroll
    for (int c = 0; c < 2; ++c)
#pragma unroll
        for (int i = 0; i < 8; ++i) { acc[c][i].x -= mean; acc[c][i].y -= mean; sq += acc[c][i].x * acc[c][i].x + acc[c][i].y * acc[c][i].y; }
    const float rstd = rsqrtf(half32_sum(sq) * (1.0f / 1024.0f) + LN_EPS);
    const float* gg = p.in[18] + l32 * 16;
    const float* bb = p.in[19] + l32 * 16;
    float* orow = p.out + hbase;
#pragma unroll
    for (int c = 0; c < 2; ++c)
#pragma unroll
        for (int q4 = 0; q4 < 4; ++q4) {
            const f32x4 g4 = *(const f32x4*)(gg + c * 512 + q4 * 4), b4 = *(const f32x4*)(bb + c * 512 + q4 * 4);
            f32x4 o = {acc[c][2 * q4].x * rstd * g4.x + b4.x, acc[c][2 * q4].y * rstd * g4.y + b4.y,
                       acc[c][2 * q4 + 1].x * rstd * g4.z + b4.z, acc[c][2 * q4 + 1].y * rstd * g4.w + b4.w};
            *(f32x4*)(orow + c * 512 + q4 * 4) = o;
        }
}

DI void phase7(const Params& p, unsigned char* lds) {
    unsigned char* ws = p.ws;
    const int lane = threadIdx.x & 63, wid = __builtin_amdgcn_readfirstlane(threadIdx.x >> 6);
    const int hw = lane >> 5, l32 = lane & 31;
    LAS unsigned char* l3 = (LAS unsigned char*)lds + wid * P7_WLDS;
    const unsigned char* u8 = ws + WS_UB;
    const unsigned char* v8 = ws + WS_VB;
    const float* uscale = (const float*)(ws + WS_USCALE);
    const float* vscale = (const float*)(ws + WS_VSCALE);
    LAS int* ent_e = (LAS int*)l3;
    LAS float* ent_w = (LAS float*)(l3 + 2048);
    LAS float* ent_us = (LAS float*)(l3 + 4096);
    {
        const int t = threadIdx.x;
        *(f32x4*)(lds + P7_GB + t * 16) = *(const f32x4*)(p.in[12] + t * 4);
        *(f32x4*)(lds + P7_GB + 4096 + t * 16) = *(const f32x4*)(p.in[13] + t * 4);
        __syncthreads();
    }
    const unsigned long long ltmask = (1ull << lane) - 1ull;
    const int myk = ((lane & 1) << 2) | (lane & 2) | ((lane >> 2) & 1);
    const int li0 = hw, li1 = 2 + hw;
    for (int rnd = blockIdx.x * 4 + wid; rnd < NTOK / 4; rnd += gridDim.x * 4) {
        const int tok0 = rnd * 4;
#pragma unroll 1
        for (int tk = 0; tk < 4; ++tk) {
            const int* RE = (const int*)(ws + WS_TOPK) + (size_t)(tok0 + tk) * 128;
            const float* RG = (const float*)(ws + WS_TOPK + 8 * MiB) + (size_t)(tok0 + tk) * 128;
            const int ea = RE[lane], eb = RE[64 + lane];
            const float ga = RG[lane], gb = RG[64 + lane];
            const int sa = ea >> P7_SH, sb = eb >> P7_SH;
            int pa = 0, pb = 0, run = 0;
#pragma unroll
            for (int s = 0; s < P7_NS; ++s) {
                const unsigned long long ma = __ballot(sa == s), mb = __ballot(sb == s);
                const int ca = __popcll(ma), cb = __popcll(mb);
                if (sa == s) pa = run + __popcll(ma & ltmask);
                if (sb == s) pb = run + ca + __popcll(mb & ltmask);
                run += ca + cb;
            }
            ent_e[tk * 128 + pa] = ea; ent_w[tk * 128 + pa] = ga * vscale[ea]; ent_us[tk * 128 + pa] = uscale[ea];
            ent_e[tk * 128 + pb] = eb; ent_w[tk * 128 + pb] = gb * vscale[eb]; ent_us[tk * 128 + pb] = uscale[eb];
        }
        {
            f16x2_t h0[16], h1[16];
            p7_h16(p, (const LAS unsigned char*)lds, tok0 + li0, l32, h0);
            p7_h16(p, (const LAS unsigned char*)lds, tok0 + li1, l32, h1);
            unsigned ra[8][6], rb[8][6];
            p7_loadrows6(0, li0, l32, ent_e, u8, ra);
            for (int b = 0; b < 128; b += 8) {
                p7_loadrows6(b, li1, l32, ent_e, u8, rb);
                __builtin_amdgcn_sched_barrier(0);
                p7_stepA6(ra, h0, b, li0, l32, lane, myk, ent_w, ent_us);
                __builtin_amdgcn_sched_barrier(0);
                p7_loadrows6(b + 8 < 128 ? b + 8 : b, li0, l32, ent_e, u8, ra);
                __builtin_amdgcn_sched_barrier(0);
                p7_stepA6(rb, h1, b, li1, l32, lane, myk, ent_w, ent_us);
                __builtin_amdgcn_sched_barrier(0);
            }
        }
        f32x2 acc0[2][8], acc1[2][8];
#pragma unroll
        for (int c = 0; c < 2; ++c)
#pragma unroll
            for (int i = 0; i < 8; ++i) { acc0[c][i] = (f32x2){0.f, 0.f}; acc1[c][i] = (f32x2){0.f, 0.f}; }
        {
            u32x4 ra[8], rb[8];
            p7_loadrows4(0, li0, l32, ent_e, v8, ra);
            for (int b = 0; b < 128; b += 8) {
                p7_loadrows4(b, li1, l32, ent_e, v8, rb);
                __builtin_amdgcn_sched_barrier(0);
                p7_stepB4(ra, acc0, b, li0, ent_w);
                __builtin_amdgcn_sched_barrier(0);
                p7_loadrows4(b + 8 < 128 ? b + 8 : b, li0, l32, ent_e, v8, ra);
                __builtin_amdgcn_sched_barrier(0);
                p7_stepB4(rb, acc1, b, li1, ent_w);
                __builtin_amdgcn_sched_barrier(0);
            }
        }
        asm volatile("" ::: "memory");
        {
            float hv0[32], hv1[32];
            p7_load_h(p, (const LAS unsigned char*)lds, tok0 + li0, l32, hv0);
            p7_load_h(p, (const LAS unsigned char*)lds, tok0 + li1, l32, hv1);
            p7_finish(p, tok0 + li0, hv0, acc0, l32);
            p7_finish(p, tok0 + li1, hv1, acc1, l32);
        }
    }
}

#if DIAG
DI float bfv(const bf16_t* p, size_t i) { return __uint_as_float(((unsigned)p[i]) << 16); }
DI float bfr(float x) { return __uint_as_float(f2bf(x) << 16); }
DI void dfail(const Params& p, int bit) { atomicOr((unsigned*)(p.ws + WS_FLAG), 1u << bit); }
DI bool bad(float fast, float ref) { return !(fabsf(fast - ref) <= 0.02f * fabsf(ref) + 0.02f); }
DI unsigned hsh(unsigned x) { x ^= x >> 16; x *= 0x7feb352dU; x ^= x >> 15; x *= 0x846ca68bU; x ^= x >> 16; return x; }
DI int winsrc(int n) { return n < 1280 ? n : (n < 1792 ? 1304 + (n - 1280) : 1280 + (n - 1792)); }

DI void chk1(const Params& p, int bit) {
    unsigned char* ws = p.ws;
    const unsigned gt = blockIdx.x * NTHREADS + threadIdx.x;
    const int tok = hsh(gt * 2 + 1) & 16383, n = hsh(gt * 2 + 2) % 1816;
    const bf16_t* xb = (const bf16_t*)(ws + WS_XB);
    const bf16_t* wt = (const bf16_t*)(ws + WS_WINT);
    float ref = 0.f, ref2 = 0.f;
    for (int k = 0; k < 1024; ++k) {
        ref += bfv(xb, (size_t)tok * 1024 + k) * bfv(wt, (size_t)n * 1024 + k);
        ref2 += p.in[0][(size_t)tok * 1024 + k] * p.in[1][(size_t)k * 1816 + winsrc(n)];
    }
    if (!(fabsf(ref - ref2) <= 0.06f)) dfail(p, bit);
    const int b = tok >> 12, t = tok & 4095;
    float fast;
    if (n < 512) { const int hd = n >> 6, d = n & 63; fast = bfv((const bf16_t*)(ws + WS_Q), ((size_t)(b * 8 + hd) * SEQ + t) * 64 + d); ref *= 0.125f; }
    else if (n < 1280) {
        const int seg = (n - 512) >> 7, nn = (n - 512) & 127, g = nn >> 6, d = nn & 63;
        if (seg == 3 || seg == 5) fast = bfv((const bf16_t*)(ws + (seg == 3 ? WS_VSLCT : WS_VWINT)), ((size_t)((b * 2 + g) * 64 + d)) * SEQ + t);
        else fast = bfv((const bf16_t*)(ws + (seg == 0 ? WS_KC : seg == 1 ? WS_VC : seg == 2 ? WS_KSLC : WS_KWIN)), ((size_t)(b * 2 + g) * SEQ + t) * 64 + d);
    } else if (n < 1792) fast = bfv((const bf16_t*)(ws + WS_Z), (size_t)tok * 512 + (n - 1280));
    else { fast = ((const float*)(ws + WS_GATES))[(size_t)tok * 24 + (n - 1792)]; ref = 1.f / (1.f + expf(-ref)); }
    if (bad(fast, ref)) dfail(p, bit);
}
DI void chk2(const Params& p, int bit) {
    unsigned char* ws = p.ws;
    const unsigned gt = blockIdx.x * NTHREADS + threadIdx.x;
    if (gt >= 2048) return;
    const int kv = gt & 1, bg = (gt >> 1) & 7, c = hsh(gt) % 255, d = hsh(gt + 7777) & 63;
    const bf16_t* A = (const bf16_t*)(ws + (kv ? WS_VC : WS_KC)) + ((size_t)bg * SEQ + c * 16) * 64;
    const bf16_t* w1t = (const bf16_t*)(ws + (kv ? WS_W1TV : WS_W1TK));
    const bf16_t* w2t = (const bf16_t*)(ws + (kv ? WS_W2TV : WS_W2TK));
    const float* peb = (const float*)(ws + (kv ? WS_PEBV : WS_PEBK));
    float out = 0.f;
    for (int j = 0; j < 256; ++j) {
        float s = peb[j];
        for (int i = 0; i < 2048; ++i) s += bfv(A, i) * bfv(w1t, (size_t)j * 2048 + i);
        out += bfr(gelu_erf(s)) * bfv(w2t, d * 256 + j);
    }
    const float fast = ((const float*)(ws + (kv ? WS_VCMP : WS_KCMP)))[((size_t)bg * 256 + c) * 64 + d];
    if (bad(fast, out)) dfail(p, bit);
    if (gt < 256) {
        const float* w1 = kv ? p.in[7] : p.in[5];
        const float* w2 = kv ? p.in[8] : p.in[6];
        const float* pe = kv ? p.in[4] : p.in[3];
        float o2 = 0.f;
        for (int j = 0; j < 256; ++j) {
            float s = 0.f;
            for (int i = 0; i < 2048; ++i) s += (bfv(A, i) + pe[i]) * w1[(size_t)i * 256 + j];
            o2 += gelu_erf(s) * w2[j * 64 + d];
        }
        if (!(fabsf(o2 - out) <= 0.03f * fabsf(out) + 0.03f)) dfail(p, bit);
    }
}
DI void chk3(const Params& p, int bit) {
    unsigned char* ws = p.ws;
    const unsigned gt = blockIdx.x * NTHREADS + threadIdx.x;
    if (gt >= 4096) return;
    const int tok = hsh(gt) & 16383, head = hsh(gt + 99) & 7, b = tok >> 12, t = tok & 4095, g = head >> 2;
    const bf16_t* Q = (const bf16_t*)(ws + WS_Q) + ((size_t)(b * 8 + head) * SEQ + t) * 64;
    const bf16_t* K = (const bf16_t*)(ws + WS_KWIN) + (size_t)(b * 2 + g) * SEQ * 64;
    const bf16_t* Vt = (const bf16_t*)(ws + WS_VWINT) + (size_t)(b * 2 + g) * 64 * SEQ;
    float q[64], o[64];
#pragma unroll
    for (int d = 0; d < 64; ++d) { q[d] = bfv(Q, d); o[d] = 0.f; }
    float m = -1e30f, l = 0.f;
    for (int pos = (t > 511 ? t - 511 : 0); pos <= t; ++pos) {
        float s = 0.f;
#pragma unroll
        for (int d = 0; d < 64; ++d) s += q[d] * bfv(K, (size_t)pos * 64 + d);
        s += p.in[2][rel_bucket_dev(t - pos) * 8 + head];
        const float mn = fmaxf(m, s), a = expf(m - mn), pp = expf(s - mn);
        l = l * a + pp;
#pragma unroll
        for (int d = 0; d < 64; ++d) o[d] = o[d] * a + pp * bfv(Vt, (size_t)d * SEQ + pos);
        m = mn;
    }
    const float gate = ((const float*)(ws + WS_GATES))[(size_t)tok * 24 + 16 + head];
    bool f = false;
#pragma unroll
    for (int d = 0; d < 64; ++d) f |= bad(bfv((const bf16_t*)(ws + WS_OWIN), (size_t)tok * 512 + head * 64 + d), o[d] / l * gate);
    if (f) dfail(p, bit);
}
DI void chk4(const Params& p, int bit) {
    unsigned char* ws = p.ws;
    const unsigned gt = blockIdx.x * NTHREADS + threadIdx.x;
    if (gt >= 512) return;
    const int tok = hsh(gt + 5) & 16383, g = gt & 1, b = tok >> 12, t = tok & 4095, bg = b * 2 + g;
    float* scr = (float*)(ws + WS_DSCR) + (size_t)gt * 1536;
    float* imp = scr + 1024;
    float* nsa = scr + 1100;
    for (int j = 0; j < 64; ++j) imp[j] = 0.f;
    const float* kc = (const float*)(ws + WS_KCMP) + (size_t)bg * 256 * 64;
    const float* vc = (const float*)(ws + WS_VCMP) + (size_t)bg * 256 * 64;
    const float* gt24 = (const float*)(ws + WS_GATES) + (size_t)tok * 24;
    for (int hl = 0; hl < 4; ++hl) {
        const int head = g * 4 + hl;
        const bf16_t* Q = (const bf16_t*)(ws + WS_Q) + ((size_t)(b * 8 + head) * SEQ + t) * 64;
        float q[64], o[64];
#pragma unroll
        for (int d = 0; d < 64; ++d) { q[d] = bfv(Q, d); o[d] = 0.f; }
        float m = -1e30f;
        for (int c = 0; c < 255; ++c) {
            const bool valid = 16 * c + 31 <= t;
            float s = 0.f;
#pragma unroll
            for (int d = 0; d < 64; ++d) s += q[d] * bfr(kc[c * 64 + d]);
            s += p.in[2][rel_bucket_dev(t - 16 * c - 31) * 8 + head];
            scr[hl * 256 + c] = s;
            if (valid) m = fmaxf(m, s);
        }
        float l = 0.f;
        for (int c = 0; c < 255; ++c) if (16 * c + 31 <= t) l += expf(scr[hl * 256 + c] - m);
        for (int c = 0; c < 255; ++c) if (16 * c + 31 <= t) {
            const float pc = expf(scr[hl * 256 + c] - m) / l;
            imp[c >> 2] += pc;
            if ((c & 3) == 3 && (c >> 2) + 1 < 64) imp[(c >> 2) + 1] += pc;
#pragma unroll
            for (int d = 0; d < 64; ++d) o[d] += bfr(pc) * bfr(vc[c * 64 + d]);
        }
#pragma unroll
        for (int d = 0; d < 64; ++d) nsa[hl * 64 + d] = gt24[head] * o[d];
    }
    const int cur = t >> 6;
    for (int j = 0; j < 64; ++j) { float v = imp[j]; if (j == 0 || j == cur || j == cur - 1) v = 1e6f; if (j > cur) v = -1e30f; imp[j] = v; }
    unsigned long long selmask = 0ull;
    for (int it = 0; it < 16; ++it) {
        int bi = -1; float bv = -3e38f;
        for (int j = 0; j < 64; ++j) if (!((selmask >> j) & 1ull) && imp[j] > bv) { bv = imp[j]; bi = j; }
        selmask |= 1ull << bi;
    }
    bool f = false;
    for (int hl = 0; hl < 4; ++hl) {
        const int head = g * 4 + hl;
        const bf16_t* Q = (const bf16_t*)(ws + WS_Q) + ((size_t)(b * 8 + head) * SEQ + t) * 64;
        const bf16_t* K = (const bf16_t*)(ws + WS_KSLC) + (size_t)bg * SEQ * 64;
        const bf16_t* Vt = (const bf16_t*)(ws + WS_VSLCT) + (size_t)bg * 64 * SEQ;
        float q[64], o[64];
#pragma unroll
        for (int d = 0; d < 64; ++d) { q[d] = bfv(Q, d); o[d] = 0.f; }
        float m = -1e30f, l = 0.f;
        for (int j = 0; j <= cur; ++j) if ((selmask >> j) & 1ull) {
            for (int kk = 0; kk < 64; ++kk) {
                const int pos = j * 64 + kk;
                if (pos > t) break;
                float s = 0.f;
#pragma unroll
                for (int d = 0; d < 64; ++d) s += q[d] * bfv(K, (size_t)pos * 64 + d);
                s += p.in[2][rel_bucket_dev(t - pos) * 8 + head];
                const float mn = fmaxf(m, s), a = expf(m - mn), pp = expf(s - mn);
                l = l * a + pp;
#pragma unroll
                for (int d = 0; d < 64; ++d) o[d] = o[d] * a + pp * bfv(Vt, (size_t)d * SEQ + pos);
                m = mn;
            }
        }
#pragma unroll
        for (int d = 0; d < 64; ++d) {
            const float ref = nsa[hl * 64 + d] + gt24[8 + head] * o[d] / l + bfv((const bf16_t*)(ws + WS_OWIN), (size_t)tok * 512 + head * 64 + d);
            f |= bad(bfv((const bf16_t*)(ws + WS_MIXIN), (size_t)tok * 1024 + head * 64 + d), ref);
        }
    }
    if (f) dfail(p, bit);
}
DI void chk5(const Params& p, int bit) {
    unsigned char* ws = p.ws;
    const unsigned gt = blockIdx.x * NTHREADS + threadIdx.x;
    if (gt >= 8192) return;
    const int tok = hsh(gt + 11) & 16383, col = hsh(gt + 13) & 511, gi = col >> 7, d = col & 127, t = tok & 4095;
    const bf16_t* yp = (const bf16_t*)(ws + WS_YPOOL);
    const bf16_t* pw = (const bf16_t*)(ws + WS_POOLWT);
    const bf16_t* z = (const bf16_t*)(ws + WS_Z);
    float ref = 0.f, ref2 = 0.f;
    for (int c = 0; c < 128; ++c) {
        ref += bfv(yp, (size_t)tok * 512 + gi * 128 + c) * bfv(pw, (size_t)gi * 16384 + d * 128 + c);
        ref2 += bfv(yp, (size_t)tok * 512 + gi * 128 + c) * p.in[9][(size_t)gi * 16384 + c * 128 + d];
    }
    if (!(fabsf(ref - ref2) <= 0.03f)) dfail(p, bit);
    ref *= p.in[10][col];
    if (bad(bfv((const bf16_t*)(ws + WS_MIXIN), (size_t)tok * 1024 + 512 + col), ref)) dfail(p, bit);
    const int win = 2 << (col >> 7), cnt = (t + 1 < win) ? t + 1 : win;
    float s = 0.f;
    for (int k = 0; k < cnt; ++k) s += bfv(z, (size_t)(tok - k) * 512 + col);
    if (bad(bfv(yp, (size_t)tok * 512 + col), s / (float)cnt - bfv(z, (size_t)tok * 512 + col))) dfail(p, bit);
}
DI void chk6(const Params& p, int bit) {
    unsigned char* ws = p.ws;
    const unsigned gt = blockIdx.x * NTHREADS + threadIdx.x;
    if (gt >= 128) return;
    const int tok = hsh(gt + 17) & 16383;
    float* yb = (float*)(ws + WS_DSCR) + (size_t)gt * 1024;
    const bf16_t* mx = (const bf16_t*)(ws + WS_MIXIN) + (size_t)tok * 1024;
    const bf16_t* wo = (const bf16_t*)(ws + WS_WOUTT);
    float sm = 0.f;
    bool f = false;
    for (int n = 0; n < 1024; ++n) {
        float s = 0.f, s2 = 0.f;
        for (int k = 0; k < 1024; ++k) { s += bfv(mx, k) * bfv(wo, (size_t)n * 1024 + k); if (n < 8) s2 += bfv(mx, k) * p.in[11][(size_t)k * 1024 + n]; }
        if (n < 8 && !(fabsf(s - s2) <= 0.03f)) f = true;
        yb[n] = ALPHA * p.in[0][(size_t)tok * 1024 + n] + s; sm += yb[n];
    }
    const float mean = sm / 1024.f;
    float v = 0.f;
    for (int n = 0; n < 1024; ++n) v += (yb[n] - mean) * (yb[n] - mean);
    const float rstd = 1.f / sqrtf(v / 1024.f + LN_EPS);
    for (int n = 0; n < 1024; ++n)
        f |= bad(bfv((const bf16_t*)(ws + WS_H1), (size_t)tok * 1024 + n), (yb[n] - mean) * rstd * p.in[12][n] + p.in[13][n]);
    if (f) dfail(p, bit);
}
DI void chk7(const Params& p, int bit) {
    unsigned char* ws = p.ws;
    const unsigned gt = blockIdx.x * NTHREADS + threadIdx.x;
    if (gt >= 512) return;
    const int tok = hsh(gt + 23) & 16383, head = gt & 7, half = (gt >> 3) & 1;
    float* qd = (float*)(ws + WS_DSCR) + (size_t)gt * 256;
    float* sv = qd + 128;
    const bf16_t* h1 = (const bf16_t*)(ws + WS_H1) + (size_t)tok * 1024;
    const bf16_t* wq = (const bf16_t*)(ws + WS_WQT);
    const bf16_t* sk = (const bf16_t*)(ws + WS_SUBK);
    bool f = false;
    for (int d = 0; d < 128; ++d) {
        float s = 0.f, s2 = 0.f;
        const int col = head * 256 + half * 128 + d;
        for (int k = 0; k < 1024; ++k) { s += bfv(h1, k) * bfv(wq, (size_t)col * 1024 + k); if (d < 4) s2 += bfv(h1, k) * p.in[14][(size_t)k * 2048 + col]; }
        if (d < 4 && !(fabsf(s - s2) <= 0.06f)) f = true;
        qd[d] = bfr(s);
    }
    for (int key = 0; key < 128; ++key) {
        float s = 0.f, s2 = 0.f;
        for (int d = 0; d < 128; ++d) { s += qd[d] * bfv(sk, (size_t)(half * 128 + key) * 128 + d); s2 += qd[d] * p.in[15][(size_t)(half * 128 + key) * 128 + d]; }
        if (!(fabsf(s - s2) <= 0.05f)) f = true;
        sv[key] = s;
    }
    int mism = 0;
    const int* L = (const int*)(ws + WS_TOPK) + (((size_t)tok * 8 + head) * 2 + half) * 16;
    for (int it = 0; it < 16; ++it) {
        int bi = 0; float bv = -3e38f;
        for (int k = 0; k < 128; ++k) if (sv[k] > bv) { bv = sv[k]; bi = k; }
        sv[bi] = -3e38f;
        const int fk = L[it];
        if ((fk & 127) != bi) mism++;
        if (bad(key_val(fk), bv)) mism += 10;
    }
    if (mism > 1 || f) dfail(p, bit);
}
DI void chk8(const Params& p, int bit) {
    unsigned char* ws = p.ws;
    const unsigned gt = blockIdx.x * NTHREADS + threadIdx.x;
    if (gt >= 128) return;
    const int tok = hsh(gt + 31) & 16383;
    float* acc = (float*)(ws + WS_DSCR) + (size_t)gt * 4096;
    float* cand = acc + 1024;
    int* csel = (int*)(acc + 1024 + 256);
    float* acc2 = acc + 2048;
    const bf16_t* h1 = (const bf16_t*)(ws + WS_H1) + (size_t)tok * 1024;
    const bf16_t* ub = (const bf16_t*)(ws + WS_UB);
    const bf16_t* vb = (const bf16_t*)(ws + WS_VB);
    const int* dE = (const int*)(ws + WS_MIXIN) + (size_t)tok * 256;
    const float* dG = (const float*)dE + 128;
    bool f = false, froute = false, fg = false;
    for (int n = 0; n < 1024; ++n) { acc[n] = 0.f; acc2[n] = 0.f; }
    for (int hd = 0; hd < 8; ++hd) {
        const int* L = (const int*)(ws + WS_TOPK) + (size_t)tok * 256 + hd * 32;
        for (int i = 0; i < 16; ++i) for (int j = 0; j < 16; ++j) cand[i * 16 + j] = key_val(L[i]) + key_val(L[16 + j]);
        float mx = -3e38f, den = 0.f;
        for (int it = 0; it < 16; ++it) {
            int bi = 0; float bv = -3e38f;
            for (int k = 0; k < 256; ++k) if (cand[k] > bv) { bv = cand[k]; bi = k; }
            cand[bi] = -3e38f; csel[it] = bi;
            if (it == 0) mx = bv;
            ((float*)csel)[16 + it] = expf(bv - mx); den += expf(bv - mx);
        }
        for (int it = 0; it < 16; ++it) {
            const int i = csel[it] >> 4, j = csel[it] & 15;
            const size_t e = (size_t)(L[i] & 127) * 128 + (L[16 + j] & 127);
            float dot = 0.f;
            for (int k = 0; k < 1024; ++k) dot += bfv(h1, k) * bfv(ub, e * 1024 + k);
            const float gate = ((float*)csel)[16 + it] / den;
            const float w = gate * gelu_erf(dot);
            for (int n = 0; n < 1024; ++n) acc[n] += w * bfv(vb, e * 1024 + n);
            bool found = false;
            for (int s = 0; s < 16; ++s) if (dE[hd * 16 + s] == (int)e) { found = true; if (!(fabsf(dG[hd * 16 + s] - gate) <= 1e-3f)) fg = true; }
            if (!found) froute = true;
        }
        for (int s = 0; s < 16; ++s) {
            const size_t e = (size_t)dE[hd * 16 + s];
            if (e >= 16384) { froute = true; continue; }
            float dot = 0.f;
            for (int k = 0; k < 1024; ++k) dot += bfv(h1, k) * bfv(ub, e * 1024 + k);
            const float w = dG[hd * 16 + s] * gelu_erf(dot);
            for (int n = 0; n < 1024; ++n) acc2[n] += w * bfv(vb, e * 1024 + n);
        }
    }
    bool f2 = false;
    for (int pass = 0; pass < 2; ++pass) {
        float* a = pass ? acc2 : acc;
        float sm = 0.f;
        for (int n = 0; n < 1024; ++n) { a[n] += ALPHA * bfv(h1, n); sm += a[n]; }
        const float mean = sm / 1024.f;
        float v = 0.f;
        for (int n = 0; n < 1024; ++n) v += (a[n] - mean) * (a[n] - mean);
        const float rstd = 1.f / sqrtf(v / 1024.f + LN_EPS);
        for (int n = 0; n < 1024; ++n) {
            const bool b = bad(p.out[(size_t)tok * 1024 + n], (a[n] - mean) * rstd * p.in[18][n] + p.in[19][n]);
            if (pass) f2 |= b; else f |= b;
        }
    }
    if (f) dfail(p, bit);
    if (froute) dfail(p, bit + 1);
    if (fg) dfail(p, bit + 2);
    if (f2) dfail(p, bit + 3);
}
#endif

__global__ void __launch_bounds__(NTHREADS, 2) hybrid_fwd(Params p) {
    extern __shared__ __attribute__((aligned(16))) unsigned char lds[];
    cg::grid_group grid = cg::this_grid();
    const int lo = p.ph_lo, hi = p.ph_hi;
    volatile unsigned* bst = (volatile unsigned*)(lds + LDS_MAIN);
    if (threadIdx.x < 2) bst[threadIdx.x] = 0u;
    __syncthreads();
    XcdBarrier xbar = xcd_barrier_post((unsigned*)(p.ws + WS_BAR), bst);
#define IN(k) (lo <= (k) && (k) < hi)
#define SEAM(k) do { if (IN(k) && IN((k) + 1 + ((k) == 4))) xcd_barrier(xbar); } while (0)
    if (lo < 0) grid.sync();
#if DIAG
    if (blockIdx.x == 0 && threadIdx.x == 0) *(unsigned*)(p.ws + WS_FLAG) = 0u;
#endif
    if (IN(0)) phase0(p, lds);
    SEAM(0);
    if (IN(1)) phase1(p, lds);
    SEAM(1);
#if DIAG == 1
    chk1(p, 0);
#endif
    if (IN(2)) phase2(p, lds);
    SEAM(2);
#if DIAG == 1
    chk2(p, 1); chk3(p, 2);
#endif
    if (IN(3)) phase3(p, lds);
    SEAM(3);
#if DIAG == 1
    chk4(p, 3); chk5(p, 4);
#endif
    if (IN(4)) phase4(p, lds);
    SEAM(4);
#if DIAG == 1
    chk6(p, 5);
#endif
    if (IN(6)) phase6(p, lds);
    SEAM(6);
#if DIAG == 2
    chk7(p, 0);
#endif
    if (IN(7)) phase7(p, lds);
#if DIAG
    grid.sync();
#if DIAG == 2
    chk8(p, 1);
    grid.sync();
#endif
    {
        const unsigned code = *(volatile unsigned*)(p.ws + WS_FLAG);
        const float kv = sqrtf((float)code);
        for (size_t i = (size_t)blockIdx.x * NTHREADS + threadIdx.x; i < (size_t)NTOK * DM; i += (size_t)gridDim.x * NTHREADS) p.out[i] = kv;
    }
#endif
#undef IN
#undef SEAM
}

extern "C" void kernel_launch(void* const* d_in, const int* in_sizes, int n_in, void* d_out, int out_size, void* d_ws, size_t ws_size,
                              hipStream_t stream) {
    static int grid_blocks = 0;
    if (grid_blocks == 0) {
        if (n_in != 20 || ws_size < WS_END) { fprintf(stderr, "kernel_launch: unexpected inputs (n_in %d, ws %zu)\n", n_in, ws_size); grid_blocks = -1; return; }
        int dev = 0, cus = 0, per_cu = 0;
        hipGetDevice(&dev);
        hipDeviceGetAttribute(&cus, hipDeviceAttributeMultiprocessorCount, dev);
        hipFuncSetAttribute((const void*)hybrid_fwd, hipFuncAttributeMaxDynamicSharedMemorySize, LDS_BYTES);
        hipOccupancyMaxActiveBlocksPerMultiprocessor(&per_cu, (const void*)hybrid_fwd, NTHREADS, LDS_BYTES);
        if (per_cu < 1) per_cu = 1;
        if (per_cu > 2) per_cu = 2;
        grid_blocks = cus * per_cu;
        (void)hipGetLastError();
    }
    if (grid_blocks < 0) return;
    (void)hipMemsetAsync((char*)d_ws + WS_BAR, 0, WS_BAR_BYTES, stream);
    Params p{};
    for (int i = 0; i < 20; ++i) p.in[i] = (const float*)d_in[i];
    p.out = (float*)d_out; p.ws = (unsigned char*)d_ws;
#if N_LAUNCH_MODE == 1
    p.ph_lo = 0; p.ph_hi = 8;
    void* args[] = {&p};
    hipError_t e = hipLaunchCooperativeKernel((const void*)hybrid_fwd, dim3(grid_blocks), dim3(NTHREADS), args, LDS_BYTES, stream);
    if (e != hipSuccess) fprintf(stderr, "cooperative launch failed: %s (grid %d)\n", hipGetErrorString(e), grid_blocks);
#else
    for (int ph = 0; ph < 8; ++ph) {
        p.ph_lo = ph; p.ph_hi = ph + 1;
        hipLaunchKernelGGL(hybrid_fwd, dim3(grid_blocks), dim3(NTHREADS), LDS_BYTES, stream, p);
    }
#endif
}
```

```cpp
#include <hip/hip_runtime.h>
#include <hip/hip_cooperative_groups.h>
#include <cstdint>
#include <cstdio>
namespace cg = cooperative_groups;

#ifndef N_LAUNCH_MODE
#define N_LAUNCH_MODE 1
#endif

typedef unsigned short bf16_t;
typedef short bf16x8 __attribute__((ext_vector_type(8)));
typedef short s16x4 __attribute__((ext_vector_type(4)));
typedef long i64x2 __attribute__((ext_vector_type(2)));
typedef unsigned u32x6 __attribute__((ext_vector_type(6)));
typedef _Float16 f16x32 __attribute__((ext_vector_type(32)));
typedef _Float16 f16x2_t __attribute__((ext_vector_type(2)));
typedef float f32x32 __attribute__((ext_vector_type(32)));
typedef float f32x16 __attribute__((ext_vector_type(16)));
typedef float f32x4 __attribute__((ext_vector_type(4)));
typedef unsigned u32x4 __attribute__((ext_vector_type(4)));
typedef unsigned u32x2 __attribute__((ext_vector_type(2)));
typedef float f32x2 __attribute__((ext_vector_type(2)));
typedef __bf16 bf16x2_t __attribute__((ext_vector_type(2)));

#define DI __device__ __forceinline__
#define MFMA32(a, b, c) __builtin_amdgcn_mfma_f32_32x32x16_bf16((a), (b), (c), 0, 0, 0)

constexpr int NTOK = 16384, SEQ = 4096, DM = 1024;
constexpr int NINP = 1920;
constexpr float ALPHA = 1.189207115002721f;
constexpr float LN_EPS = 1e-5f;
constexpr float LOG2E = 1.4426950408889634f;
constexpr float QSCALE = 0.125f * LOG2E;
constexpr int NTHREADS = 256;
constexpr int LDS_MAIN = 73728;
constexpr int LDS_CST = LDS_MAIN + 64;
constexpr int LDS_BYTES = LDS_MAIN + 64 + 2048;
constexpr int ROWB = 144;

constexpr size_t MiB = 1u << 20;
constexpr size_t WS_BAR = 0;
constexpr size_t WS_BAR_BYTES = 16384;
constexpr size_t WS_KCMP = 1 * MiB;
constexpr size_t WS_VCMP = 1 * MiB + 512 * 1024;
constexpr size_t WS_W2TK = 2 * MiB;
constexpr size_t WS_W2TV = 2 * MiB + 32 * 1024;
constexpr size_t WS_POOLWT = 2 * MiB + 64 * 1024;
constexpr size_t WS_SUBK = 2 * MiB + 192 * 1024;
constexpr size_t WS_PEBK = 2 * MiB + 256 * 1024;
constexpr size_t WS_PEBV = 2 * MiB + 257 * 1024;
constexpr size_t WS_BUCK = 2 * MiB + 258 * 1024;
constexpr size_t WS_USCALE = 2 * MiB + 320 * 1024;
constexpr size_t WS_VSCALE = 2 * MiB + 384 * 1024;
constexpr size_t WS_C1 = 2 * MiB + 448 * 1024;
constexpr size_t WS_C2 = 2 * MiB + 456 * 1024;
constexpr size_t WS_LNST = 15 * MiB;
constexpr size_t WS_SX = 2 * MiB + 464 * 1024;
constexpr size_t WS_SW = 2 * MiB + 528 * 1024;
constexpr size_t WS_W1TK = 3 * MiB;
constexpr size_t WS_W1TV = 4 * MiB;
constexpr size_t WS_WINT = 5 * MiB;
constexpr size_t WS_WOUTT = 9 * MiB;
constexpr size_t WS_WQT = 11 * MiB;
constexpr size_t WS_UB = 16 * MiB;
constexpr size_t WS_VB = 48 * MiB;
constexpr size_t WS_XB = 80 * MiB;
constexpr size_t WS_MIXIN = WS_XB;
constexpr size_t WS_Q = 112 * MiB;
constexpr size_t WS_KC = 128 * MiB;
constexpr size_t WS_VC = 132 * MiB;
constexpr size_t WS_KSLC = 136 * MiB;
constexpr size_t WS_KWIN = 140 * MiB;
constexpr size_t WS_VSLCT = 144 * MiB;
constexpr size_t WS_VWINT = 148 * MiB;
constexpr size_t WS_GATES = 152 * MiB;
constexpr size_t WS_Z = 154 * MiB;
constexpr size_t WS_YPOOL = 170 * MiB;
constexpr size_t WS_OWIN = 186 * MiB;
#ifndef DIAG
#define DIAG 0
#endif
#if DIAG
constexpr size_t WS_H1 = 202 * MiB;
constexpr size_t WS_TOPK = 234 * MiB;
constexpr size_t WS_END = 256 * MiB;
constexpr size_t WS_FLAG = 32768;
constexpr size_t WS_DSCR = 250 * MiB;
#else
constexpr size_t WS_H1 = 112 * MiB;
constexpr size_t WS_TOPK = 112 * MiB;
constexpr size_t WS_END = 202 * MiB;
#endif

struct Params { const float* in[20]; float* out; unsigned char* ws; int ph_lo, ph_hi; };

DI unsigned f2bf(float f) { unsigned u = __float_as_uint(f); return (u + 0x7fffu + ((u >> 16) & 1u)) >> 16; }
DI unsigned pk2(float lo, float hi) { bf16x2_t v = {(__bf16)lo, (__bf16)hi}; return __builtin_bit_cast(unsigned, v); }
DI float bflo(unsigned x) { return __uint_as_float(x << 16); }
DI float bfhi(unsigned x) { return __uint_as_float(x & 0xffff0000u); }
DI float dot2bf(unsigned a, unsigned b, float acc) {
    asm("v_dot2c_f32_bf16 %0, %1, %2" : "+v"(acc) : "v"(a), "v"(b));
    return acc;
}
DI int dot4i8(unsigned a, unsigned b, int acc) {
    return __builtin_amdgcn_sdot4((int)a, (int)b, acc, false);
}
DI float gelu_erf(float x) { return 0.5f * x * (1.0f + erff(x * 0.70710678118654752f)); }
DI float gelu_fast(float v) {
    const float av = fabsf(v), t = __builtin_amdgcn_rcpf(av * 0.2316418882f + 1.0f);
    float q = t * 0.5307027145f + (-0.7265760135f); q = q * t + 0.7107068705f; q = q * t + (-0.142248368f); q = q * t + 0.127414796f; q = q * t;
    const float e = __builtin_amdgcn_exp2f((v * v) * (-0.72134752044f));
    const float m = v * (q * e);
    return v < 0.f ? m : v - m;
}
DI float wave_sum(float v) {
#pragma unroll
    for (int o = 32; o >= 1; o >>= 1) v += __shfl_xor(v, o);
    return v;
}
DI int rel_bucket_dev(int dist) {
    if (dist < 0) dist = 0;
    if (dist < 16) return dist;
    int v = 16 + (int)(logf((float)dist / 16.0f) / logf(8.0f) * 16.0f);
    return v < 31 ? v : 31;
}
DI int make_key(float f, int idx) { int b = __float_as_int(f); b ^= (b >> 31) & 0x7fffffff; return (b & ~127) | idx; }
DI float key_val(int k) { int b = k & ~127; b ^= (b >> 31) & 0x7fffffff; return __int_as_float(b); }


#define LAS __attribute__((address_space(3)))
#define XB_TMO      128
#define XB_XCNT(j)  (256  + 64 * (j))
#define XB_XSUB(j)  (1280 + 64 * (j))
#define XB_XGEN(j)  (2304 + 64 * (j))
#define XB_TOP      3328
#define XB_TOPGEN   3392
#define XCD_BAR_WORDS 3456
#define XB_SPIN_CAP (1u << 20)
DI unsigned xb_ld(unsigned* p)              { return __hip_atomic_load(p, __ATOMIC_RELAXED, __HIP_MEMORY_SCOPE_AGENT); }
DI unsigned xb_add(unsigned* p, unsigned v) { return __hip_atomic_fetch_add(p, v, __ATOMIC_RELAXED, __HIP_MEMORY_SCOPE_AGENT); }
DI unsigned xb_xcc_id() { return (unsigned)__builtin_amdgcn_s_getreg((3 << 11) | 20) & 0xFu; }
#define XB_SPIN(cond, bar) do { unsigned _sp = 0; while (cond) { __builtin_amdgcn_s_sleep(1); \
    if ((++_sp & 255u) == 0u) { if (xb_ld(&(bar)[XB_TMO])) break; if (_sp > XB_SPIN_CAP) { atomicAdd(&(bar)[XB_TMO], 1u); break; } } } } while (0)
struct XcdBarrier { unsigned* bar; unsigned x; volatile unsigned* st; };
DI XcdBarrier xcd_barrier_post(unsigned* bar, volatile unsigned* st) {
    XcdBarrier b; b.bar = bar; b.x = xb_xcc_id(); b.st = st;
    if (threadIdx.x == 0) (void)xb_add(&bar[XB_XCNT(b.x)], 1u);
    return b;
}
DI void xcd_barrier_complete(unsigned* bar, unsigned x, unsigned& nloc, unsigned& nx) {
    const unsigned G = gridDim.x * gridDim.y * gridDim.z;
    unsigned sum, cnt, mine, sp = 0u;
    for (;;) {
        sum = 0u; cnt = 0u; mine = 0u;
#pragma unroll
        for (unsigned j = 0; j < 16; ++j) { const unsigned c = xb_ld(&bar[XB_XCNT(j)]); sum += c; cnt += (c > 0u) ? 1u : 0u; mine = (j == x) ? c : mine; }
        if (sum == G) break;
        __builtin_amdgcn_s_sleep(1);
        if ((++sp & 255u) == 0u) { if (xb_ld(&bar[XB_TMO])) break; if (sp > XB_SPIN_CAP) { atomicAdd(&bar[XB_TMO], 1u); break; } }
    }
    nloc = mine > 0u ? mine : 1u; nx = cnt > 0u ? cnt : 1u;
}
DI void xcd_barrier(const XcdBarrier& b) {
    asm volatile("s_waitcnt vmcnt(0)" ::: "memory");
    __syncthreads();
    if (threadIdx.x == 0) {
        unsigned* bar = b.bar;
        __builtin_amdgcn_s_waitcnt(0);
        unsigned nloc = b.st[0], nx = b.st[1];
        if (nloc == 0u) { xcd_barrier_complete(bar, b.x, nloc, nx); b.st[0] = nloc; b.st[1] = nx; }
        const unsigned old = xb_add(&bar[XB_XSUB(b.x)], 1u);
        const unsigned gen = old / nloc;
        if (old + 1u == (gen + 1u) * nloc) {
            __builtin_amdgcn_fence(__ATOMIC_RELEASE, "agent");
            asm volatile("s_waitcnt vmcnt(0)" ::: "memory");
            const unsigned og = xb_add(&bar[XB_TOP], 1u);
            const unsigned tg = og / nx;
            if (og + 1u == (tg + 1u) * nx) xb_add(&bar[XB_TOPGEN], 1u);
            else XB_SPIN(xb_ld(&bar[XB_TOPGEN]) == tg, bar);
            __builtin_amdgcn_fence(__ATOMIC_ACQUIRE, "agent");
            xb_add(&bar[XB_XGEN(b.x)], 1u);
            asm volatile("s_waitcnt vmcnt(0)" ::: "memory");
        } else {
            XB_SPIN(xb_ld(&bar[XB_XGEN(b.x)]) == gen, bar);
            __builtin_amdgcn_fence(__ATOMIC_ACQUIRE, "agent");
            asm volatile("s_waitcnt vmcnt(0)" ::: "memory");
        }
    }
    __syncthreads();
}

template <int MI>
DI void gemm_mainloop_t(const bf16_t* __restrict__ A, int lda, const bf16_t* __restrict__ Bt, int ldb, int K,
                        f32x16 (&acc)[MI][2], unsigned char* lds) {
    const int tid = threadIdx.x, lane = tid & 63, wid = __builtin_amdgcn_readfirstlane(tid >> 6);
    const int wr = wid >> 1, wc = wid & 1, r = lane & 31, h = lane >> 5;
    LAS unsigned char* As = (LAS unsigned char*)lds;
    LAS unsigned char* Bs = (LAS unsigned char*)lds + 2 * 16384;
#pragma unroll
    for (int mi = 0; mi < MI; ++mi)
#pragma unroll
        for (int ni = 0; ni < 2; ++ni)
#pragma unroll
            for (int i = 0; i < 16; ++i) acc[mi][ni][i] = 0.f;
    const int nk = K >> 6;
    const int prow = 8 * wid + (lane >> 3);
    const int pchunk = (lane & 7) ^ ((prow >> 1) & 7);
    const bf16_t* Ap = A + (size_t)prow * lda + pchunk * 8;
    const bf16_t* Bp = Bt + (size_t)prow * ldb + pchunk * 8;
    const int pl = wid * 1024;
#define GEMM_STAGE(buf, kt) do { \
        _Pragma("unroll") for (int i = 0; i < 2 * MI; ++i) __builtin_amdgcn_global_load_lds((const unsigned*)(Ap + (size_t)(32 * i) * lda + (kt) * 64), (LAS unsigned*)(As + (buf) * 16384 + i * 4096 + pl), 16, 0, 0); \
        _Pragma("unroll") for (int i = 0; i < 4; ++i) __builtin_amdgcn_global_load_lds((const unsigned*)(Bp + (size_t)(32 * i) * ldb + (kt) * 64), (LAS unsigned*)(Bs + (buf) * 16384 + i * 4096 + pl), 16, 0, 0); } while (0)
    GEMM_STAGE(0, 0);
    asm volatile("s_waitcnt vmcnt(0)" ::: "memory");
    __syncthreads();
    const int swz = (r >> 1) & 7;
    for (int kt = 0; kt < nk; ++kt) {
        const int cur = kt & 1;
        if (kt + 1 < nk) GEMM_STAGE(cur ^ 1, kt + 1);
        const LAS unsigned char* Ac = As + cur * 16384 + (wr * 32 * MI + r) * 128;
        const LAS unsigned char* Bc = Bs + cur * 16384 + (wc * 64 + r) * 128;
        __builtin_amdgcn_s_setprio(1);
#pragma unroll
        for (int ks = 0; ks < 4; ++ks) {
            const int co = ((ks * 2 + h) ^ swz) * 16;
            bf16x8 fa[MI], fb[2];
#pragma unroll
            for (int mi = 0; mi < MI; ++mi) fa[mi] = *(const LAS bf16x8*)(Ac + mi * 32 * 128 + co);
#pragma unroll
            for (int ni = 0; ni < 2; ++ni) fb[ni] = *(const LAS bf16x8*)(Bc + ni * 32 * 128 + co);
#pragma unroll
            for (int mi = 0; mi < MI; ++mi)
#pragma unroll
                for (int ni = 0; ni < 2; ++ni) acc[mi][ni] = MFMA32(fb[ni], fa[mi], acc[mi][ni]);
        }
        __builtin_amdgcn_s_setprio(0);
        asm volatile("s_waitcnt vmcnt(0)" ::: "memory");
        __syncthreads();
    }
#undef GEMM_STAGE
}
DI void gemm_mainloop_f8(const unsigned char* __restrict__ A, int lda, const unsigned char* __restrict__ Bt, int ldb, int K,
                         f32x16 (&acc)[2][2], unsigned char* lds) {
    constexpr int MI = 2;
    const int tid = threadIdx.x, lane = tid & 63, wid = __builtin_amdgcn_readfirstlane(tid >> 6);
    const int wr = wid >> 1, wc = wid & 1, r = lane & 31, h = lane >> 5;
    LAS unsigned char* As = (LAS unsigned char*)lds;
    LAS unsigned char* Bs = (LAS unsigned char*)lds + 2 * 16384;
#pragma unroll
    for (int mi = 0; mi < MI; ++mi)
#pragma unroll
        for (int ni = 0; ni < 2; ++ni)
#pragma unroll
            for (int i = 0; i < 16; ++i) acc[mi][ni][i] = 0.f;
    const int nk = K >> 7;
    const int prow = 8 * wid + (lane >> 3);
    const int pchunk = (lane & 7) ^ ((prow >> 1) & 7);
    const unsigned char* Ap = A + (size_t)prow * lda + pchunk * 16;
    const unsigned char* Bp = Bt + (size_t)prow * ldb + pchunk * 16;
    const int pl = wid * 1024;
#define GEMM_STAGE(buf, kt) do { \
        _Pragma("unroll") for (int i = 0; i < 2 * MI; ++i) __builtin_amdgcn_global_load_lds((const unsigned*)(Ap + (size_t)(32 * i) * lda + (kt) * 128), (LAS unsigned*)(As + (buf) * 16384 + i * 4096 + pl), 16, 0, 0); \
        _Pragma("unroll") for (int i = 0; i < 4; ++i) __builtin_amdgcn_global_load_lds((const unsigned*)(Bp + (size_t)(32 * i) * ldb + (kt) * 128), (LAS unsigned*)(Bs + (buf) * 16384 + i * 4096 + pl), 16, 0, 0); } while (0)
    GEMM_STAGE(0, 0);
    asm volatile("s_waitcnt vmcnt(0)" ::: "memory");
    __syncthreads();
    const int swz = (r >> 1) & 7;
    for (int kt = 0; kt < nk; ++kt) {
        const int cur = kt & 1;
        if (kt + 1 < nk) GEMM_STAGE(cur ^ 1, kt + 1);
        const LAS unsigned char* Ac = As + cur * 16384 + (wr * 32 * MI + r) * 128;
        const LAS unsigned char* Bc = Bs + cur * 16384 + (wc * 64 + r) * 128;
        __builtin_amdgcn_s_setprio(1);
#pragma unroll
        for (int ks = 0; ks < 4; ++ks) {
            const int co = ((ks * 2 + h) ^ swz) * 16;
            i64x2 fa[MI], fb[2];
#pragma unroll
            for (int mi = 0; mi < MI; ++mi) fa[mi] = *(const LAS i64x2*)(Ac + mi * 32 * 128 + co);
#pragma unroll
            for (int ni = 0; ni < 2; ++ni) fb[ni] = *(const LAS i64x2*)(Bc + ni * 32 * 128 + co);
#pragma unroll
            for (int mi = 0; mi < MI; ++mi)
#pragma unroll
                for (int ni = 0; ni < 2; ++ni) { acc[mi][ni] = __builtin_amdgcn_mfma_f32_32x32x16_fp8_fp8(fb[ni].x, fa[mi].x, acc[mi][ni], 0, 0, 0);
                    acc[mi][ni] = __builtin_amdgcn_mfma_f32_32x32x16_fp8_fp8(fb[ni].y, fa[mi].y, acc[mi][ni], 0, 0, 0); }
        }
        __builtin_amdgcn_s_setprio(0);
        asm volatile("s_waitcnt vmcnt(0)" ::: "memory");
        __syncthreads();
    }
#undef GEMM_STAGE
}
DI void gemm_mainloop(const bf16_t* __restrict__ A, int lda, const bf16_t* __restrict__ Bt, int ldb, int K,
                      f32x16 (&acc)[2][2], unsigned char* lds) { gemm_mainloop_t<2>(A, lda, Bt, ldb, K, acc, lds); }

template <int MI, class F> DI void epi_foreach_t(const f32x16 (&acc)[MI][2], F f) {
    const int tid = threadIdx.x, lane = tid & 63, wid = tid >> 6;
    const int wr = wid >> 1, wc = wid & 1, r = lane & 31, h = lane >> 5;
#pragma unroll
    for (int mi = 0; mi < MI; ++mi)
#pragma unroll
        for (int ni = 0; ni < 2; ++ni)
#pragma unroll
            for (int grp = 0; grp < 4; ++grp) {
                f32x4 v = {acc[mi][ni][4 * grp], acc[mi][ni][4 * grp + 1], acc[mi][ni][4 * grp + 2], acc[mi][ni][4 * grp + 3]};
                f(wr * 32 * MI + mi * 32 + r, wc * 64 + ni * 32 + 8 * grp + 4 * h, v);
            }
}
template <class F> DI void epi_foreach(const f32x16 (&acc)[2][2], F f) { epi_foreach_t<2>(acc, f); }

template <class S> DI void epi_stage_rows(const f32x16 (&acc)[2][2], unsigned char* lds, S colscale) {
    epi_foreach(acc, [&](int m, int n, f32x4 v) {
        const f32x4 s = colscale(n);
        u32x2 o = {pk2(v.x * s.x, v.y * s.y), pk2(v.z * s.z, v.w * s.w)};
        *(u32x2*)(lds + m * 272 + n * 2) = o;
    });
}
DI void epi_stage_cols(const f32x16 (&acc)[2][2], unsigned char* lds) {
    epi_foreach(acc, [&](int m, int n, f32x4 v) {
        *(bf16_t*)(lds + (n + 0) * 272 + m * 2) = (bf16_t)f2bf(v.x); *(bf16_t*)(lds + (n + 1) * 272 + m * 2) = (bf16_t)f2bf(v.y);
        *(bf16_t*)(lds + (n + 2) * 272 + m * 2) = (bf16_t)f2bf(v.z); *(bf16_t*)(lds + (n + 3) * 272 + m * 2) = (bf16_t)f2bf(v.w);
    });
}
template <class F> DI void rows_foreach(const unsigned char* lds, F f) {
    const int tid = threadIdx.x;
#pragma unroll
    for (int i = 0; i < 8; ++i) {
        const int c = tid + 256 * i, m = c >> 4, cc = c & 15;
        f(m, cc, *(const u32x4*)(lds + m * 272 + cc * 16));
    }
}

DI void cvt_rows(const float* __restrict__ src, bf16_t* __restrict__ dst, size_t n8, size_t gtid, size_t gstride) {
    for (size_t i = gtid; i < n8; i += gstride) {
        f32x4 a = ((const f32x4*)src)[2 * i], b = ((const f32x4*)src)[2 * i + 1];
        u32x4 o = {pk2(a.x, a.y), pk2(a.z, a.w), pk2(b.x, b.y), pk2(b.z, b.w)};
        ((u32x4*)dst)[i] = o;
    }
}
template <class F> DI void transpose_cvt(const float* __restrict__ in, int K, int Nin, bf16_t* __restrict__ out, int Nout, F src,
                                         size_t gtid, size_t gstride) {
    const size_t total = (size_t)Nout * (K / 8);
    for (size_t i = gtid; i < total; i += gstride) {
        const int n = (int)(i % Nout), k8 = (int)(i / Nout);
        const int s = src(n);
        float v[8];
#pragma unroll
        for (int j = 0; j < 8; ++j) v[j] = s >= 0 ? in[(size_t)(k8 * 8 + j) * Nin + s] : 0.f;
        u32x4 o = {pk2(v[0], v[1]), pk2(v[2], v[3]), pk2(v[4], v[5]), pk2(v[6], v[7])};
        *(u32x4*)(out + (size_t)n * K + k8 * 8) = o;
    }
}

DI void transpose_cvt_scaled(const float* __restrict__ in, int K, int N, bf16_t* __restrict__ out, const float* __restrict__ scale, size_t gtid, size_t gstride) {
    const size_t total = (size_t)N * (K / 8);
    for (size_t i = gtid; i < total; i += gstride) {
        const int n = (int)(i % N), k8 = (int)(i / N);
        float v[8];
#pragma unroll
        for (int j = 0; j < 8; ++j) v[j] = in[(size_t)(k8 * 8 + j) * N + n] * scale[k8 * 8 + j];
        u32x4 o = {pk2(v[0], v[1]), pk2(v[2], v[3]), pk2(v[4], v[5]), pk2(v[6], v[7])};
        *(u32x4*)(out + (size_t)n * K + k8 * 8) = o;
    }
}

DI void convert_tables(const Params& p) {
    unsigned char* ws = p.ws;
    const size_t gtid = (size_t)blockIdx.x * NTHREADS + threadIdx.x, gstride = (size_t)gridDim.x * NTHREADS;
    const int lane = threadIdx.x & 63, gw = (int)(gtid >> 6), ngw = (int)(gstride >> 6);
    {
        const int hw = lane >> 5, l32 = lane & 31;
        for (int rr = gw * 2 + hw; rr < 2 * 16384; rr += ngw * 2) {
            const int which = rr >> 14, row = rr & 16383;
            const float* src = (which ? p.in[17] : p.in[16]) + (size_t)row * 1024 + l32 * 16;
            f32x16 a, b;
            float am = 0.f;
#pragma unroll
            for (int j = 0; j < 4; ++j) {
                const f32x4 x = *(const f32x4*)(src + 4 * j), y = *(const f32x4*)(src + 512 + 4 * j);
                a[4 * j] = x.x; a[4 * j + 1] = x.y; a[4 * j + 2] = x.z; a[4 * j + 3] = x.w;
                b[4 * j] = y.x; b[4 * j + 1] = y.y; b[4 * j + 2] = y.z; b[4 * j + 3] = y.w;
                am = fmaxf(am, fmaxf(fmaxf(fabsf(x.x), fabsf(x.y)), fmaxf(fabsf(x.z), fabsf(x.w))));
                am = fmaxf(am, fmaxf(fmaxf(fabsf(y.x), fabsf(y.y)), fmaxf(fabsf(y.z), fabsf(y.w))));
            }
#pragma unroll
            for (int o = 16; o >= 1; o >>= 1) am = fmaxf(am, __shfl_xor(am, o));
            if (which) {
                const float s4 = am > 0.f ? 6.0f / am : 1.0f;
                u32x4 o = {0u, 0u, 0u, 0u};
#define PK4(dst, src, d, q) dst = __builtin_amdgcn_cvt_scalef32_pk_fp4_f32(dst, src[(d) * 8 + 2 * (q)] * s4, src[(d) * 8 + 2 * (q) + 1] * s4, 1.0f, q)
                PK4(o[0], a, 0, 0); PK4(o[0], a, 0, 1); PK4(o[0], a, 0, 2); PK4(o[0], a, 0, 3);
                PK4(o[1], a, 1, 0); PK4(o[1], a, 1, 1); PK4(o[1], a, 1, 2); PK4(o[1], a, 1, 3);
                PK4(o[2], b, 0, 0); PK4(o[2], b, 0, 1); PK4(o[2], b, 0, 2); PK4(o[2], b, 0, 3);
                PK4(o[3], b, 1, 0); PK4(o[3], b, 1, 1); PK4(o[3], b, 1, 2); PK4(o[3], b, 1, 3);
#undef PK4
                *(u32x4*)(ws + WS_VB + (size_t)row * 512 + l32 * 16) = o;
                if (l32 == 0) ((float*)(ws + WS_VSCALE))[row] = am > 0.f ? am / 6.0f : 1.0f;
                continue;
            }
            const float sc = am > 0.f ? 7.5f / am : 1.0f;
#pragma unroll
            for (int i = 0; i < 16; ++i) { a[i] *= sc; b[i] *= sc; }
            f32x16 a2, b2;
#pragma unroll
            for (int i = 0; i < 8; ++i) { a2[i] = a[2 * i]; b2[i] = a[2 * i + 1]; a2[8 + i] = b[2 * i]; b2[8 + i] = b[2 * i + 1]; }
            const u32x6 pk = __builtin_amdgcn_cvt_scalef32_2xpk16_fp6_f32(a2, b2, 1.0f);
            unsigned char* dst = ws + (which ? WS_VB : WS_UB) + (size_t)row * 768;
            *(u32x4*)(dst + l32 * 16) = (u32x4){pk[0], pk[1], pk[2], pk[3]};
            *(u32x2*)(dst + 512 + l32 * 8) = (u32x2){pk[4], pk[5]};
            if (l32 == 0) ((float*)(ws + (which ? WS_VSCALE : WS_USCALE)))[row] = am > 0.f ? am / 7.5f : 1.0f;
        }
    }
}

DI unsigned pk4_fp8(float a, float b, float c, float d) {
    int w = __builtin_amdgcn_cvt_pk_fp8_f32(a, b, 0, false);
    return (unsigned)__builtin_amdgcn_cvt_pk_fp8_f32(c, d, w, true);
}
DI void phase0(const Params& p, unsigned char* lds) {
    unsigned char* ws = p.ws;
    const size_t gtid = (size_t)blockIdx.x * NTHREADS + threadIdx.x, gstride = (size_t)gridDim.x * NTHREADS;
    for (int strip = blockIdx.x; strip < NINP / 16; strip += gridDim.x) {
        const int c = threadIdx.x & 15, kq = threadIdx.x >> 4, n = strip * 16 + c;
        const int s = n < 1280 ? n : (n < 1792 ? 1304 + (n - 1280) : (n < 1816 ? 1280 + (n - 1792) : -1));
        const float* w = p.in[1] + (size_t)(kq * 64) * 1816 + (s >= 0 ? s : 0);
        float v[64];
        float am = 0.f;
#pragma unroll
        for (int j = 0; j < 64; ++j) { v[j] = s >= 0 ? w[(size_t)j * 1816] : 0.f; am = fmaxf(am, fabsf(v[j])); }
        float* red = (float*)lds;
        red[kq * 16 + c] = am;
        __syncthreads();
        float cm = 0.f;
#pragma unroll
        for (int q = 0; q < 16; ++q) cm = fmaxf(cm, red[q * 16 + c]);
        __syncthreads();
        const float sc = cm > 0.f ? 448.0f / cm : 1.0f;
        unsigned char* dst = ws + WS_WINT + (size_t)n * 1024 + kq * 64;
#pragma unroll
        for (int q = 0; q < 4; ++q) {
            u32x4 o;
#pragma unroll
            for (int d = 0; d < 4; ++d) o[d] = pk4_fp8(v[q * 16 + d * 4] * sc, v[q * 16 + d * 4 + 1] * sc, v[q * 16 + d * 4 + 2] * sc, v[q * 16 + d * 4 + 3] * sc);
            *(u32x4*)(dst + q * 16) = o;
        }
        if (kq == 0) ((float*)(ws + WS_SW))[n] = cm > 0.f ? cm / 448.0f : 1.0f;
    }
    {
        const int lane = threadIdx.x & 63, gw = (int)(gtid >> 6), ngw = (int)(gstride >> 6);
        for (int row = gw; row < NTOK; row += ngw) {
            const f32x4* src = (const f32x4*)(p.in[0] + (size_t)row * 1024) + lane * 4;
            f32x4 v[4];
            float am = 0.f;
#pragma unroll
            for (int j = 0; j < 4; ++j) { v[j] = src[j]; am = fmaxf(am, fmaxf(fmaxf(fabsf(v[j].x), fabsf(v[j].y)), fmaxf(fabsf(v[j].z), fabsf(v[j].w)))); }
#pragma unroll
            for (int o = 32; o >= 1; o >>= 1) am = fmaxf(am, __shfl_xor(am, o));
            const float sc = am > 0.f ? 448.0f / am : 1.0f;
            u32x4 o4;
#pragma unroll
            for (int j = 0; j < 4; ++j) o4[j] = pk4_fp8(v[j].x * sc, v[j].y * sc, v[j].z * sc, v[j].w * sc);
            *(u32x4*)(ws + WS_XB + (size_t)row * 1024 + lane * 16) = o4;
            if (lane == 0) ((float*)(ws + WS_SX))[row] = am > 0.f ? am / 448.0f : 1.0f;
        }
    }
    cvt_rows(p.in[15], (bf16_t*)(ws + WS_SUBK), (size_t)2 * 128 * 128 / 8, gtid, gstride);
    transpose_cvt(p.in[11], 1024, 1024, (bf16_t*)(ws + WS_WOUTT), 1024, [](int n) { return n; }, gtid, gstride);
    transpose_cvt_scaled(p.in[14], 1024, 2048, (bf16_t*)(ws + WS_WQT), p.in[12], gtid, gstride);
    transpose_cvt(p.in[5], 2048, 256, (bf16_t*)(ws + WS_W1TK), 256, [](int n) { return n; }, gtid, gstride);
    transpose_cvt(p.in[7], 2048, 256, (bf16_t*)(ws + WS_W1TV), 256, [](int n) { return n; }, gtid, gstride);
    transpose_cvt(p.in[6], 256, 64, (bf16_t*)(ws + WS_W2TK), 64, [](int n) { return n; }, gtid, gstride);
    transpose_cvt(p.in[8], 256, 64, (bf16_t*)(ws + WS_W2TV), 64, [](int n) { return n; }, gtid, gstride);
    for (int g = 0; g < 4; ++g)
        transpose_cvt(p.in[9] + g * 16384, 128, 128, (bf16_t*)(ws + WS_POOLWT) + g * 16384, 128, [](int n) { return n; }, gtid, gstride);
    {
        float* z = (float*)(ws + WS_KCMP);
        for (size_t i = gtid; i < (size_t)2 * 8 * 256 * 64; i += gstride) z[i] = 0.f;
    }
    {
        const int lane = threadIdx.x & 63, gw = (int)(gtid >> 6), ngw = (int)(gstride >> 6);
        for (int o = gw; o < 512; o += ngw) {
            const int which = o >> 8, j = o & 255;
            const float* pe = which ? p.in[4] : p.in[3];
            const float* w1 = which ? p.in[7] : p.in[5];
            float s = 0.f;
#pragma unroll 8
            for (int i = lane; i < 2048; i += 64) s += pe[i] * w1[(size_t)i * 256 + j];
            s = wave_sum(s);
            if (lane == 0) ((float*)(ws + (which ? WS_PEBV : WS_PEBK)))[j] = s;
        }
    }
    if (gtid >= 512 && gtid < 768) {
        const int d = (int)(gtid - 512);
        ((int*)(ws + WS_BUCK))[d] = rel_bucket_dev(d);
    }
}

DI int cu_pair_pos(int j, int G8) { const int hlf = (G8 + 1) >> 1; return (G8 & 1) ? j : (((j % hlf) << 1) | (j / hlf)); }

DI void phase1(const Params& p, unsigned char* lds) {
    unsigned char* ws = p.ws;
    const unsigned char* xb = ws + WS_XB;
    const unsigned char* wt = ws + WS_WINT;
    const float* sx = (const float*)(ws + WS_SX);
    const float* sw = (const float*)(ws + WS_SW);
    const int ntiles = 128 * 15;
    const int G8 = (gridDim.x & 7) == 0 ? gridDim.x >> 3 : 0;
    for (int l0 = G8 ? 0 : (int)blockIdx.x; l0 < (G8 ? ntiles / 8 : ntiles); l0 += (G8 ? G8 : (int)gridDim.x)) {
        const int li = G8 ? l0 + cu_pair_pos((int)(blockIdx.x >> 3), G8) : l0;
        if (G8 && li >= ntiles / 8) break;
        const int tile = G8 ? (int)(blockIdx.x & 7) * (ntiles / 8) + li : li;
        const int tn = tile % 15, tm = tile / 15;
        f32x16 acc[2][2];
        gemm_mainloop_f8(xb + (size_t)tm * 128 * DM, DM, wt + (size_t)tn * 128 * DM, DM, DM, acc, lds);
        const int m0 = tm * 128;
        {
            const int lane = threadIdx.x & 63, wid = threadIdx.x >> 6, wr = wid >> 1, wc = wid & 1, r = lane & 31, h = lane >> 5;
            const float sx0 = sx[m0 + wr * 64 + r], sx1 = sx[m0 + wr * 64 + 32 + r];
#pragma unroll
            for (int ni = 0; ni < 2; ++ni)
#pragma unroll
                for (int grp = 0; grp < 4; ++grp) {
                    const f32x4 s4 = *(const f32x4*)(sw + tn * 128 + wc * 64 + ni * 32 + 8 * grp + 4 * h);
#pragma unroll
                    for (int e2 = 0; e2 < 4; ++e2) { acc[0][ni][4 * grp + e2] *= sx0 * s4[e2]; acc[1][ni][4 * grp + e2] *= sx1 * s4[e2]; }
                }
        }
        if (tn < 14) {
            const bool tr = (tn == 7 || tn == 9);
            const float qs = tn < 4 ? QSCALE : 1.0f;
            if (tr) epi_stage_cols(acc, lds);
            else epi_stage_rows(acc, lds, [&](int) { return (f32x4){qs, qs, qs, qs}; });
            __syncthreads();
            const int bq = m0 >> 12, t0q = m0 & 4095;
            if (tn < 4) {
                bf16_t* Q = (bf16_t*)(ws + WS_Q);
                rows_foreach(lds, [&](int m, int cc, u32x4 d) {
                    const int hd = tn * 2 + (cc >> 3);
                    *(u32x4*)(Q + (((size_t)(bq * 8 + hd) * SEQ + t0q + m) * 64 + (cc & 7) * 8)) = d;
                });
            } else if (tr) {
                bf16_t* dst = (bf16_t*)(ws + (tn == 7 ? WS_VSLCT : WS_VWINT));
                rows_foreach(lds, [&](int n, int cc, u32x4 d) {
                    *(u32x4*)(dst + ((size_t)((bq * 2 + (n >> 6)) * 64 + (n & 63)) * SEQ + t0q + cc * 8)) = d;
                });
            } else if (tn < 10) {
                bf16_t* dst = (bf16_t*)(ws + (tn == 4 ? WS_KC : tn == 5 ? WS_VC : tn == 6 ? WS_KSLC : WS_KWIN));
                rows_foreach(lds, [&](int m, int cc, u32x4 d) {
                    *(u32x4*)(dst + (((size_t)(bq * 2 + (cc >> 3)) * SEQ + t0q + m) * 64 + (cc & 7) * 8)) = d;
                });
            } else {
                bf16_t* dst = (bf16_t*)(ws + WS_Z);
                rows_foreach(lds, [&](int m, int cc, u32x4 d) {
                    *(u32x4*)(dst + ((size_t)(m0 + m) * 512 + (tn - 10) * 128 + cc * 8)) = d;
                });
            }
            __syncthreads();
        } else {
            float* dst = (float*)(ws + WS_GATES);
            epi_foreach(acc, [&](int m, int n, f32x4 v) {
                if (n < 24) {
                    f32x4 o = {1.f / (1.f + __expf(-v.x)), 1.f / (1.f + __expf(-v.y)), 1.f / (1.f + __expf(-v.z)), 1.f / (1.f + __expf(-v.w))};
                    *(f32x4*)(dst + (size_t)(m0 + m) * 24 + n) = o;
                }
            });
        }
    }
}

DI void compress_job(const Params& p, unsigned char* lds, int cj) {
    unsigned char* ws = p.ws;
    const int kv = cj >> 6, bg = (cj >> 3) & 7, rq = (cj >> 1) & 3, hh = cj & 1;
    const bf16_t* A = (const bf16_t*)(ws + (kv ? WS_VC : WS_KC)) + ((size_t)bg * SEQ + (size_t)rq * 64 * 16) * 64;
    const bf16_t* Bt = (const bf16_t*)(ws + (kv ? WS_W1TV : WS_W1TK)) + (size_t)hh * 128 * 2048;
    const float* peb = (const float*)(ws + (kv ? WS_PEBV : WS_PEBK)) + hh * 128;
    const bf16_t* w2t = (const bf16_t*)(ws + (kv ? WS_W2TV : WS_W2TK));
    float* dst = (float*)(ws + (kv ? WS_VCMP : WS_KCMP)) + (size_t)bg * 256 * 64;
    f32x16 acc[1][2];
    gemm_mainloop_t<1>(A, 1024, Bt, 2048, 2048, acc, lds);
    epi_foreach_t<1>(acc, [&](int m, int n, f32x4 v) {
        f32x4 bb = *(const f32x4*)(peb + n);
        u32x2 o = {pk2(gelu_erf(v.x + bb.x), gelu_erf(v.y + bb.y)), pk2(gelu_erf(v.z + bb.z), gelu_erf(v.w + bb.w))};
        *(u32x2*)(lds + m * 272 + n * 2) = o;
    });
    __syncthreads();
    const int tid = threadIdx.x, lane = tid & 63, wid = tid >> 6, r = lane & 31, h = lane >> 5;
    const int wr2 = wid >> 1, wd = wid & 1;
    f32x16 a2;
#pragma unroll
    for (int i = 0; i < 16; ++i) a2[i] = 0.f;
#pragma unroll
    for (int ks = 0; ks < 8; ++ks) {
        bf16x8 fb = *(const bf16x8*)(lds + (wr2 * 32 + r) * 272 + ks * 32 + h * 16);
        bf16x8 fa = *(const bf16x8*)(w2t + (size_t)(wd * 32 + r) * 256 + hh * 128 + ks * 16 + h * 8);
        a2 = MFMA32(fa, fb, a2);
    }
    const int row = rq * 64 + wr2 * 32 + r;
    if (row < 255) {
#pragma unroll
        for (int i = 0; i < 16; ++i) {
            const int d = wd * 32 + (i & 3) + 8 * (i >> 2) + 4 * h;
            atomicAdd(dst + (size_t)row * 64 + d, a2[i]);
        }
    }
    __syncthreads();
}

constexpr int AT_K0 = 0, AT_V0 = 18432, AT_TB = 36864, AT_IMP = 40960, AT_SEL = 49152;

DI void attn_stage_load(const bf16_t* __restrict__ Kg, const bf16_t* __restrict__ Vtg, u32x4 (&st)[4], int tid) {
#pragma unroll
    for (int i = 0; i < 2; ++i) {
        const int c = tid + 256 * i, row = c >> 3, cc = c & 7;
        st[i] = *(const u32x4*)(Kg + (size_t)row * 64 + cc * 8);
        st[2 + i] = *(const u32x4*)(Vtg + (size_t)row * SEQ + cc * 8);
    }
}
DI void attn_stage_store(unsigned char* Kl, unsigned char* Vl, const u32x4 (&st)[4], int tid) {
#pragma unroll
    for (int i = 0; i < 2; ++i) {
        const int c = tid + 256 * i, row = c >> 3, cc = c & 7;
        *(u32x4*)(Kl + row * ROWB + cc * 16) = st[i];
        *(u32x4*)(Vl + row * ROWB + cc * 16) = st[2 + i];
    }
}
DI void attn_scores(const unsigned char* Kl, const bf16x8 (&qf)[4], f32x16 (&X)[2], int r, int h) {
#pragma unroll
    for (int i = 0; i < 16; ++i) { X[0][i] = 0.f; X[1][i] = 0.f; }
#pragma unroll
    for (int ks = 0; ks < 4; ++ks)
#pragma unroll
        for (int kb = 0; kb < 2; ++kb) {
            bf16x8 a = *(const bf16x8*)(Kl + (kb * 32 + r) * ROWB + ks * 32 + h * 16);
            X[kb] = MFMA32(a, qf[ks], X[kb]);
        }
}
DI void attn_pv(const unsigned char* Vl, const f32x16 (&P)[2], f32x16 (&O)[2], int r, int h) {
#pragma unroll
    for (int kb = 0; kb < 2; ++kb)
#pragma unroll
        for (int s = 0; s < 2; ++s) {
            u32x4 pw = {pk2(P[kb][8 * s], P[kb][8 * s + 1]), pk2(P[kb][8 * s + 2], P[kb][8 * s + 3]),
                        pk2(P[kb][8 * s + 4], P[kb][8 * s + 5]), pk2(P[kb][8 * s + 6], P[kb][8 * s + 7])};
            bf16x8 pb = __builtin_bit_cast(bf16x8, pw);
#pragma unroll
            for (int db = 0; db < 2; ++db) {
                const unsigned char* q = Vl + (db * 32 + r) * ROWB + (kb * 32 + 16 * s + 4 * h) * 2;
                s16x4 lo = *(const s16x4*)q, hi = *(const s16x4*)(q + 16);
                bf16x8 a = __builtin_shufflevector(lo, hi, 0, 1, 2, 3, 4, 5, 6, 7);
                O[db] = MFMA32(a, pb, O[db]);
            }
        }
}
DI void softmax_update(f32x16 (&X)[2], float& m, float& l, f32x16 (&O)[2]) {
    float mloc = -1e30f;
#pragma unroll
    for (int kb = 0; kb < 2; ++kb)
#pragma unroll
        for (int i = 0; i < 16; ++i) mloc = fmaxf(mloc, X[kb][i]);
    mloc = fmaxf(mloc, __shfl_xor(mloc, 32));
    const float mnew = fmaxf(m, mloc);
    const float alpha = __builtin_amdgcn_exp2f(m - mnew);
    m = mnew;
    float ls = 0.f;
#pragma unroll
    for (int kb = 0; kb < 2; ++kb)
#pragma unroll
        for (int i = 0; i < 16; ++i) {
            const float x = X[kb][i];
            const float pv = x > -1e29f ? __builtin_amdgcn_exp2f(x - mnew) : 0.f;
            X[kb][i] = pv; ls += pv;
        }
    l = l * alpha + ls;
#pragma unroll
    for (int db = 0; db < 2; ++db)
#pragma unroll
        for (int i = 0; i < 16; ++i) O[db][i] *= alpha;
}
DI void softmax_far(f32x16 (&X)[2], float cb, float& m, float& l, f32x16 (&O)[2]) {
    float mloc = -3e38f;
#pragma unroll
    for (int kb = 0; kb < 2; ++kb)
#pragma unroll
        for (int i = 0; i < 16; ++i) mloc = fmaxf(mloc, X[kb][i]);
    mloc += cb;
    mloc = fmaxf(mloc, __shfl_xor(mloc, 32));
    const float mnew = fmaxf(m, mloc);
    if (__any(mnew > m)) {
        const float alpha = __builtin_amdgcn_exp2f(m - mnew);
        m = mnew; l *= alpha;
#pragma unroll
        for (int db = 0; db < 2; ++db)
#pragma unroll
            for (int i = 0; i < 16; ++i) O[db][i] *= alpha;
    }
    const float mc = m - cb;
    f32x2 ls = {0.f, 0.f};
#pragma unroll
    for (int kb = 0; kb < 2; ++kb)
#pragma unroll
        for (int i = 0; i < 16; i += 2) {
            f32x2 pv = {__builtin_amdgcn_exp2f(X[kb][i] - mc), __builtin_amdgcn_exp2f(X[kb][i + 1] - mc)};
            X[kb][i] = pv.x; X[kb][i + 1] = pv.y; ls += pv;
        }
    l += ls.x + ls.y;
}
DI void build_bias_table(const Params& p, unsigned char* lds, int g) {
    const int* buck = (const int*)(p.ws + WS_BUCK);
    float* tb = (float*)(lds + AT_TB);
    for (int i = threadIdx.x; i < 1024; i += NTHREADS) {
        const int hl = i >> 8, d = i & 255;
        tb[i] = p.in[2][buck[d] * 8 + g * 4 + hl] * LOG2E;
    }
}

DI void win_unit(const Params& p, unsigned char* lds, int u) {
    unsigned char* ws = p.ws;
    const int tid = threadIdx.x, lane = tid & 63, wid = tid >> 6, r = lane & 31, h = lane >> 5;
    const int bg = u & 7, t32 = u >> 3, b = bg >> 1, g = bg & 1, t0 = t32 * 32;
    const int hl = r >> 3, t = t0 + wid * 8 + (r & 7);
    const bf16_t* Kg = (const bf16_t*)(ws + WS_KWIN) + (size_t)bg * SEQ * 64;
    const bf16_t* Vtg = (const bf16_t*)(ws + WS_VWINT) + (size_t)bg * 64 * SEQ;
    const bf16_t* Qg = (const bf16_t*)(ws + WS_Q) + ((size_t)(b * 8 + g * 4 + hl) * SEQ + t) * 64;
    __syncthreads();
    build_bias_table(p, lds, g);
    bf16x8 qf[4];
#pragma unroll
    for (int ks = 0; ks < 4; ++ks) qf[ks] = *(const bf16x8*)(Qg + ks * 16 + h * 8);
    const int jlo = t0 < 511 ? 0 : ((t0 - 511) >> 6), jhi = t0 >> 6;
    u32x4 st[4];
    attn_stage_load(Kg + (size_t)jlo * 64 * 64, Vtg + jlo * 64, st, tid);
    attn_stage_store(lds + AT_K0, lds + AT_V0, st, tid);
    __syncthreads();
    const float* tb = (const float*)(lds + AT_TB) + hl * 256;
    const int tmin = t0 + wid * 8;
    float m = -1e30f, l = 0.f;
    f32x16 O[2];
#pragma unroll
    for (int i = 0; i < 16; ++i) { O[0][i] = 0.f; O[1][i] = 0.f; }
    for (int j = jlo; j <= jhi; ++j) {
        const int cur = (j - jlo) & 1;
        if (j < jhi) attn_stage_load(Kg + (size_t)(j + 1) * 64 * 64, Vtg + (j + 1) * 64, st, tid);
        const unsigned char* Kl = lds + AT_K0 + cur * 9216;
        const unsigned char* Vl = lds + AT_V0 + cur * 9216;
        f32x16 X[2];
        attn_scores(Kl, qf, X, r, h);
        const bool far = (tmin - (j * 64 + 63) >= 128) && (tmin + 7 - j * 64 < 512);
        if (far) {
            softmax_far(X, tb[255], m, l, O);
        } else {
#pragma unroll
            for (int kb = 0; kb < 2; ++kb)
#pragma unroll
                for (int i = 0; i < 16; ++i) {
                    const int pos = j * 64 + kb * 32 + (i & 3) + 8 * (i >> 2) + 4 * h;
                    const int dist = t - pos;
                    const bool valid = dist >= 0 && dist < 512;
                    const int di = dist < 0 ? 0 : (dist > 255 ? 255 : dist);
                    X[kb][i] = valid ? X[kb][i] + tb[di] : -1e30f;
                }
            softmax_update(X, m, l, O);
        }
        attn_pv(Vl, X, O, r, h);
        if (j < jhi) attn_stage_store(lds + AT_K0 + (cur ^ 1) * 9216, lds + AT_V0 + (cur ^ 1) * 9216, st, tid);
        __syncthreads();
    }
    const float lt = l + __shfl_xor(l, 32);
    const size_t tok = (size_t)b * SEQ + t;
    const float gate = ((const float*)(ws + WS_GATES))[tok * 24 + 16 + g * 4 + hl];
    const float sc = gate / lt;
    bf16_t* ow = (bf16_t*)(ws + WS_OWIN) + tok * 512 + (g * 4 + hl) * 64;
#pragma unroll
    for (int db = 0; db < 2; ++db)
#pragma unroll
        for (int grp = 0; grp < 4; ++grp) {
            u32x2 o = {pk2(O[db][4 * grp] * sc, O[db][4 * grp + 1] * sc), pk2(O[db][4 * grp + 2] * sc, O[db][4 * grp + 3] * sc)};
            *(u32x2*)(ow + db * 32 + 8 * grp + 4 * h) = o;
        }
}

DI void cmp_load(const float* __restrict__ kc, const float* __restrict__ vc, int ct, bool withv, int tid, f32x4 (&kr)[4], f32x4 (&vr)[4]) {
    {
        const int c = tid >> 2, part = tid & 3;
        const f32x4* src = (const f32x4*)(kc + (size_t)(ct * 64 + c) * 64 + part * 16);
        kr[0] = src[0]; kr[1] = src[1]; kr[2] = src[2]; kr[3] = src[3];
    }
    if (withv) {
        const int c = tid & 63, dg = tid >> 6;
        const f32x4* src = (const f32x4*)(vc + (size_t)(ct * 64 + c) * 64 + dg * 16);
        vr[0] = src[0]; vr[1] = src[1]; vr[2] = src[2]; vr[3] = src[3];
    }
}
DI void cmp_store(unsigned char* Kl, unsigned char* Vl, bool withv, int tid, const f32x4 (&kr)[4], const f32x4 (&vr)[4]) {
    {
        const int c = tid >> 2, part = tid & 3;
        u32x4 o0 = {pk2(kr[0].x, kr[0].y), pk2(kr[0].z, kr[0].w), pk2(kr[1].x, kr[1].y), pk2(kr[1].z, kr[1].w)};
        u32x4 o1 = {pk2(kr[2].x, kr[2].y), pk2(kr[2].z, kr[2].w), pk2(kr[3].x, kr[3].y), pk2(kr[3].z, kr[3].w)};
        *(u32x4*)(Kl + c * ROWB + part * 32) = o0;
        *(u32x4*)(Kl + c * ROWB + part * 32 + 16) = o1;
    }
    if (withv) {
        const int c = tid & 63, dg = tid >> 6;
#pragma unroll
        for (int q4 = 0; q4 < 4; ++q4) {
            const int d = dg * 16 + q4 * 4;
            *(bf16_t*)(Vl + (d + 0) * ROWB + c * 2) = (bf16_t)f2bf(vr[q4].x);
            *(bf16_t*)(Vl + (d + 1) * ROWB + c * 2) = (bf16_t)f2bf(vr[q4].y);
            *(bf16_t*)(Vl + (d + 2) * ROWB + c * 2) = (bf16_t)f2bf(vr[q4].z);
            *(bf16_t*)(Vl + (d + 3) * ROWB + c * 2) = (bf16_t)f2bf(vr[q4].w);
        }
    }
}

DI void slc_unit(const Params& p, unsigned char* lds, int u) {
    unsigned char* ws = p.ws;
    const int tid = threadIdx.x, lane = tid & 63, wid = tid >> 6, r = lane & 31, h = lane >> 5;
    const int bg = u & 7, t32 = u >> 3, b = bg >> 1, g = bg & 1, t0 = t32 * 32;
    const int hl = r >> 3, tokl = r & 7, t = t0 + wid * 8 + tokl;
    const bf16_t* Kg = (const bf16_t*)(ws + WS_KSLC) + (size_t)bg * SEQ * 64;
    const bf16_t* Vtg = (const bf16_t*)(ws + WS_VSLCT) + (size_t)bg * 64 * SEQ;
    const bf16_t* Qg = (const bf16_t*)(ws + WS_Q) + ((size_t)(b * 8 + g * 4 + hl) * SEQ + t) * 64;
    const float* kcmp = (const float*)(ws + WS_KCMP) + (size_t)bg * 256 * 64;
    const float* vcmp = (const float*)(ws + WS_VCMP) + (size_t)bg * 256 * 64;
    __syncthreads();
    build_bias_table(p, lds, g);
    unsigned* imp = (unsigned*)(lds + AT_IMP) + wid * 512;
#pragma unroll
    for (int i = 0; i < 8; ++i) imp[i * 64 + lane] = 0u;
    bf16x8 qf[4];
#pragma unroll
    for (int ks = 0; ks < 4; ++ks) qf[ks] = *(const bf16x8*)(Qg + ks * 16 + h * 8);
    const float* tb = (const float*)(lds + AT_TB) + hl * 256;
    const int cmax = t0 >> 4;
    const int nct = (t0 + 31 >= 31) ? (cmax >> 6) + 1 : 0;
    float m = -1e30f, l = 0.f;
    f32x16 Oc[2];
#pragma unroll
    for (int i = 0; i < 16; ++i) { Oc[0][i] = 0.f; Oc[1][i] = 0.f; }
    {
        f32x4 kr[4], vr[4];
        cmp_load(kcmp, vcmp, 0, false, tid, kr, vr);
        cmp_store(lds + AT_K0, lds + AT_V0, false, tid, kr, vr);
        __syncthreads();
#pragma unroll 1
        for (int ct = 0; ct < nct; ++ct) {
            const bool last = ct + 1 == nct;
            cmp_load(kcmp, vcmp, last ? 0 : ct + 1, last, tid, kr, vr);
            f32x16 X[2];
            attn_scores(lds + AT_K0 + (ct & 1) * 9216, qf, X, r, h);
            f32x16 dummy[2];
#pragma unroll
            for (int i = 0; i < 16; ++i) { dummy[0][i] = 0.f; dummy[1][i] = 0.f; }
            const bool farc = ct < 3 && (t0 + wid * 8 - (16 * (ct * 64 + 63) + 31) >= 128);
            if (farc) {
                softmax_far(X, tb[255], m, l, dummy);
            } else {
#pragma unroll
                for (int kb = 0; kb < 2; ++kb)
#pragma unroll
                    for (int i = 0; i < 16; ++i) {
                        const int c = ct * 64 + kb * 32 + (i & 3) + 8 * (i >> 2) + 4 * h;
                        const int dist = t - (16 * c + 31);
                        const bool valid = dist >= 0 && c < 255;
                        const int di = dist < 0 ? 0 : (dist > 255 ? 255 : dist);
                        X[kb][i] = valid ? X[kb][i] + tb[di] : -1e30f;
                    }
                softmax_update(X, m, l, dummy);
            }
            cmp_store(lds + AT_K0 + ((ct + 1) & 1) * 9216, lds + AT_V0 + ((ct + 1) & 1) * 9216, last, tid, kr, vr);
            __syncthreads();
        }
        const float lt = l + __shfl_xor(l, 32);
        const float invl = lt > 0.f ? 1.0f / lt : 0.f;
#pragma unroll 1
        for (int ct = 0; ct < nct; ++ct) {
            const int bsel = (nct + ct) & 1;
            const bool more = ct + 1 < nct;
            if (more) cmp_load(kcmp, vcmp, ct + 1, true, tid, kr, vr);
            f32x16 X[2];
            attn_scores(lds + AT_K0 + bsel * 9216, qf, X, r, h);
            const bool farc = ct < 3 && (t0 + wid * 8 - (16 * (ct * 64 + 63) + 31) >= 128);
            if (farc) {
                const float mc = m - tb[255];
#pragma unroll
                for (int kb = 0; kb < 2; ++kb)
#pragma unroll
                    for (int i = 0; i < 16; ++i) X[kb][i] = __builtin_amdgcn_exp2f(X[kb][i] - mc) * invl;
            } else {
#pragma unroll
                for (int kb = 0; kb < 2; ++kb)
#pragma unroll
                    for (int i = 0; i < 16; ++i) {
                        const int c = ct * 64 + kb * 32 + (i & 3) + 8 * (i >> 2) + 4 * h;
                        const int dist = t - (16 * c + 31);
                        const bool valid = dist >= 0 && c < 255;
                        const int di = dist < 0 ? 0 : (dist > 255 ? 255 : dist);
                        X[kb][i] = valid ? __builtin_amdgcn_exp2f(X[kb][i] + tb[di] - m) * invl : 0.f;
                    }
            }
#pragma unroll
            for (int kb = 0; kb < 2; ++kb)
#pragma unroll
                for (int grp = 0; grp < 4; ++grp) {
                    const float s4 = (X[kb][4 * grp] + X[kb][4 * grp + 1]) + (X[kb][4 * grp + 2] + X[kb][4 * grp + 3]);
                    const int jj = ct * 16 + kb * 8 + 2 * grp + h;
                    atomicAdd(&imp[tokl * 64 + jj], (unsigned)(s4 * 67108864.0f + 0.5f));
                    if (jj + 1 < 64) atomicAdd(&imp[tokl * 64 + jj + 1], (unsigned)(X[kb][4 * grp + 3] * 67108864.0f + 0.5f));
                }
            attn_pv(lds + AT_V0 + bsel * 9216, X, Oc, r, h);
            if (more) cmp_store(lds + AT_K0 + (bsel ^ 1) * 9216, lds + AT_V0 + (bsel ^ 1) * 9216, true, tid, kr, vr);
            __syncthreads();
        }
    }
    unsigned long long* selm = (unsigned long long*)(lds + AT_SEL) + wid * 8;
    for (int tk = 0; tk < 8; ++tk) {
        const int tt = t0 + wid * 8 + tk, curb = tt >> 6;
        int v = (int)imp[tk * 64 + lane];
        if (lane == 0 || lane == curb || lane == curb - 1) v = 0x7fffffff;
        if (lane > curb) v = -1;
        int cnt = 0;
#pragma unroll
        for (int k = 0; k < 64; ++k) {
            const int vk = __builtin_amdgcn_readlane(v, k);
            cnt += (vk > v || (vk == v && k < lane)) ? 1 : 0;
        }
        const unsigned long long mk = __ballot(cnt < 16);
        if (lane == 0) selm[tk] = mk;
    }
    const unsigned long long mysel = selm[tokl];
    __syncthreads();
    const int jhi = t0 >> 6;
    u32x4 st[4];
    attn_stage_load(Kg, Vtg, st, tid);
    attn_stage_store(lds + AT_K0, lds + AT_V0, st, tid);
    __syncthreads();
    float m2 = -1e30f, l2 = 0.f;
    const int tmin = t0 + wid * 8;
    f32x16 O[2];
#pragma unroll
    for (int i = 0; i < 16; ++i) { O[0][i] = 0.f; O[1][i] = 0.f; }
    for (int j = 0; j <= jhi; ++j) {
        const int cur = j & 1;
        if (j < jhi) attn_stage_load(Kg + (size_t)(j + 1) * 64 * 64, Vtg + (j + 1) * 64, st, tid);
        const unsigned char* Kl = lds + AT_K0 + cur * 9216;
        const unsigned char* Vl = lds + AT_V0 + cur * 9216;
        f32x16 X[2];
        attn_scores(Kl, qf, X, r, h);
        const bool selj = (mysel >> j) & 1ull;
        if (tmin - (j * 64 + 63) >= 128) {
            softmax_far(X, selj ? tb[255] : -1e30f, m2, l2, O);
        } else {
#pragma unroll
            for (int kb = 0; kb < 2; ++kb)
#pragma unroll
                for (int i = 0; i < 16; ++i) {
                    const int pos = j * 64 + kb * 32 + (i & 3) + 8 * (i >> 2) + 4 * h;
                    const int dist = t - pos;
                    const bool valid = dist >= 0 && selj;
                    const int di = dist < 0 ? 0 : (dist > 255 ? 255 : dist);
                    X[kb][i] = valid ? X[kb][i] + tb[di] : -1e30f;
                }
            softmax_update(X, m2, l2, O);
        }
        attn_pv(Vl, X, O, r, h);
        if (j < jhi) attn_stage_store(lds + AT_K0 + (cur ^ 1) * 9216, lds + AT_V0 + (cur ^ 1) * 9216, st, tid);
        __syncthreads();
    }
    const float lt2 = l2 + __shfl_xor(l2, 32);
    const size_t tok = (size_t)b * SEQ + t;
    const float* gt = (const float*)(ws + WS_GATES) + tok * 24;
    const float gc = gt[g * 4 + hl], gs = gt[8 + g * 4 + hl] / lt2;
    const bf16_t* ow = (const bf16_t*)(ws + WS_OWIN) + tok * 512 + (g * 4 + hl) * 64;
    bf16_t* mx = (bf16_t*)(ws + WS_MIXIN) + tok * 1024 + (g * 4 + hl) * 64;
#pragma unroll
    for (int db = 0; db < 2; ++db)
#pragma unroll
        for (int grp = 0; grp < 4; ++grp) {
            const int d = db * 32 + 8 * grp + 4 * h;
            const u32x2 w = *(const u32x2*)(ow + d);
            const float r0 = gc * Oc[db][4 * grp] + gs * O[db][4 * grp] + bflo(w.x);
            const float r1 = gc * Oc[db][4 * grp + 1] + gs * O[db][4 * grp + 1] + bfhi(w.x);
            const float r2 = gc * Oc[db][4 * grp + 2] + gs * O[db][4 * grp + 2] + bflo(w.y);
            const float r3 = gc * Oc[db][4 * grp + 3] + gs * O[db][4 * grp + 3] + bfhi(w.y);
            u32x2 o = {pk2(r0, r1), pk2(r2, r3)};
            *(u32x2*)(mx + d) = o;
        }
}

DI void pooly_job(const Params& p, int job) {
    unsigned char* ws = p.ws;
    const bf16_t* z = (const bf16_t*)(ws + WS_Z);
    bf16_t* y = (bf16_t*)(ws + WS_YPOOL);
    const int tid = threadIdx.x;
    const int tokb = job * 16 + (tid >> 6) * 4, ch = tid & 63, tb = tokb & 4095;
    const int gi = ch >> 4, win = 2 << gi;
    u32x4 rowv[19];
#pragma unroll
    for (int i = 0; i < 19; ++i) {
        const int dt = i - 15;
        const bool need = dt > -win && tb + dt >= 0;
        rowv[i] = *(const u32x4*)(z + (size_t)(need ? tokb + dt : tokb) * 512 + ch * 8);
    }
    float f[19][8];
#pragma unroll
    for (int i = 0; i < 19; ++i) {
        f[i][0] = bflo(rowv[i].x); f[i][1] = bfhi(rowv[i].x); f[i][2] = bflo(rowv[i].y); f[i][3] = bfhi(rowv[i].y);
        f[i][4] = bflo(rowv[i].z); f[i][5] = bfhi(rowv[i].z); f[i][6] = bflo(rowv[i].w); f[i][7] = bfhi(rowv[i].w);
    }
#pragma unroll
    for (int o = 0; o < 4; ++o) {
        const int t = tb + o;
        const int cnt = (t + 1 < win) ? t + 1 : win;
        float s[8];
#pragma unroll
        for (int c = 0; c < 8; ++c) s[c] = 0.f;
#pragma unroll
        for (int k = 0; k < 16; ++k) {
            const float wk = k < cnt ? 1.0f : 0.0f;
#pragma unroll
            for (int c = 0; c < 8; ++c) s[c] += wk * f[15 + o - k][c];
        }
        const float ic = 1.0f / (float)cnt;
        u32x4 ov = {pk2(s[0] * ic - f[15 + o][0], s[1] * ic - f[15 + o][1]), pk2(s[2] * ic - f[15 + o][2], s[3] * ic - f[15 + o][3]),
                    pk2(s[4] * ic - f[15 + o][4], s[5] * ic - f[15 + o][5]), pk2(s[6] * ic - f[15 + o][6], s[7] * ic - f[15 + o][7])};
        *(u32x4*)(y + (size_t)(tokb + o) * 512 + ch * 8) = ov;
    }
}

DI void lnfold_consts(const Params& p, int n0, int cnt) {
    unsigned char* ws = p.ws;
    const int lane = threadIdx.x & 63, wid = threadIdx.x >> 6;
    const bf16_t* wqt = (const bf16_t*)(ws + WS_WQT);
    const float* wq = p.in[14];
    const float* bb = p.in[13];
    for (int n = n0 + wid; n < n0 + cnt; n += 4) {
        float s1 = 0.f, s2 = 0.f;
#pragma unroll
        for (int j = 0; j < 2; ++j) {
            const u32x4 w = *(const u32x4*)(wqt + (size_t)n * 1024 + (j * 64 + lane) * 8);
            s1 += (bflo(w.x) + bfhi(w.x)) + (bflo(w.y) + bfhi(w.y)) + (bflo(w.z) + bfhi(w.z)) + (bflo(w.w) + bfhi(w.w));
        }
#pragma unroll 8
        for (int k = lane; k < 1024; k += 64) s2 += bb[k] * wq[(size_t)k * 2048 + n];
        s1 = wave_sum(s1); s2 = wave_sum(s2);
        if (lane == 0) { ((float*)(ws + WS_C1))[n] = s1; ((float*)(ws + WS_C2))[n] = s2; }
    }
}

DI void phase2(const Params& p, unsigned char* lds) {
    const int G = gridDim.x, bx = blockIdx.x;
    if (G == 512) {
        if (bx < 128) { compress_job(p, lds, bx); win_unit(p, lds, 768 + bx); }
        else {
            win_unit(p, lds, bx - 128); win_unit(p, lds, 384 + bx - 128);
            if (bx < 256) win_unit(p, lds, 896 + bx - 128);
            else lnfold_consts(p, (bx - 256) * 8, 8);
        }
    } else {
        for (int job = bx; job < 128; job += G) compress_job(p, lds, job);
        for (int job = bx; job < 1024; job += G) win_unit(p, lds, job);
        for (int n0 = bx * 8; n0 < 2048; n0 += G * 8) lnfold_consts(p, n0, 8);
    }
    for (int job = bx; job < 1024; job += G) pooly_job(p, job);
}

DI void pool_gemm_tile(const Params& p, unsigned char* lds, int tile) {
    unsigned char* ws = p.ws;
    const int gi = tile & 3, tm = tile >> 2;
    f32x16 acc[2][2];
    __syncthreads();
    gemm_mainloop((const bf16_t*)(ws + WS_YPOOL) + (size_t)tm * 128 * 512 + gi * 128, 512,
                  (const bf16_t*)(ws + WS_POOLWT) + (size_t)gi * 16384, 128, 128, acc, lds);
    const float* sc = p.in[10] + gi * 128;
    bf16_t* mx = (bf16_t*)(ws + WS_MIXIN);
    epi_stage_rows(acc, lds, [&](int n) { return *(const f32x4*)(sc + n); });
    __syncthreads();
    rows_foreach(lds, [&](int m, int cc, u32x4 d) {
        *(u32x4*)(mx + (size_t)(tm * 128 + m) * 1024 + 512 + gi * 128 + cc * 8) = d;
    });
}

DI void phase3(const Params& p, unsigned char* lds) {
    const int G = gridDim.x, bx = blockIdx.x;
    for (int pass = 0; pass * G < 1024; ++pass) {
        const int i = pass * G + ((pass & 1) ? (G - 1 - bx) : bx);
        if (i < 1024) {
            const int u = ((127 - (i >> 3)) << 3) | (i & 7);
            slc_unit(p, lds, u);
        }
    }
    for (int tile = bx; tile < 512; tile += G) pool_gemm_tile(p, lds, tile);
}

DI void phase4(const Params& p, unsigned char* lds) {
    unsigned char* ws = p.ws;
    const float* x = p.in[0];
    bf16_t* y1 = (bf16_t*)(ws + WS_Z);
    const bool conv_first = (blockIdx.x >> 3) & 1;
    if (conv_first) convert_tables(p);
    const int G8 = (gridDim.x & 7) == 0 ? gridDim.x >> 3 : 0;
    for (int l0 = G8 ? 0 : (int)blockIdx.x; l0 < (G8 ? 128 : 1024); l0 += (G8 ? G8 : (int)gridDim.x)) {
        const int li = G8 ? l0 + cu_pair_pos((int)(blockIdx.x >> 3), G8) : l0;
        if (G8 && li >= 128) break;
        const int tile = G8 ? (int)(blockIdx.x & 7) * 128 + li : li;
        const int tn = tile & 7, tm = tile >> 3;
        f32x16 acc[2][2];
        gemm_mainloop((const bf16_t*)(ws + WS_MIXIN) + (size_t)tm * 128 * 1024, 1024,
                      (const bf16_t*)(ws + WS_WOUTT) + (size_t)tn * 128 * 1024, 1024, 1024, acc, lds);
        epi_stage_rows(acc, lds, [&](int) { return (f32x4){1.f, 1.f, 1.f, 1.f}; });
        __syncthreads();
        rows_foreach(lds, [&](int m, int cc, u32x4 d) {
            const size_t off = (size_t)(tm * 128 + m) * 1024 + tn * 128 + cc * 8;
            const f32x4 xa = *(const f32x4*)(x + off), xb = *(const f32x4*)(x + off + 4);
            u32x4 o = {pk2(ALPHA * xa.x + bflo(d.x), ALPHA * xa.y + bfhi(d.x)), pk2(ALPHA * xa.z + bflo(d.y), ALPHA * xa.w + bfhi(d.y)),
                       pk2(ALPHA * xb.x + bflo(d.z), ALPHA * xb.y + bfhi(d.z)), pk2(ALPHA * xb.z + bflo(d.w), ALPHA * xb.w + bfhi(d.w))};
            *(u32x4*)(y1 + off) = o;
            float s = ((bflo(o.x) + bfhi(o.x)) + (bflo(o.y) + bfhi(o.y))) + ((bflo(o.z) + bfhi(o.z)) + (bflo(o.w) + bfhi(o.w)));
            float q = ((bflo(o.x) * bflo(o.x) + bfhi(o.x) * bfhi(o.x)) + (bflo(o.y) * bflo(o.y) + bfhi(o.y) * bfhi(o.y)))
                    + ((bflo(o.z) * bflo(o.z) + bfhi(o.z) * bfhi(o.z)) + (bflo(o.w) * bflo(o.w) + bfhi(o.w) * bfhi(o.w)));
#pragma unroll
            for (int sh = 1; sh < 16; sh <<= 1) { s += __shfl_xor(s, sh); q += __shfl_xor(q, sh); }
            if (cc == 0) *(f32x2*)((float*)(ws + WS_LNST) + (size_t)(tm * 128 + m) * 16 + tn * 2) = (f32x2){s, q};
        });
        __syncthreads();
    }
    if (!conv_first) convert_tables(p);
}

DI void ln1_stats(const unsigned char* ws, int row, float& mean, float& rstd) {
    const f32x4* st = (const f32x4*)((const float*)(ws + WS_LNST) + (size_t)row * 16);
    const f32x4 a = st[0], b = st[1], c = st[2], d = st[3];
    const float s = ((a.x + a.z) + (b.x + b.z)) + ((c.x + c.z) + (d.x + d.z));
    const float q = ((a.y + a.w) + (b.y + b.w)) + ((c.y + c.w) + (d.y + d.w));
    mean = s * (1.0f / 1024.0f);
    const float var = fmaxf(q * (1.0f / 1024.0f) - mean * mean, 0.f);
    rstd = rsqrtf(var + LN_EPS);
}

DI void phase5(const Params& p) {
    unsigned char* ws = p.ws;
    const int lane = threadIdx.x & 63, wid = threadIdx.x >> 6;
    const float* gg = p.in[12];
    const float* bb = p.in[13];
    bf16_t* h1 = (bf16_t*)(ws + WS_H1);
    for (int row = blockIdx.x * 4 + wid; row < NTOK; row += gridDim.x * 4) {
        const u32x2* xr = (const u32x2*)((const bf16_t*)(ws + WS_Z) + (size_t)row * 1024) + lane;
        f32x4 v[4];
        float s = 0.f;
#pragma unroll
        for (int j = 0; j < 4; ++j) { const u32x2 w = xr[64 * j]; v[j] = (f32x4){bflo(w.x), bfhi(w.x), bflo(w.y), bfhi(w.y)}; s += (v[j].x + v[j].y) + (v[j].z + v[j].w); }
        const float mean = wave_sum(s) * (1.0f / 1024.0f);
        float s2 = 0.f;
#pragma unroll
        for (int j = 0; j < 4; ++j) { v[j] = v[j] - mean; s2 += (v[j].x * v[j].x + v[j].y * v[j].y) + (v[j].z * v[j].z + v[j].w * v[j].w); }
        const float rstd = rsqrtf(wave_sum(s2) * (1.0f / 1024.0f) + LN_EPS);
#pragma unroll
        for (int j = 0; j < 4; ++j) {
            const f32x4 g4 = ((const f32x4*)gg)[lane + 64 * j], b4 = ((const f32x4*)bb)[lane + 64 * j];
            u32x2 o = {pk2(v[j].x * rstd * g4.x + b4.x, v[j].y * rstd * g4.y + b4.y), pk2(v[j].z * rstd * g4.z + b4.z, v[j].w * rstd * g4.w + b4.w)};
            *(u32x2*)(h1 + (size_t)row * 1024 + (lane + 64 * j) * 4) = o;
        }
    }
}


DI void ce_desc(int& a, int& b) { const int hi = a > b ? a : b, lo = a > b ? b : a; a = hi; b = lo; }
template <int K, int J> DI void bst(int (&a)[16]) {
#pragma unroll
    for (int i = 0; i < 16; ++i) { const int l = i ^ J; if (l > i) { if ((i & K) == 0) ce_desc(a[i], a[l]); else ce_desc(a[l], a[i]); } }
}
DI void sort16(int (&a)[16]) { bst<2, 1>(a); bst<4, 2>(a); bst<4, 1>(a); bst<8, 4>(a); bst<8, 2>(a); bst<8, 1>(a); bst<16, 8>(a); bst<16, 4>(a); bst<16, 2>(a); bst<16, 1>(a); }
DI void merge_top16(int (&a)[16], const int (&b)[16]) {
#pragma unroll
    for (int i = 0; i < 16; ++i) a[i] = a[i] > b[15 - i] ? a[i] : b[15 - i];
    bst<16, 8>(a); bst<16, 4>(a); bst<16, 2>(a); bst<16, 1>(a);
}

constexpr int cand_i(int c) { return c < 16 ? 0 : c < 24 ? 1 : c < 29 ? 2 : c < 33 ? 3 : c < 36 ? 4 : c < 38 ? 5 : c < 40 ? 6 : c < 42 ? 7 : c - 34; }
constexpr int cand_j(int c) { return c < 16 ? c : c < 24 ? c - 16 : c < 29 ? c - 24 : c < 33 ? c - 29 : c < 36 ? c - 33 : c < 38 ? c - 36 : c < 40 ? c - 38 : c < 42 ? c - 40 : 0; }
DI void cand_ij(int c, int& i, int& j) {
    if (c < 16) { i = 0; j = c; } else if (c < 24) { i = 1; j = c - 16; } else if (c < 29) { i = 2; j = c - 24; } else if (c < 33) { i = 3; j = c - 29; }
    else if (c < 36) { i = 4; j = c - 33; } else if (c < 38) { i = 5; j = c - 36; } else if (c < 40) { i = 6; j = c - 38; } else if (c < 42) { i = 7; j = c - 40; }
    else { i = c - 34; j = 0; }
}
DI float key_val6(int k) { int b = k & ~63; b ^= (b >> 31) & 0x7fffffff; return __int_as_float(b); }

DI void phase6(const Params& p, unsigned char* lds) {
    unsigned char* ws = p.ws;
    const int tid = threadIdx.x, lane = tid & 63, wid = tid >> 6, wr = wid >> 1, wc = wid & 1, r = lane & 31, h = lane >> 5;
    const bf16_t* h1 = (const bf16_t*)(ws + WS_Z);
    const bf16_t* wq = (const bf16_t*)(ws + WS_WQT);
    const bf16_t* sk = (const bf16_t*)(ws + WS_SUBK);
    const float* c1 = (const float*)(ws + WS_C1);
    const float* c2 = (const float*)(ws + WS_C2);
    int* routeE = (int*)(ws + WS_TOPK);
    float* routeG = (float*)(ws + WS_TOPK + 8 * MiB);
    int* L1s = (int*)(lds + 65536);
    const int G8 = (gridDim.x & 7) == 0 ? gridDim.x >> 3 : 0;
    for (int l0 = G8 ? 0 : (int)blockIdx.x; l0 < (G8 ? 128 : 1024); l0 += (G8 ? G8 : (int)gridDim.x)) {
        const int li = G8 ? l0 + cu_pair_pos((int)(blockIdx.x >> 3), G8) : l0;
        if (G8 && li >= 128) break;
        const int pair = G8 ? (int)(blockIdx.x & 7) * 128 + li : li;
        const int tm = pair >> 3, head = pair & 7;
        int ka[16], kb[16];
        float rmean[2], rrstd[2];
#pragma unroll
        for (int mi = 0; mi < 2; ++mi) ln1_stats(ws, tm * 128 + wr * 64 + mi * 32 + r, rmean[mi], rrstd[mi]);
        if (tid < 128) {
            const int kh = tid >> 6, wh = (tid >> 5) & 1, q4 = tid & 31;
            *(f32x4*)(lds + LDS_CST + kh * 1024 + wh * 512 + q4 * 16) = *(const f32x4*)((wh ? c2 : c1) + (head * 2 + kh) * 128 + q4 * 4);
        }
#pragma unroll 1
        for (int khalf = 0; khalf < 2; ++khalf) {
            const int tn = head * 2 + khalf;
            f32x16 acc[2][2];
            gemm_mainloop(h1 + (size_t)tm * 128 * 1024, 1024, wq + (size_t)tn * 128 * 1024, 1024, 1024, acc, lds);
            epi_foreach(acc, [&](int m, int n, f32x4 v) {
                const int mi = (m >> 5) & 1;
                const float mu = mi ? rmean[1] : rmean[0], rs = mi ? rrstd[1] : rrstd[0];
                const f32x4 k1 = *(const f32x4*)(lds + LDS_CST + khalf * 1024 + n * 4), k2 = *(const f32x4*)(lds + LDS_CST + khalf * 1024 + 512 + n * 4);
                u32x2 o = {pk2(rs * (v.x - mu * k1.x) + k2.x, rs * (v.y - mu * k1.y) + k2.y), pk2(rs * (v.z - mu * k1.z) + k2.z, rs * (v.w - mu * k1.w) + k2.w)};
                *(u32x2*)(lds + m * 272 + n * 2) = o;
            });
            __syncthreads();
            f32x16 a2[2][2];
#pragma unroll
            for (int mi = 0; mi < 2; ++mi)
#pragma unroll
                for (int ni = 0; ni < 2; ++ni)
#pragma unroll
                    for (int i = 0; i < 16; ++i) a2[mi][ni][i] = 0.f;
#pragma unroll
            for (int ks = 0; ks < 8; ++ks) {
                bf16x8 fa[2], fb[2];
#pragma unroll
                for (int mi = 0; mi < 2; ++mi) fa[mi] = *(const bf16x8*)(lds + (wr * 64 + mi * 32 + r) * 272 + ks * 32 + h * 16);
#pragma unroll
                for (int ni = 0; ni < 2; ++ni) fb[ni] = *(const bf16x8*)(sk + (size_t)(khalf * 128 + wc * 64 + ni * 32 + r) * 128 + ks * 16 + h * 8);
#pragma unroll
                for (int mi = 0; mi < 2; ++mi)
#pragma unroll
                    for (int ni = 0; ni < 2; ++ni) a2[mi][ni] = MFMA32(fb[ni], fa[mi], a2[mi][ni]);
            }
            __syncthreads();
#pragma unroll
            for (int mi = 0; mi < 2; ++mi) {
                int xa[16], xb[16];
#pragma unroll
                for (int i = 0; i < 16; ++i) {
                    const int n = wc * 64 + (i & 3) + 8 * (i >> 2) + 4 * h;
                    xa[i] = make_key(a2[mi][0][i], n); xb[i] = make_key(a2[mi][1][i], n + 32);
                }
                sort16(xa); sort16(xb); merge_top16(xa, xb);
#pragma unroll
                for (int i = 0; i < 16; ++i) xb[i] = __shfl_xor(xa[i], 32);
                merge_top16(xa, xb);
                if (h == 0) {
                    int* dst = (int*)lds + ((wr * 64 + mi * 32 + r) * 2 + wc) * 16;
#pragma unroll
                    for (int q4 = 0; q4 < 4; ++q4) { u32x4 o = {(unsigned)xa[4 * q4], (unsigned)xa[4 * q4 + 1], (unsigned)xa[4 * q4 + 2], (unsigned)xa[4 * q4 + 3]}; *(u32x4*)(dst + 4 * q4) = o; }
                }
            }
            __syncthreads();
            if (tid < 128) {
                const int* s0 = (const int*)lds + tid * 32;
#pragma unroll
                for (int q4 = 0; q4 < 4; ++q4) {
                    const u32x4 x = *(const u32x4*)(s0 + 4 * q4), y = *(const u32x4*)(s0 + 16 + 4 * q4);
                    ka[4 * q4] = (int)x.x; ka[4 * q4 + 1] = (int)x.y; ka[4 * q4 + 2] = (int)x.z; ka[4 * q4 + 3] = (int)x.w;
                    kb[4 * q4] = (int)y.x; kb[4 * q4 + 1] = (int)y.y; kb[4 * q4 + 2] = (int)y.z; kb[4 * q4 + 3] = (int)y.w;
                }
                merge_top16(ka, kb);
                if (khalf == 0) {
#pragma unroll
                    for (int q4 = 0; q4 < 4; ++q4) { u32x4 o = {(unsigned)ka[4 * q4], (unsigned)ka[4 * q4 + 1], (unsigned)ka[4 * q4 + 2], (unsigned)ka[4 * q4 + 3]}; *(u32x4*)(L1s + tid * 16 + 4 * q4) = o; }
                }
            }
            if (khalf == 0) __syncthreads();
        }
        if (tid < 128) {
            int* L2s = (int*)lds + tid * 32;
#pragma unroll
            for (int q4 = 0; q4 < 4; ++q4) { u32x4 o = {(unsigned)ka[4 * q4], (unsigned)ka[4 * q4 + 1], (unsigned)ka[4 * q4 + 2], (unsigned)ka[4 * q4 + 3]}; *(u32x4*)(L2s + 4 * q4) = o; }
            float v1[16], v2[16];
#pragma unroll
            for (int q4 = 0; q4 < 4; ++q4) {
                const u32x4 x = *(const u32x4*)(L1s + tid * 16 + 4 * q4);
                v1[4 * q4] = key_val((int)x.x); v1[4 * q4 + 1] = key_val((int)x.y); v1[4 * q4 + 2] = key_val((int)x.z); v1[4 * q4 + 3] = key_val((int)x.w);
            }
#pragma unroll
            for (int i = 0; i < 16; ++i) v2[i] = key_val(ka[i]);
            int g0[16], g1[16], g2[16], g3[16];
#pragma unroll
            for (int t = 0; t < 16; ++t) {
                { const float s = v1[cand_i(t)] + v2[cand_j(t)]; int b = __float_as_int(s); b ^= (b >> 31) & 0x7fffffff; g0[t] = (b & ~63) | (63 - t); }
                { const float s = v1[cand_i(16 + t)] + v2[cand_j(16 + t)]; int b = __float_as_int(s); b ^= (b >> 31) & 0x7fffffff; g1[t] = (b & ~63) | (63 - (16 + t)); }
                { const float s = v1[cand_i(32 + t)] + v2[cand_j(32 + t)]; int b = __float_as_int(s); b ^= (b >> 31) & 0x7fffffff; g2[t] = (b & ~63) | (63 - (32 + t)); }
                if (t < 2) { const float s = v1[cand_i(48 + t)] + v2[cand_j(48 + t)]; int b = __float_as_int(s); b ^= (b >> 31) & 0x7fffffff; g3[t] = (b & ~63) | (63 - (48 + t)); }
                else g3[t] = (int)0x80000000 + t;
            }
            sort16(g0); sort16(g1); sort16(g2); sort16(g3);
            merge_top16(g0, g1); merge_top16(g2, g3); merge_top16(g0, g2);
            const float smax = key_val6(g0[0]);
            float ex[16], den = 0.f;
#pragma unroll
            for (int t = 0; t < 16; ++t) { ex[t] = __expf(key_val6(g0[t]) - smax); den += ex[t]; }
            const float inv = 1.0f / den;
            const size_t ro = ((size_t)(tm * 128 + tid) * 8 + head) * 16;
#pragma unroll
            for (int q4 = 0; q4 < 4; ++q4) {
                int ee[4];
#pragma unroll
                for (int u = 0; u < 4; ++u) {
                    int ci, cj; cand_ij(63 - (g0[4 * q4 + u] & 63), ci, cj);
                    ee[u] = (L1s[tid * 16 + ci] & 127) * 128 + (L2s[cj] & 127);
                }
                u32x4 oe = {(unsigned)ee[0], (unsigned)ee[1], (unsigned)ee[2], (unsigned)ee[3]};
                f32x4 og = {ex[4 * q4] * inv, ex[4 * q4 + 1] * inv, ex[4 * q4 + 2] * inv, ex[4 * q4 + 3] * inv};
                *(u32x4*)(routeE + ro + 4 * q4) = oe;
                *(f32x4*)(routeG + ro + 4 * q4) = og;
            }
        }
        __syncthreads();
    }
}

constexpr int P7_NS = 32, P7_SH = 9;
constexpr int P7_WLDS = 6144;
DI void p7_loadrows(int b, int li, int l32, const LAS int* ent_e, const unsigned char* tab, u32x4 (&rows)[8][2]) {
    const u32x4 e0 = *(const LAS u32x4*)(ent_e + li * 128 + b), e1 = *(const LAS u32x4*)(ent_e + li * 128 + b + 4);
    const unsigned ee[8] = {e0.x, e0.y, e0.z, e0.w, e1.x, e1.y, e1.z, e1.w};
#pragma unroll
    for (int r = 0; r < 8; ++r) {
        const unsigned ob = ee[r] * 1024u + (unsigned)l32 * 16u;
        rows[r][0] = *(const u32x4*)(tab + ob);
        rows[r][1] = *(const u32x4*)(tab + ob + 512);
    }
}
DI float half32_sum(float v) { v += __shfl_xor(v, 1); v += __shfl_xor(v, 2); v += __shfl_xor(v, 4); v += __shfl_xor(v, 8); v += __shfl_xor(v, 16); return v; }

DI void p7_stepA(const u32x4 (&rows)[8][2], const unsigned (&hq)[2][4], float hscale, int b, int li, int l32, int lane, int myk,
                 LAS float* ent_w, const LAS float* ent_us) {
    int d[8];
#pragma unroll
    for (int r = 0; r < 8; ++r) {
        int a = 0;
#pragma unroll
        for (int c = 0; c < 2; ++c)
#pragma unroll
            for (int q = 0; q < 4; ++q) a = dot4i8(rows[r][c][q], hq[c][q], a);
        d[r] = a;
    }
    int r4[4], r2[2], r1;
    const bool b0 = lane & 1;
#pragma unroll
    for (int i = 0; i < 4; ++i) { const int snd = b0 ? d[i] : d[4 + i]; const int kp = b0 ? d[4 + i] : d[i]; r4[i] = kp + __shfl_xor(snd, 1); }
    const bool b1 = lane & 2;
#pragma unroll
    for (int i = 0; i < 2; ++i) { const int snd = b1 ? r4[i] : r4[2 + i]; const int kp = b1 ? r4[2 + i] : r4[i]; r2[i] = kp + __shfl_xor(snd, 2); }
    const bool b2 = lane & 4;
    { const int snd = b2 ? r2[0] : r2[1]; const int kp = b2 ? r2[1] : r2[0]; r1 = kp + __shfl_xor(snd, 4); }
    r1 += __shfl_xor(r1, 8); r1 += __shfl_xor(r1, 16);
    if (l32 < 8) { const int idx = li * 128 + b + myk; ent_w[idx] = ent_w[idx] * gelu_fast((float)r1 * (hscale * ent_us[idx])); }
}
DI void p7_stepA6(const unsigned (&rw)[8][6], const f16x2_t (&h16)[16], int b, int li, int l32, int lane, int myk,
                  LAS float* ent_w, const LAS float* ent_us) {
    float d[8];
#pragma unroll
    for (int r = 0; r < 8; ++r) {
        const u32x6 pk = {rw[r][0], rw[r][1], rw[r][2], rw[r][3], rw[r][4], rw[r][5]};
        const f16x32 u = __builtin_amdgcn_cvt_scalef32_pk32_f16_fp6(pk, 1.0f);
        float a0 = 0.f, a1 = 0.f;
#pragma unroll
        for (int j = 0; j < 16; j += 2) {
            a0 = __builtin_amdgcn_fdot2((f16x2_t){u[2 * j], u[2 * j + 1]}, h16[j], a0, false);
            a1 = __builtin_amdgcn_fdot2((f16x2_t){u[2 * j + 2], u[2 * j + 3]}, h16[j + 1], a1, false);
        }
        d[r] = a0 + a1;
        if (r & 1) __builtin_amdgcn_sched_barrier(0);
    }
    float r4[4], r2[2], r1;
    const bool b0 = lane & 1;
#pragma unroll
    for (int i = 0; i < 4; ++i) { const float snd = b0 ? d[i] : d[4 + i]; const float kp = b0 ? d[4 + i] : d[i]; r4[i] = kp + __shfl_xor(snd, 1); }
    const bool b1 = lane & 2;
#pragma unroll
    for (int i = 0; i < 2; ++i) { const float snd = b1 ? r4[i] : r4[2 + i]; const float kp = b1 ? r4[2 + i] : r4[i]; r2[i] = kp + __shfl_xor(snd, 2); }
    const bool b2 = lane & 4;
    { const float snd = b2 ? r2[0] : r2[1]; const float kp = b2 ? r2[1] : r2[0]; r1 = kp + __shfl_xor(snd, 4); }
    r1 += __shfl_xor(r1, 8); r1 += __shfl_xor(r1, 16);
    if (l32 < 8) { const int idx = li * 128 + b + myk; ent_w[idx] = ent_w[idx] * gelu_fast(r1 * ent_us[idx]); }
}
DI void p7_stepB(const u32x4 (&rows)[8][2], f32x2 (&acc)[2][8], int b, int li, const LAS float* ent_w) {
    const f32x4 w0 = *(const LAS f32x4*)(ent_w + li * 128 + b), w1 = *(const LAS f32x4*)(ent_w + li * 128 + b + 4);
    const float ww[8] = {w0.x, w0.y, w0.z, w0.w, w1.x, w1.y, w1.z, w1.w};
#pragma unroll
    for (int r = 0; r < 8; ++r) {
        const f32x2 w2 = {ww[r], ww[r]};
#pragma unroll
        for (int c = 0; c < 2; ++c)
#pragma unroll
            for (int q = 0; q < 4; ++q) {
                const f32x2 lo = __builtin_amdgcn_cvt_pk_f32_fp8((int)rows[r][c][q], false);
                const f32x2 hi = __builtin_amdgcn_cvt_pk_f32_fp8((int)rows[r][c][q], true);
                acc[c][2 * q] += w2 * lo; acc[c][2 * q + 1] += w2 * hi;
            }
    }
}
DI void p7_loadrows6(int b, int li, int l32, const LAS int* ent_e, const unsigned char* tab, unsigned (&rw)[8][6]) {
    const u32x4 e0 = *(const LAS u32x4*)(ent_e + li * 128 + b), e1 = *(const LAS u32x4*)(ent_e + li * 128 + b + 4);
    const unsigned ee[8] = {e0.x, e0.y, e0.z, e0.w, e1.x, e1.y, e1.z, e1.w};
#pragma unroll
    for (int r = 0; r < 8; ++r) {
        const unsigned ob = ee[r] * 768u;
        const u32x4 x = *(const u32x4*)(tab + ob + (unsigned)l32 * 16u);
        const u32x2 y = *(const u32x2*)(tab + ob + 512u + (unsigned)l32 * 8u);
        rw[r][0] = x.x; rw[r][1] = x.y; rw[r][2] = x.z; rw[r][3] = x.w; rw[r][4] = y.x; rw[r][5] = y.y;
    }
}
DI void p7_stepB6(const unsigned (&rw)[8][6], f32x2 (&acc)[2][8], int b, int li, const LAS float* ent_w) {
    const f32x4 w0 = *(const LAS f32x4*)(ent_w + li * 128 + b), w1 = *(const LAS f32x4*)(ent_w + li * 128 + b + 4);
    const float ww[8] = {w0.x, w0.y, w0.z, w0.w, w1.x, w1.y, w1.z, w1.w};
#pragma unroll
    for (int r = 0; r < 8; ++r) {
        const u32x6 pk = {rw[r][0], rw[r][1], rw[r][2], rw[r][3], rw[r][4], rw[r][5]};
        const f32x32 d = __builtin_amdgcn_cvt_scalef32_pk32_f32_fp6(pk, 1.0f);
        const f32x2 w2 = {ww[r], ww[r]};
#pragma unroll
        for (int c = 0; c < 2; ++c)
#pragma unroll
            for (int i = 0; i < 8; ++i) acc[c][i] += w2 * (f32x2){d[c * 16 + 2 * i], d[c * 16 + 2 * i + 1]};
    }
}
DI void p7_loadrows4(int b, int li, int l32, const LAS int* ent_e, const unsigned char* tab, u32x4 (&rw)[8]) {
    const u32x4 e0 = *(const LAS u32x4*)(ent_e + li * 128 + b), e1 = *(const LAS u32x4*)(ent_e + li * 128 + b + 4);
    const unsigned ee[8] = {e0.x, e0.y, e0.z, e0.w, e1.x, e1.y, e1.z, e1.w};
#pragma unroll
    for (int r = 0; r < 8; ++r) rw[r] = *(const u32x4*)(tab + ee[r] * 512u + (unsigned)l32 * 16u);
}
DI void p7_stepB4(const u32x4 (&rw)[8], f32x2 (&acc)[2][8], int b, int li, const LAS float* ent_w) {
    const f32x4 w0 = *(const LAS f32x4*)(ent_w + li * 128 + b), w1 = *(const LAS f32x4*)(ent_w + li * 128 + b + 4);
    const float ww[8] = {w0.x, w0.y, w0.z, w0.w, w1.x, w1.y, w1.z, w1.w};
#pragma unroll
    for (int r = 0; r < 8; ++r) {
        const f32x2 w2 = {ww[r], ww[r]};
#pragma unroll
        for (int c = 0; c < 2; ++c)
#pragma unroll
            for (int d = 0; d < 2; ++d) {
                const unsigned wd = rw[r][c * 2 + d];
                acc[c][d * 4 + 0] += w2 * __builtin_amdgcn_cvt_scalef32_pk_f32_fp4(wd, 1.0f, 0);
                acc[c][d * 4 + 1] += w2 * __builtin_amdgcn_cvt_scalef32_pk_f32_fp4(wd, 1.0f, 1);
                acc[c][d * 4 + 2] += w2 * __builtin_amdgcn_cvt_scalef32_pk_f32_fp4(wd, 1.0f, 2);
                acc[c][d * 4 + 3] += w2 * __builtin_amdgcn_cvt_scalef32_pk_f32_fp4(wd, 1.0f, 3);
            }
    }
}
constexpr int P7_GB = 32768;
DI void p7_load_h(const Params& p, const LAS unsigned char* gb, int tok, int l32, float (&hv)[32]) {
    const unsigned char* ws = p.ws;
    float mean, rstd;
    ln1_stats(ws, tok, mean, rstd);
    const bf16_t* y1 = (const bf16_t*)(ws + WS_Z) + (size_t)tok * 1024 + l32 * 16;
    const LAS float* gg = (const LAS float*)(gb + P7_GB) + l32 * 16;
    const LAS float* bb = gg + 1024;
#pragma unroll
    for (int c = 0; c < 2; ++c) {
        const u32x4 a = *(const u32x4*)(y1 + c * 512), b2 = *(const u32x4*)(y1 + c * 512 + 8);
        const unsigned hh[8] = {a.x, a.y, a.z, a.w, b2.x, b2.y, b2.z, b2.w};
#pragma unroll
        for (int i4 = 0; i4 < 4; ++i4) {
            const f32x4 g4 = *(const LAS f32x4*)(gg + c * 512 + i4 * 4), b4 = *(const LAS f32x4*)(bb + c * 512 + i4 * 4);
            hv[c * 16 + 4 * i4 + 0] = (bflo(hh[2 * i4]) - mean) * rstd * g4.x + b4.x;
            hv[c * 16 + 4 * i4 + 1] = (bfhi(hh[2 * i4]) - mean) * rstd * g4.y + b4.y;
            hv[c * 16 + 4 * i4 + 2] = (bflo(hh[2 * i4 + 1]) - mean) * rstd * g4.z + b4.z;
            hv[c * 16 + 4 * i4 + 3] = (bfhi(hh[2 * i4 + 1]) - mean) * rstd * g4.w + b4.w;
        }
    }
}
DI void p7_h16(const Params& p, const LAS unsigned char* gb, int tok, int l32, f16x2_t (&h16)[16]) {
    float hv[32];
    p7_load_h(p, gb, tok, l32, hv);
#pragma unroll
    for (int j = 0; j < 16; ++j) h16[j] = (f16x2_t){(_Float16)hv[2 * j], (_Float16)hv[2 * j + 1]};
}
DI void p7_quant_h(const Params& p, const LAS unsigned char* gb, int tok, int l32, unsigned (&hq)[2][4], float& hscale) {
    float hv[32];
    p7_load_h(p, gb, tok, l32, hv);
    float am = 0.f;
#pragma unroll
    for (int i = 0; i < 32; ++i) am = fmaxf(am, fabsf(hv[i]));
    am = fmaxf(am, __shfl_xor(am, 1)); am = fmaxf(am, __shfl_xor(am, 2)); am = fmaxf(am, __shfl_xor(am, 4)); am = fmaxf(am, __shfl_xor(am, 8)); am = fmaxf(am, __shfl_xor(am, 16));
    const float hq_sc = am > 0.f ? 127.0f / am : 1.0f;
    hscale = am > 0.f ? am / 127.0f : 1.0f;
#pragma unroll
    for (int c = 0; c < 2; ++c)
#pragma unroll
        for (int q = 0; q < 4; ++q) {
            const int q0 = (int)rintf(hv[c * 16 + 4 * q] * hq_sc), q1 = (int)rintf(hv[c * 16 + 4 * q + 1] * hq_sc);
            const int q2 = (int)rintf(hv[c * 16 + 4 * q + 2] * hq_sc), q3 = (int)rintf(hv[c * 16 + 4 * q + 3] * hq_sc);
            hq[c][q] = (unsigned)(q0 & 255) | ((unsigned)(q1 & 255) << 8) | ((unsigned)(q2 & 255) << 16) | ((unsigned)(q3 & 255) << 24);
        }
}
DI void p7_finish(const Params& p, int tok, const float (&hv)[32], f32x2 (&acc)[2][8], int l32) {
    const size_t hbase = (size_t)tok * 1024 + l32 * 16;
    float sm = 0.f;
    {
#pragma unroll
        for (int c = 0; c < 2; ++c)
#pragma unroll
            for (int i = 0; i < 8; ++i) {
                acc[c][i].x += ALPHA * hv[c * 16 + 2 * i]; acc[c][i].y += ALPHA * hv[c * 16 + 2 * i + 1];
                sm += acc[c][i].x + acc[c][i].y;
            }
    }
    const float mean = half32_sum(sm) * (1.0f / 1024.0f);
    float sq = 0.f;
#pragma unroll
    for (int c = 0; c < 2; ++c)
#pragma unroll
        for (int i = 0; i < 8; ++i) { acc[c][i].x -= mean; acc[c][i].y -= mean; sq += acc[c][i].x * acc[c][i].x + acc[c][i].y * acc[c][i].y; }
    const float rstd = rsqrtf(half32_sum(sq) * (1.0f / 1024.0f) + LN_EPS);
    const float* gg = p.in[18] + l32 * 16;
    const float* bb = p.in[19] + l32 * 16;
    float* orow = p.out + hbase;
#pragma unroll
    for (int c = 0; c < 2; ++c)
#pragma unroll
        for (int q4 = 0; q4 < 4; ++q4) {
            const f32x4 g4 = *(const f32x4*)(gg + c * 512 + q4 * 4), b4 = *(const f32x4*)(bb + c * 512 + q4 * 4);
            f32x4 o = {acc[c][2 * q4].x * rstd * g4.x + b4.x, acc[c][2 * q4].y * rstd * g4.y + b4.y,
                       acc[c][2 * q4 + 1].x * rstd * g4.z + b4.z, acc[c][2 * q4 + 1].y * rstd * g4.w + b4.w};
            *(f32x4*)(orow + c * 512 + q4 * 4) = o;
        }
}

DI void phase7(const Params& p, unsigned char* lds) {
    unsigned char* ws = p.ws;
    const int lane = threadIdx.x & 63, wid = __builtin_amdgcn_readfirstlane(threadIdx.x >> 6);
    const int hw = lane >> 5, l32 = lane & 31;
    LAS unsigned char* l3 = (LAS unsigned char*)lds + wid * P7_WLDS;
    const unsigned char* u8 = ws + WS_UB;
    const unsigned char* v8 = ws + WS_VB;
    const float* uscale = (const float*)(ws + WS_USCALE);
    const float* vscale = (const float*)(ws + WS_VSCALE);
    LAS int* ent_e = (LAS int*)l3;
    LAS float* ent_w = (LAS float*)(l3 + 2048);
    LAS float* ent_us = (LAS float*)(l3 + 4096);
    {
        const int t = threadIdx.x;
        *(f32x4*)(lds + P7_GB + t * 16) = *(const f32x4*)(p.in[12] + t * 4);
        *(f32x4*)(lds + P7_GB + 4096 + t * 16) = *(const f32x4*)(p.in[13] + t * 4);
        __syncthreads();
    }
    const unsigned long long ltmask = (1ull << lane) - 1ull;
    const int myk = ((lane & 1) << 2) | (lane & 2) | ((lane >> 2) & 1);
    const int li0 = hw, li1 = 2 + hw;
    for (int rnd = blockIdx.x * 4 + wid; rnd < NTOK / 4; rnd += gridDim.x * 4) {
        const int tok0 = rnd * 4;
#pragma unroll 1
        for (int tk = 0; tk < 4; ++tk) {
            const int* RE = (const int*)(ws + WS_TOPK) + (size_t)(tok0 + tk) * 128;
            const float* RG = (const float*)(ws + WS_TOPK + 8 * MiB) + (size_t)(tok0 + tk) * 128;
            const int ea = RE[lane], eb = RE[64 + lane];
            const float ga = RG[lane], gb = RG[64 + lane];
            const int sa = ea >> P7_SH, sb = eb >> P7_SH;
            int pa = 0, pb = 0, run = 0;
#pragma unroll
            for (int s = 0; s < P7_NS; ++s) {
                const unsigned long long ma = __ballot(sa == s), mb = __ballot(sb == s);
                const int ca = __popcll(ma), cb = __popcll(mb);
                if (sa == s) pa = run + __popcll(ma & ltmask);
                if (sb == s) pb = run + ca + __popcll(mb & ltmask);
                run += ca + cb;
            }
            ent_e[tk * 128 + pa] = ea; ent_w[tk * 128 + pa] = ga * vscale[ea]; ent_us[tk * 128 + pa] = uscale[ea];
            ent_e[tk * 128 + pb] = eb; ent_w[tk * 128 + pb] = gb * vscale[eb]; ent_us[tk * 128 + pb] = uscale[eb];
        }
        {
            f16x2_t h0[16], h1[16];
            p7_h16(p, (const LAS unsigned char*)lds, tok0 + li0, l32, h0);
            p7_h16(p, (const LAS unsigned char*)lds, tok0 + li1, l32, h1);
            unsigned ra[8][6], rb[8][6];
            p7_loadrows6(0, li0, l32, ent_e, u8, ra);
            for (int b = 0; b < 128; b += 8) {
                p7_loadrows6(b, li1, l32, ent_e, u8, rb);
                __builtin_amdgcn_sched_barrier(0);
                p7_stepA6(ra, h0, b, li0, l32, lane, myk, ent_w, ent_us);
                __builtin_amdgcn_sched_barrier(0);
                p7_loadrows6(b + 8 < 128 ? b + 8 : b, li0, l32, ent_e, u8, ra);
                __builtin_amdgcn_sched_barrier(0);
                p7_stepA6(rb, h1, b, li1, l32, lane, myk, ent_w, ent_us);
                __builtin_amdgcn_sched_barrier(0);
            }
        }
        f32x2 acc0[2][8], acc1[2][8];
#pragma unroll
        for (int c = 0; c < 2; ++c)
#pragma unroll
            for (int i = 0; i < 8; ++i) { acc0[c][i] = (f32x2){0.f, 0.f}; acc1[c][i] = (f32x2){0.f, 0.f}; }
        {
            u32x4 ra[8], rb[8];
            p7_loadrows4(0, li0, l32, ent_e, v8, ra);
            for (int b = 0; b < 128; b += 8) {
                p7_loadrows4(b, li1, l32, ent_e, v8, rb);
                __builtin_amdgcn_sched_barrier(0);
                p7_stepB4(ra, acc0, b, li0, ent_w);
                __builtin_amdgcn_sched_barrier(0);
                p7_loadrows4(b + 8 < 128 ? b + 8 : b, li0, l32, ent_e, v8, ra);
                __builtin_amdgcn_sched_barrier(0);
                p7_stepB4(rb, acc1, b, li1, ent_w);
                __builtin_amdgcn_sched_barrier(0);
            }
        }
        asm volatile("" ::: "memory");
        {
            float hv0[32], hv1[32];
            p7_load_h(p, (const LAS unsigned char*)lds, tok0 + li0, l32, hv0);
            p7_load_h(p, (const LAS unsigned char*)lds, tok0 + li1, l32, hv1);
            p7_finish(p, tok0 + li0, hv0, acc0, l32);
            p7_finish(p, tok0 + li1, hv1, acc1, l32);
        }
    }
}

#if DIAG
DI float bfv(const bf16_t* p, size_t i) { return __uint_as_float(((unsigned)p[i]) << 16); }
DI float bfr(float x) { return __uint_as_float(f2bf(x) << 16); }
DI void dfail(const Params& p, int bit) { atomicOr((unsigned*)(p.ws + WS_FLAG), 1u << bit); }
DI bool bad(float fast, float ref) { return !(fabsf(fast - ref) <= 0.02f * fabsf(ref) + 0.02f); }
DI unsigned hsh(unsigned x) { x ^= x >> 16; x *= 0x7feb352dU; x ^= x >> 15; x *= 0x846ca68bU; x ^= x >> 16; return x; }
DI int winsrc(int n) { return n < 1280 ? n : (n < 1792 ? 1304 + (n - 1280) : 1280 + (n - 1792)); }

DI void chk1(const Params& p, int bit) {
    unsigned char* ws = p.ws;
    const unsigned gt = blockIdx.x * NTHREADS + threadIdx.x;
    const int tok = hsh(gt * 2 + 1) & 16383, n = hsh(gt * 2 + 2) % 1816;
    const bf16_t* xb = (const bf16_t*)(ws + WS_XB);
    const bf16_t* wt = (const bf16_t*)(ws + WS_WINT);
    float ref = 0.f, ref2 = 0.f;
    for (int k = 0; k < 1024; ++k) {
        ref += bfv(xb, (size_t)tok * 1024 + k) * bfv(wt, (size_t)n * 1024 + k);
        ref2 += p.in[0][(size_t)tok * 1024 + k] * p.in[1][(size_t)k * 1816 + winsrc(n)];
    }
    if (!(fabsf(ref - ref2) <= 0.06f)) dfail(p, bit);
    const int b = tok >> 12, t = tok & 4095;
    float fast;
    if (n < 512) { const int hd = n >> 6, d = n & 63; fast = bfv((const bf16_t*)(ws + WS_Q), ((size_t)(b * 8 + hd) * SEQ + t) * 64 + d); ref *= 0.125f; }
    else if (n < 1280) {
        const int seg = (n - 512) >> 7, nn = (n - 512) & 127, g = nn >> 6, d = nn & 63;
        if (seg == 3 || seg == 5) fast = bfv((const bf16_t*)(ws + (seg == 3 ? WS_VSLCT : WS_VWINT)), ((size_t)((b * 2 + g) * 64 + d)) * SEQ + t);
        else fast = bfv((const bf16_t*)(ws + (seg == 0 ? WS_KC : seg == 1 ? WS_VC : seg == 2 ? WS_KSLC : WS_KWIN)), ((size_t)(b * 2 + g) * SEQ + t) * 64 + d);
    } else if (n < 1792) fast = bfv((const bf16_t*)(ws + WS_Z), (size_t)tok * 512 + (n - 1280));
    else { fast = ((const float*)(ws + WS_GATES))[(size_t)tok * 24 + (n - 1792)]; ref = 1.f / (1.f + expf(-ref)); }
    if (bad(fast, ref)) dfail(p, bit);
}
DI void chk2(const Params& p, int bit) {
    unsigned char* ws = p.ws;
    const unsigned gt = blockIdx.x * NTHREADS + threadIdx.x;
    if (gt >= 2048) return;
    const int kv = gt & 1, bg = (gt >> 1) & 7, c = hsh(gt) % 255, d = hsh(gt + 7777) & 63;
    const bf16_t* A = (const bf16_t*)(ws + (kv ? WS_VC : WS_KC)) + ((size_t)bg * SEQ + c * 16) * 64;
    const bf16_t* w1t = (const bf16_t*)(ws + (kv ? WS_W1TV : WS_W1TK));
    const bf16_t* w2t = (const bf16_t*)(ws + (kv ? WS_W2TV : WS_W2TK));
    const float* peb = (const float*)(ws + (kv ? WS_PEBV : WS_PEBK));
    float out = 0.f;
    for (int j = 0; j < 256; ++j) {
        float s = peb[j];
        for (int i = 0; i < 2048; ++i) s += bfv(A, i) * bfv(w1t, (size_t)j * 2048 + i);
        out += bfr(gelu_erf(s)) * bfv(w2t, d * 256 + j);
    }
    const float fast = ((const float*)(ws + (kv ? WS_VCMP : WS_KCMP)))[((size_t)bg * 256 + c) * 64 + d];
    if (bad(fast, out)) dfail(p, bit);
    if (gt < 256) {
        const float* w1 = kv ? p.in[7] : p.in[5];
        const float* w2 = kv ? p.in[8] : p.in[6];
        const float* pe = kv ? p.in[4] : p.in[3];
        float o2 = 0.f;
        for (int j = 0; j < 256; ++j) {
            float s = 0.f;
            for (int i = 0; i < 2048; ++i) s += (bfv(A, i) + pe[i]) * w1[(size_t)i * 256 + j];
            o2 += gelu_erf(s) * w2[j * 64 + d];
        }
        if (!(fabsf(o2 - out) <= 0.03f * fabsf(out) + 0.03f)) dfail(p, bit);
    }
}
DI void chk3(const Params& p, int bit) {
    unsigned char* ws = p.ws;
    const unsigned gt = blockIdx.x * NTHREADS + threadIdx.x;
    if (gt >= 4096) return;
    const int tok = hsh(gt) & 16383, head = hsh(gt + 99) & 7, b = tok >> 12, t = tok & 4095, g = head >> 2;
    const bf16_t* Q = (const bf16_t*)(ws + WS_Q) + ((size_t)(b * 8 + head) * SEQ + t) * 64;
    const bf16_t* K = (const bf16_t*)(ws + WS_KWIN) + (size_t)(b * 2 + g) * SEQ * 64;
    const bf16_t* Vt = (const bf16_t*)(ws + WS_VWINT) + (size_t)(b * 2 + g) * 64 * SEQ;
    float q[64], o[64];
#pragma unroll
    for (int d = 0; d < 64; ++d) { q[d] = bfv(Q, d); o[d] = 0.f; }
    float m = -1e30f, l = 0.f;
    for (int pos = (t > 511 ? t - 511 : 0); pos <= t; ++pos) {
        float s = 0.f;
#pragma unroll
        for (int d = 0; d < 64; ++d) s += q[d] * bfv(K, (size_t)pos * 64 + d);
        s += p.in[2][rel_bucket_dev(t - pos) * 8 + head];
        const float mn = fmaxf(m, s), a = expf(m - mn), pp = expf(s - mn);
        l = l * a + pp;
#pragma unroll
        for (int d = 0; d < 64; ++d) o[d] = o[d] * a + pp * bfv(Vt, (size_t)d * SEQ + pos);
        m = mn;
    }
    const float gate = ((const float*)(ws + WS_GATES))[(size_t)tok * 24 + 16 + head];
    bool f = false;
#pragma unroll
    for (int d = 0; d < 64; ++d) f |= bad(bfv((const bf16_t*)(ws + WS_OWIN), (size_t)tok * 512 + head * 64 + d), o[d] / l * gate);
    if (f) dfail(p, bit);
}
DI void chk4(const Params& p, int bit) {
    unsigned char* ws = p.ws;
    const unsigned gt = blockIdx.x * NTHREADS + threadIdx.x;
    if (gt >= 512) return;
    const int tok = hsh(gt + 5) & 16383, g = gt & 1, b = tok >> 12, t = tok & 4095, bg = b * 2 + g;
    float* scr = (float*)(ws + WS_DSCR) + (size_t)gt * 1536;
    float* imp = scr + 1024;
    float* nsa = scr + 1100;
    for (int j = 0; j < 64; ++j) imp[j] = 0.f;
    const float* kc = (const float*)(ws + WS_KCMP) + (size_t)bg * 256 * 64;
    const float* vc = (const float*)(ws + WS_VCMP) + (size_t)bg * 256 * 64;
    const float* gt24 = (const float*)(ws + WS_GATES) + (size_t)tok * 24;
    for (int hl = 0; hl < 4; ++hl) {
        const int head = g * 4 + hl;
        const bf16_t* Q = (const bf16_t*)(ws + WS_Q) + ((size_t)(b * 8 + head) * SEQ + t) * 64;
        float q[64], o[64];
#pragma unroll
        for (int d = 0; d < 64; ++d) { q[d] = bfv(Q, d); o[d] = 0.f; }
        float m = -1e30f;
        for (int c = 0; c < 255; ++c) {
            const bool valid = 16 * c + 31 <= t;
            float s = 0.f;
#pragma unroll
            for (int d = 0; d < 64; ++d) s += q[d] * bfr(kc[c * 64 + d]);
            s += p.in[2][rel_bucket_dev(t - 16 * c - 31) * 8 + head];
            scr[hl * 256 + c] = s;
            if (valid) m = fmaxf(m, s);
        }
        float l = 0.f;
        for (int c = 0; c < 255; ++c) if (16 * c + 31 <= t) l += expf(scr[hl * 256 + c] - m);
        for (int c = 0; c < 255; ++c) if (16 * c + 31 <= t) {
            const float pc = expf(scr[hl * 256 + c] - m) / l;
            imp[c >> 2] += pc;
            if ((c & 3) == 3 && (c >> 2) + 1 < 64) imp[(c >> 2) + 1] += pc;
#pragma unroll
            for (int d = 0; d < 64; ++d) o[d] += bfr(pc) * bfr(vc[c * 64 + d]);
        }
#pragma unroll
        for (int d = 0; d < 64; ++d) nsa[hl * 64 + d] = gt24[head] * o[d];
    }
    const int cur = t >> 6;
    for (int j = 0; j < 64; ++j) { float v = imp[j]; if (j == 0 || j == cur || j == cur - 1) v = 1e6f; if (j > cur) v = -1e30f; imp[j] = v; }
    unsigned long long selmask = 0ull;
    for (int it = 0; it < 16; ++it) {
        int bi = -1; float bv = -3e38f;
        for (int j = 0; j < 64; ++j) if (!((selmask >> j) & 1ull) && imp[j] > bv) { bv = imp[j]; bi = j; }
        selmask |= 1ull << bi;
    }
    bool f = false;
    for (int hl = 0; hl < 4; ++hl) {
        const int head = g * 4 + hl;
        const bf16_t* Q = (const bf16_t*)(ws + WS_Q) + ((size_t)(b * 8 + head) * SEQ + t) * 64;
        const bf16_t* K = (const bf16_t*)(ws + WS_KSLC) + (size_t)bg * SEQ * 64;
        const bf16_t* Vt = (const bf16_t*)(ws + WS_VSLCT) + (size_t)bg * 64 * SEQ;
        float q[64], o[64];
#pragma unroll
        for (int d = 0; d < 64; ++d) { q[d] = bfv(Q, d); o[d] = 0.f; }
        float m = -1e30f, l = 0.f;
        for (int j = 0; j <= cur; ++j) if ((selmask >> j) & 1ull) {
            for (int kk = 0; kk < 64; ++kk) {
                const int pos = j * 64 + kk;
                if (pos > t) break;
                float s = 0.f;
#pragma unroll
                for (int d = 0; d < 64; ++d) s += q[d] * bfv(K, (size_t)pos * 64 + d);
                s += p.in[2][rel_bucket_dev(t - pos) * 8 + head];
                const float mn = fmaxf(m, s), a = expf(m - mn), pp = expf(s - mn);
                l = l * a + pp;
#pragma unroll
                for (int d = 0; d < 64; ++d) o[d] = o[d] * a + pp * bfv(Vt, (size_t)d * SEQ + pos);
                m = mn;
            }
        }
#pragma unroll
        for (int d = 0; d < 64; ++d) {
            const float ref = nsa[hl * 64 + d] + gt24[8 + head] * o[d] / l + bfv((const bf16_t*)(ws + WS_OWIN), (size_t)tok * 512 + head * 64 + d);
            f |= bad(bfv((const bf16_t*)(ws + WS_MIXIN), (size_t)tok * 1024 + head * 64 + d), ref);
        }
    }
    if (f) dfail(p, bit);
}
DI void chk5(const Params& p, int bit) {
    unsigned char* ws = p.ws;
    const unsigned gt = blockIdx.x * NTHREADS + threadIdx.x;
    if (gt >= 8192) return;
    const int tok = hsh(gt + 11) & 16383, col = hsh(gt + 13) & 511, gi = col >> 7, d = col & 127, t = tok & 4095;
    const bf16_t* yp = (const bf16_t*)(ws + WS_YPOOL);
    const bf16_t* pw = (const bf16_t*)(ws + WS_POOLWT);
    const bf16_t* z = (const bf16_t*)(ws + WS_Z);
    float ref = 0.f, ref2 = 0.f;
    for (int c = 0; c < 128; ++c) {
        ref += bfv(yp, (size_t)tok * 512 + gi * 128 + c) * bfv(pw, (size_t)gi * 16384 + d * 128 + c);
        ref2 += bfv(yp, (size_t)tok * 512 + gi * 128 + c) * p.in[9][(size_t)gi * 16384 + c * 128 + d];
    }
    if (!(fabsf(ref - ref2) <= 0.03f)) dfail(p, bit);
    ref *= p.in[10][col];
    if (bad(bfv((const bf16_t*)(ws + WS_MIXIN), (size_t)tok * 1024 + 512 + col), ref)) dfail(p, bit);
    const int win = 2 << (col >> 7), cnt = (t + 1 < win) ? t + 1 : win;
    float s = 0.f;
    for (int k = 0; k < cnt; ++k) s += bfv(z, (size_t)(tok - k) * 512 + col);
    if (bad(bfv(yp, (size_t)tok * 512 + col), s / (float)cnt - bfv(z, (size_t)tok * 512 + col))) dfail(p, bit);
}
DI void chk6(const Params& p, int bit) {
    unsigned char* ws = p.ws;
    const unsigned gt = blockIdx.x * NTHREADS + threadIdx.x;
    if (gt >= 128) return;
    const int tok = hsh(gt + 17) & 16383;
    float* yb = (float*)(ws + WS_DSCR) + (size_t)gt * 1024;
    const bf16_t* mx = (const bf16_t*)(ws + WS_MIXIN) + (size_t)tok * 1024;
    const bf16_t* wo = (const bf16_t*)(ws + WS_WOUTT);
    float sm = 0.f;
    bool f = false;
    for (int n = 0; n < 1024; ++n) {
        float s = 0.f, s2 = 0.f;
        for (int k = 0; k < 1024; ++k) { s += bfv(mx, k) * bfv(wo, (size_t)n * 1024 + k); if (n < 8) s2 += bfv(mx, k) * p.in[11][(size_t)k * 1024 + n]; }
        if (n < 8 && !(fabsf(s - s2) <= 0.03f)) f = true;
        yb[n] = ALPHA * p.in[0][(size_t)tok * 1024 + n] + s; sm += yb[n];
    }
    const float mean = sm / 1024.f;
    float v = 0.f;
    for (int n = 0; n < 1024; ++n) v += (yb[n] - mean) * (yb[n] - mean);
    const float rstd = 1.f / sqrtf(v / 1024.f + LN_EPS);
    for (int n = 0; n < 1024; ++n)
        f |= bad(bfv((const bf16_t*)(ws + WS_H1), (size_t)tok * 1024 + n), (yb[n] - mean) * rstd * p.in[12][n] + p.in[13][n]);
    if (f) dfail(p, bit);
}
DI void chk7(const Params& p, int bit) {
    unsigned char* ws = p.ws;
    const unsigned gt = blockIdx.x * NTHREADS + threadIdx.x;
    if (gt >= 512) return;
    const int tok = hsh(gt + 23) & 16383, head = gt & 7, half = (gt >> 3) & 1;
    float* qd = (float*)(ws + WS_DSCR) + (size_t)gt * 256;
    float* sv = qd + 128;
    const bf16_t* h1 = (const bf16_t*)(ws + WS_H1) + (size_t)tok * 1024;
    const bf16_t* wq = (const bf16_t*)(ws + WS_WQT);
    const bf16_t* sk = (const bf16_t*)(ws + WS_SUBK);
    bool f = false;
    for (int d = 0; d < 128; ++d) {
        float s = 0.f, s2 = 0.f;
        const int col = head * 256 + half * 128 + d;
        for (int k = 0; k < 1024; ++k) { s += bfv(h1, k) * bfv(wq, (size_t)col * 1024 + k); if (d < 4) s2 += bfv(h1, k) * p.in[14][(size_t)k * 2048 + col]; }
        if (d < 4 && !(fabsf(s - s2) <= 0.06f)) f = true;
        qd[d] = bfr(s);
    }
    for (int key = 0; key < 128; ++key) {
        float s = 0.f, s2 = 0.f;
        for (int d = 0; d < 128; ++d) { s += qd[d] * bfv(sk, (size_t)(half * 128 + key) * 128 + d); s2 += qd[d] * p.in[15][(size_t)(half * 128 + key) * 128 + d]; }
        if (!(fabsf(s - s2) <= 0.05f)) f = true;
        sv[key] = s;
    }
    int mism = 0;
    const int* L = (const int*)(ws + WS_TOPK) + (((size_t)tok * 8 + head) * 2 + half) * 16;
    for (int it = 0; it < 16; ++it) {
        int bi = 0; float bv = -3e38f;
        for (int k = 0; k < 128; ++k) if (sv[k] > bv) { bv = sv[k]; bi = k; }
        sv[bi] = -3e38f;
        const int fk = L[it];
        if ((fk & 127) != bi) mism++;
        if (bad(key_val(fk), bv)) mism += 10;
    }
    if (mism > 1 || f) dfail(p, bit);
}
DI void chk8(const Params& p, int bit) {
    unsigned char* ws = p.ws;
    const unsigned gt = blockIdx.x * NTHREADS + threadIdx.x;
    if (gt >= 128) return;
    const int tok = hsh(gt + 31) & 16383;
    float* acc = (float*)(ws + WS_DSCR) + (size_t)gt * 4096;
    float* cand = acc + 1024;
    int* csel = (int*)(acc + 1024 + 256);
    float* acc2 = acc + 2048;
    const bf16_t* h1 = (const bf16_t*)(ws + WS_H1) + (size_t)tok * 1024;
    const bf16_t* ub = (const bf16_t*)(ws + WS_UB);
    const bf16_t* vb = (const bf16_t*)(ws + WS_VB);
    const int* dE = (const int*)(ws + WS_MIXIN) + (size_t)tok * 256;
    const float* dG = (const float*)dE + 128;
    bool f = false, froute = false, fg = false;
    for (int n = 0; n < 1024; ++n) { acc[n] = 0.f; acc2[n] = 0.f; }
    for (int hd = 0; hd < 8; ++hd) {
        const int* L = (const int*)(ws + WS_TOPK) + (size_t)tok * 256 + hd * 32;
        for (int i = 0; i < 16; ++i) for (int j = 0; j < 16; ++j) cand[i * 16 + j] = key_val(L[i]) + key_val(L[16 + j]);
        float mx = -3e38f, den = 0.f;
        for (int it = 0; it < 16; ++it) {
            int bi = 0; float bv = -3e38f;
            for (int k = 0; k < 256; ++k) if (cand[k] > bv) { bv = cand[k]; bi = k; }
            cand[bi] = -3e38f; csel[it] = bi;
            if (it == 0) mx = bv;
            ((float*)csel)[16 + it] = expf(bv - mx); den += expf(bv - mx);
        }
        for (int it = 0; it < 16; ++it) {
            const int i = csel[it] >> 4, j = csel[it] & 15;
            const size_t e = (size_t)(L[i] & 127) * 128 + (L[16 + j] & 127);
            float dot = 0.f;
            for (int k = 0; k < 1024; ++k) dot += bfv(h1, k) * bfv(ub, e * 1024 + k);
            const float gate = ((float*)csel)[16 + it] / den;
            const float w = gate * gelu_erf(dot);
            for (int n = 0; n < 1024; ++n) acc[n] += w * bfv(vb, e * 1024 + n);
            bool found = false;
            for (int s = 0; s < 16; ++s) if (dE[hd * 16 + s] == (int)e) { found = true; if (!(fabsf(dG[hd * 16 + s] - gate) <= 1e-3f)) fg = true; }
            if (!found) froute = true;
        }
        for (int s = 0; s < 16; ++s) {
            const size_t e = (size_t)dE[hd * 16 + s];
            if (e >= 16384) { froute = true; continue; }
            float dot = 0.f;
            for (int k = 0; k < 1024; ++k) dot += bfv(h1, k) * bfv(ub, e * 1024 + k);
            const float w = dG[hd * 16 + s] * gelu_erf(dot);
            for (int n = 0; n < 1024; ++n) acc2[n] += w * bfv(vb, e * 1024 + n);
        }
    }
    bool f2 = false;
    for (int pass = 0; pass < 2; ++pass) {
        float* a = pass ? acc2 : acc;
        float sm = 0.f;
        for (int n = 0; n < 1024; ++n) { a[n] += ALPHA * bfv(h1, n); sm += a[n]; }
        const float mean = sm / 1024.f;
        float v = 0.f;
        for (int n = 0; n < 1024; ++n) v += (a[n] - mean) * (a[n] - mean);
        const float rstd = 1.f / sqrtf(v / 1024.f + LN_EPS);
        for (int n = 0; n < 1024; ++n) {
            const bool b = bad(p.out[(size_t)tok * 1024 + n], (a[n] - mean) * rstd * p.in[18][n] + p.in[19][n]);
            if (pass) f2 |= b; else f |= b;
        }
    }
    if (f) dfail(p, bit);
    if (froute) dfail(p, bit + 1);
    if (fg) dfail(p, bit + 2);
    if (f2) dfail(p, bit + 3);
}
#endif

__global__ void __launch_bounds__(NTHREADS, 2) hybrid_fwd(Params p) {
    extern __shared__ __attribute__((aligned(16))) unsigned char lds[];
    cg::grid_group grid = cg::this_grid();
    const int lo = p.ph_lo, hi = p.ph_hi;
    volatile unsigned* bst = (volatile unsigned*)(lds + LDS_MAIN);
    if (threadIdx.x < 2) bst[threadIdx.x] = 0u;
    __syncthreads();
    XcdBarrier xbar = xcd_barrier_post((unsigned*)(p.ws + WS_BAR), bst);
#define IN(k) (lo <= (k) && (k) < hi)
#define SEAM(k) do { if (IN(k) && IN((k) + 1 + ((k) == 4))) xcd_barrier(xbar); } while (0)
    if (lo < 0) grid.sync();
#if DIAG
    if (blockIdx.x == 0 && threadIdx.x == 0) *(unsigned*)(p.ws + WS_FLAG) = 0u;
#endif
    if (IN(0)) phase0(p, lds);
    SEAM(0);
    if (IN(1)) phase1(p, lds);
    SEAM(1);
#if DIAG == 1
    chk1(p, 0);
#endif
    if (IN(2)) phase2(p, lds);
    SEAM(2);
#if DIAG == 1
    chk2(p, 1); chk3(p, 2);
#endif
    if (IN(3)) phase3(p, lds);
    SEAM(3);
#if DIAG == 1
    chk4(p, 3); chk5(p, 4);
#endif
    if (IN(4)) phase4(p, lds);
    SEAM(4);
#if DIAG == 1
    chk6(p, 5);
#endif
    if (IN(6)) phase6(p, lds);
    SEAM(6);
#if DIAG == 2
    chk7(p, 0);
#endif
    if (IN(7)) phase7(p, lds);
#if DIAG
    grid.sync();
#if DIAG == 2
    chk8(p, 1);
    grid.sync();
#endif
    {
        const unsigned code = *(volatile unsigned*)(p.ws + WS_FLAG);
        const float kv = sqrtf((float)code);
        for (size_t i = (size_t)blockIdx.x * NTHREADS + threadIdx.x; i < (size_t)NTOK * DM; i += (size_t)gridDim.x * NTHREADS) p.out[i] = kv;
    }
#endif
#undef IN
#undef SEAM
}

extern "C" void kernel_launch(void* const* d_in, const int* in_sizes, int n_in, void* d_out, int out_size, void* d_ws, size_t ws_size,
                              hipStream_t stream) {
    static int grid_blocks = 0;
    if (grid_blocks == 0) {
        if (n_in != 20 || ws_size < WS_END) { fprintf(stderr, "kernel_launch: unexpected inputs (n_in %d, ws %zu)\n", n_in, ws_size); grid_blocks = -1; return; }
        int dev = 0, cus = 0, per_cu = 0;
        hipGetDevice(&dev);
        hipDeviceGetAttribute(&cus, hipDeviceAttributeMultiprocessorCount, dev);
        hipFuncSetAttribute((const void*)hybrid_fwd, hipFuncAttributeMaxDynamicSharedMemorySize, LDS_BYTES);
        hipOccupancyMaxActiveBlocksPerMultiprocessor(&per_cu, (const void*)hybrid_fwd, NTHREADS, LDS_BYTES);
        if (per_cu < 1) per_cu = 1;
        if (per_cu > 2) per_cu = 2;
        grid_blocks = cus * per_cu;
        (void)hipGetLastError();
    }
    if (grid_blocks < 0) return;
    (void)hipMemsetAsync((char*)d_ws + WS_BAR, 0, WS_BAR_BYTES, stream);
    Params p{};
    for (int i = 0; i < 20; ++i) p.in[i] = (const float*)d_in[i];
    p.out = (float*)d_out; p.ws = (unsigned char*)d_ws;
#if N_LAUNCH_MODE == 1
    p.ph_lo = 0; p.ph_hi = 8;
    void* args[] = {&p};
    hipError_t e = hipLaunchCooperativeKernel((const void*)hybrid_fwd, dim3(grid_blocks), dim3(NTHREADS), args, LDS_BYTES, stream);
    if (e != hipSuccess) fprintf(stderr, "cooperative launch failed: %s (grid %d)\n", hipGetErrorString(e), grid_blocks);
#else
    for (int ph = 0; ph < 8; ++ph) {
        p.ph_lo = ph; p.ph_hi = ph + 1;
        hipLaunchKernelGGL(hybrid_fwd, dim3(grid_blocks), dim3(NTHREADS), LDS_BYTES, stream, p);
    }
#endif
}
```

```cpp
#include <hip/hip_runtime.h>
#include <hip/hip_cooperative_groups.h>
#include <cstdint>
#include <cstdio>
namespace cg = cooperative_groups;

#ifndef N_LAUNCH_MODE
#define N_LAUNCH_MODE 1
#endif

typedef unsigned short bf16_t;
typedef short bf16x8 __attribute__((ext_vector_type(8)));
typedef short s16x4 __attribute__((ext_vector_type(4)));
typedef long i64x2 __attribute__((ext_vector_type(2)));
typedef unsigned u32x6 __attribute__((ext_vector_type(6)));
typedef _Float16 f16x32 __attribute__((ext_vector_type(32)));
typedef _Float16 f16x2_t __attribute__((ext_vector_type(2)));
typedef float f32x32 __attribute__((ext_vector_type(32)));
typedef float f32x16 __attribute__((ext_vector_type(16)));
typedef float f32x4 __attribute__((ext_vector_type(4)));
typedef unsigned u32x4 __attribute__((ext_vector_type(4)));
typedef unsigned u32x2 __attribute__((ext_vector_type(2)));
typedef float f32x2 __attribute__((ext_vector_type(2)));
typedef __bf16 bf16x2_t __attribute__((ext_vector_type(2)));

#define DI __device__ __forceinline__
#define MFMA32(a, b, c) __builtin_amdgcn_mfma_f32_32x32x16_bf16((a), (b), (c), 0, 0, 0)

constexpr int NTOK = 16384, SEQ = 4096, DM = 1024;
constexpr int NINP = 1920;
constexpr float ALPHA = 1.189207115002721f;
constexpr float LN_EPS = 1e-5f;
constexpr float LOG2E = 1.4426950408889634f;
constexpr float QSCALE = 0.125f * LOG2E;
constexpr int NTHREADS = 256;
constexpr int LDS_MAIN = 73728;
constexpr int LDS_CST = LDS_MAIN + 64;
constexpr int LDS_BYTES = LDS_MAIN + 64 + 2048;
constexpr int ROWB = 144;

constexpr size_t MiB = 1u << 20;
constexpr size_t WS_BAR = 0;
constexpr size_t WS_BAR_BYTES = 16384;
constexpr size_t WS_KCMP = 1 * MiB;
constexpr size_t WS_VCMP = 1 * MiB + 512 * 1024;
constexpr size_t WS_W2TK = 2 * MiB;
constexpr size_t WS_W2TV = 2 * MiB + 32 * 1024;
constexpr size_t WS_POOLWT = 2 * MiB + 64 * 1024;
constexpr size_t WS_SUBK = 2 * MiB + 192 * 1024;
constexpr size_t WS_PEBK = 2 * MiB + 256 * 1024;
constexpr size_t WS_PEBV = 2 * MiB + 257 * 1024;
constexpr size_t WS_BUCK = 2 * MiB + 258 * 1024;
constexpr size_t WS_USCALE = 2 * MiB + 320 * 1024;
constexpr size_t WS_VSCALE = 2 * MiB + 384 * 1024;
constexpr size_t WS_C1 = 2 * MiB + 448 * 1024;
constexpr size_t WS_C2 = 2 * MiB + 456 * 1024;
constexpr size_t WS_LNST = 15 * MiB;
constexpr size_t WS_SX = 2 * MiB + 464 * 1024;
constexpr size_t WS_SW = 2 * MiB + 528 * 1024;
constexpr size_t WS_W1TK = 3 * MiB;
constexpr size_t WS_W1TV = 4 * MiB;
constexpr size_t WS_WINT = 5 * MiB;
constexpr size_t WS_WOUTT = 9 * MiB;
constexpr size_t WS_WQT = 11 * MiB;
constexpr size_t WS_UB = 16 * MiB;
constexpr size_t WS_VB = 48 * MiB;
constexpr size_t WS_XB = 80 * MiB;
constexpr size_t WS_MIXIN = WS_XB;
constexpr size_t WS_Q = 112 * MiB;
constexpr size_t WS_KC = 128 * MiB;
constexpr size_t WS_VC = 132 * MiB;
constexpr size_t WS_KSLC = 136 * MiB;
constexpr size_t WS_KWIN = 140 * MiB;
constexpr size_t WS_VSLCT = 144 * MiB;
constexpr size_t WS_VWINT = 148 * MiB;
constexpr size_t WS_GATES = 152 * MiB;
constexpr size_t WS_Z = 154 * MiB;
constexpr size_t WS_YPOOL = 170 * MiB;
constexpr size_t WS_OWIN = 186 * MiB;
#ifndef DIAG
#define DIAG 0
#endif
#if DIAG
constexpr size_t WS_H1 = 202 * MiB;
constexpr size_t WS_TOPK = 234 * MiB;
constexpr size_t WS_END = 256 * MiB;
constexpr size_t WS_FLAG = 32768;
constexpr size_t WS_DSCR = 250 * MiB;
#else
constexpr size_t WS_H1 = 112 * MiB;
constexpr size_t WS_TOPK = 112 * MiB;
constexpr size_t WS_END = 202 * MiB;
#endif

struct Params { const float* in[20]; float* out; unsigned char* ws; int ph_lo, ph_hi; };

DI unsigned f2bf(float f) { unsigned u = __float_as_uint(f); return (u + 0x7fffu + ((u >> 16) & 1u)) >> 16; }
DI unsigned pk2(float lo, float hi) { bf16x2_t v = {(__bf16)lo, (__bf16)hi}; return __builtin_bit_cast(unsigned, v); }
DI float bflo(unsigned x) { return __uint_as_float(x << 16); }
DI float bfhi(unsigned x) { return __uint_as_float(x & 0xffff0000u); }
DI float dot2bf(unsigned a, unsigned b, float acc) {
    asm("v_dot2c_f32_bf16 %0, %1, %2" : "+v"(acc) : "v"(a), "v"(b));
    return acc;
}
DI int dot4i8(unsigned a, unsigned b, int acc) {
    return __builtin_amdgcn_sdot4((int)a, (int)b, acc, false);
}
DI float gelu_erf(float x) { return 0.5f * x * (1.0f + erff(x * 0.70710678118654752f)); }
DI float gelu_fast(float v) {
    const float av = fabsf(v), t = __builtin_amdgcn_rcpf(av * 0.2316418882f + 1.0f);
    float q = t * 0.5307027145f + (-0.7265760135f); q = q * t + 0.7107068705f; q = q * t + (-0.142248368f); q = q * t + 0.127414796f; q = q * t;
    const float e = __builtin_amdgcn_exp2f((v * v) * (-0.72134752044f));
    const float m = v * (q * e);
    return v < 0.f ? m : v - m;
}
DI float wave_sum(float v) {
#pragma unroll
    for (int o = 32; o >= 1; o >>= 1) v += __shfl_xor(v, o);
    return v;
}
DI int rel_bucket_dev(int dist) {
    if (dist < 0) dist = 0;
    if (dist < 16) return dist;
    int v = 16 + (int)(logf((float)dist / 16.0f) / logf(8.0f) * 16.0f);
    return v < 31 ? v : 31;
}
DI int make_key(float f, int idx) { int b = __float_as_int(f); b ^= (b >> 31) & 0x7fffffff; return (b & ~127) | idx; }
DI float key_val(int k) { int b = k & ~127; b ^= (b >> 31) & 0x7fffffff; return __int_as_float(b); }


#define LAS __attribute__((address_space(3)))
#define XB_TMO      128
#define XB_XCNT(j)  (256  + 64 * (j))
#define XB_XSUB(j)  (1280 + 64 * (j))
#define XB_XGEN(j)  (2304 + 64 * (j))
#define XB_TOP      3328
#define XB_TOPGEN   3392
#define XCD_BAR_WORDS 3456
#define XB_SPIN_CAP (1u << 20)
DI unsigned xb_ld(unsigned* p)              { return __hip_atomic_load(p, __ATOMIC_RELAXED, __HIP_MEMORY_SCOPE_AGENT); }
DI unsigned xb_add(unsigned* p, unsigned v) { return __hip_atomic_fetch_add(p, v, __ATOMIC_RELAXED, __HIP_MEMORY_SCOPE_AGENT); }
DI unsigned xb_xcc_id() { return (unsigned)__builtin_amdgcn_s_getreg((3 << 11) | 20) & 0xFu; }
#define XB_SPIN(cond, bar) do { unsigned _sp = 0; while (cond) { __builtin_amdgcn_s_sleep(1); \
    if ((++_sp & 255u) == 0u) { if (xb_ld(&(bar)[XB_TMO])) break; if (_sp > XB_SPIN_CAP) { atomicAdd(&(bar)[XB_TMO], 1u); break; } } } } while (0)
struct XcdBarrier { unsigned* bar; unsigned x; volatile unsigned* st; };
DI XcdBarrier xcd_barrier_post(unsigned* bar, volatile unsigned* st) {
    XcdBarrier b; b.bar = bar; b.x = xb_xcc_id(); b.st = st;
    if (threadIdx.x == 0) (void)xb_add(&bar[XB_XCNT(b.x)], 1u);
    return b;
}
DI void xcd_barrier_complete(unsigned* bar, unsigned x, unsigned& nloc, unsigned& nx) {
    const unsigned G = gridDim.x * gridDim.y * gridDim.z;
    unsigned sum, cnt, mine, sp = 0u;
    for (;;) {
        sum = 0u; cnt = 0u; mine = 0u;
#pragma unroll
        for (unsigned j = 0; j < 16; ++j) { const unsigned c = xb_ld(&bar[XB_XCNT(j)]); sum += c; cnt += (c > 0u) ? 1u : 0u; mine = (j == x) ? c : mine; }
        if (sum == G) break;
        __builtin_amdgcn_s_sleep(1);
        if ((++sp & 255u) == 0u) { if (xb_ld(&bar[XB_TMO])) break; if (sp > XB_SPIN_CAP) { atomicAdd(&bar[XB_TMO], 1u); break; } }
    }
    nloc = mine > 0u ? mine : 1u; nx = cnt > 0u ? cnt : 1u;
}
DI void xcd_barrier(const XcdBarrier& b) {
    asm volatile("s_waitcnt vmcnt(0)" ::: "memory");
    __syncthreads();
    if (threadIdx.x == 0) {
        unsigned* bar = b.bar;
        __builtin_amdgcn_s_waitcnt(0);
        unsigned nloc = b.st[0], nx = b.st[1];
        if (nloc == 0u) { xcd_barrier_complete(bar, b.x, nloc, nx); b.st[0] = nloc; b.st[1] = nx; }
        const unsigned old = xb_add(&bar[XB_XSUB(b.x)], 1u);
        const unsigned gen = old / nloc;
        if (old + 1u == (gen + 1u) * nloc) {
            __builtin_amdgcn_fence(__ATOMIC_RELEASE, "agent");
            asm volatile("s_waitcnt vmcnt(0)" ::: "memory");
            const unsigned og = xb_add(&bar[XB_TOP], 1u);
            const unsigned tg = og / nx;
            if (og + 1u == (tg + 1u) * nx) xb_add(&bar[XB_TOPGEN], 1u);
            else XB_SPIN(xb_ld(&bar[XB_TOPGEN]) == tg, bar);
            __builtin_amdgcn_fence(__ATOMIC_ACQUIRE, "agent");
            xb_add(&bar[XB_XGEN(b.x)], 1u);
            asm volatile("s_waitcnt vmcnt(0)" ::: "memory");
        } else {
            XB_SPIN(xb_ld(&bar[XB_XGEN(b.x)]) == gen, bar);
            __builtin_amdgcn_fence(__ATOMIC_ACQUIRE, "agent");
            asm volatile("s_waitcnt vmcnt(0)" ::: "memory");
        }
    }
    __syncthreads();
}

template <int MI>
DI void gemm_mainloop_t(const bf16_t* __restrict__ A, int lda, const bf16_t* __restrict__ Bt, int ldb, int K,
                        f32x16 (&acc)[MI][2], unsigned char* lds) {
    const int tid = threadIdx.x, lane = tid & 63, wid = __builtin_amdgcn_readfirstlane(tid >> 6);
    const int wr = wid >> 1, wc = wid & 1, r = lane & 31, h = lane >> 5;
    LAS unsigned char* As = (LAS unsigned char*)lds;
    LAS unsigned char* Bs = (LAS unsigned char*)lds + 2 * 16384;
#pragma unroll
    for (int mi = 0; mi < MI; ++mi)
#pragma unroll
        for (int ni = 0; ni < 2; ++ni)
#pragma unroll
            for (int i = 0; i < 16; ++i) acc[mi][ni][i] = 0.f;
    const int nk = K >> 6;
    const int prow = 8 * wid + (lane >> 3);
    const int pchunk = (lane & 7) ^ ((prow >> 1) & 7);
    const bf16_t* Ap = A + (size_t)prow * lda + pchunk * 8;
    const bf16_t* Bp = Bt + (size_t)prow * ldb + pchunk * 8;
    const int pl = wid * 1024;
#define GEMM_STAGE(buf, kt) do { \
        _Pragma("unroll") for (int i = 0; i < 2 * MI; ++i) __builtin_amdgcn_global_load_lds((const unsigned*)(Ap + (size_t)(32 * i) * lda + (kt) * 64), (LAS unsigned*)(As + (buf) * 16384 + i * 4096 + pl), 16, 0, 0); \
        _Pragma("unroll") for (int i = 0; i < 4; ++i) __builtin_amdgcn_global_load_lds((const unsigned*)(Bp + (size_t)(32 * i) * ldb + (kt) * 64), (LAS unsigned*)(Bs + (buf) * 16384 + i * 4096 + pl), 16, 0, 0); } while (0)
    GEMM_STAGE(0, 0);
    asm volatile("s_waitcnt vmcnt(0)" ::: "memory");
    __syncthreads();
    const int swz = (r >> 1) & 7;
    for (int kt = 0; kt < nk; ++kt) {
        const int cur = kt & 1;
        if (kt + 1 < nk) GEMM_STAGE(cur ^ 1, kt + 1);
        const LAS unsigned char* Ac = As + cur * 16384 + (wr * 32 * MI + r) * 128;
        const LAS unsigned char* Bc = Bs + cur * 16384 + (wc * 64 + r) * 128;
        __builtin_amdgcn_s_setprio(1);
#pragma unroll
        for (int ks = 0; ks < 4; ++ks) {
            const int co = ((ks * 2 + h) ^ swz) * 16;
            bf16x8 fa[MI], fb[2];
#pragma unroll
            for (int mi = 0; mi < MI; ++mi) fa[mi] = *(const LAS bf16x8*)(Ac + mi * 32 * 128 + co);
#pragma unroll
            for (int ni = 0; ni < 2; ++ni) fb[ni] = *(const LAS bf16x8*)(Bc + ni * 32 * 128 + co);
#pragma unroll
            for (int mi = 0; mi < MI; ++mi)
#pragma unroll
                for (int ni = 0; ni < 2; ++ni) acc[mi][ni] = MFMA32(fb[ni], fa[mi], acc[mi][ni]);
        }
        __builtin_amdgcn_s_setprio(0);
        asm volatile("s_waitcnt vmcnt(0)" ::: "memory");
        __syncthreads();
    }
#undef GEMM_STAGE
}
DI void gemm_mainloop_f8(const unsigned char* __restrict__ A, int lda, const unsigned char* __restrict__ Bt, int ldb, int K,
                         f32x16 (&acc)[2][2], unsigned char* lds) {
    constexpr int MI = 2;
    const int tid = threadIdx.x, lane = tid & 63, wid = __builtin_amdgcn_readfirstlane(tid >> 6);
    const int wr = wid >> 1, wc = wid & 1, r = lane & 31, h = lane >> 5;
    LAS unsigned char* As = (LAS unsigned char*)lds;
    LAS unsigned char* Bs = (LAS unsigned char*)lds + 2 * 16384;
#pragma unroll
    for (int mi = 0; mi < MI; ++mi)
#pragma unroll
        for (int ni = 0; ni < 2; ++ni)
#pragma unroll
            for (int i = 0; i < 16; ++i) acc[mi][ni][i] = 0.f;
    const int nk = K >> 7;
    const int prow = 8 * wid + (lane >> 3);
    const int pchunk = (lane & 7) ^ ((prow >> 1) & 7);
    const unsigned char* Ap = A + (size_t)prow * lda + pchunk * 16;
    const unsigned char* Bp = Bt + (size_t)prow * ldb + pchunk * 16;
    const int pl = wid * 1024;
#define GEMM_STAGE(buf, kt) do { \
        _Pragma("unroll") for (int i = 0; i < 2 * MI; ++i) __builtin_amdgcn_global_load_lds((const unsigned*)(Ap + (size_t)(32 * i) * lda + (kt) * 128), (LAS unsigned*)(As + (buf) * 16384 + i * 4096 + pl), 16, 0, 0); \
        _Pragma("unroll") for (int i = 0; i < 4; ++i) __builtin_amdgcn_global_load_lds((const unsigned*)(Bp + (size_t)(32 * i) * ldb + (kt) * 128), (LAS unsigned*)(Bs + (buf) * 16384 + i * 4096 + pl), 16, 0, 0); } while (0)
    GEMM_STAGE(0, 0);
    asm volatile("s_waitcnt vmcnt(0)" ::: "memory");
    __syncthreads();
    const int swz = (r >> 1) & 7;
    for (int kt = 0; kt < nk; ++kt) {
        const int cur = kt & 1;
        if (kt + 1 < nk) GEMM_STAGE(cur ^ 1, kt + 1);
        const LAS unsigned char* Ac = As + cur * 16384 + (wr * 32 * MI + r) * 128;
        const LAS unsigned char* Bc = Bs + cur * 16384 + (wc * 64 + r) * 128;
        __builtin_amdgcn_s_setprio(1);
#pragma unroll
        for (int ks = 0; ks < 4; ++ks) {
            const int co = ((ks * 2 + h) ^ swz) * 16;
            i64x2 fa[MI], fb[2];
#pragma unroll
            for (int mi = 0; mi < MI; ++mi) fa[mi] = *(const LAS i64x2*)(Ac + mi * 32 * 128 + co);
#pragma unroll
            for (int ni = 0; ni < 2; ++ni) fb[ni] = *(const LAS i64x2*)(Bc + ni * 32 * 128 + co);
#pragma unroll
            for (int mi = 0; mi < MI; ++mi)
#pragma unroll
                for (int ni = 0; ni < 2; ++ni) { acc[mi][ni] = __builtin_amdgcn_mfma_f32_32x32x16_fp8_fp8(fb[ni].x, fa[mi].x, acc[mi][ni], 0, 0, 0);
                    acc[mi][ni] = __builtin_amdgcn_mfma_f32_32x32x16_fp8_fp8(fb[ni].y, fa[mi].y, acc[mi][ni], 0, 0, 0); }
        }
        __builtin_amdgcn_s_setprio(0);
        asm volatile("s_waitcnt vmcnt(0)" ::: "memory");
        __syncthreads();
    }
#undef GEMM_STAGE
}
DI void gemm_mainloop(const bf16_t* __restrict__ A, int lda, const bf16_t* __restrict__ Bt, int ldb, int K,
                      f32x16 (&acc)[2][2], unsigned char* lds) { gemm_mainloop_t<2>(A, lda, Bt, ldb, K, acc, lds); }

template <int MI, class F> DI void epi_foreach_t(const f32x16 (&acc)[MI][2], F f) {
    const int tid = threadIdx.x, lane = tid & 63, wid = tid >> 6;
    const int wr = wid >> 1, wc = wid & 1, r = lane & 31, h = lane >> 5;
#pragma unroll
    for (int mi = 0; mi < MI; ++mi)
#pragma unroll
        for (int ni = 0; ni < 2; ++ni)
#pragma unroll
            for (int grp = 0; grp < 4; ++grp) {
                f32x4 v = {acc[mi][ni][4 * grp], acc[mi][ni][4 * grp + 1], acc[mi][ni][4 * grp + 2], acc[mi][ni][4 * grp + 3]};
                f(wr * 32 * MI + mi * 32 + r, wc * 64 + ni * 32 + 8 * grp + 4 * h, v);
            }
}
template <class F> DI void epi_foreach(const f32x16 (&acc)[2][2], F f) { epi_foreach_t<2>(acc, f); }

template <class S> DI void epi_stage_rows(const f32x16 (&acc)[2][2], unsigned char* lds, S colscale) {
    epi_foreach(acc, [&](int m, int n, f32x4 v) {
        const f32x4 s = colscale(n);
        u32x2 o = {pk2(v.x * s.x, v.y * s.y), pk2(v.z * s.z, v.w * s.w)};
        *(u32x2*)(lds + m * 272 + n * 2) = o;
    });
}
DI void epi_stage_cols(const f32x16 (&acc)[2][2], unsigned char* lds) {
    epi_foreach(acc, [&](int m, int n, f32x4 v) {
        *(bf16_t*)(lds + (n + 0) * 272 + m * 2) = (bf16_t)f2bf(v.x); *(bf16_t*)(lds + (n + 1) * 272 + m * 2) = (bf16_t)f2bf(v.y);
        *(bf16_t*)(lds + (n + 2) * 272 + m * 2) = (bf16_t)f2bf(v.z); *(bf16_t*)(lds + (n + 3) * 272 + m * 2) = (bf16_t)f2bf(v.w);
    });
}
template <class F> DI void rows_foreach(const unsigned char* lds, F f) {
    const int tid = threadIdx.x;
#pragma unroll
    for (int i = 0; i < 8; ++i) {
        const int c = tid + 256 * i, m = c >> 4, cc = c & 15;
        f(m, cc, *(const u32x4*)(lds + m * 272 + cc * 16));
    }
}

DI void cvt_rows(const float* __restrict__ src, bf16_t* __restrict__ dst, size_t n8, size_t gtid, size_t gstride) {
    for (size_t i = gtid; i < n8; i += gstride) {
        f32x4 a = ((const f32x4*)src)[2 * i], b = ((const f32x4*)src)[2 * i + 1];
        u32x4 o = {pk2(a.x, a.y), pk2(a.z, a.w), pk2(b.x, b.y), pk2(b.z, b.w)};
        ((u32x4*)dst)[i] = o;
    }
}
template <class F> DI void transpose_cvt(const float* __restrict__ in, int K, int Nin, bf16_t* __restrict__ out, int Nout, F src,
                                         size_t gtid, size_t gstride) {
    const size_t total = (size_t)Nout * (K / 8);
    for (size_t i = gtid; i < total; i += gstride) {
        const int n = (int)(i % Nout), k8 = (int)(i / Nout);
        const int s = src(n);
        float v[8];
#pragma unroll
        for (int j = 0; j < 8; ++j) v[j] = s >= 0 ? in[(size_t)(k8 * 8 + j) * Nin + s] : 0.f;
        u32x4 o = {pk2(v[0], v[1]), pk2(v[2], v[3]), pk2(v[4], v[5]), pk2(v[6], v[7])};
        *(u32x4*)(out + (size_t)n * K + k8 * 8) = o;
    }
}

DI void transpose_cvt_scaled(const float* __restrict__ in, int K, int N, bf16_t* __restrict__ out, const float* __restrict__ scale, size_t gtid, size_t gstride) {
    const size_t total = (size_t)N * (K / 8);
    for (size_t i = gtid; i < total; i += gstride) {
        const int n = (int)(i % N), k8 = (int)(i / N);
        float v[8];
#pragma unroll
        for (int j = 0; j < 8; ++j) v[j] = in[(size_t)(k8 * 8 + j) * N + n] * scale[k8 * 8 + j];
        u32x4 o = {pk2(v[0], v[1]), pk2(v[2], v[3]), pk2(v[4], v[5]), pk2(v[6], v[7])};
        *(u32x4*)(out + (size_t)n * K + k8 * 8) = o;
    }
}

DI void convert_tables(const Params& p) {
    unsigned char* ws = p.ws;
    const size_t gtid = (size_t)blockIdx.x * NTHREADS + threadIdx.x, gstride = (size_t)gridDim.x * NTHREADS;
    const int lane = threadIdx.x & 63, gw = (int)(gtid >> 6), ngw = (int)(gstride >> 6);
    {
        const int hw = lane >> 5, l32 = lane & 31;
        for (int rr = gw * 2 + hw; rr < 2 * 16384; rr += ngw * 2) {
            const int which = rr >> 14, row = rr & 16383;
            const float* src = (which ? p.in[17] : p.in[16]) + (size_t)row * 1024 + l32 * 16;
            f32x16 a, b;
            float am = 0.f;
#pragma unroll
            for (int j = 0; j < 4; ++j) {
                const f32x4 x = *(const f32x4*)(src + 4 * j), y = *(const f32x4*)(src + 512 + 4 * j);
                a[4 * j] = x.x; a[4 * j + 1] = x.y; a[4 * j + 2] = x.z; a[4 * j + 3] = x.w;
                b[4 * j] = y.x; b[4 * j + 1] = y.y; b[4 * j + 2] = y.z; b[4 * j + 3] = y.w;
                am = fmaxf(am, fmaxf(fmaxf(fabsf(x.x), fabsf(x.y)), fmaxf(fabsf(x.z), fabsf(x.w))));
                am = fmaxf(am, fmaxf(fmaxf(fabsf(y.x), fabsf(y.y)), fmaxf(fabsf(y.z), fabsf(y.w))));
            }
#pragma unroll
            for (int o = 16; o >= 1; o >>= 1) am = fmaxf(am, __shfl_xor(am, o));
            if (which) {
                const float s4 = am > 0.f ? 6.0f / am : 1.0f;
                u32x4 o = {0u, 0u, 0u, 0u};
#define PK4(dst, src, d, q) dst = __builtin_amdgcn_cvt_scalef32_pk_fp4_f32(dst, src[(d) * 8 + 2 * (q)] * s4, src[(d) * 8 + 2 * (q) + 1] * s4, 1.0f, q)
                PK4(o[0], a, 0, 0); PK4(o[0], a, 0, 1); PK4(o[0], a, 0, 2); PK4(o[0], a, 0, 3);
                PK4(o[1], a, 1, 0); PK4(o[1], a, 1, 1); PK4(o[1], a, 1, 2); PK4(o[1], a, 1, 3);
                PK4(o[2], b, 0, 0); PK4(o[2], b, 0, 1); PK4(o[2], b, 0, 2); PK4(o[2], b, 0, 3);
                PK4(o[3], b, 1, 0); PK4(o[3], b, 1, 1); PK4(o[3], b, 1, 2); PK4(o[3], b, 1, 3);
#undef PK4
                *(u32x4*)(ws + WS_VB + (size_t)row * 512 + l32 * 16) = o;
                if (l32 == 0) ((float*)(ws + WS_VSCALE))[row] = am > 0.f ? am / 6.0f : 1.0f;
                continue;
            }
            const float sc = am > 0.f ? 7.5f / am : 1.0f;
#pragma unroll
            for (int i = 0; i < 16; ++i) { a[i] *= sc; b[i] *= sc; }
            f32x16 a2, b2;
#pragma unroll
            for (int i = 0; i < 8; ++i) { a2[i] = a[2 * i]; b2[i] = a[2 * i + 1]; a2[8 + i] = b[2 * i]; b2[8 + i] = b[2 * i + 1]; }
            const u32x6 pk = __builtin_amdgcn_cvt_scalef32_2xpk16_fp6_f32(a2, b2, 1.0f);
            unsigned char* dst = ws + (which ? WS_VB : WS_UB) + (size_t)row * 768;
            *(u32x4*)(dst + l32 * 16) = (u32x4){pk[0], pk[1], pk[2], pk[3]};
            *(u32x2*)(dst + 512 + l32 * 8) = (u32x2){pk[4], pk[5]};
            if (l32 == 0) ((float*)(ws + (which ? WS_VSCALE : WS_USCALE)))[row] = am > 0.f ? am / 7.5f : 1.0f;
        }
    }
}

DI unsigned pk4_fp8(float a, float b, float c, float d) {
    int w = __builtin_amdgcn_cvt_pk_fp8_f32(a, b, 0, false);
    return (unsigned)__builtin_amdgcn_cvt_pk_fp8_f32(c, d, w, true);
}
DI void phase0(const Params& p, unsigned char* lds) {
    unsigned char* ws = p.ws;
    const size_t gtid = (size_t)blockIdx.x * NTHREADS + threadIdx.x, gstride = (size_t)gridDim.x * NTHREADS;
    for (int strip = blockIdx.x; strip < NINP / 16; strip += gridDim.x) {
        const int c = threadIdx.x & 15, kq = threadIdx.x >> 4, n = strip * 16 + c;
        const int s = n < 1280 ? n : (n < 1792 ? 1304 + (n - 1280) : (n < 1816 ? 1280 + (n - 1792) : -1));
        const float* w = p.in[1] + (size_t)(kq * 64) * 1816 + (s >= 0 ? s : 0);
        float v[64];
        float am = 0.f;
#pragma unroll
        for (int j = 0; j < 64; ++j) { v[j] = s >= 0 ? w[(size_t)j * 1816] : 0.f; am = fmaxf(am, fabsf(v[j])); }
        float* red = (float*)lds;
        red[kq * 16 + c] = am;
        __syncthreads();
        float cm = 0.f;
#pragma unroll
        for (int q = 0; q < 16; ++q) cm = fmaxf(cm, red[q * 16 + c]);
        __syncthreads();
        const float sc = cm > 0.f ? 448.0f / cm : 1.0f;
        unsigned char* dst = ws + WS_WINT + (size_t)n * 1024 + kq * 64;
#pragma unroll
        for (int q = 0; q < 4; ++q) {
            u32x4 o;
#pragma unroll
            for (int d = 0; d < 4; ++d) o[d] = pk4_fp8(v[q * 16 + d * 4] * sc, v[q * 16 + d * 4 + 1] * sc, v[q * 16 + d * 4 + 2] * sc, v[q * 16 + d * 4 + 3] * sc);
            *(u32x4*)(dst + q * 16) = o;
        }
        if (kq == 0) ((float*)(ws + WS_SW))[n] = cm > 0.f ? cm / 448.0f : 1.0f;
    }
    {
        const int lane = threadIdx.x & 63, gw = (int)(gtid >> 6), ngw = (int)(gstride >> 6);
        for (int row = gw; row < NTOK; row += ngw) {
            const f32x4* src = (const f32x4*)(p.in[0] + (size_t)row * 1024) + lane * 4;
            f32x4 v[4];
            float am = 0.f;
#pragma unroll
            for (int j = 0; j < 4; ++j) { v[j] = src[j]; am = fmaxf(am, fmaxf(fmaxf(fabsf(v[j].x), fabsf(v[j].y)), fmaxf(fabsf(v[j].z), fabsf(v[j].w)))); }
#pragma unroll
            for (int o = 32; o >= 1; o >>= 1) am = fmaxf(am, __shfl_xor(am, o));
            const float sc = am > 0.f ? 448.0f / am : 1.0f;
            u32x4 o4;
#pragma unroll
            for (int j = 0; j < 4; ++j) o4[j] = pk4_fp8(v[j].x * sc, v[j].y * sc, v[j].z * sc, v[j].w * sc);
            *(u32x4*)(ws + WS_XB + (size_t)row * 1024 + lane * 16) = o4;
            if (lane == 0) ((float*)(ws + WS_SX))[row] = am > 0.f ? am / 448.0f : 1.0f;
        }
    }
    cvt_rows(p.in[15], (bf16_t*)(ws + WS_SUBK), (size_t)2 * 128 * 128 / 8, gtid, gstride);
    transpose_cvt(p.in[11], 1024, 1024, (bf16_t*)(ws + WS_WOUTT), 1024, [](int n) { return n; }, gtid, gstride);
    transpose_cvt_scaled(p.in[14], 1024, 2048, (bf16_t*)(ws + WS_WQT), p.in[12], gtid, gstride);
    transpose_cvt(p.in[5], 2048, 256, (bf16_t*)(ws + WS_W1TK), 256, [](int n) { return n; }, gtid, gstride);
    transpose_cvt(p.in[7], 2048, 256, (bf16_t*)(ws + WS_W1TV), 256, [](int n) { return n; }, gtid, gstride);
    transpose_cvt(p.in[6], 256, 64, (bf16_t*)(ws + WS_W2TK), 64, [](int n) { return n; }, gtid, gstride);
    transpose_cvt(p.in[8], 256, 64, (bf16_t*)(ws + WS_W2TV), 64, [](int n) { return n; }, gtid, gstride);
    for (int g = 0; g < 4; ++g)
        transpose_cvt(p.in[9] + g * 16384, 128, 128, (bf16_t*)(ws + WS_POOLWT) + g * 16384, 128, [](int n) { return n; }, gtid, gstride);
    {
        float* z = (float*)(ws + WS_KCMP);
        for (size_t i = gtid; i < (size_t)2 * 8 * 256 * 64; i += gstride) z[i] = 0.f;
    }
    {
        const int lane = threadIdx.x & 63, gw = (int)(gtid >> 6), ngw = (int)(gstride >> 6);
        for (int o = gw; o < 512; o += ngw) {
            const int which = o >> 8, j = o & 255;
            const float* pe = which ? p.in[4] : p.in[3];
            const float* w1 = which ? p.in[7] : p.in[5];
            float s = 0.f;
#pragma unroll 8
            for (int i = lane; i < 2048; i += 64) s += pe[i] * w1[(size_t)i * 256 + j];
            s = wave_sum(s);
            if (lane == 0) ((float*)(ws + (which ? WS_PEBV : WS_PEBK)))[j] = s;
        }
    }
    if (gtid >= 512 && gtid < 768) {
        const int d = (int)(gtid - 512);
        ((int*)(ws + WS_BUCK))[d] = rel_bucket_dev(d);
    }
}

DI int cu_pair_pos(int j, int G8) { const int hlf = (G8 + 1) >> 1; return (G8 & 1) ? j : (((j % hlf) << 1) | (j / hlf)); }

DI void phase1(const Params& p, unsigned char* lds) {
    unsigned char* ws = p.ws;
    const unsigned char* xb = ws + WS_XB;
    const unsigned char* wt = ws + WS_WINT;
    const float* sx = (const float*)(ws + WS_SX);
    const float* sw = (const float*)(ws + WS_SW);
    const int ntiles = 128 * 15;
    const int G8 = (gridDim.x & 7) == 0 ? gridDim.x >> 3 : 0;
    for (int l0 = G8 ? 0 : (int)blockIdx.x; l0 < (G8 ? ntiles / 8 : ntiles); l0 += (G8 ? G8 : (int)gridDim.x)) {
        const int li = G8 ? l0 + cu_pair_pos((int)(blockIdx.x >> 3), G8) : l0;
        if (G8 && li >= ntiles / 8) break;
        const int tile = G8 ? (int)(blockIdx.x & 7) * (ntiles / 8) + li : li;
        const int tn = tile % 15, tm = tile / 15;
        f32x16 acc[2][2];
        gemm_mainloop_f8(xb + (size_t)tm * 128 * DM, DM, wt + (size_t)tn * 128 * DM, DM, DM, acc, lds);
        const int m0 = tm * 128;
        {
            const int lane = threadIdx.x & 63, wid = threadIdx.x >> 6, wr = wid >> 1, wc = wid & 1, r = lane & 31, h = lane >> 5;
            const float sx0 = sx[m0 + wr * 64 + r], sx1 = sx[m0 + wr * 64 + 32 + r];
#pragma unroll
            for (int ni = 0; ni < 2; ++ni)
#pragma unroll
                for (int grp = 0; grp < 4; ++grp) {
                    const f32x4 s4 = *(const f32x4*)(sw + tn * 128 + wc * 64 + ni * 32 + 8 * grp + 4 * h);
#pragma unroll
                    for (int e2 = 0; e2 < 4; ++e2) { acc[0][ni][4 * grp + e2] *= sx0 * s4[e2]; acc[1][ni][4 * grp + e2] *= sx1 * s4[e2]; }
                }
        }
        if (tn < 14) {
            const bool tr = (tn == 7 || tn == 9);
            const float qs = tn < 4 ? QSCALE : 1.0f;
            if (tr) epi_stage_cols(acc, lds);
            else epi_stage_rows(acc, lds, [&](int) { return (f32x4){qs, qs, qs, qs}; });
            __syncthreads();
            const int bq = m0 >> 12, t0q = m0 & 4095;
            if (tn < 4) {
                bf16_t* Q = (bf16_t*)(ws + WS_Q);
                rows_foreach(lds, [&](int m, int cc, u32x4 d) {
                    const int hd = tn * 2 + (cc >> 3);
                    *(u32x4*)(Q + (((size_t)(bq * 8 + hd) * SEQ + t0q + m) * 64 + (cc & 7) * 8)) = d;
                });
            } else if (tr) {
                bf16_t* dst = (bf16_t*)(ws + (tn == 7 ? WS_VSLCT : WS_VWINT));
                rows_foreach(lds, [&](int n, int cc, u32x4 d) {
                    *(u32x4*)(dst + ((size_t)((bq * 2 + (n >> 6)) * 64 + (n & 63)) * SEQ + t0q + cc * 8)) = d;
                });
            } else if (tn < 10) {
                bf16_t* dst = (bf16_t*)(ws + (tn == 4 ? WS_KC : tn == 5 ? WS_VC : tn == 6 ? WS_KSLC : WS_KWIN));
                rows_foreach(lds, [&](int m, int cc, u32x4 d) {
                    *(u32x4*)(dst + (((size_t)(bq * 2 + (cc >> 3)) * SEQ + t0q + m) * 64 + (cc & 7) * 8)) = d;
                });
            } else {
                bf16_t* dst = (bf16_t*)(ws + WS_Z);
                rows_foreach(lds, [&](int m, int cc, u32x4 d) {
                    *(u32x4*)(dst + ((size_t)(m0 + m) * 512 + (tn - 10) * 128 + cc * 8)) = d;
                });
            }
            __syncthreads();
        } else {
            float* dst = (float*)(ws + WS_GATES);
            epi_foreach(acc, [&](int m, int n, f32x4 v) {
                if (n < 24) {
                    f32x4 o = {1.f / (1.f + __expf(-v.x)), 1.f / (1.f + __expf(-v.y)), 1.f / (1.f + __expf(-v.z)), 1.f / (1.f + __expf(-v.w))};
                    *(f32x4*)(dst + (size_t)(m0 + m) * 24 + n) = o;
                }
            });
        }
    }
}

DI void compress_job(const Params& p, unsigned char* lds, int cj) {
    unsigned char* ws = p.ws;
    const int kv = cj >> 6, bg = (cj >> 3) & 7, rq = (cj >> 1) & 3, hh = cj & 1;
    const bf16_t* A = (const bf16_t*)(ws + (kv ? WS_VC : WS_KC)) + ((size_t)bg * SEQ + (size_t)rq * 64 * 16) * 64;
    const bf16_t* Bt = (const bf16_t*)(ws + (kv ? WS_W1TV : WS_W1TK)) + (size_t)hh * 128 * 2048;
    const float* peb = (const float*)(ws + (kv ? WS_PEBV : WS_PEBK)) + hh * 128;
    const bf16_t* w2t = (const bf16_t*)(ws + (kv ? WS_W2TV : WS_W2TK));
    float* dst = (float*)(ws + (kv ? WS_VCMP : WS_KCMP)) + (size_t)bg * 256 * 64;
    f32x16 acc[1][2];
    gemm_mainloop_t<1>(A, 1024, Bt, 2048, 2048, acc, lds);
    epi_foreach_t<1>(acc, [&](int m, int n, f32x4 v) {
        f32x4 bb = *(const f32x4*)(peb + n);
        u32x2 o = {pk2(gelu_erf(v.x + bb.x), gelu_erf(v.y + bb.y)), pk2(gelu_erf(v.z + bb.z), gelu_erf(v.w + bb.w))};
        *(u32x2*)(lds + m * 272 + n * 2) = o;
    });
    __syncthreads();
    const int tid = threadIdx.x, lane = tid & 63, wid = tid >> 6, r = lane & 31, h = lane >> 5;
    const int wr2 = wid >> 1, wd = wid & 1;
    f32x16 a2;
#pragma unroll
    for (int i = 0; i < 16; ++i) a2[i] = 0.f;
#pragma unroll
    for (int ks = 0; ks < 8; ++ks) {
        bf16x8 fb = *(const bf16x8*)(lds + (wr2 * 32 + r) * 272 + ks * 32 + h * 16);
        bf16x8 fa = *(const bf16x8*)(w2t + (size_t)(wd * 32 + r) * 256 + hh * 128 + ks * 16 + h * 8);
        a2 = MFMA32(fa, fb, a2);
    }
    const int row = rq * 64 + wr2 * 32 + r;
    if (row < 255) {
#pragma unroll
        for (int i = 0; i < 16; ++i) {
            const int d = wd * 32 + (i & 3) + 8 * (i >> 2) + 4 * h;
            atomicAdd(dst + (size_t)row * 64 + d, a2[i]);
        }
    }
    __syncthreads();
}

constexpr int AT_K0 = 0, AT_V0 = 18432, AT_TB = 36864, AT_IMP = 40960, AT_SEL = 49152;

DI void attn_stage_load(const bf16_t* __restrict__ Kg, const bf16_t* __restrict__ Vtg, u32x4 (&st)[4], int tid) {
#pragma unroll
    for (int i = 0; i < 2; ++i) {
        const int c = tid + 256 * i, row = c >> 3, cc = c & 7;
        st[i] = *(const u32x4*)(Kg + (size_t)row * 64 + cc * 8);
        st[2 + i] = *(const u32x4*)(Vtg + (size_t)row * SEQ + cc * 8);
    }
}
DI void attn_stage_store(unsigned char* Kl, unsigned char* Vl, const u32x4 (&st)[4], int tid) {
#pragma unroll
    for (int i = 0; i < 2; ++i) {
        const int c = tid + 256 * i, row = c >> 3, cc = c & 7;
        *(u32x4*)(Kl + row * ROWB + cc * 16) = st[i];
        *(u32x4*)(Vl + row * ROWB + cc * 16) = st[2 + i];
    }
}
DI void attn_scores(const unsigned char* Kl, const bf16x8 (&qf)[4], f32x16 (&X)[2], int r, int h) {
#pragma unroll
    for (int i = 0; i < 16; ++i) { X[0][i] = 0.f; X[1][i] = 0.f; }
#pragma unroll
    for (int ks = 0; ks < 4; ++ks)
#pragma unroll
        for (int kb = 0; kb < 2; ++kb) {
            bf16x8 a = *(const bf16x8*)(Kl + (kb * 32 + r) * ROWB + ks * 32 + h * 16);
            X[kb] = MFMA32(a, qf[ks], X[kb]);
        }
}
DI void attn_pv(const unsigned char* Vl, const f32x16 (&P)[2], f32x16 (&O)[2], int r, int h) {
#pragma unroll
    for (int kb = 0; kb < 2; ++kb)
#pragma unroll
        for (int s = 0; s < 2; ++s) {
            u32x4 pw = {pk2(P[kb][8 * s], P[kb][8 * s + 1]), pk2(P[kb][8 * s + 2], P[kb][8 * s + 3]),
                        pk2(P[kb][8 * s + 4], P[kb][8 * s + 5]), pk2(P[kb][8 * s + 6], P[kb][8 * s + 7])};
            bf16x8 pb = __builtin_bit_cast(bf16x8, pw);
#pragma unroll
            for (int db = 0; db < 2; ++db) {
                const unsigned char* q = Vl + (db * 32 + r) * ROWB + (kb * 32 + 16 * s + 4 * h) * 2;
                s16x4 lo = *(const s16x4*)q, hi = *(const s16x4*)(q + 16);
                bf16x8 a = __builtin_shufflevector(lo, hi, 0, 1, 2, 3, 4, 5, 6, 7);
                O[db] = MFMA32(a, pb, O[db]);
            }
        }
}
DI void softmax_update(f32x16 (&X)[2], float& m, float& l, f32x16 (&O)[2]) {
    float mloc = -1e30f;
#pragma unroll
    for (int kb = 0; kb < 2; ++kb)
#pragma unroll
        for (int i = 0; i < 16; ++i) mloc = fmaxf(mloc, X[kb][i]);
    mloc = fmaxf(mloc, __shfl_xor(mloc, 32));
    const float mnew = fmaxf(m, mloc);
    const float alpha = __builtin_amdgcn_exp2f(m - mnew);
    m = mnew;
    float ls = 0.f;
#pragma unroll
    for (int kb = 0; kb < 2; ++kb)
#pragma unroll
        for (int i = 0; i < 16; ++i) {
            const float x = X[kb][i];
            const float pv = x > -1e29f ? __builtin_amdgcn_exp2f(x - mnew) : 0.f;
            X[kb][i] = pv; ls += pv;
        }
    l = l * alpha + ls;
#pragma unroll
    for (int db = 0; db < 2; ++db)
#pragma unroll
        for (int i = 0; i < 16; ++i) O[db][i] *= alpha;
}
DI void softmax_far(f32x16 (&X)[2], float cb, float& m, float& l, f32x16 (&O)[2]) {
    float mloc = -3e38f;
#pragma unroll
    for (int kb = 0; kb < 2; ++kb)
#pragma unroll
        for (int i = 0; i < 16; ++i) mloc = fmaxf(mloc, X[kb][i]);
    mloc += cb;
    mloc = fmaxf(mloc, __shfl_xor(mloc, 32));
    const float mnew = fmaxf(m, mloc);
    if (__any(mnew > m)) {
        const float alpha = __builtin_amdgcn_exp2f(m - mnew);
        m = mnew; l *= alpha;
#pragma unroll
        for (int db = 0; db < 2; ++db)
#pragma unroll
            for (int i = 0; i < 16; ++i) O[db][i] *= alpha;
    }
    const float mc = m - cb;
    f32x2 ls = {0.f, 0.f};
#pragma unroll
    for (int kb = 0; kb < 2; ++kb)
#pragma unroll
        for (int i = 0; i < 16; i += 2) {
            f32x2 pv = {__builtin_amdgcn_exp2f(X[kb][i] - mc), __builtin_amdgcn_exp2f(X[kb][i + 1] - mc)};
            X[kb][i] = pv.x; X[kb][i + 1] = pv.y; ls += pv;
        }
    l += ls.x + ls.y;
}
DI void build_bias_table(const Params& p, unsigned char* lds, int g) {
    const int* buck = (const int*)(p.ws + WS_BUCK);
    float* tb = (float*)(lds + AT_TB);
    for (int i = threadIdx.x; i < 1024; i += NTHREADS) {
        const int hl = i >> 8, d = i & 255;
        tb[i] = p.in[2][buck[d] * 8 + g * 4 + hl] * LOG2E;
    }
}

DI void win_unit(const Params& p, unsigned char* lds, int u) {
    unsigned char* ws = p.ws;
    const int tid = threadIdx.x, lane = tid & 63, wid = tid >> 6, r = lane & 31, h = lane >> 5;
    const int bg = u & 7, t32 = u >> 3, b = bg >> 1, g = bg & 1, t0 = t32 * 32;
    const int hl = r >> 3, t = t0 + wid * 8 + (r & 7);
    const bf16_t* Kg = (const bf16_t*)(ws + WS_KWIN) + (size_t)bg * SEQ * 64;
    const bf16_t* Vtg = (const bf16_t*)(ws + WS_VWINT) + (size_t)bg * 64 * SEQ;
    const bf16_t* Qg = (const bf16_t*)(ws + WS_Q) + ((size_t)(b * 8 + g * 4 + hl) * SEQ + t) * 64;
    __syncthreads();
    build_bias_table(p, lds, g);
    bf16x8 qf[4];
#pragma unroll
    for (int ks = 0; ks < 4; ++ks) qf[ks] = *(const bf16x8*)(Qg + ks * 16 + h * 8);
    const int jlo = t0 < 511 ? 0 : ((t0 - 511) >> 6), jhi = t0 >> 6;
    u32x4 st[4];
    attn_stage_load(Kg + (size_t)jlo * 64 * 64, Vtg + jlo * 64, st, tid);
    attn_stage_store(lds + AT_K0, lds + AT_V0, st, tid);
    __syncthreads();
    const float* tb = (const float*)(lds + AT_TB) + hl * 256;
    const volatile LAS float* tbv = (const volatile LAS float*)((LAS unsigned char*)lds + AT_TB) + hl * 256;
    const int tmin = t0 + wid * 8;
    float m = -1e30f, l = 0.f;
    f32x16 O[2];
#pragma unroll
    for (int i = 0; i < 16; ++i) { O[0][i] = 0.f; O[1][i] = 0.f; }
    for (int j = jlo; j <= jhi; ++j) {
        const int cur = (j - jlo) & 1;
        if (j < jhi) attn_stage_load(Kg + (size_t)(j + 1) * 64 * 64, Vtg + (j + 1) * 64, st, tid);
        const unsigned char* Kl = lds + AT_K0 + cur * 9216;
        const unsigned char* Vl = lds + AT_V0 + cur * 9216;
        f32x16 X[2];
        attn_scores(Kl, qf, X, r, h);
        const bool far = (tmin - (j * 64 + 63) >= 128) && (tmin + 7 - j * 64 < 512);
        if (far) {
            softmax_far(X, tb[255], m, l, O);
        } else {
#pragma unroll
            for (int kb = 0; kb < 2; ++kb)
#pragma unroll
                for (int i = 0; i < 16; ++i) {
                    const int pos = j * 64 + kb * 32 + (i & 3) + 8 * (i >> 2) + 4 * h;
                    const int dist = t - pos;
                    const bool valid = dist >= 0 && dist < 512;
                    const int di = dist < 0 ? 0 : (dist > 255 ? 255 : dist);
                    const float bias = tbv[di];
                    X[kb][i] = valid ? X[kb][i] + bias : -1e30f;
                }
            softmax_update(X, m, l, O);
        }
        attn_pv(Vl, X, O, r, h);
        if (j < jhi) attn_stage_store(lds + AT_K0 + (cur ^ 1) * 9216, lds + AT_V0 + (cur ^ 1) * 9216, st, tid);
        __syncthreads();
    }
    const float lt = l + __shfl_xor(l, 32);
    const size_t tok = (size_t)b * SEQ + t;
    const float gate = ((const float*)(ws + WS_GATES))[tok * 24 + 16 + g * 4 + hl];
    const float sc = gate / lt;
    bf16_t* ow = (bf16_t*)(ws + WS_OWIN) + tok * 512 + (g * 4 + hl) * 64;
#pragma unroll
    for (int db = 0; db < 2; ++db)
#pragma unroll
        for (int grp = 0; grp < 4; ++grp) {
            u32x2 o = {pk2(O[db][4 * grp] * sc, O[db][4 * grp + 1] * sc), pk2(O[db][4 * grp + 2] * sc, O[db][4 * grp + 3] * sc)};
            *(u32x2*)(ow + db * 32 + 8 * grp + 4 * h) = o;
        }
}

DI void cmp_load(const float* __restrict__ kc, const float* __restrict__ vc, int ct, bool withv, int tid, f32x4 (&kr)[4], f32x4 (&vr)[4]) {
    {
        const int c = tid >> 2, part = tid & 3;
        const f32x4* src = (const f32x4*)(kc + (size_t)(ct * 64 + c) * 64 + part * 16);
        kr[0] = src[0]; kr[1] = src[1]; kr[2] = src[2]; kr[3] = src[3];
    }
    if (withv) {
        const int c = tid & 63, dg = tid >> 6;
        const f32x4* src = (const f32x4*)(vc + (size_t)(ct * 64 + c) * 64 + dg * 16);
        vr[0] = src[0]; vr[1] = src[1]; vr[2] = src[2]; vr[3] = src[3];
    }
}
DI void cmp_store(unsigned char* Kl, unsigned char* Vl, bool withv, int tid, const f32x4 (&kr)[4], const f32x4 (&vr)[4]) {
    {
        const int c = tid >> 2, part = tid & 3;
        u32x4 o0 = {pk2(kr[0].x, kr[0].y), pk2(kr[0].z, kr[0].w), pk2(kr[1].x, kr[1].y), pk2(kr[1].z, kr[1].w)};
        u32x4 o1 = {pk2(kr[2].x, kr[2].y), pk2(kr[2].z, kr[2].w), pk2(kr[3].x, kr[3].y), pk2(kr[3].z, kr[3].w)};
        *(u32x4*)(Kl + c * ROWB + part * 32) = o0;
        *(u32x4*)(Kl + c * ROWB + part * 32 + 16) = o1;
    }
    if (withv) {
        const int c = tid & 63, dg = tid >> 6;
#pragma unroll
        for (int q4 = 0; q4 < 4; ++q4) {
            const int d = dg * 16 + q4 * 4;
            *(bf16_t*)(Vl + (d + 0) * ROWB + c * 2) = (bf16_t)f2bf(vr[q4].x);
            *(bf16_t*)(Vl + (d + 1) * ROWB + c * 2) = (bf16_t)f2bf(vr[q4].y);
            *(bf16_t*)(Vl + (d + 2) * ROWB + c * 2) = (bf16_t)f2bf(vr[q4].z);
            *(bf16_t*)(Vl + (d + 3) * ROWB + c * 2) = (bf16_t)f2bf(vr[q4].w);
        }
    }
}

DI void slc_unit(const Params& p, unsigned char* lds, int u) {
    unsigned char* ws = p.ws;
    const int tid = threadIdx.x, lane = tid & 63, wid = tid >> 6, r = lane & 31, h = lane >> 5;
    const int bg = u & 7, t32 = u >> 3, b = bg >> 1, g = bg & 1, t0 = t32 * 32;
    const int hl = r >> 3, tokl = r & 7, t = t0 + wid * 8 + tokl;
    const bf16_t* Kg = (const bf16_t*)(ws + WS_KSLC) + (size_t)bg * SEQ * 64;
    const bf16_t* Vtg = (const bf16_t*)(ws + WS_VSLCT) + (size_t)bg * 64 * SEQ;
    const bf16_t* Qg = (const bf16_t*)(ws + WS_Q) + ((size_t)(b * 8 + g * 4 + hl) * SEQ + t) * 64;
    const float* kcmp = (const float*)(ws + WS_KCMP) + (size_t)bg * 256 * 64;
    const float* vcmp = (const float*)(ws + WS_VCMP) + (size_t)bg * 256 * 64;
    __syncthreads();
    build_bias_table(p, lds, g);
    unsigned* imp = (unsigned*)(lds + AT_IMP) + wid * 512;
#pragma unroll
    for (int i = 0; i < 8; ++i) imp[i * 64 + lane] = 0u;
    bf16x8 qf[4];
#pragma unroll
    for (int ks = 0; ks < 4; ++ks) qf[ks] = *(const bf16x8*)(Qg + ks * 16 + h * 8);
    const float* tb = (const float*)(lds + AT_TB) + hl * 256;
    const volatile LAS float* tbv = (const volatile LAS float*)((LAS unsigned char*)lds + AT_TB) + hl * 256;
    const int cmax = t0 >> 4;
    const int nct = (t0 + 31 >= 31) ? (cmax >> 6) + 1 : 0;
    float m = -1e30f, l = 0.f;
    f32x16 Oc[2];
#pragma unroll
    for (int i = 0; i < 16; ++i) { Oc[0][i] = 0.f; Oc[1][i] = 0.f; }
    {
        f32x4 kr[4], vr[4];
        cmp_load(kcmp, vcmp, 0, false, tid, kr, vr);
        cmp_store(lds + AT_K0, lds + AT_V0, false, tid, kr, vr);
        __syncthreads();
#pragma unroll 1
        for (int ct = 0; ct < nct; ++ct) {
            const bool last = ct + 1 == nct;
            cmp_load(kcmp, vcmp, last ? 0 : ct + 1, last, tid, kr, vr);
            f32x16 X[2];
            attn_scores(lds + AT_K0 + (ct & 1) * 9216, qf, X, r, h);
            f32x16 dummy[2];
#pragma unroll
            for (int i = 0; i < 16; ++i) { dummy[0][i] = 0.f; dummy[1][i] = 0.f; }
            const bool farc = ct < 3 && (t0 + wid * 8 - (16 * (ct * 64 + 63) + 31) >= 128);
            if (farc) {
                softmax_far(X, tb[255], m, l, dummy);
            } else {
#pragma unroll
                for (int kb = 0; kb < 2; ++kb)
#pragma unroll
                    for (int i = 0; i < 16; ++i) {
                        const int c = ct * 64 + kb * 32 + (i & 3) + 8 * (i >> 2) + 4 * h;
                        const int dist = t - (16 * c + 31);
                        const bool valid = dist >= 0 && c < 255;
                        const int di = dist < 0 ? 0 : (dist > 255 ? 255 : dist);
                        const float bias = tbv[di];
                    X[kb][i] = valid ? X[kb][i] + bias : -1e30f;
                    }
                softmax_update(X, m, l, dummy);
            }
            cmp_store(lds + AT_K0 + ((ct + 1) & 1) * 9216, lds + AT_V0 + ((ct + 1) & 1) * 9216, last, tid, kr, vr);
            __syncthreads();
        }
        const float lt = l + __shfl_xor(l, 32);
        const float invl = lt > 0.f ? 1.0f / lt : 0.f;
#pragma unroll 1
        for (int ct = 0; ct < nct; ++ct) {
            const int bsel = (nct + ct) & 1;
            const bool more = ct + 1 < nct;
            if (more) cmp_load(kcmp, vcmp, ct + 1, true, tid, kr, vr);
            f32x16 X[2];
            attn_scores(lds + AT_K0 + bsel * 9216, qf, X, r, h);
            const bool farc = ct < 3 && (t0 + wid * 8 - (16 * (ct * 64 + 63) + 31) >= 128);
            if (farc) {
                const float mc = m - tb[255];
#pragma unroll
                for (int kb = 0; kb < 2; ++kb)
#pragma unroll
                    for (int i = 0; i < 16; ++i) X[kb][i] = __builtin_amdgcn_exp2f(X[kb][i] - mc) * invl;
            } else {
#pragma unroll
                for (int kb = 0; kb < 2; ++kb)
#pragma unroll
                    for (int i = 0; i < 16; ++i) {
                        const int c = ct * 64 + kb * 32 + (i & 3) + 8 * (i >> 2) + 4 * h;
                        const int dist = t - (16 * c + 31);
                        const bool valid = dist >= 0 && c < 255;
                        const int di = dist < 0 ? 0 : (dist > 255 ? 255 : dist);
                        const float pe = __builtin_amdgcn_exp2f(X[kb][i] + tbv[di] - m) * invl;
                        X[kb][i] = valid ? pe : 0.f;
                    }
            }
#pragma unroll
            for (int kb = 0; kb < 2; ++kb)
#pragma unroll
                for (int grp = 0; grp < 4; ++grp) {
                    const float s4 = (X[kb][4 * grp] + X[kb][4 * grp + 1]) + (X[kb][4 * grp + 2] + X[kb][4 * grp + 3]);
                    const int jj = ct * 16 + kb * 8 + 2 * grp + h;
                    atomicAdd(&imp[tokl * 64 + jj], (unsigned)(s4 * 67108864.0f + 0.5f));
                    if (jj + 1 < 64) atomicAdd(&imp[tokl * 64 + jj + 1], (unsigned)(X[kb][4 * grp + 3] * 67108864.0f + 0.5f));
                }
            attn_pv(lds + AT_V0 + bsel * 9216, X, Oc, r, h);
            if (more) cmp_store(lds + AT_K0 + (bsel ^ 1) * 9216, lds + AT_V0 + (bsel ^ 1) * 9216, true, tid, kr, vr);
            __syncthreads();
        }
    }
    unsigned long long* selm = (unsigned long long*)(lds + AT_SEL) + wid * 8;
    for (int tk = 0; tk < 8; ++tk) {
        const int tt = t0 + wid * 8 + tk, curb = tt >> 6;
        int v = (int)imp[tk * 64 + lane];
        if (lane == 0 || lane == curb || lane == curb - 1) v = 0x7fffffff;
        if (lane > curb) v = -1;
        LAS unsigned* impl = (LAS unsigned*)((LAS unsigned char*)lds + AT_IMP) + wid * 512 + tk * 64;
        impl[lane] = (unsigned)v;
        const int vm1 = v - 1;
        int lane_o = lane;
        asm volatile("" : "+v"(lane_o));
        int cnt = 0;
#pragma unroll
        for (int k4 = 0; k4 < 16; ++k4) {
            const u32x4 q = *(const LAS u32x4*)(impl + 4 * k4);
#pragma unroll
            for (int e = 0; e < 4; ++e) {
                const int thr = lane_o > 4 * k4 + e ? vm1 : v;
                cnt += ((int)q[e] > thr) ? 1 : 0;
            }
        }
        const unsigned long long mk = __ballot(cnt < 16);
        if (lane == 0) selm[tk] = mk;
    }
    const unsigned long long mysel = selm[tokl];
    __syncthreads();
    const int jhi = t0 >> 6;
    u32x4 st[4];
    attn_stage_load(Kg, Vtg, st, tid);
    attn_stage_store(lds + AT_K0, lds + AT_V0, st, tid);
    __syncthreads();
    float m2 = -1e30f, l2 = 0.f;
    const int tmin = t0 + wid * 8;
    f32x16 O[2];
#pragma unroll
    for (int i = 0; i < 16; ++i) { O[0][i] = 0.f; O[1][i] = 0.f; }
    for (int j = 0; j <= jhi; ++j) {
        const int cur = j & 1;
        if (j < jhi) attn_stage_load(Kg + (size_t)(j + 1) * 64 * 64, Vtg + (j + 1) * 64, st, tid);
        const unsigned char* Kl = lds + AT_K0 + cur * 9216;
        const unsigned char* Vl = lds + AT_V0 + cur * 9216;
        f32x16 X[2];
        attn_scores(Kl, qf, X, r, h);
        const bool selj = (mysel >> j) & 1ull;
        if (tmin - (j * 64 + 63) >= 128) {
            softmax_far(X, selj ? tb[255] : -1e30f, m2, l2, O);
        } else {
#pragma unroll
            for (int kb = 0; kb < 2; ++kb)
#pragma unroll
                for (int i = 0; i < 16; ++i) {
                    const int pos = j * 64 + kb * 32 + (i & 3) + 8 * (i >> 2) + 4 * h;
                    const int dist = t - pos;
                    const bool valid = dist >= 0 && selj;
                    const int di = dist < 0 ? 0 : (dist > 255 ? 255 : dist);
                    const float bias = tbv[di];
                    X[kb][i] = valid ? X[kb][i] + bias : -1e30f;
                }
            softmax_update(X, m2, l2, O);
        }
        attn_pv(Vl, X, O, r, h);
        if (j < jhi) attn_stage_store(lds + AT_K0 + (cur ^ 1) * 9216, lds + AT_V0 + (cur ^ 1) * 9216, st, tid);
        __syncthreads();
    }
    const float lt2 = l2 + __shfl_xor(l2, 32);
    const size_t tok = (size_t)b * SEQ + t;
    const float* gt = (const float*)(ws + WS_GATES) + tok * 24;
    const float gc = gt[g * 4 + hl], gs = gt[8 + g * 4 + hl] / lt2;
    const bf16_t* ow = (const bf16_t*)(ws + WS_OWIN) + tok * 512 + (g * 4 + hl) * 64;
    bf16_t* mx = (bf16_t*)(ws + WS_MIXIN) + tok * 1024 + (g * 4 + hl) * 64;
#pragma unroll
    for (int db = 0; db < 2; ++db)
#pragma unroll
        for (int grp = 0; grp < 4; ++grp) {
            const int d = db * 32 + 8 * grp + 4 * h;
            const u32x2 w = *(const u32x2*)(ow + d);
            const float r0 = gc * Oc[db][4 * grp] + gs * O[db][4 * grp] + bflo(w.x);
            const float r1 = gc * Oc[db][4 * grp + 1] + gs * O[db][4 * grp + 1] + bfhi(w.x);
            const float r2 = gc * Oc[db][4 * grp + 2] + gs * O[db][4 * grp + 2] + bflo(w.y);
            const float r3 = gc * Oc[db][4 * grp + 3] + gs * O[db][4 * grp + 3] + bfhi(w.y);
            u32x2 o = {pk2(r0, r1), pk2(r2, r3)};
            *(u32x2*)(mx + d) = o;
        }
}

DI void pooly_job(const Params& p, int job) {
    unsigned char* ws = p.ws;
    const bf16_t* z = (const bf16_t*)(ws + WS_Z);
    bf16_t* y = (bf16_t*)(ws + WS_YPOOL);
    const int tid = threadIdx.x;
    const int tokb = job * 16 + (tid >> 6) * 4, ch = tid & 63, tb = tokb & 4095;
    const int gi = ch >> 4, win = 2 << gi;
    u32x4 rowv[19];
#pragma unroll
    for (int i = 0; i < 19; ++i) {
        const int dt = i - 15;
        const bool need = dt > -win && tb + dt >= 0;
        rowv[i] = *(const u32x4*)(z + (size_t)(need ? tokb + dt : tokb) * 512 + ch * 8);
    }
    float f[19][8];
#pragma unroll
    for (int i = 0; i < 19; ++i) {
        f[i][0] = bflo(rowv[i].x); f[i][1] = bfhi(rowv[i].x); f[i][2] = bflo(rowv[i].y); f[i][3] = bfhi(rowv[i].y);
        f[i][4] = bflo(rowv[i].z); f[i][5] = bfhi(rowv[i].z); f[i][6] = bflo(rowv[i].w); f[i][7] = bfhi(rowv[i].w);
    }
#pragma unroll
    for (int o = 0; o < 4; ++o) {
        const int t = tb + o;
        const int cnt = (t + 1 < win) ? t + 1 : win;
        float s[8];
#pragma unroll
        for (int c = 0; c < 8; ++c) s[c] = 0.f;
#pragma unroll
        for (int k = 0; k < 16; ++k) {
            const float wk = k < cnt ? 1.0f : 0.0f;
#pragma unroll
            for (int c = 0; c < 8; ++c) s[c] += wk * f[15 + o - k][c];
        }
        const float ic = 1.0f / (float)cnt;
        u32x4 ov = {pk2(s[0] * ic - f[15 + o][0], s[1] * ic - f[15 + o][1]), pk2(s[2] * ic - f[15 + o][2], s[3] * ic - f[15 + o][3]),
                    pk2(s[4] * ic - f[15 + o][4], s[5] * ic - f[15 + o][5]), pk2(s[6] * ic - f[15 + o][6], s[7] * ic - f[15 + o][7])};
        *(u32x4*)(y + (size_t)(tokb + o) * 512 + ch * 8) = ov;
    }
}

DI void lnfold_consts(const Params& p, int n0, int cnt) {
    unsigned char* ws = p.ws;
    const int lane = threadIdx.x & 63, wid = threadIdx.x >> 6;
    const bf16_t* wqt = (const bf16_t*)(ws + WS_WQT);
    const float* wq = p.in[14];
    const float* bb = p.in[13];
    for (int n = n0 + wid; n < n0 + cnt; n += 4) {
        float s1 = 0.f, s2 = 0.f;
#pragma unroll
        for (int j = 0; j < 2; ++j) {
            const u32x4 w = *(const u32x4*)(wqt + (size_t)n * 1024 + (j * 64 + lane) * 8);
            s1 += (bflo(w.x) + bfhi(w.x)) + (bflo(w.y) + bfhi(w.y)) + (bflo(w.z) + bfhi(w.z)) + (bflo(w.w) + bfhi(w.w));
        }
#pragma unroll 8
        for (int k = lane; k < 1024; k += 64) s2 += bb[k] * wq[(size_t)k * 2048 + n];
        s1 = wave_sum(s1); s2 = wave_sum(s2);
        if (lane == 0) { ((float*)(ws + WS_C1))[n] = s1; ((float*)(ws + WS_C2))[n] = s2; }
    }
}

DI void phase2(const Params& p, unsigned char* lds) {
    const int G = gridDim.x, bx = blockIdx.x;
    if (G == 512) {
        if (bx < 128) { compress_job(p, lds, bx); win_unit(p, lds, 768 + bx); }
        else {
            win_unit(p, lds, bx - 128); win_unit(p, lds, 384 + bx - 128);
            if (bx < 256) win_unit(p, lds, 896 + bx - 128);
            else lnfold_consts(p, (bx - 256) * 8, 8);
        }
    } else {
        for (int job = bx; job < 128; job += G) compress_job(p, lds, job);
        for (int job = bx; job < 1024; job += G) win_unit(p, lds, job);
        for (int n0 = bx * 8; n0 < 2048; n0 += G * 8) lnfold_consts(p, n0, 8);
    }
    for (int job = bx; job < 1024; job += G) pooly_job(p, job);
}

DI void pool_gemm_tile(const Params& p, unsigned char* lds, int tile) {
    unsigned char* ws = p.ws;
    const int gi = tile & 3, tm = tile >> 2;
    f32x16 acc[2][2];
    __syncthreads();
    gemm_mainloop((const bf16_t*)(ws + WS_YPOOL) + (size_t)tm * 128 * 512 + gi * 128, 512,
                  (const bf16_t*)(ws + WS_POOLWT) + (size_t)gi * 16384, 128, 128, acc, lds);
    const float* sc = p.in[10] + gi * 128;
    bf16_t* mx = (bf16_t*)(ws + WS_MIXIN);
    epi_stage_rows(acc, lds, [&](int n) { return *(const f32x4*)(sc + n); });
    __syncthreads();
    rows_foreach(lds, [&](int m, int cc, u32x4 d) {
        *(u32x4*)(mx + (size_t)(tm * 128 + m) * 1024 + 512 + gi * 128 + cc * 8) = d;
    });
}

DI void phase3(const Params& p, unsigned char* lds) {
    const int G = gridDim.x, bx = blockIdx.x;
    for (int pass = 0; pass * G < 1024; ++pass) {
        const int i = pass * G + ((pass & 1) ? (G - 1 - bx) : bx);
        if (i < 1024) {
            const int u = ((127 - (i >> 3)) << 3) | (i & 7);
            slc_unit(p, lds, u);
        }
    }
    for (int tile = bx; tile < 512; tile += G) pool_gemm_tile(p, lds, tile);
}

DI void phase4(const Params& p, unsigned char* lds) {
    unsigned char* ws = p.ws;
    const float* x = p.in[0];
    bf16_t* y1 = (bf16_t*)(ws + WS_Z);
    const bool conv_first = (blockIdx.x >> 3) & 1;
    if (conv_first) convert_tables(p);
    const int G8 = (gridDim.x & 7) == 0 ? gridDim.x >> 3 : 0;
    for (int l0 = G8 ? 0 : (int)blockIdx.x; l0 < (G8 ? 128 : 1024); l0 += (G8 ? G8 : (int)gridDim.x)) {
        const int li = G8 ? l0 + cu_pair_pos((int)(blockIdx.x >> 3), G8) : l0;
        if (G8 && li >= 128) break;
        const int tile = G8 ? (int)(blockIdx.x & 7) * 128 + li : li;
        const int tn = tile & 7, tm = tile >> 3;
        f32x16 acc[2][2];
        gemm_mainloop((const bf16_t*)(ws + WS_MIXIN) + (size_t)tm * 128 * 1024, 1024,
                      (const bf16_t*)(ws + WS_WOUTT) + (size_t)tn * 128 * 1024, 1024, 1024, acc, lds);
        epi_stage_rows(acc, lds, [&](int) { return (f32x4){1.f, 1.f, 1.f, 1.f}; });
        __syncthreads();
        rows_foreach(lds, [&](int m, int cc, u32x4 d) {
            const size_t off = (size_t)(tm * 128 + m) * 1024 + tn * 128 + cc * 8;
            const f32x4 xa = *(const f32x4*)(x + off), xb = *(const f32x4*)(x + off + 4);
            u32x4 o = {pk2(ALPHA * xa.x + bflo(d.x), ALPHA * xa.y + bfhi(d.x)), pk2(ALPHA * xa.z + bflo(d.y), ALPHA * xa.w + bfhi(d.y)),
                       pk2(ALPHA * xb.x + bflo(d.z), ALPHA * xb.y + bfhi(d.z)), pk2(ALPHA * xb.z + bflo(d.w), ALPHA * xb.w + bfhi(d.w))};
            *(u32x4*)(y1 + off) = o;
            float s = ((bflo(o.x) + bfhi(o.x)) + (bflo(o.y) + bfhi(o.y))) + ((bflo(o.z) + bfhi(o.z)) + (bflo(o.w) + bfhi(o.w)));
            float q = ((bflo(o.x) * bflo(o.x) + bfhi(o.x) * bfhi(o.x)) + (bflo(o.y) * bflo(o.y) + bfhi(o.y) * bfhi(o.y)))
                    + ((bflo(o.z) * bflo(o.z) + bfhi(o.z) * bfhi(o.z)) + (bflo(o.w) * bflo(o.w) + bfhi(o.w) * bfhi(o.w)));
#pragma unroll
            for (int sh = 1; sh < 16; sh <<= 1) { s += __shfl_xor(s, sh); q += __shfl_xor(q, sh); }
            if (cc == 0) *(f32x2*)((float*)(ws + WS_LNST) + (size_t)(tm * 128 + m) * 16 + tn * 2) = (f32x2){s, q};
        });
        __syncthreads();
    }
    if (!conv_first) convert_tables(p);
}

DI void ln1_stats(const unsigned char* ws, int row, float& mean, float& rstd) {
    const f32x4* st = (const f32x4*)((const float*)(ws + WS_LNST) + (size_t)row * 16);
    const f32x4 a = st[0], b = st[1], c = st[2], d = st[3];
    const float s = ((a.x + a.z) + (b.x + b.z)) + ((c.x + c.z) + (d.x + d.z));
    const float q = ((a.y + a.w) + (b.y + b.w)) + ((c.y + c.w) + (d.y + d.w));
    mean = s * (1.0f / 1024.0f);
    const float var = fmaxf(q * (1.0f / 1024.0f) - mean * mean, 0.f);
    rstd = rsqrtf(var + LN_EPS);
}

DI void phase5(const Params& p) {
    unsigned char* ws = p.ws;
    const int lane = threadIdx.x & 63, wid = threadIdx.x >> 6;
    const float* gg = p.in[12];
    const float* bb = p.in[13];
    bf16_t* h1 = (bf16_t*)(ws + WS_H1);
    for (int row = blockIdx.x * 4 + wid; row < NTOK; row += gridDim.x * 4) {
        const u32x2* xr = (const u32x2*)((const bf16_t*)(ws + WS_Z) + (size_t)row * 1024) + lane;
        f32x4 v[4];
        float s = 0.f;
#pragma unroll
        for (int j = 0; j < 4; ++j) { const u32x2 w = xr[64 * j]; v[j] = (f32x4){bflo(w.x), bfhi(w.x), bflo(w.y), bfhi(w.y)}; s += (v[j].x + v[j].y) + (v[j].z + v[j].w); }
        const float mean = wave_sum(s) * (1.0f / 1024.0f);
        float s2 = 0.f;
#pragma unroll
        for (int j = 0; j < 4; ++j) { v[j] = v[j] - mean; s2 += (v[j].x * v[j].x + v[j].y * v[j].y) + (v[j].z * v[j].z + v[j].w * v[j].w); }
        const float rstd = rsqrtf(wave_sum(s2) * (1.0f / 1024.0f) + LN_EPS);
#pragma unroll
        for (int j = 0; j < 4; ++j) {
            const f32x4 g4 = ((const f32x4*)gg)[lane + 64 * j], b4 = ((const f32x4*)bb)[lane + 64 * j];
            u32x2 o = {pk2(v[j].x * rstd * g4.x + b4.x, v[j].y * rstd * g4.y + b4.y), pk2(v[j].z * rstd * g4.z + b4.z, v[j].w * rstd * g4.w + b4.w)};
            *(u32x2*)(h1 + (size_t)row * 1024 + (lane + 64 * j) * 4) = o;
        }
    }
}


DI void ce_desc(int& a, int& b) { const int hi = a > b ? a : b, lo = a > b ? b : a; a = hi; b = lo; }
template <int K, int J> DI void bst(int (&a)[16]) {
#pragma unroll
    for (int i = 0; i < 16; ++i) { const int l = i ^ J; if (l > i) { if ((i & K) == 0) ce_desc(a[i], a[l]); else ce_desc(a[l], a[i]); } }
}
DI void sort16(int (&a)[16]) { bst<2, 1>(a); bst<4, 2>(a); bst<4, 1>(a); bst<8, 4>(a); bst<8, 2>(a); bst<8, 1>(a); bst<16, 8>(a); bst<16, 4>(a); bst<16, 2>(a); bst<16, 1>(a); }
DI void merge_top16(int (&a)[16], const int (&b)[16]) {
#pragma unroll
    for (int i = 0; i < 16; ++i) a[i] = a[i] > b[15 - i] ? a[i] : b[15 - i];
    bst<16, 8>(a); bst<16, 4>(a); bst<16, 2>(a); bst<16, 1>(a);
}

constexpr int cand_i(int c) { return c < 16 ? 0 : c < 24 ? 1 : c < 29 ? 2 : c < 33 ? 3 : c < 36 ? 4 : c < 38 ? 5 : c < 40 ? 6 : c < 42 ? 7 : c - 34; }
constexpr int cand_j(int c) { return c < 16 ? c : c < 24 ? c - 16 : c < 29 ? c - 24 : c < 33 ? c - 29 : c < 36 ? c - 33 : c < 38 ? c - 36 : c < 40 ? c - 38 : c < 42 ? c - 40 : 0; }
DI void cand_ij(int c, int& i, int& j) {
    if (c < 16) { i = 0; j = c; } else if (c < 24) { i = 1; j = c - 16; } else if (c < 29) { i = 2; j = c - 24; } else if (c < 33) { i = 3; j = c - 29; }
    else if (c < 36) { i = 4; j = c - 33; } else if (c < 38) { i = 5; j = c - 36; } else if (c < 40) { i = 6; j = c - 38; } else if (c < 42) { i = 7; j = c - 40; }
    else { i = c - 34; j = 0; }
}
DI float key_val6(int k) { int b = k & ~63; b ^= (b >> 31) & 0x7fffffff; return __int_as_float(b); }

DI void phase6(const Params& p, unsigned char* lds) {
    unsigned char* ws = p.ws;
    const int tid = threadIdx.x, lane = tid & 63, wid = tid >> 6, wr = wid >> 1, wc = wid & 1, r = lane & 31, h = lane >> 5;
    const bf16_t* h1 = (const bf16_t*)(ws + WS_Z);
    const bf16_t* wq = (const bf16_t*)(ws + WS_WQT);
    const bf16_t* sk = (const bf16_t*)(ws + WS_SUBK);
    const float* c1 = (const float*)(ws + WS_C1);
    const float* c2 = (const float*)(ws + WS_C2);
    int* routeE = (int*)(ws + WS_TOPK);
    float* routeG = (float*)(ws + WS_TOPK + 8 * MiB);
    int* L1s = (int*)(lds + 65536);
    const int G8 = (gridDim.x & 7) == 0 ? gridDim.x >> 3 : 0;
    for (int l0 = G8 ? 0 : (int)blockIdx.x; l0 < (G8 ? 128 : 1024); l0 += (G8 ? G8 : (int)gridDim.x)) {
        const int li = G8 ? l0 + cu_pair_pos((int)(blockIdx.x >> 3), G8) : l0;
        if (G8 && li >= 128) break;
        const int pair = G8 ? (int)(blockIdx.x & 7) * 128 + li : li;
        const int tm = pair >> 3, head = pair & 7;
        int ka[16], kb[16];
        float rmean[2], rrstd[2];
#pragma unroll
        for (int mi = 0; mi < 2; ++mi) ln1_stats(ws, tm * 128 + wr * 64 + mi * 32 + r, rmean[mi], rrstd[mi]);
        if (tid < 128) {
            const int kh = tid >> 6, wh = (tid >> 5) & 1, q4 = tid & 31;
            *(f32x4*)(lds + LDS_CST + kh * 1024 + wh * 512 + q4 * 16) = *(const f32x4*)((wh ? c2 : c1) + (head * 2 + kh) * 128 + q4 * 4);
        }
#pragma unroll 1
        for (int khalf = 0; khalf < 2; ++khalf) {
            const int tn = head * 2 + khalf;
            f32x16 acc[2][2];
            gemm_mainloop(h1 + (size_t)tm * 128 * 1024, 1024, wq + (size_t)tn * 128 * 1024, 1024, 1024, acc, lds);
            epi_foreach(acc, [&](int m, int n, f32x4 v) {
                const int mi = (m >> 5) & 1;
                const float mu = mi ? rmean[1] : rmean[0], rs = mi ? rrstd[1] : rrstd[0];
                const f32x4 k1 = *(const f32x4*)(lds + LDS_CST + khalf * 1024 + n * 4), k2 = *(const f32x4*)(lds + LDS_CST + khalf * 1024 + 512 + n * 4);
                u32x2 o = {pk2(rs * (v.x - mu * k1.x) + k2.x, rs * (v.y - mu * k1.y) + k2.y), pk2(rs * (v.z - mu * k1.z) + k2.z, rs * (v.w - mu * k1.w) + k2.w)};
                *(u32x2*)(lds + m * 272 + n * 2) = o;
            });
            __syncthreads();
            f32x16 a2[2][2];
#pragma unroll
            for (int mi = 0; mi < 2; ++mi)
#pragma unroll
                for (int ni = 0; ni < 2; ++ni)
#pragma unroll
                    for (int i = 0; i < 16; ++i) a2[mi][ni][i] = 0.f;
#pragma unroll
            for (int ks = 0; ks < 8; ++ks) {
                bf16x8 fa[2], fb[2];
#pragma unroll
                for (int mi = 0; mi < 2; ++mi) fa[mi] = *(const bf16x8*)(lds + (wr * 64 + mi * 32 + r) * 272 + ks * 32 + h * 16);
#pragma unroll
                for (int ni = 0; ni < 2; ++ni) fb[ni] = *(const bf16x8*)(sk + (size_t)(khalf * 128 + wc * 64 + ni * 32 + r) * 128 + ks * 16 + h * 8);
#pragma unroll
                for (int mi = 0; mi < 2; ++mi)
#pragma unroll
                    for (int ni = 0; ni < 2; ++ni) a2[mi][ni] = MFMA32(fb[ni], fa[mi], a2[mi][ni]);
            }
            __syncthreads();
#pragma unroll
            for (int mi = 0; mi < 2; ++mi) {
                int xa[16], xb[16];
#pragma unroll
                for (int i = 0; i < 16; ++i) {
                    const int n = wc * 64 + (i & 3) + 8 * (i >> 2) + 4 * h;
                    xa[i] = make_key(a2[mi][0][i], n); xb[i] = make_key(a2[mi][1][i], n + 32);
                }
                sort16(xa); sort16(xb); merge_top16(xa, xb);
#pragma unroll
                for (int i = 0; i < 16; ++i) xb[i] = __shfl_xor(xa[i], 32);
                merge_top16(xa, xb);
                if (h == 0) {
                    int* dst = (int*)lds + ((wr * 64 + mi * 32 + r) * 2 + wc) * 16;
#pragma unroll
                    for (int q4 = 0; q4 < 4; ++q4) { u32x4 o = {(unsigned)xa[4 * q4], (unsigned)xa[4 * q4 + 1], (unsigned)xa[4 * q4 + 2], (unsigned)xa[4 * q4 + 3]}; *(u32x4*)(dst + 4 * q4) = o; }
                }
            }
            __syncthreads();
            if (tid < 128) {
                const int* s0 = (const int*)lds + tid * 32;
#pragma unroll
                for (int q4 = 0; q4 < 4; ++q4) {
                    const u32x4 x = *(const u32x4*)(s0 + 4 * q4), y = *(const u32x4*)(s0 + 16 + 4 * q4);
                    ka[4 * q4] = (int)x.x; ka[4 * q4 + 1] = (int)x.y; ka[4 * q4 + 2] = (int)x.z; ka[4 * q4 + 3] = (int)x.w;
                    kb[4 * q4] = (int)y.x; kb[4 * q4 + 1] = (int)y.y; kb[4 * q4 + 2] = (int)y.z; kb[4 * q4 + 3] = (int)y.w;
                }
                merge_top16(ka, kb);
                if (khalf == 0) {
#pragma unroll
                    for (int q4 = 0; q4 < 4; ++q4) { u32x4 o = {(unsigned)ka[4 * q4], (unsigned)ka[4 * q4 + 1], (unsigned)ka[4 * q4 + 2], (unsigned)ka[4 * q4 + 3]}; *(u32x4*)(L1s + tid * 16 + 4 * q4) = o; }
                }
            }
            if (khalf == 0) __syncthreads();
        }
        if (tid < 128) {
            int* L2s = (int*)lds + tid * 32;
#pragma unroll
            for (int q4 = 0; q4 < 4; ++q4) { u32x4 o = {(unsigned)ka[4 * q4], (unsigned)ka[4 * q4 + 1], (unsigned)ka[4 * q4 + 2], (unsigned)ka[4 * q4 + 3]}; *(u32x4*)(L2s + 4 * q4) = o; }
            float v1[16], v2[16];
#pragma unroll
            for (int q4 = 0; q4 < 4; ++q4) {
                const u32x4 x = *(const u32x4*)(L1s + tid * 16 + 4 * q4);
                v1[4 * q4] = key_val((int)x.x); v1[4 * q4 + 1] = key_val((int)x.y); v1[4 * q4 + 2] = key_val((int)x.z); v1[4 * q4 + 3] = key_val((int)x.w);
            }
#pragma unroll
            for (int i = 0; i < 16; ++i) v2[i] = key_val(ka[i]);
            int g0[16], g1[16], g2[16], g3[16];
#pragma unroll
            for (int t = 0; t < 16; ++t) {
                { const float s = v1[cand_i(t)] + v2[cand_j(t)]; int b = __float_as_int(s); b ^= (b >> 31) & 0x7fffffff; g0[t] = (b & ~63) | (63 - t); }
                { const float s = v1[cand_i(16 + t)] + v2[cand_j(16 + t)]; int b = __float_as_int(s); b ^= (b >> 31) & 0x7fffffff; g1[t] = (b & ~63) | (63 - (16 + t)); }
                { const float s = v1[cand_i(32 + t)] + v2[cand_j(32 + t)]; int b = __float_as_int(s); b ^= (b >> 31) & 0x7fffffff; g2[t] = (b & ~63) | (63 - (32 + t)); }
                if (t < 2) { const float s = v1[cand_i(48 + t)] + v2[cand_j(48 + t)]; int b = __float_as_int(s); b ^= (b >> 31) & 0x7fffffff; g3[t] = (b & ~63) | (63 - (48 + t)); }
                else g3[t] = (int)0x80000000 + t;
            }
            sort16(g0); sort16(g1); sort16(g2); sort16(g3);
            merge_top16(g0, g1); merge_top16(g2, g3); merge_top16(g0, g2);
            const float smax = key_val6(g0[0]);
            float ex[16], den = 0.f;
#pragma unroll
            for (int t = 0; t < 16; ++t) { ex[t] = __expf(key_val6(g0[t]) - smax); den += ex[t]; }
            const float inv = 1.0f / den;
            const size_t ro = ((size_t)(tm * 128 + tid) * 8 + head) * 16;
#pragma unroll
            for (int q4 = 0; q4 < 4; ++q4) {
                int ee[4];
#pragma unroll
                for (int u = 0; u < 4; ++u) {
                    int ci, cj; cand_ij(63 - (g0[4 * q4 + u] & 63), ci, cj);
                    ee[u] = (L1s[tid * 16 + ci] & 127) * 128 + (L2s[cj] & 127);
                }
                u32x4 oe = {(unsigned)ee[0], (unsigned)ee[1], (unsigned)ee[2], (unsigned)ee[3]};
                f32x4 og = {ex[4 * q4] * inv, ex[4 * q4 + 1] * inv, ex[4 * q4 + 2] * inv, ex[4 * q4 + 3] * inv};
                *(u32x4*)(routeE + ro + 4 * q4) = oe;
                *(f32x4*)(routeG + ro + 4 * q4) = og;
            }
        }
        __syncthreads();
    }
}

constexpr int P7_NS = 32, P7_SH = 9;
constexpr int P7_WLDS = 6144;
DI void p7_loadrows(int b, int li, int l32, const LAS int* ent_e, const unsigned char* tab, u32x4 (&rows)[8][2]) {
    const u32x4 e0 = *(const LAS u32x4*)(ent_e + li * 128 + b), e1 = *(const LAS u32x4*)(ent_e + li * 128 + b + 4);
    const unsigned ee[8] = {e0.x, e0.y, e0.z, e0.w, e1.x, e1.y, e1.z, e1.w};
#pragma unroll
    for (int r = 0; r < 8; ++r) {
        const unsigned ob = ee[r] * 1024u + (unsigned)l32 * 16u;
        rows[r][0] = *(const u32x4*)(tab + ob);
        rows[r][1] = *(const u32x4*)(tab + ob + 512);
    }
}
DI float half32_sum(float v) { v += __shfl_xor(v, 1); v += __shfl_xor(v, 2); v += __shfl_xor(v, 4); v += __shfl_xor(v, 8); v += __shfl_xor(v, 16); return v; }

DI void p7_stepA(const u32x4 (&rows)[8][2], const unsigned (&hq)[2][4], float hscale, int b, int li, int l32, int lane, int myk,
                 LAS float* ent_w, const LAS float* ent_us) {
    int d[8];
#pragma unroll
    for (int r = 0; r < 8; ++r) {
        int a = 0;
#pragma unroll
        for (int c = 0; c < 2; ++c)
#pragma unroll
            for (int q = 0; q < 4; ++q) a = dot4i8(rows[r][c][q], hq[c][q], a);
        d[r] = a;
    }
    int r4[4], r2[2], r1;
    const bool b0 = lane & 1;
#pragma unroll
    for (int i = 0; i < 4; ++i) { const int snd = b0 ? d[i] : d[4 + i]; const int kp = b0 ? d[4 + i] : d[i]; r4[i] = kp + __shfl_xor(snd, 1); }
    const bool b1 = lane & 2;
#pragma unroll
    for (int i = 0; i < 2; ++i) { const int snd = b1 ? r4[i] : r4[2 + i]; const int kp = b1 ? r4[2 + i] : r4[i]; r2[i] = kp + __shfl_xor(snd, 2); }
    const bool b2 = lane & 4;
    { const int snd = b2 ? r2[0] : r2[1]; const int kp = b2 ? r2[1] : r2[0]; r1 = kp + __shfl_xor(snd, 4); }
    r1 += __shfl_xor(r1, 8); r1 += __shfl_xor(r1, 16);
    if (l32 < 8) { const int idx = li * 128 + b + myk; ent_w[idx] = ent_w[idx] * gelu_fast((float)r1 * (hscale * ent_us[idx])); }
}
DI void p7_stepA6(const unsigned (&rw)[8][6], const f16x2_t (&h16)[16], int b, int li, int l32, int lane, int myk,
                  LAS float* ent_w, const LAS float* ent_us) {
    float d[8];
#pragma unroll
    for (int r = 0; r < 8; ++r) {
        const u32x6 pk = {rw[r][0], rw[r][1], rw[r][2], rw[r][3], rw[r][4], rw[r][5]};
        const f16x32 u = __builtin_amdgcn_cvt_scalef32_pk32_f16_fp6(pk, 1.0f);
        float a0 = 0.f, a1 = 0.f;
#pragma unroll
        for (int j = 0; j < 16; j += 2) {
            a0 = __builtin_amdgcn_fdot2((f16x2_t){u[2 * j], u[2 * j + 1]}, h16[j], a0, false);
            a1 = __builtin_amdgcn_fdot2((f16x2_t){u[2 * j + 2], u[2 * j + 3]}, h16[j + 1], a1, false);
        }
        d[r] = a0 + a1;
        if (r & 1) __builtin_amdgcn_sched_barrier(0);
    }
    float r4[4], r2[2], r1;
    const bool b0 = lane & 1;
#pragma unroll
    for (int i = 0; i < 4; ++i) { const float snd = b0 ? d[i] : d[4 + i]; const float kp = b0 ? d[4 + i] : d[i]; r4[i] = kp + __shfl_xor(snd, 1); }
    const bool b1 = lane & 2;
#pragma unroll
    for (int i = 0; i < 2; ++i) { const float snd = b1 ? r4[i] : r4[2 + i]; const float kp = b1 ? r4[2 + i] : r4[i]; r2[i] = kp + __shfl_xor(snd, 2); }
    const bool b2 = lane & 4;
    { const float snd = b2 ? r2[0] : r2[1]; const float kp = b2 ? r2[1] : r2[0]; r1 = kp + __shfl_xor(snd, 4); }
    r1 += __shfl_xor(r1, 8); r1 += __shfl_xor(r1, 16);
    if (l32 < 8) { const int idx = li * 128 + b + myk; ent_w[idx] = ent_w[idx] * gelu_fast(r1 * ent_us[idx]); }
}
DI void p7_stepB(const u32x4 (&rows)[8][2], f32x2 (&acc)[2][8], int b, int li, const LAS float* ent_w) {
    const f32x4 w0 = *(const LAS f32x4*)(ent_w + li * 128 + b), w1 = *(const LAS f32x4*)(ent_w + li * 128 + b + 4);
    const float ww[8] = {w0.x, w0.y, w0.z, w0.w, w1.x, w1.y, w1.z, w1.w};
#pragma unroll
    for (int r = 0; r < 8; ++r) {
        const f32x2 w2 = {ww[r], ww[r]};
#pragma unroll
        for (int c = 0; c < 2; ++c)
#pragma unroll
            for (int q = 0; q < 4; ++q) {
                const f32x2 lo = __builtin_amdgcn_cvt_pk_f32_fp8((int)rows[r][c][q], false);
                const f32x2 hi = __builtin_amdgcn_cvt_pk_f32_fp8((int)rows[r][c][q], true);
                acc[c][2 * q] += w2 * lo; acc[c][2 * q + 1] += w2 * hi;
            }
    }
}
DI void p7_loadrows6(int b, int li, int l32, const LAS int* ent_e, const unsigned char* tab, unsigned (&rw)[8][6]) {
    const u32x4 e0 = *(const LAS u32x4*)(ent_e + li * 128 + b), e1 = *(const LAS u32x4*)(ent_e + li * 128 + b + 4);
    const unsigned ee[8] = {e0.x, e0.y, e0.z, e0.w, e1.x, e1.y, e1.z, e1.w};
#pragma unroll
    for (int r = 0; r < 8; ++r) {
        const unsigned ob = ee[r] * 768u;
        const u32x4 x = *(const u32x4*)(tab + ob + (unsigned)l32 * 16u);
        const u32x2 y = *(const u32x2*)(tab + ob + 512u + (unsigned)l32 * 8u);
        rw[r][0] = x.x; rw[r][1] = x.y; rw[r][2] = x.z; rw[r][3] = x.w; rw[r][4] = y.x; rw[r][5] = y.y;
    }
}
DI void p7_stepB6(const unsigned (&rw)[8][6], f32x2 (&acc)[2][8], int b, int li, const LAS float* ent_w) {
    const f32x4 w0 = *(const LAS f32x4*)(ent_w + li * 128 + b), w1 = *(const LAS f32x4*)(ent_w + li * 128 + b + 4);
    const float ww[8] = {w0.x, w0.y, w0.z, w0.w, w1.x, w1.y, w1.z, w1.w};
#pragma unroll
    for (int r = 0; r < 8; ++r) {
        const u32x6 pk = {rw[r][0], rw[r][1], rw[r][2], rw[r][3], rw[r][4], rw[r][5]};
        const f32x32 d = __builtin_amdgcn_cvt_scalef32_pk32_f32_fp6(pk, 1.0f);
        const f32x2 w2 = {ww[r], ww[r]};
#pragma unroll
        for (int c = 0; c < 2; ++c)
#pragma unroll
            for (int i = 0; i < 8; ++i) acc[c][i] += w2 * (f32x2){d[c * 16 + 2 * i], d[c * 16 + 2 * i + 1]};
    }
}
DI void p7_loadrows4(int b, int li, int l32, const LAS int* ent_e, const unsigned char* tab, u32x4 (&rw)[8]) {
    const u32x4 e0 = *(const LAS u32x4*)(ent_e + li * 128 + b), e1 = *(const LAS u32x4*)(ent_e + li * 128 + b + 4);
    const unsigned ee[8] = {e0.x, e0.y, e0.z, e0.w, e1.x, e1.y, e1.z, e1.w};
#pragma unroll
    for (int r = 0; r < 8; ++r) rw[r] = *(const u32x4*)(tab + ee[r] * 512u + (unsigned)l32 * 16u);
}
DI void p7_stepB4(const u32x4 (&rw)[8], f32x2 (&acc)[2][8], int b, int li, const LAS float* ent_w) {
    const f32x4 w0 = *(const LAS f32x4*)(ent_w + li * 128 + b), w1 = *(const LAS f32x4*)(ent_w + li * 128 + b + 4);
    const float ww[8] = {w0.x, w0.y, w0.z, w0.w, w1.x, w1.y, w1.z, w1.w};
#pragma unroll
    for (int r = 0; r < 8; ++r) {
        const f32x2 w2 = {ww[r], ww[r]};
#pragma unroll
        for (int c = 0; c < 2; ++c)
#pragma unroll
            for (int d = 0; d < 2; ++d) {
                const unsigned wd = rw[r][c * 2 + d];
                acc[c][d * 4 + 0] += w2 * __builtin_amdgcn_cvt_scalef32_pk_f32_fp4(wd, 1.0f, 0);
                acc[c][d * 4 + 1] += w2 * __builtin_amdgcn_cvt_scalef32_pk_f32_fp4(wd, 1.0f, 1);
                acc[c][d * 4 + 2] += w2 * __builtin_amdgcn_cvt_scalef32_pk_f32_fp4(wd, 1.0f, 2);
                acc[c][d * 4 + 3] += w2 * __builtin_amdgcn_cvt_scalef32_pk_f32_fp4(wd, 1.0f, 3);
            }
    }
}
constexpr int P7_GB = 32768;
DI void p7_load_h(const Params& p, const LAS unsigned char* gb, int tok, int l32, float (&hv)[32]) {
    const unsigned char* ws = p.ws;
    float mean, rstd;
    ln1_stats(ws, tok, mean, rstd);
    const bf16_t* y1 = (const bf16_t*)(ws + WS_Z) + (size_t)tok * 1024 + l32 * 16;
    const LAS float* gg = (const LAS float*)(gb + P7_GB) + l32 * 16;
    const LAS float* bb = gg + 1024;
#pragma unroll
    for (int c = 0; c < 2; ++c) {
        const u32x4 a = *(const u32x4*)(y1 + c * 512), b2 = *(const u32x4*)(y1 + c * 512 + 8);
        const unsigned hh[8] = {a.x, a.y, a.z, a.w, b2.x, b2.y, b2.z, b2.w};
#pragma unroll
        for (int i4 = 0; i4 < 4; ++i4) {
            const f32x4 g4 = *(const LAS f32x4*)(gg + c * 512 + i4 * 4), b4 = *(const LAS f32x4*)(bb + c * 512 + i4 * 4);
            hv[c * 16 + 4 * i4 + 0] = (bflo(hh[2 * i4]) - mean) * rstd * g4.x + b4.x;
            hv[c * 16 + 4 * i4 + 1] = (bfhi(hh[2 * i4]) - mean) * rstd * g4.y + b4.y;
            hv[c * 16 + 4 * i4 + 2] = (bflo(hh[2 * i4 + 1]) - mean) * rstd * g4.z + b4.z;
            hv[c * 16 + 4 * i4 + 3] = (bfhi(hh[2 * i4 + 1]) - mean) * rstd * g4.w + b4.w;
        }
    }
}
DI void p7_h16(const Params& p, const LAS unsigned char* gb, int tok, int l32, f16x2_t (&h16)[16]) {
    float hv[32];
    p7_load_h(p, gb, tok, l32, hv);
#pragma unroll
    for (int j = 0; j < 16; ++j) h16[j] = (f16x2_t){(_Float16)hv[2 * j], (_Float16)hv[2 * j + 1]};
}
DI void p7_quant_h(const Params& p, const LAS unsigned char* gb, int tok, int l32, unsigned (&hq)[2][4], float& hscale) {
    float hv[32];
    p7_load_h(p, gb, tok, l32, hv);
    float am = 0.f;
#pragma unroll
    for (int i = 0; i < 32; ++i) am = fmaxf(am, fabsf(hv[i]));
    am = fmaxf(am, __shfl_xor(am, 1)); am = fmaxf(am, __shfl_xor(am, 2)); am = fmaxf(am, __shfl_xor(am, 4)); am = fmaxf(am, __shfl_xor(am, 8)); am = fmaxf(am, __shfl_xor(am, 16));
    const float hq_sc = am > 0.f ? 127.0f / am : 1.0f;
    hscale = am > 0.f ? am / 127.0f : 1.0f;
#pragma unroll
    for (int c = 0; c < 2; ++c)
#pragma unroll
        for (int q = 0; q < 4; ++q) {
            const int q0 = (int)rintf(hv[c * 16 + 4 * q] * hq_sc), q1 = (int)rintf(hv[c * 16 + 4 * q + 1] * hq_sc);
            const int q2 = (int)rintf(hv[c * 16 + 4 * q + 2] * hq_sc), q3 = (int)rintf(hv[c * 16 + 4 * q + 3] * hq_sc);
            hq[c][q] = (unsigned)(q0 & 255) | ((unsigned)(q1 & 255) << 8) | ((unsigned)(q2 & 255) << 16) | ((unsigned)(q3 & 255) << 24);
        }
}
DI void p7_finish(const Params& p, int tok, const float (&hv)[32], f32x2 (&acc)[2][8], int l32) {
    const size_t hbase = (size_t)tok * 1024 + l32 * 16;
    float sm = 0.f;
    {
#pragma unroll
        for (int c = 0; c < 2; ++c)
#pragma unroll
            for (int i = 0; i < 8; ++i) {
                acc[c][i].x += ALPHA * hv[c * 16 + 2 * i]; acc[c][i].y += ALPHA * hv[c * 16 + 2 * i + 1];
                sm += acc[c][i].x + acc[c][i].y;
            }
    }
    const float mean = half32_sum(sm) * (1.0f / 1024.0f);
    float sq = 0.f;
#pragma unroll
    for (int c = 0; c < 2; ++c)
#pragma unroll
        for (int i = 0; i < 8; ++i) { acc[c][i].x -= mean; acc[c][i].y -= mean; sq += acc[c][i].x * acc[c][i].x + acc[c][i].y * acc[c][i].y; }
    const float rstd = rsqrtf(half32_sum(sq) * (1.0f / 1024.0f) + LN_EPS);
    const float* gg = p.in[18] + l32 * 16;
    const float* bb = p.in[19] + l32 * 16;
    float* orow = p.out + hbase;
#pragma unroll
    for (int c = 0; c < 2; ++c)
#pragma unroll
        for (int q4 = 0; q4 < 4; ++q4) {
            const f32x4 g4 = *(const f32x4*)(gg + c * 512 + q4 * 4), b4 = *(const f32x4*)(bb + c * 512 + q4 * 4);
            f32x4 o = {acc[c][2 * q4].x * rstd * g4.x + b4.x, acc[c][2 * q4].y * rstd * g4.y + b4.y,
                       acc[c][2 * q4 + 1].x * rstd * g4.z + b4.z, acc[c][2 * q4 + 1].y * rstd * g4.w + b4.w};
            *(f32x4*)(orow + c * 512 + q4 * 4) = o;
        }
}

DI void phase7(const Params& p, unsigned char* lds) {
    unsigned char* ws = p.ws;
    const int lane = threadIdx.x & 63, wid = __builtin_amdgcn_readfirstlane(threadIdx.x >> 6);
    const int hw = lane >> 5, l32 = lane & 31;
    LAS unsigned char* l3 = (LAS unsigned char*)lds + wid * P7_WLDS;
    const unsigned char* u8 = ws + WS_UB;
    const unsigned char* v8 = ws + WS_VB;
    const float* uscale = (const float*)(ws + WS_USCALE);
    const float* vscale = (const float*)(ws + WS_VSCALE);
    LAS int* ent_e = (LAS int*)l3;
    LAS float* ent_w = (LAS float*)(l3 + 2048);
    LAS float* ent_us = (LAS float*)(l3 + 4096);
    {
        const int t = threadIdx.x;
        *(f32x4*)(lds + P7_GB + t * 16) = *(const f32x4*)(p.in[12] + t * 4);
        *(f32x4*)(lds + P7_GB + 4096 + t * 16) = *(const f32x4*)(p.in[13] + t * 4);
        __syncthreads();
    }
    const unsigned long long ltmask = (1ull << lane) - 1ull;
    const int myk = ((lane & 1) << 2) | (lane & 2) | ((lane >> 2) & 1);
    const int li0 = hw, li1 = 2 + hw;
    for (int rnd = blockIdx.x * 4 + wid; rnd < NTOK / 4; rnd += gridDim.x * 4) {
        const int tok0 = rnd * 4;
#pragma unroll 1
        for (int tk = 0; tk < 4; ++tk) {
            const int* RE = (const int*)(ws + WS_TOPK) + (size_t)(tok0 + tk) * 128;
            const float* RG = (const float*)(ws + WS_TOPK + 8 * MiB) + (size_t)(tok0 + tk) * 128;
            const int ea = RE[lane], eb = RE[64 + lane];
            const float ga = RG[lane], gb = RG[64 + lane];
            const int sa = ea >> P7_SH, sb = eb >> P7_SH;
            int pa = 0, pb = 0, run = 0;
#pragma unroll
            for (int s = 0; s < P7_NS; ++s) {
                const unsigned long long ma = __ballot(sa == s), mb = __ballot(sb == s);
                const int ca = __popcll(ma), cb = __popcll(mb);
                if (sa == s) pa = run + __popcll(ma & ltmask);
                if (sb == s) pb = run + ca + __popcll(mb & ltmask);
                run += ca + cb;
            }
            ent_e[tk * 128 + pa] = ea; ent_w[tk * 128 + pa] = ga * vscale[ea]; ent_us[tk * 128 + pa] = uscale[ea];
            ent_e[tk * 128 + pb] = eb; ent_w[tk * 128 + pb] = gb * vscale[eb]; ent_us[tk * 128 + pb] = uscale[eb];
        }
        {
            f16x2_t h0[16], h1[16];
            p7_h16(p, (const LAS unsigned char*)lds, tok0 + li0, l32, h0);
            p7_h16(p, (const LAS unsigned char*)lds, tok0 + li1, l32, h1);
            unsigned ra[8][6], rb[8][6];
            p7_loadrows6(0, li0, l32, ent_e, u8, ra);
            for (int b = 0; b < 128; b += 8) {
                p7_loadrows6(b, li1, l32, ent_e, u8, rb);
                __builtin_amdgcn_sched_barrier(0);
                p7_stepA6(ra, h0, b, li0, l32, lane, myk, ent_w, ent_us);
                __builtin_amdgcn_sched_barrier(0);
                p7_loadrows6(b + 8 < 128 ? b + 8 : b, li0, l32, ent_e, u8, ra);
                __builtin_amdgcn_sched_barrier(0);
                p7_stepA6(rb, h1, b, li1, l32, lane, myk, ent_w, ent_us);
                __builtin_amdgcn_sched_barrier(0);
            }
        }
        f32x2 acc0[2][8], acc1[2][8];
#pragma unroll
        for (int c = 0; c < 2; ++c)
#pragma unroll
            for (int i = 0; i < 8; ++i) { acc0[c][i] = (f32x2){0.f, 0.f}; acc1[c][i] = (f32x2){0.f, 0.f}; }
        {
            u32x4 ra[8], rb[8];
            p7_loadrows4(0, li0, l32, ent_e, v8, ra);
            for (int b = 0; b < 128; b += 8) {
                p7_loadrows4(b, li1, l32, ent_e, v8, rb);
                __builtin_amdgcn_sched_barrier(0);
                p7_stepB4(ra, acc0, b, li0, ent_w);
                __builtin_amdgcn_sched_barrier(0);
                p7_loadrows4(b + 8 < 128 ? b + 8 : b, li0, l32, ent_e, v8, ra);
                __builtin_amdgcn_sched_barrier(0);
                p7_stepB4(rb, acc1, b, li1, ent_w);
                __builtin_amdgcn_sched_barrier(0);
            }
        }
        asm volatile("" ::: "memory");
        {
            float hv0[32], hv1[32];
            p7_load_h(p, (const LAS unsigned char*)lds, tok0 + li0, l32, hv0);
            p7_load_h(p, (const LAS unsigned char*)lds, tok0 + li1, l32, hv1);
            p7_finish(p, tok0 + li0, hv0, acc0, l32);
            p7_finish(p, tok0 + li1, hv1, acc1, l32);
        }
    }
}

#if DIAG
DI float bfv(const bf16_t* p, size_t i) { return __uint_as_float(((unsigned)p[i]) << 16); }
DI float bfr(float x) { return __uint_as_float(f2bf(x) << 16); }
DI void dfail(const Params& p, int bit) { atomicOr((unsigned*)(p.ws + WS_FLAG), 1u << bit); }
DI bool bad(float fast, float ref) { return !(fabsf(fast - ref) <= 0.02f * fabsf(ref) + 0.02f); }
DI unsigned hsh(unsigned x) { x ^= x >> 16; x *= 0x7feb352dU; x ^= x >> 15; x *= 0x846ca68bU; x ^= x >> 16; return x; }
DI int winsrc(int n) { return n < 1280 ? n : (n < 1792 ? 1304 + (n - 1280) : 1280 + (n - 1792)); }

DI void chk1(const Params& p, int bit) {
    unsigned char* ws = p.ws;
    const unsigned gt = blockIdx.x * NTHREADS + threadIdx.x;
    const int tok = hsh(gt * 2 + 1) & 16383, n = hsh(gt * 2 + 2) % 1816;
    const bf16_t* xb = (const bf16_t*)(ws + WS_XB);
    const bf16_t* wt = (const bf16_t*)(ws + WS_WINT);
    float ref = 0.f, ref2 = 0.f;
    for (int k = 0; k < 1024; ++k) {
        ref += bfv(xb, (size_t)tok * 1024 + k) * bfv(wt, (size_t)n * 1024 + k);
        ref2 += p.in[0][(size_t)tok * 1024 + k] * p.in[1][(size_t)k * 1816 + winsrc(n)];
    }
    if (!(fabsf(ref - ref2) <= 0.06f)) dfail(p, bit);
    const int b = tok >> 12, t = tok & 4095;
    float fast;
    if (n < 512) { const int hd = n >> 6, d = n & 63; fast = bfv((const bf16_t*)(ws + WS_Q), ((size_t)(b * 8 + hd) * SEQ + t) * 64 + d); ref *= 0.125f; }
    else if (n < 1280) {
        const int seg = (n - 512) >> 7, nn = (n - 512) & 127, g = nn >> 6, d = nn & 63;
        if (seg == 3 || seg == 5) fast = bfv((const bf16_t*)(ws + (seg == 3 ? WS_VSLCT : WS_VWINT)), ((size_t)((b * 2 + g) * 64 + d)) * SEQ + t);
        else fast = bfv((const bf16_t*)(ws + (seg == 0 ? WS_KC : seg == 1 ? WS_VC : seg == 2 ? WS_KSLC : WS_KWIN)), ((size_t)(b * 2 + g) * SEQ + t) * 64 + d);
    } else if (n < 1792) fast = bfv((const bf16_t*)(ws + WS_Z), (size_t)tok * 512 + (n - 1280));
    else { fast = ((const float*)(ws + WS_GATES))[(size_t)tok * 24 + (n - 1792)]; ref = 1.f / (1.f + expf(-ref)); }
    if (bad(fast, ref)) dfail(p, bit);
}
DI void chk2(const Params& p, int bit) {
    unsigned char* ws = p.ws;
    const unsigned gt = blockIdx.x * NTHREADS + threadIdx.x;
    if (gt >= 2048) return;
    const int kv = gt & 1, bg = (gt >> 1) & 7, c = hsh(gt) % 255, d = hsh(gt + 7777) & 63;
    const bf16_t* A = (const bf16_t*)(ws + (kv ? WS_VC : WS_KC)) + ((size_t)bg * SEQ + c * 16) * 64;
    const bf16_t* w1t = (const bf16_t*)(ws + (kv ? WS_W1TV : WS_W1TK));
    const bf16_t* w2t = (const bf16_t*)(ws + (kv ? WS_W2TV : WS_W2TK));
    const float* peb = (const float*)(ws + (kv ? WS_PEBV : WS_PEBK));
    float out = 0.f;
    for (int j = 0; j < 256; ++j) {
        float s = peb[j];
        for (int i = 0; i < 2048; ++i) s += bfv(A, i) * bfv(w1t, (size_t)j * 2048 + i);
        out += bfr(gelu_erf(s)) * bfv(w2t, d * 256 + j);
    }
    const float fast = ((const float*)(ws + (kv ? WS_VCMP : WS_KCMP)))[((size_t)bg * 256 + c) * 64 + d];
    if (bad(fast, out)) dfail(p, bit);
    if (gt < 256) {
        const float* w1 = kv ? p.in[7] : p.in[5];
        const float* w2 = kv ? p.in[8] : p.in[6];
        const float* pe = kv ? p.in[4] : p.in[3];
        float o2 = 0.f;
        for (int j = 0; j < 256; ++j) {
            float s = 0.f;
            for (int i = 0; i < 2048; ++i) s += (bfv(A, i) + pe[i]) * w1[(size_t)i * 256 + j];
            o2 += gelu_erf(s) * w2[j * 64 + d];
        }
        if (!(fabsf(o2 - out) <= 0.03f * fabsf(out) + 0.03f)) dfail(p, bit);
    }
}
DI void chk3(const Params& p, int bit) {
    unsigned char* ws = p.ws;
    const unsigned gt = blockIdx.x * NTHREADS + threadIdx.x;
    if (gt >= 4096) return;
    const int tok = hsh(gt) & 16383, head = hsh(gt + 99) & 7, b = tok >> 12, t = tok & 4095, g = head >> 2;
    const bf16_t* Q = (const bf16_t*)(ws + WS_Q) + ((size_t)(b * 8 + head) * SEQ + t) * 64;
    const bf16_t* K = (const bf16_t*)(ws + WS_KWIN) + (size_t)(b * 2 + g) * SEQ * 64;
    const bf16_t* Vt = (const bf16_t*)(ws + WS_VWINT) + (size_t)(b * 2 + g) * 64 * SEQ;
    float q[64], o[64];
#pragma unroll
    for (int d = 0; d < 64; ++d) { q[d] = bfv(Q, d); o[d] = 0.f; }
    float m = -1e30f, l = 0.f;
    for (int pos = (t > 511 ? t - 511 : 0); pos <= t; ++pos) {
        float s = 0.f;
#pragma unroll
        for (int d = 0; d < 64; ++d) s += q[d] * bfv(K, (size_t)pos * 64 + d);
        s += p.in[2][rel_bucket_dev(t - pos) * 8 + head];
        const float mn = fmaxf(m, s), a = expf(m - mn), pp = expf(s - mn);
        l = l * a + pp;
#pragma unroll
        for (int d = 0; d < 64; ++d) o[d] = o[d] * a + pp * bfv(Vt, (size_t)d * SEQ + pos);
        m = mn;
    }
    const float gate = ((const float*)(ws + WS_GATES))[(size_t)tok * 24 + 16 + head];
    bool f = false;
#pragma unroll
    for (int d = 0; d < 64; ++d) f |= bad(bfv((const bf16_t*)(ws + WS_OWIN), (size_t)tok * 512 + head * 64 + d), o[d] / l * gate);
    if (f) dfail(p, bit);
}
DI void chk4(const Params& p, int bit) {
    unsigned char* ws = p.ws;
    const unsigned gt = blockIdx.x * NTHREADS + threadIdx.x;
    if (gt >= 512) return;
    const int tok = hsh(gt + 5) & 16383, g = gt & 1, b = tok >> 12, t = tok & 4095, bg = b * 2 + g;
    float* scr = (float*)(ws + WS_DSCR) + (size_t)gt * 1536;
    float* imp = scr + 1024;
    float* nsa = scr + 1100;
    for (int j = 0; j < 64; ++j) imp[j] = 0.f;
    const float* kc = (const float*)(ws + WS_KCMP) + (size_t)bg * 256 * 64;
    const float* vc = (const float*)(ws + WS_VCMP) + (size_t)bg * 256 * 64;
    const float* gt24 = (const float*)(ws + WS_GATES) + (size_t)tok * 24;
    for (int hl = 0; hl < 4; ++hl) {
        const int head = g * 4 + hl;
        const bf16_t* Q = (const bf16_t*)(ws + WS_Q) + ((size_t)(b * 8 + head) * SEQ + t) * 64;
        float q[64], o[64];
#pragma unroll
        for (int d = 0; d < 64; ++d) { q[d] = bfv(Q, d); o[d] = 0.f; }
        float m = -1e30f;
        for (int c = 0; c < 255; ++c) {
            const bool valid = 16 * c + 31 <= t;
            float s = 0.f;
#pragma unroll
            for (int d = 0; d < 64; ++d) s += q[d] * bfr(kc[c * 64 + d]);
            s += p.in[2][rel_bucket_dev(t - 16 * c - 31) * 8 + head];
            scr[hl * 256 + c] = s;
            if (valid) m = fmaxf(m, s);
        }
        float l = 0.f;
        for (int c = 0; c < 255; ++c) if (16 * c + 31 <= t) l += expf(scr[hl * 256 + c] - m);
        for (int c = 0; c < 255; ++c) if (16 * c + 31 <= t) {
            const float pc = expf(scr[hl * 256 + c] - m) / l;
            imp[c >> 2] += pc;
            if ((c & 3) == 3 && (c >> 2) + 1 < 64) imp[(c >> 2) + 1] += pc;
#pragma unroll
            for (int d = 0; d < 64; ++d) o[d] += bfr(pc) * bfr(vc[c * 64 + d]);
        }
#pragma unroll
        for (int d = 0; d < 64; ++d) nsa[hl * 64 + d] = gt24[head] * o[d];
    }
    const int cur = t >> 6;
    for (int j = 0; j < 64; ++j) { float v = imp[j]; if (j == 0 || j == cur || j == cur - 1) v = 1e6f; if (j > cur) v = -1e30f; imp[j] = v; }
    unsigned long long selmask = 0ull;
    for (int it = 0; it < 16; ++it) {
        int bi = -1; float bv = -3e38f;
        for (int j = 0; j < 64; ++j) if (!((selmask >> j) & 1ull) && imp[j] > bv) { bv = imp[j]; bi = j; }
        selmask |= 1ull << bi;
    }
    bool f = false;
    for (int hl = 0; hl < 4; ++hl) {
        const int head = g * 4 + hl;
        const bf16_t* Q = (const bf16_t*)(ws + WS_Q) + ((size_t)(b * 8 + head) * SEQ + t) * 64;
        const bf16_t* K = (const bf16_t*)(ws + WS_KSLC) + (size_t)bg * SEQ * 64;
        const bf16_t* Vt = (const bf16_t*)(ws + WS_VSLCT) + (size_t)bg * 64 * SEQ;
        float q[64], o[64];
#pragma unroll
        for (int d = 0; d < 64; ++d) { q[d] = bfv(Q, d); o[d] = 0.f; }
        float m = -1e30f, l = 0.f;
        for (int j = 0; j <= cur; ++j) if ((selmask >> j) & 1ull) {
            for (int kk = 0; kk < 64; ++kk) {
                const int pos = j * 64 + kk;
                if (pos > t) break;
                float s = 0.f;
#pragma unroll
                for (int d = 0; d < 64; ++d) s += q[d] * bfv(K, (size_t)pos * 64 + d);
                s += p.in[2][rel_bucket_dev(t - pos) * 8 + head];
                const float mn = fmaxf(m, s), a = expf(m - mn), pp = expf(s - mn);
                l = l * a + pp;
#pragma unroll
                for (int d = 0; d < 64; ++d) o[d] = o[d] * a + pp * bfv(Vt, (size_t)d * SEQ + pos);
                m = mn;
            }
        }
#pragma unroll
        for (int d = 0; d < 64; ++d) {
            const float ref = nsa[hl * 64 + d] + gt24[8 + head] * o[d] / l + bfv((const bf16_t*)(ws + WS_OWIN), (size_t)tok * 512 + head * 64 + d);
            f |= bad(bfv((const bf16_t*)(ws + WS_MIXIN), (size_t)tok * 1024 + head * 64 + d), ref);
        }
    }
    if (f) dfail(p, bit);
}
DI void chk5(const Params& p, int bit) {
    unsigned char* ws = p.ws;
    const unsigned gt = blockIdx.x * NTHREADS + threadIdx.x;
    if (gt >= 8192) return;
    const int tok = hsh(gt + 11) & 16383, col = hsh(gt + 13) & 511, gi = col >> 7, d = col & 127, t = tok & 4095;
    const bf16_t* yp = (const bf16_t*)(ws + WS_YPOOL);
    const bf16_t* pw = (const bf16_t*)(ws + WS_POOLWT);
    const bf16_t* z = (const bf16_t*)(ws + WS_Z);
    float ref = 0.f, ref2 = 0.f;
    for (int c = 0; c < 128; ++c) {
        ref += bfv(yp, (size_t)tok * 512 + gi * 128 + c) * bfv(pw, (size_t)gi * 16384 + d * 128 + c);
        ref2 += bfv(yp, (size_t)tok * 512 + gi * 128 + c) * p.in[9][(size_t)gi * 16384 + c * 128 + d];
    }
    if (!(fabsf(ref - ref2) <= 0.03f)) dfail(p, bit);
    ref *= p.in[10][col];
    if (bad(bfv((const bf16_t*)(ws + WS_MIXIN), (size_t)tok * 1024 + 512 + col), ref)) dfail(p, bit);
    const int win = 2 << (col >> 7), cnt = (t + 1 < win) ? t + 1 : win;
    float s = 0.f;
    for (int k = 0; k < cnt; ++k) s += bfv(z, (size_t)(tok - k) * 512 + col);
    if (bad(bfv(yp, (size_t)tok * 512 + col), s / (float)cnt - bfv(z, (size_t)tok * 512 + col))) dfail(p, bit);
}
DI void chk6(const Params& p, int bit) {
    unsigned char* ws = p.ws;
    const unsigned gt = blockIdx.x * NTHREADS + threadIdx.x;
    if (gt >= 128) return;
    const int tok = hsh(gt + 17) & 16383;
    float* yb = (float*)(ws + WS_DSCR) + (size_t)gt * 1024;
    const bf16_t* mx = (const bf16_t*)(ws + WS_MIXIN) + (size_t)tok * 1024;
    const bf16_t* wo = (const bf16_t*)(ws + WS_WOUTT);
    float sm = 0.f;
    bool f = false;
    for (int n = 0; n < 1024; ++n) {
        float s = 0.f, s2 = 0.f;
        for (int k = 0; k < 1024; ++k) { s += bfv(mx, k) * bfv(wo, (size_t)n * 1024 + k); if (n < 8) s2 += bfv(mx, k) * p.in[11][(size_t)k * 1024 + n]; }
        if (n < 8 && !(fabsf(s - s2) <= 0.03f)) f = true;
        yb[n] = ALPHA * p.in[0][(size_t)tok * 1024 + n] + s; sm += yb[n];
    }
    const float mean = sm / 1024.f;
    float v = 0.f;
    for (int n = 0; n < 1024; ++n) v += (yb[n] - mean) * (yb[n] - mean);
    const float rstd = 1.f / sqrtf(v / 1024.f + LN_EPS);
    for (int n = 0; n < 1024; ++n)
        f |= bad(bfv((const bf16_t*)(ws + WS_H1), (size_t)tok * 1024 + n), (yb[n] - mean) * rstd * p.in[12][n] + p.in[13][n]);
    if (f) dfail(p, bit);
}
DI void chk7(const Params& p, int bit) {
    unsigned char* ws = p.ws;
    const unsigned gt = blockIdx.x * NTHREADS + threadIdx.x;
    if (gt >= 512) return;
    const int tok = hsh(gt + 23) & 16383, head = gt & 7, half = (gt >> 3) & 1;
    float* qd = (float*)(ws + WS_DSCR) + (size_t)gt * 256;
    float* sv = qd + 128;
    const bf16_t* h1 = (const bf16_t*)(ws + WS_H1) + (size_t)tok * 1024;
    const bf16_t* wq = (const bf16_t*)(ws + WS_WQT);
    const bf16_t* sk = (const bf16_t*)(ws + WS_SUBK);
    bool f = false;
    for (int d = 0; d < 128; ++d) {
        float s = 0.f, s2 = 0.f;
        const int col = head * 256 + half * 128 + d;
        for (int k = 0; k < 1024; ++k) { s += bfv(h1, k) * bfv(wq, (size_t)col * 1024 + k); if (d < 4) s2 += bfv(h1, k) * p.in[14][(size_t)k * 2048 + col]; }
        if (d < 4 && !(fabsf(s - s2) <= 0.06f)) f = true;
        qd[d] = bfr(s);
    }
    for (int key = 0; key < 128; ++key) {
        float s = 0.f, s2 = 0.f;
        for (int d = 0; d < 128; ++d) { s += qd[d] * bfv(sk, (size_t)(half * 128 + key) * 128 + d); s2 += qd[d] * p.in[15][(size_t)(half * 128 + key) * 128 + d]; }
        if (!(fabsf(s - s2) <= 0.05f)) f = true;
        sv[key] = s;
    }
    int mism = 0;
    const int* L = (const int*)(ws + WS_TOPK) + (((size_t)tok * 8 + head) * 2 + half) * 16;
    for (int it = 0; it < 16; ++it) {
        int bi = 0; float bv = -3e38f;
        for (int k = 0; k < 128; ++k) if (sv[k] > bv) { bv = sv[k]; bi = k; }
        sv[bi] = -3e38f;
        const int fk = L[it];
        if ((fk & 127) != bi) mism++;
        if (bad(key_val(fk), bv)) mism += 10;
    }
    if (mism > 1 || f) dfail(p, bit);
}
DI void chk8(const Params& p, int bit) {
    unsigned char* ws = p.ws;
    const unsigned gt = blockIdx.x * NTHREADS + threadIdx.x;
    if (gt >= 128) return;
    const int tok = hsh(gt + 31) & 16383;
    float* acc = (float*)(ws + WS_DSCR) + (size_t)gt * 4096;
    float* cand = acc + 1024;
    int* csel = (int*)(acc + 1024 + 256);
    float* acc2 = acc + 2048;
    const bf16_t* h1 = (const bf16_t*)(ws + WS_H1) + (size_t)tok * 1024;
    const bf16_t* ub = (const bf16_t*)(ws + WS_UB);
    const bf16_t* vb = (const bf16_t*)(ws + WS_VB);
    const int* dE = (const int*)(ws + WS_MIXIN) + (size_t)tok * 256;
    const float* dG = (const float*)dE + 128;
    bool f = false, froute = false, fg = false;
    for (int n = 0; n < 1024; ++n) { acc[n] = 0.f; acc2[n] = 0.f; }
    for (int hd = 0; hd < 8; ++hd) {
        const int* L = (const int*)(ws + WS_TOPK) + (size_t)tok * 256 + hd * 32;
        for (int i = 0; i < 16; ++i) for (int j = 0; j < 16; ++j) cand[i * 16 + j] = key_val(L[i]) + key_val(L[16 + j]);
        float mx = -3e38f, den = 0.f;
        for (int it = 0; it < 16; ++it) {
            int bi = 0; float bv = -3e38f;
            for (int k = 0; k < 256; ++k) if (cand[k] > bv) { bv = cand[k]; bi = k; }
            cand[bi] = -3e38f; csel[it] = bi;
            if (it == 0) mx = bv;
            ((float*)csel)[16 + it] = expf(bv - mx); den += expf(bv - mx);
        }
        for (int it = 0; it < 16; ++it) {
            const int i = csel[it] >> 4, j = csel[it] & 15;
            const size_t e = (size_t)(L[i] & 127) * 128 + (L[16 + j] & 127);
            float dot = 0.f;
            for (int k = 0; k < 1024; ++k) dot += bfv(h1, k) * bfv(ub, e * 1024 + k);
            const float gate = ((float*)csel)[16 + it] / den;
            const float w = gate * gelu_erf(dot);
            for (int n = 0; n < 1024; ++n) acc[n] += w * bfv(vb, e * 1024 + n);
            bool found = false;
            for (int s = 0; s < 16; ++s) if (dE[hd * 16 + s] == (int)e) { found = true; if (!(fabsf(dG[hd * 16 + s] - gate) <= 1e-3f)) fg = true; }
            if (!found) froute = true;
        }
        for (int s = 0; s < 16; ++s) {
            const size_t e = (size_t)dE[hd * 16 + s];
            if (e >= 16384) { froute = true; continue; }
            float dot = 0.f;
            for (int k = 0; k < 1024; ++k) dot += bfv(h1, k) * bfv(ub, e * 1024 + k);
            const float w = dG[hd * 16 + s] * gelu_erf(dot);
            for (int n = 0; n < 1024; ++n) acc2[n] += w * bfv(vb, e * 1024 + n);
        }
    }
    bool f2 = false;
    for (int pass = 0; pass < 2; ++pass) {
        float* a = pass ? acc2 : acc;
        float sm = 0.f;
        for (int n = 0; n < 1024; ++n) { a[n] += ALPHA * bfv(h1, n); sm += a[n]; }
        const float mean = sm / 1024.f;
        float v = 0.f;
        for (int n = 0; n < 1024; ++n) v += (a[n] - mean) * (a[n] - mean);
        const float rstd = 1.f / sqrtf(v / 1024.f + LN_EPS);
        for (int n = 0; n < 1024; ++n) {
            const bool b = bad(p.out[(size_t)tok * 1024 + n], (a[n] - mean) * rstd * p.in[18][n] + p.in[19][n]);
            if (pass) f2 |= b; else f |= b;
        }
    }
    if (f) dfail(p, bit);
    if (froute) dfail(p, bit + 1);
    if (fg) dfail(p, bit + 2);
    if (f2) dfail(p, bit + 3);
}
#endif

__global__ void __launch_bounds__(NTHREADS, 2) hybrid_fwd(Params p) {
    extern __shared__ __attribute__((aligned(16))) unsigned char lds[];
    cg::grid_group grid = cg::this_grid();
    const int lo = p.ph_lo, hi = p.ph_hi;
    volatile unsigned* bst = (volatile unsigned*)(lds + LDS_MAIN);
    if (threadIdx.x < 2) bst[threadIdx.x] = 0u;
    __syncthreads();
    XcdBarrier xbar = xcd_barrier_post((unsigned*)(p.ws + WS_BAR), bst);
#define IN(k) (lo <= (k) && (k) < hi)
#define SEAM(k) do { if (IN(k) && IN((k) + 1 + ((k) == 4))) xcd_barrier(xbar); } while (0)
    if (lo < 0) grid.sync();
#if DIAG
    if (blockIdx.x == 0 && threadIdx.x == 0) *(unsigned*)(p.ws + WS_FLAG) = 0u;
#endif
    if (IN(0)) phase0(p, lds);
    SEAM(0);
    if (IN(1)) phase1(p, lds);
    SEAM(1);
#if DIAG == 1
    chk1(p, 0);
#endif
    if (IN(2)) phase2(p, lds);
    SEAM(2);
#if DIAG == 1
    chk2(p, 1); chk3(p, 2);
#endif
    if (IN(3)) phase3(p, lds);
    SEAM(3);
#if DIAG == 1
    chk4(p, 3); chk5(p, 4);
#endif
    if (IN(4)) phase4(p, lds);
    SEAM(4);
#if DIAG == 1
    chk6(p, 5);
#endif
    if (IN(6)) phase6(p, lds);
    SEAM(6);
#if DIAG == 2
    chk7(p, 0);
#endif
    if (IN(7)) phase7(p, lds);
#if DIAG
    grid.sync();
#if DIAG == 2
    chk8(p, 1);
    grid.sync();
#endif
    {
        const unsigned code = *(volatile unsigned*)(p.ws + WS_FLAG);
        const float kv = sqrtf((float)code);
        for (size_t i = (size_t)blockIdx.x * NTHREADS + threadIdx.x; i < (size_t)NTOK * DM; i += (size_t)gridDim.x * NTHREADS) p.out[i] = kv;
    }
#endif
#undef IN
#undef SEAM
}

extern "C" void kernel_launch(void* const* d_in, const int* in_sizes, int n_in, void* d_out, int out_size, void* d_ws, size_t ws_size,
                              hipStream_t stream) {
    static int grid_blocks = 0;
    if (grid_blocks == 0) {
        if (n_in != 20 || ws_size < WS_END) { fprintf(stderr, "kernel_launch: unexpected inputs (n_in %d, ws %zu)\n", n_in, ws_size); grid_blocks = -1; return; }
        int dev = 0, cus = 0, per_cu = 0;
        hipGetDevice(&dev);
        hipDeviceGetAttribute(&cus, hipDeviceAttributeMultiprocessorCount, dev);
        hipFuncSetAttribute((const void*)hybrid_fwd, hipFuncAttributeMaxDynamicSharedMemorySize, LDS_BYTES);
        hipOccupancyMaxActiveBlocksPerMultiprocessor(&per_cu, (const void*)hybrid_fwd, NTHREADS, LDS_BYTES);
        if (per_cu < 1) per_cu = 1;
        if (per_cu > 2) per_cu = 2;
        grid_blocks = cus * per_cu;
        (void)hipGetLastError();
    }
    if (grid_blocks < 0) return;
    (void)hipMemsetAsync((char*)d_ws + WS_BAR, 0, WS_BAR_BYTES, stream);
    Params p{};
    for (int i = 0; i < 20; ++i) p.in[i] = (const float*)d_in[i];
    p.out = (float*)d_out; p.ws = (unsigned char*)d_ws;
#if N_LAUNCH_MODE == 1
    p.ph_lo = 0; p.ph_hi = 8;
    void* args[] = {&p};
    hipError_t e = hipLaunchCooperativeKernel((const void*)hybrid_fwd, dim3(grid_blocks), dim3(NTHREADS), args, LDS_BYTES, stream);
    if (e != hipSuccess) fprintf(stderr, "cooperative launch failed: %s (grid %d)\n", hipGetErrorString(e), grid_blocks);
#else
    for (int ph = 0; ph < 8; ++ph) {
        p.ph_lo = ph; p.ph_hi = ph + 1;
        hipLaunchKernelGGL(hybrid_fwd, dim3(grid_blocks), dim3(NTHREADS), LDS_BYTES, stream, p);
    }
#endif
}
```
